# Optimizing an MI355X kernel written in HIP

```python
import jax, jax.numpy as jnp
from jax import lax
import numpy as np

D_MODEL = 1024
BATCH = 8
SEQ = 4096
DEPTH = 2

N_EVEN = (DEPTH + 1) // 2
N_ODD = DEPTH // 2
D_A = D_MODEL // 2
CONV_WIDTH = 31
CONV_PAD = CONV_WIDTH // 2
N_POOL = 4
POOL_WINDOWS = (2, 4, 8, 16)
D_B = D_MODEL // 2
G_POOL = D_B // N_POOL
N_FOURIER = 4
D_C = D_MODEL // 2
H_C = D_C // N_FOURIER
N_SGU = 4
D_D = D_MODEL // 2
H_D = D_D // N_SGU
CHUNK = 128
D_IN_EVEN = 2 * D_A + D_B
D_IN_ODD = D_C + 2 * D_D
D_MIX = D_A + D_B
D_FF = ((8 * D_MODEL // 3 + 255) // 256) * 256
EPS = 1e-6

kernel_name = "hybrid_conv_pool_fourier_sgu_encoder"


def rmsnorm(x, g):
    xf = x.astype(jnp.float32)
    y = xf * lax.rsqrt(jnp.mean(xf * xf, axis=-1, keepdims=True) + EPS)
    return (y * g.astype(jnp.float32)).astype(x.dtype)


def layernorm(x, g, b):
    xf = x.astype(jnp.float32)
    mu = jnp.mean(xf, axis=-1, keepdims=True)
    var = jnp.mean(jnp.square(xf - mu), axis=-1, keepdims=True)
    y = (xf - mu) * lax.rsqrt(var + EPS)
    return (y * g.astype(jnp.float32) + b.astype(jnp.float32)).astype(x.dtype)


def conformer_conv(a, gate, conv_w, conv_b, ln_g, ln_b):
    u = a * jax.nn.sigmoid(gate)
    u = lax.conv_general_dilated(
        u, conv_w[:, None, :].astype(u.dtype), window_strides=(1,),
        padding=[(CONV_PAD, CONV_PAD)], dimension_numbers=('NWC', 'WIO', 'NWC'),
        feature_group_count=D_A) + conv_b
    return jax.nn.silu(layernorm(u, ln_g, ln_b))


def multiscale_pool(p, pool_w, pool_scale):
    bn, s, _ = p.shape
    y = p.reshape(bn, s, N_POOL, G_POOL).astype(jnp.float32)
    cs = jnp.concatenate([jnp.zeros((bn, 1, N_POOL, G_POOL), jnp.float32),
                          jnp.cumsum(y, axis=1)], axis=1)
    t = jnp.arange(s)[:, None]
    half = jnp.array(POOL_WINDOWS, dtype=jnp.int32)[None, :] // 2
    lo = jnp.clip(t - half, 0, s - 1)
    hi = jnp.clip(t + half - 1, 0, s - 1)
    gi = jnp.arange(N_POOL)[None, :]
    win_sum = cs[:, hi + 1, gi] - cs[:, lo, gi]
    count = (hi - lo + 1).astype(jnp.float32)[..., None]
    pooled = (win_sum / count - y).astype(p.dtype)
    mixed = jnp.einsum('bsgc,gcd->bsgd', pooled, pool_w) * pool_scale
    return mixed.reshape(bn, s, D_B)


def even_mixer(h, w_in, conv_w, conv_b, ln_g, ln_b, pool_w, pool_scale, w_out):
    z = h @ w_in
    a, gate, p = z[..., :D_A], z[..., D_A:2 * D_A], z[..., 2 * D_A:]
    ya = conformer_conv(a, gate, conv_w, conv_b, ln_g, ln_b)
    yb = multiscale_pool(p, pool_w, pool_scale)
    return jnp.concatenate([ya, yb], axis=-1) @ w_out


def fourier_mix(c, fourier_w):
    bn, s, _ = c.shape
    cf = c.reshape(bn, s, N_FOURIER, H_C).astype(jnp.float32)
    yc = jnp.fft.fft2(cf, axes=(1, 3), norm='ortho').real.astype(c.dtype)
    return jnp.einsum('bshc,hcd->bshd', yc, fourier_w).reshape(bn, s, D_C)


def spatial_gating(u, v, v_ln_g, v_ln_b, spatial_w, spatial_b):
    bn, s, _ = v.shape
    vn = layernorm(v.reshape(bn, s, N_SGU, H_D), v_ln_g, v_ln_b)
    vn = vn.reshape(bn, s // CHUNK, CHUNK, N_SGU, H_D)
    sv = jnp.einsum('hqk,bnkhc->bnqhc', spatial_w, vn) + spatial_b.T[:, :, None]
    return u * sv.reshape(bn, s, D_D)


def odd_mixer(h, w_in, fourier_w, v_ln_g, v_ln_b, spatial_w, spatial_b, w_out):
    z = h @ w_in
    c = z[..., :D_C]
    uv = jax.nn.gelu(z[..., D_C:], approximate=False)
    u, v = uv[..., :D_D], uv[..., D_D:]
    yc = fourier_mix(c, fourier_w)
    yd = spatial_gating(u, v, v_ln_g, v_ln_b, spatial_w, spatial_b)
    return jnp.concatenate([yc, yd], axis=-1) @ w_out


def swiglu(h, w_gate, w_up, w_down):
    return (jax.nn.silu(h @ w_gate) * (h @ w_up)) @ w_down


def setup_inputs(seed: int = 0) -> dict:
    key = jax.random.key(seed)
    ks = jax.random.split(key, 24)
    f32 = jnp.float32
    nrm = lambda k, shape, scale: jax.random.normal(k, shape, f32) * scale
    return {
        'x': jax.random.normal(ks[0], (BATCH, SEQ, D_MODEL), f32),
        'mix_norm_g': 1.0 + nrm(ks[1], (DEPTH, D_MODEL), 0.02),
        'ffn_norm_g': 1.0 + nrm(ks[2], (DEPTH, D_MODEL), 0.02),
        'ev_w_in': nrm(ks[3], (N_EVEN, D_MODEL, D_IN_EVEN), D_MODEL ** -0.5),
        'ev_conv_w': nrm(ks[4], (N_EVEN, CONV_WIDTH, D_A), CONV_WIDTH ** -0.5),
        'ev_conv_b': nrm(ks[5], (N_EVEN, D_A), 0.02),
        'ev_ln_g': 1.0 + nrm(ks[6], (N_EVEN, D_A), 0.02),
        'ev_ln_b': nrm(ks[7], (N_EVEN, D_A), 0.02),
        'ev_pool_w': nrm(ks[8], (N_EVEN, N_POOL, G_POOL, G_POOL), G_POOL ** -0.5),
        'ev_pool_scale': 1.0 + nrm(ks[9], (N_EVEN, N_POOL, G_POOL), 0.02),
        'ev_w_out': nrm(ks[10], (N_EVEN, D_MIX, D_MODEL), D_MIX ** -0.5),
        'od_w_in': nrm(ks[11], (N_ODD, D_MODEL, D_IN_ODD), D_MODEL ** -0.5),
        'od_fourier_w': nrm(ks[12], (N_ODD, N_FOURIER, H_C, H_C), H_C ** -0.5),
        'od_v_ln_g': 1.0 + nrm(ks[13], (N_ODD, N_SGU, H_D), 0.02),
        'od_v_ln_b': nrm(ks[14], (N_ODD, N_SGU, H_D), 0.02),
        'od_spatial_w': nrm(ks[15], (N_ODD, N_SGU, CHUNK, CHUNK), CHUNK ** -0.5),
        'od_spatial_b': 1.0 + nrm(ks[16], (N_ODD, N_SGU, CHUNK), 0.02),
        'od_w_out': nrm(ks[17], (N_ODD, D_MIX, D_MODEL), D_MIX ** -0.5),
        'ffn_w_gate': nrm(ks[18], (DEPTH, D_MODEL, D_FF), D_MODEL ** -0.5),
        'ffn_w_up': nrm(ks[19], (DEPTH, D_MODEL, D_FF), D_MODEL ** -0.5),
        'ffn_w_down': nrm(ks[20], (DEPTH, D_FF, D_MODEL), D_FF ** -0.5),
        'final_norm_g': 1.0 + nrm(ks[21], (D_MODEL,), 0.02),
    }


def reference(x, mix_norm_g, ffn_norm_g, ev_w_in, ev_conv_w, ev_conv_b, ev_ln_g,
              ev_ln_b, ev_pool_w, ev_pool_scale, ev_w_out, od_w_in, od_fourier_w,
              od_v_ln_g, od_v_ln_b, od_spatial_w, od_spatial_b, od_w_out,
              ffn_w_gate, ffn_w_up, ffn_w_down, final_norm_g):
    for l in range(DEPTH):
        h = rmsnorm(x, mix_norm_g[l])
        if l % 2 == 0:
            i = l // 2
            x = x + even_mixer(h, ev_w_in[i], ev_conv_w[i], ev_conv_b[i], ev_ln_g[i],
                               ev_ln_b[i], ev_pool_w[i], ev_pool_scale[i], ev_w_out[i])
        else:
            i = l // 2
            x = x + odd_mixer(h, od_w_in[i], od_fourier_w[i], od_v_ln_g[i], od_v_ln_b[i],
                              od_spatial_w[i], od_spatial_b[i], od_w_out[i])
        h = rmsnorm(x, ffn_norm_g[l])
        x = x + swiglu(h, ffn_w_gate[l], ffn_w_up[l], ffn_w_down[l])
    return rmsnorm(x, final_norm_g)
```

```cpp
#include <hip/hip_runtime.h>
#include <math.h>

#define D_MODEL 1024
#define BATCH 8
#define SEQ 4096
#define D_A 512
#define D_B 512
#define D_C 512
#define D_D 512
#define D_FF 2816
#define D_IN 1536
#define CONV_W 31
#define EPS 1e-6f

__device__ __forceinline__ float block_sum(float v, float* red) {
    for (int o = 32; o >= 1; o >>= 1) v += __shfl_xor(v, o);
    const int w = threadIdx.x >> 6, nw = blockDim.x >> 6;
    __syncthreads();
    if ((threadIdx.x & 63) == 0) red[w] = v;
    __syncthreads();
    float s = 0.f;
    for (int i = 0; i < nw; ++i) s += red[i];
    return s;
}

__global__ void k_rmsnorm(const float* __restrict__ x, const float* __restrict__ g, float* __restrict__ y) {
    __shared__ float red[16];
    const size_t row = blockIdx.x;
    const float* xr = x + row * D_MODEL;
    float v[4]; float s = 0.f;
    for (int j = 0; j < 4; ++j) { v[j] = xr[threadIdx.x + 256 * j]; s += v[j] * v[j]; }
    s = block_sum(s, red);
    const float r = rsqrtf(s / D_MODEL + EPS);
    for (int j = 0; j < 4; ++j) y[row * D_MODEL + threadIdx.x + 256 * j] = v[j] * r * g[threadIdx.x + 256 * j];
}

__global__ void __launch_bounds__(256) k_sgemm(const float* __restrict__ A, int lda, const float* __restrict__ B, int ldb, float* __restrict__ C, int ldc,
                                               const float* __restrict__ R, int ldr, int K) {
    __shared__ float As[16][132];
    __shared__ float Bs[16][132];
    const int t = threadIdx.x, tx = t & 15, ty = t >> 4;
    const int bm = blockIdx.y * 128, bn = blockIdx.x * 128;
    float acc[8][8];
#pragma unroll
    for (int i = 0; i < 8; ++i)
#pragma unroll
        for (int j = 0; j < 8; ++j) acc[i][j] = 0.f;
    for (int k0 = 0; k0 < K; k0 += 16) {
#pragma unroll
        for (int i = 0; i < 2; ++i) {
            const int row = (t >> 2) + 64 * i, kq = t & 3;
            const float4 a = *(const float4*)(A + (size_t)(bm + row) * lda + k0 + kq * 4);
            As[kq * 4 + 0][row] = a.x; As[kq * 4 + 1][row] = a.y; As[kq * 4 + 2][row] = a.z; As[kq * 4 + 3][row] = a.w;
            const int kr = (t >> 5) + 8 * i, n4 = t & 31;
            const float4 b = *(const float4*)(B + (size_t)(k0 + kr) * ldb + bn + n4 * 4);
            *(float4*)&Bs[kr][n4 * 4] = b;
        }
        __syncthreads();
#pragma unroll
        for (int kk = 0; kk < 16; ++kk) {
            float a[8], b[8];
            *(float4*)&a[0] = *(const float4*)&As[kk][ty * 8]; *(float4*)&a[4] = *(const float4*)&As[kk][ty * 8 + 4];
            *(float4*)&b[0] = *(const float4*)&Bs[kk][tx * 8]; *(float4*)&b[4] = *(const float4*)&Bs[kk][tx * 8 + 4];
#pragma unroll
            for (int i = 0; i < 8; ++i)
#pragma unroll
                for (int j = 0; j < 8; ++j) acc[i][j] = fmaf(a[i], b[j], acc[i][j]);
        }
        __syncthreads();
    }
#pragma unroll
    for (int i = 0; i < 8; ++i) {
        const size_t r = (size_t)(bm + ty * 8 + i);
#pragma unroll
        for (int j = 0; j < 8; ++j) {
            const int c = bn + tx * 8 + j;
            float v = acc[i][j];
            if (R) v += R[r * ldr + c];
            C[r * ldc + c] = v;
        }
    }
}

__global__ void k_glu(const float* __restrict__ z, float* __restrict__ u) {
    const size_t i = (size_t)blockIdx.x * blockDim.x + threadIdx.x;
    const size_t r = i / D_A; const int c = (int)(i % D_A);
    const float a = z[r * D_IN + c], gt = z[r * D_IN + D_A + c];
    u[i] = a / (1.f + expf(-gt));
}
__global__ void k_conv_ln_silu(const float* __restrict__ u, const float* __restrict__ cw, const float* __restrict__ cb, const float* __restrict__ lg, const float* __restrict__ lb, float* __restrict__ am) {
    __shared__ float red[16];
    const int t = blockIdx.x, c = threadIdx.x;
    float s = cb[c];
    for (int j = 0; j < CONV_W; ++j) { const int tt = t + j - 15; if (tt >= 0 && tt < SEQ) s = fmaf(cw[j * D_A + c], u[(size_t)tt * D_A + c], s); }
    const float mu = block_sum(s, red) / D_A;
    const float d = s - mu;
    const float var = block_sum(d * d, red) / D_A;
    const float y = d * rsqrtf(var + EPS) * lg[c] + lb[c];
    am[(size_t)t * D_MODEL + c] = y / (1.f + expf(-y));
}
__global__ void k_pool(const float* __restrict__ z, const float* __restrict__ pw, const float* __restrict__ ps, float* __restrict__ am) {
    __shared__ float pl[512];
    const int t = blockIdx.x, c = threadIdx.x, g = c >> 7;
    const int half = 1 << g;
    int lo = t - half; if (lo < 0) lo = 0; if (lo > SEQ - 1) lo = SEQ - 1;
    int hi = t + half - 1; if (hi < 0) hi = 0; if (hi > SEQ - 1) hi = SEQ - 1;
    float s = 0.f;
    for (int tt = lo; tt <= hi; ++tt) s += z[(size_t)tt * D_IN + 2 * D_A + c];
    pl[c] = s / (float)(hi - lo + 1) - z[(size_t)t * D_IN + 2 * D_A + c];
    __syncthreads();
    const int d = c & 127;
    float acc = 0.f;
    for (int k = 0; k < 128; ++k) acc = fmaf(pl[g * 128 + k], pw[(size_t)(g * 128 + k) * 128 + d], acc);
    am[(size_t)t * D_MODEL + D_A + c] = acc * ps[c];
}

__global__ void k_swiglu(float* __restrict__ gate, const float* __restrict__ up, size_t n) {
    const size_t i = (size_t)blockIdx.x * blockDim.x + threadIdx.x;
    if (i < n) { const float g = gate[i]; gate[i] = g / (1.f + expf(-g)) * up[i]; }
}

__global__ void k_chan_dft_gelu(float* __restrict__ z, float* __restrict__ pq) {
    __shared__ float cr[512];
    const int t = blockIdx.x, c = threadIdx.x, h = c >> 7, cc = c & 127;
    cr[c] = z[(size_t)t * D_IN + c];
    __syncthreads();
    float p = 0.f, q = 0.f;
    for (int k = 0; k < 128; ++k) {
        const int ph = (k * cc) & 127;
        float sn, cs; sincospif((float)ph * (2.0f / 128.0f), &sn, &cs);
        const float v = cr[h * 128 + k];
        p = fmaf(v, cs, p); q = fmaf(v, sn, q);
    }
    pq[(size_t)t * D_C + c] = p;
    pq[(size_t)(SEQ + t) * D_C + c] = q;
    for (int j = 0; j < 2; ++j) { const size_t idx = (size_t)t * D_IN + D_C + c + 512 * j; const float v = z[idx]; z[idx] = 0.5f * v * (1.f + erff(v * 0.70710678118654752440f)); }
}
__global__ void k_dft_matrix(float* __restrict__ Dm) {
    const size_t i = (size_t)blockIdx.x * blockDim.x + threadIdx.x;
    const int sp = (int)(i / SEQ), s = (int)(i % SEQ);
    const int ph = (int)(((long long)sp * s) & (SEQ - 1));
    float sn, cs; sincospif((float)ph * (2.0f / (float)SEQ), &sn, &cs);
    Dm[(size_t)sp * (2 * SEQ) + s] = cs;
    Dm[(size_t)sp * (2 * SEQ) + SEQ + s] = -sn;
}
__global__ void k_fourier_w(const float* __restrict__ ycraw, const float* __restrict__ fw, float* __restrict__ am) {
    __shared__ float yr[512];
    const int t = blockIdx.x, c = threadIdx.x, h = c >> 7, d = c & 127;
    yr[c] = ycraw[(size_t)t * D_C + c] * (1.0f / 724.0773439350247f);
    __syncthreads();
    float acc = 0.f;
    for (int k = 0; k < 128; ++k) acc = fmaf(yr[h * 128 + k], fw[(size_t)(h * 128 + k) * 128 + d], acc);
    am[(size_t)t * D_MODEL + c] = acc;
}
__global__ void k_vln(const float* __restrict__ z, const float* __restrict__ g, const float* __restrict__ b, float* __restrict__ vn) {
    const int t = blockIdx.x, c = threadIdx.x;
    const float v = z[(size_t)t * D_IN + D_C + D_D + c];
    float s = v;
    for (int o = 32; o >= 1; o >>= 1) s += __shfl_xor(s, o);
    __shared__ float red[8], red2[8];
    if ((c & 63) == 0) red[c >> 6] = s;
    __syncthreads();
    const int h = c >> 7;
    const float mu = (red[2 * h] + red[2 * h + 1]) / 128.f;
    const float d = v - mu;
    float q = d * d;
    for (int o = 32; o >= 1; o >>= 1) q += __shfl_xor(q, o);
    if ((c & 63) == 0) red2[c >> 6] = q;
    __syncthreads();
    const float var = (red2[2 * h] + red2[2 * h + 1]) / 128.f;
    vn[(size_t)t * D_D + c] = d * rsqrtf(var + EPS) * g[c] + b[c];
}
__global__ void k_sgu(const float* __restrict__ z, const float* __restrict__ vn, const float* __restrict__ sw, const float* __restrict__ sb, float* __restrict__ am) {
    const int t = blockIdx.x, c = threadIdx.x, h = c >> 7, n = t >> 7, q = t & 127;
    float acc = 0.f;
    for (int k = 0; k < 128; ++k) acc = fmaf(sw[(size_t)(h * 128 + q) * 128 + k], vn[(size_t)(n * 128 + k) * D_D + c], acc);
    acc += sb[h * 128 + q];
    am[(size_t)t * D_MODEL + D_C + c] = z[(size_t)t * D_IN + D_C + c] * acc;
}

static void sgemm(hipStream_t st, const float* A, int lda, const float* B, int ldb, float* C, int ldc, const float* R, int ldr, int M, int N, int K) {
    hipLaunchKernelGGL(k_sgemm, dim3(N / 128, M / 128), dim3(256), 0, st, A, lda, B, ldb, C, ldc, R, ldr, K);
}

extern "C" void kernel_launch(void* const* d_in, const int* in_sizes, int n_in, void* d_out, int out_size, void* d_ws, size_t ws_size, hipStream_t stream) {
    const float* x = (const float*)d_in[0];
    const float* mix_norm_g = (const float*)d_in[1];
    const float* ffn_norm_g = (const float*)d_in[2];
    const float* ev_w_in = (const float*)d_in[3];
    const float* ev_conv_w = (const float*)d_in[4];
    const float* ev_conv_b = (const float*)d_in[5];
    const float* ev_ln_g = (const float*)d_in[6];
    const float* ev_ln_b = (const float*)d_in[7];
    const float* ev_pool_w = (const float*)d_in[8];
    const float* ev_pool_scale = (const float*)d_in[9];
    const float* ev_w_out = (const float*)d_in[10];
    const float* od_w_in = (const float*)d_in[11];
    const float* od_fourier_w = (const float*)d_in[12];
    const float* od_v_ln_g = (const float*)d_in[13];
    const float* od_v_ln_b = (const float*)d_in[14];
    const float* od_spatial_w = (const float*)d_in[15];
    const float* od_spatial_b = (const float*)d_in[16];
    const float* od_w_out = (const float*)d_in[17];
    const float* ffn_w_gate = (const float*)d_in[18];
    const float* ffn_w_up = (const float*)d_in[19];
    const float* ffn_w_down = (const float*)d_in[20];
    const float* final_norm_g = (const float*)d_in[21];
    float* out = (float*)d_out;

    const size_t S = SEQ;
    float* w = (float*)d_ws;
    float* Dm = w;              w += S * 2 * S;
    float* xa = w;              w += S * D_MODEL;
    float* xb = w;              w += S * D_MODEL;
    float* hn = w;              w += S * D_MODEL;
    float* z = w;               w += S * D_IN;
    float* am = w;              w += S * D_MODEL;
    float* u = w;               w += S * D_A;
    float* gate = w;            w += S * D_FF;
    float* up = w;              w += S * D_FF;
    float* pq = w;              w += 2 * S * D_C;
    float* ycraw = w;           w += S * D_C;
    float* vn = w;              w += S * D_D;

    hipLaunchKernelGGL(k_dft_matrix, dim3((unsigned)(S * S / 256)), dim3(256), 0, stream, Dm);
    for (int b = 0; b < BATCH; ++b) {
        const float* x0 = x + (size_t)b * S * D_MODEL;
        hipLaunchKernelGGL(k_rmsnorm, dim3(SEQ), dim3(256), 0, stream, x0, mix_norm_g, hn);
        sgemm(stream, hn, D_MODEL, ev_w_in, D_IN, z, D_IN, nullptr, 0, SEQ, D_IN, D_MODEL);
        hipLaunchKernelGGL(k_glu, dim3((unsigned)(S * D_A / 256)), dim3(256), 0, stream, z, u);
        hipLaunchKernelGGL(k_conv_ln_silu, dim3(SEQ), dim3(512), 0, stream, u, ev_conv_w, ev_conv_b, ev_ln_g, ev_ln_b, am);
        hipLaunchKernelGGL(k_pool, dim3(SEQ), dim3(512), 0, stream, z, ev_pool_w, ev_pool_scale, am);
        sgemm(stream, am, D_MODEL, ev_w_out, D_MODEL, xa, D_MODEL, x0, D_MODEL, SEQ, D_MODEL, D_MODEL);
        hipLaunchKernelGGL(k_rmsnorm, dim3(SEQ), dim3(256), 0, stream, xa, ffn_norm_g, hn);
        sgemm(stream, hn, D_MODEL, ffn_w_gate, D_FF, gate, D_FF, nullptr, 0, SEQ, D_FF, D_MODEL);
        sgemm(stream, hn, D_MODEL, ffn_w_up, D_FF, up, D_FF, nullptr, 0, SEQ, D_FF, D_MODEL);
        hipLaunchKernelGGL(k_swiglu, dim3((unsigned)(S * D_FF / 256)), dim3(256), 0, stream, gate, up, S * D_FF);
        sgemm(stream, gate, D_FF, ffn_w_down, D_MODEL, xb, D_MODEL, xa, D_MODEL, SEQ, D_MODEL, D_FF);
        hipLaunchKernelGGL(k_rmsnorm, dim3(SEQ), dim3(256), 0, stream, xb, mix_norm_g + D_MODEL, hn);
        sgemm(stream, hn, D_MODEL, od_w_in, D_IN, z, D_IN, nullptr, 0, SEQ, D_IN, D_MODEL);
        hipLaunchKernelGGL(k_chan_dft_gelu, dim3(SEQ), dim3(512), 0, stream, z, pq);
        sgemm(stream, Dm, 2 * SEQ, pq, D_C, ycraw, D_C, nullptr, 0, SEQ, D_C, 2 * SEQ);
        hipLaunchKernelGGL(k_fourier_w, dim3(SEQ), dim3(512), 0, stream, ycraw, od_fourier_w, am);
        hipLaunchKernelGGL(k_vln, dim3(SEQ), dim3(512), 0, stream, z, od_v_ln_g, od_v_ln_b, vn);
        hipLaunchKernelGGL(k_sgu, dim3(SEQ), dim3(512), 0, stream, z, vn, od_spatial_w, od_spatial_b, am);
        sgemm(stream, am, D_MODEL, od_w_out, D_MODEL, xa, D_MODEL, xb, D_MODEL, SEQ, D_MODEL, D_MODEL);
        hipLaunchKernelGGL(k_rmsnorm, dim3(SEQ), dim3(256), 0, stream, xa, ffn_norm_g + D_MODEL, hn);
        sgemm(stream, hn, D_MODEL, ffn_w_gate + (size_t)D_MODEL * D_FF, D_FF, gate, D_FF, nullptr, 0, SEQ, D_FF, D_MODEL);
        sgemm(stream, hn, D_MODEL, ffn_w_up + (size_t)D_MODEL * D_FF, D_FF, up, D_FF, nullptr, 0, SEQ, D_FF, D_MODEL);
        hipLaunchKernelGGL(k_swiglu, dim3((unsigned)(S * D_FF / 256)), dim3(256), 0, stream, gate, up, S * D_FF);
        sgemm(stream, gate, D_FF, ffn_w_down + (size_t)D_FF * D_MODEL, D_MODEL, xb, D_MODEL, xa, D_MODEL, SEQ, D_MODEL, D_FF);
        hipLaunchKernelGGL(k_rmsnorm, dim3(SEQ), dim3(256), 0, stream, xb, final_norm_g, out + (size_t)b * S * D_MODEL);
    }
}
```

```cpp
#include <hip/hip_runtime.h>
#include <cstdio>
#include <cstdint>
namespace pg8 {
#define PG8_LAS __attribute__((address_space(3)))
typedef unsigned short bf16_t;
typedef short bf16x8 __attribute__((ext_vector_type(8)));
typedef float f32x4 __attribute__((ext_vector_type(4)));
typedef unsigned u32x4 __attribute__((ext_vector_type(4)));
constexpr int BM = 256, BK = 64, HALF = 128, HTB = HALF * BK * 2  , STAGE_BYTES = 8 * HTB, NXCD = 8, WGM = 8;

__host__ __device__ __forceinline__ int lds_byte(int r, int c) { const int st = (r >> 4) * 2 + (c >> 5), rr = r & 15, cc = c & 31, ob = rr * 64 + cc * 2; return st * 1024 + (ob ^ (((ob >> 9) & 1) << 5)); }
__host__ __device__ __forceinline__ void stage_rc(int b, int& R, int& C) { const int st = b / 1024, sb = b % 1024, swz = sb ^ (((sb >> 9) & 1) << 5); R = (st >> 1) * 16 + swz / 64; C = (st & 1) * 32 + (swz % 64) / 2; }
__host__ __device__ __forceinline__ int perm32(int rho) { const int n = rho >> 4, i = rho & 15; return 8 * (i >> 2) + 4 * n + (i & 3); }

struct Unit { int pm, pn; };
struct Gemm { const bf16_t* A; const bf16_t* Bt; int M, N, K; };

struct StaticOrder {
    int nM, nN, nwg, G, c;
    __host__ __device__ void init(int M, int N, int G_, int c_) { nM = M / BM; nN = N / BM; nwg = nM * nN; G = G_; c = c_; }
    __host__ __device__ bool next(int i, Unit& u) const {
        const long L = (long)i * G + c; if (L >= nwg) return false;
        int wgid = (int)L; { const int q = nwg / NXCD, r = nwg % NXCD, xcd = wgid % NXCD, off = wgid / NXCD; wgid = (xcd < r ? xcd * (q + 1) : r * (q + 1) + (xcd - r) * q) + off; }
        const int nig = WGM * nN, gid = wgid / nig, fm = gid * WGM, gsz = (nM - fm) < WGM ? (nM - fm) : WGM;
        u.pm = fm + ((wgid % nig) % gsz); u.pn = (wgid % nig) / gsz; return true;
    }
    __device__ __forceinline__ void a_ready(const Unit&) const {}
    __device__ __forceinline__ void done(const Unit&) const {}
};

__device__ __forceinline__ unsigned cvt_pk_bf16(float lo, float hi) { unsigned r; asm volatile("v_cvt_pk_bf16_f32 %0, %1, %2" : "=v"(r) : "v"(lo), "v"(hi)); return r; }
typedef float f32x2 __attribute__((ext_vector_type(2)));
__device__ __forceinline__ f32x2 gelu_pk(f32x2 v) {
    const f32x2 av = __builtin_elementwise_abs(v), d = av * 0.2316418882f + 1.0f;
    f32x2 t; t.x = __builtin_amdgcn_rcpf(d.x); t.y = __builtin_amdgcn_rcpf(d.y);
    f32x2 q = t * 0.5307027145f + (-0.7265760135f); q = q * t + 0.7107068705f; q = q * t + (-0.142248368f); q = q * t + 0.127414796f; q = q * t;
    const f32x2 s = (v * v) * (-0.72134752044f);
    f32x2 e; e.x = __builtin_amdgcn_exp2f(s.x); e.y = __builtin_amdgcn_exp2f(s.y);
    const f32x2 m = v * (q * e), r = v - m;
    f32x2 o; o.x = v.x < 0.f ? m.x : r.x; o.y = v.y < 0.f ? m.y : r.y; return o;
}


constexpr float RMS_EPS = 1e-6f;
__device__ __forceinline__ float sigm(float x) { return __builtin_amdgcn_rcpf(1.0f + __expf(-x)); }
__device__ __forceinline__ u32x4 pack8(const f32x4 v0, const f32x4 v1) { u32x4 w; w.x = cvt_pk_bf16(v0[0], v0[1]); w.y = cvt_pk_bf16(v0[2], v0[3]); w.z = cvt_pk_bf16(v1[0], v1[1]); w.w = cvt_pk_bf16(v1[2], v1[3]); return w; }
__device__ __forceinline__ float rstd_of(float ssq) { return rsqrtf(ssq * (1.0f / 1024.0f) + RMS_EPS); }

struct EpiInL0 {
    static constexpr bool PERM = true, AFTER_DRAIN = false;
    bf16_t* UB; bf16_t* PB; const float* ssq;
    __device__ __forceinline__ void operator()(const f32x4 (&acc)[2][2][4][2], const Unit& u, int wr, int wc, int fr, int fq) const {
        const int row0 = u.pm * BM + wr * 64 + fr, cw = wc * 32 + 8 * fq;
#pragma unroll
        for (int ai = 0; ai < 2; ++ai)
#pragma unroll
            for (int m = 0; m < 4; ++m) {
                const int row = row0 + ai * HALF + m * 16;
                const float rs = rstd_of(ssq[row]);
                if (u.pn < 4) {
                    f32x4 o[2];
#pragma unroll
                    for (int n = 0; n < 2; ++n)
#pragma unroll
                        for (int j = 0; j < 4; ++j) { const float a = acc[ai][0][m][n][j] * rs, g = acc[ai][1][m][n][j] * rs; o[n][j] = a * sigm(g); }
                    *(u32x4*)(UB + (size_t)row * 512 + u.pn * 128 + cw) = pack8(o[0], o[1]);
                } else {
#pragma unroll
                    for (int bj = 0; bj < 2; ++bj) *(u32x4*)(PB + (size_t)row * 512 + (u.pn - 4) * 256 + bj * HALF + cw) = pack8(acc[ai][bj][m][0] * rs, acc[ai][bj][m][1] * rs);
                }
            }
    }
};
template <bool WRITE_XB> struct EpiResid {
    static constexpr bool PERM = true, AFTER_DRAIN = false;
    const float* R; float* OUT; bf16_t* XB; float* ssq;
    __device__ __forceinline__ void operator()(const f32x4 (&acc)[2][2][4][2], const Unit& u, int wr, int wc, int fr, int fq) const {
        const int row0 = u.pm * BM + wr * 64 + fr, cw = wc * 32 + 8 * fq;
#pragma unroll
        for (int ai = 0; ai < 2; ++ai)
#pragma unroll
            for (int m = 0; m < 4; ++m) {
                const int row = row0 + ai * HALF + m * 16;
                float s = 0.f;
#pragma unroll
                for (int bj = 0; bj < 2; ++bj) {
                    const size_t off = (size_t)row * 1024 + u.pn * BM + bj * HALF + cw;
                    const f32x4 r0 = *(const f32x4*)(R + off), r1 = *(const f32x4*)(R + off + 4);
                    const f32x4 v0 = acc[ai][bj][m][0] + r0, v1 = acc[ai][bj][m][1] + r1;
                    *(f32x4*)(OUT + off) = v0; *(f32x4*)(OUT + off + 4) = v1;
                    if (WRITE_XB) *(u32x4*)(XB + off) = pack8(v0, v1);
                    s += (v0[0] * v0[0] + v0[1] * v0[1]) + (v0[2] * v0[2] + v0[3] * v0[3]) + (v1[0] * v1[0] + v1[1] * v1[1]) + (v1[2] * v1[2] + v1[3] * v1[3]);
                }
                s += __shfl_xor(s, 16); s += __shfl_xor(s, 32);
                if (fq == 0) atomicAdd(ssq + row, s);
                asm volatile("" ::: "memory");
            }
    }
};
struct EpiSwiGLU {
    static constexpr bool PERM = true, AFTER_DRAIN = false;
    bf16_t* H; const float* ssq;
    __device__ __forceinline__ void operator()(const f32x4 (&acc)[2][2][4][2], const Unit& u, int wr, int wc, int fr, int fq) const {
        const int row0 = u.pm * BM + wr * 64 + fr, cw = wc * 32 + 8 * fq;
#pragma unroll
        for (int ai = 0; ai < 2; ++ai)
#pragma unroll
            for (int m = 0; m < 4; ++m) {
                const int row = row0 + ai * HALF + m * 16;
                const float rs = rstd_of(ssq[row]);
                f32x4 o[2];
#pragma unroll
                for (int n = 0; n < 2; ++n)
#pragma unroll
                    for (int j = 0; j < 4; ++j) { const float g = acc[ai][0][m][n][j] * rs, up = acc[ai][1][m][n][j] * rs; o[n][j] = g * sigm(g) * up; }
                *(u32x4*)(H + (size_t)row * 2816 + u.pn * 128 + cw) = pack8(o[0], o[1]);
            }
    }
};
struct EpiPQT {
    static constexpr bool PERM = true, AFTER_DRAIN = false;
    bf16_t* PQT; const float* ssq;
    __device__ __forceinline__ void operator()(const f32x4 (&acc)[2][2][4][2], const Unit& u, int wr, int wc, int fr, int fq) const {
        const int tok0 = u.pn * BM + wc * 32 + 8 * fq, b = (u.pn * BM) >> 12;
        f32x4 rs[2][2];
#pragma unroll
        for (int bj = 0; bj < 2; ++bj)
#pragma unroll
            for (int n = 0; n < 2; ++n) { const f32x4 q = *(const f32x4*)(ssq + tok0 + bj * HALF + 4 * n);
#pragma unroll
                for (int j = 0; j < 4; ++j) rs[bj][n][j] = rstd_of(q[j]); }
#pragma unroll
        for (int ai = 0; ai < 2; ++ai)
#pragma unroll
            for (int m = 0; m < 4; ++m) {
                const int r = u.pm * BM + ai * HALF + wr * 64 + m * 16 + fr, pq = r >> 9, ch = r & 511;
                bf16_t* base = PQT + ((size_t)(b * 512 + ch) * 2 + pq) * 4096;
#pragma unroll
                for (int bj = 0; bj < 2; ++bj) *(u32x4*)(base + ((tok0 + bj * HALF) & 4095)) = pack8(acc[ai][bj][m][0] * rs[bj][0], acc[ai][bj][m][1] * rs[bj][1]);
            }
    }
};
struct EpiGeluUV {
    static constexpr bool PERM = true, AFTER_DRAIN = false;
    bf16_t* U; bf16_t* V; const float* ssq;
    __device__ __forceinline__ void operator()(const f32x4 (&acc)[2][2][4][2], const Unit& u, int wr, int wc, int fr, int fq) const {
        const int row0 = u.pm * BM + wr * 64 + fr, cw = wc * 32 + 8 * fq;
        bf16_t* dst = (u.pn < 2) ? U : V; const int colb = (u.pn & 1) * BM;
#pragma unroll
        for (int ai = 0; ai < 2; ++ai)
#pragma unroll
            for (int m = 0; m < 4; ++m) {
                const int row = row0 + ai * HALF + m * 16;
                const float rs = rstd_of(ssq[row]);
#pragma unroll
                for (int bj = 0; bj < 2; ++bj) {
                    const f32x4 v0 = acc[ai][bj][m][0] * rs, v1 = acc[ai][bj][m][1] * rs;
                    const f32x2 a = gelu_pk((f32x2){v0[0], v0[1]}), bq = gelu_pk((f32x2){v0[2], v0[3]}), c = gelu_pk((f32x2){v1[0], v1[1]}), d = gelu_pk((f32x2){v1[2], v1[3]});
                    *(u32x4*)(dst + (size_t)row * 512 + colb + bj * HALF + cw) = pack8((f32x4){a.x, a.y, bq.x, bq.y}, (f32x4){c.x, c.y, d.x, d.y});
                }
            }
    }
};
struct EpiDFT {
    static constexpr bool PERM = true, AFTER_DRAIN = false;
    bf16_t* AM;
    __device__ __forceinline__ void operator()(const f32x4 (&acc)[2][2][4][2], const Unit& u, int wr, int wc, int fr, int fq) const {
        const int row0 = (u.pn >> 1) * 4096 + u.pm * BM + wr * 64 + fr, cw = (u.pn & 1) * BM + wc * 32 + 8 * fq;
#pragma unroll
        for (int ai = 0; ai < 2; ++ai)
#pragma unroll
            for (int m = 0; m < 4; ++m) {
                const int row = row0 + ai * HALF + m * 16;
#pragma unroll
                for (int bj = 0; bj < 2; ++bj) *(u32x4*)(AM + (size_t)row * 1024 + bj * HALF + cw) = pack8(acc[ai][bj][m][0], acc[ai][bj][m][1]);
            }
    }
};

template <class Epi, class Sched, bool ALIGN_EPI = false, bool SP2 = false>
__device__ __forceinline__ void gemm_phase(PG8_LAS unsigned char* lds, const Gemm g, const Sched& S, const Epi& E) {
    const int tid = threadIdx.x, wid = __builtin_amdgcn_readfirstlane(tid >> 6), lane = tid & 63, wr = wid >> 2, wc = wid & 3, fr = lane & 15, fq = lane >> 4;
    const int K = g.K, nt = K / BK;
    unsigned voffA[2], voffB[2];
#pragma unroll
    for (int i = 0; i < 2; ++i) { int R, C; stage_rc(tid * 16 + i * 8192, R, C); const int Rb = Epi::PERM ? ((R & ~31) + perm32(R & 31)) : R;
        voffA[i] = (unsigned)(R * K + C) * 2u; voffB[i] = (unsigned)(Rb * K + C) * 2u; }
    const size_t kstep = (size_t)(BK * 2);
    const size_t hstep = (size_t)HALF * K * 2;
    const size_t tstep = 2 * hstep;
    const unsigned ldsw = (unsigned)wid * 1024u;
    const int aoff = lds_byte(wr * 64 + fr, fq * 8), boff = lds_byte(wc * 32 + fr, fq * 8);
#define PG8_SA(b, h) (((b) * 2 + (h)) * HTB)
#define PG8_SB(b, h) ((4 + (b) * 2 + (h)) * HTB)
#define PG8_STAGE(bufoff, gbase, voff) do { _Pragma("unroll") for (int _i = 0; _i < 2; ++_i) \
        __builtin_amdgcn_global_load_lds((const unsigned*)((const char*)(gbase) + (voff)[_i]), (PG8_LAS unsigned*)(lds + (bufoff) + ldsw + _i * 8192), 16, 0, 0); } while (0)
#define PG8_LDA(dst, b, h) do { _Pragma("unroll") for (int m = 0; m < 4; ++m) _Pragma("unroll") for (int k = 0; k < 2; ++k) dst[m][k] = *(const PG8_LAS bf16x8*)(lds + PG8_SA(b, h) + aoff + m * 2048 + k * 1024); } while (0)
#define PG8_LDB(dst, b, h) do { _Pragma("unroll") for (int n = 0; n < 2; ++n) _Pragma("unroll") for (int k = 0; k < 2; ++k) dst[n][k] = *(const PG8_LAS bf16x8*)(lds + PG8_SB(b, h) + boff + n * 2048 + k * 1024); } while (0)
#define PG8_MMA(ai, bj, At, Bt) do { __builtin_amdgcn_s_setprio(1); _Pragma("unroll") for (int m = 0; m < 4; ++m) _Pragma("unroll") for (int n = 0; n < 2; ++n) _Pragma("unroll") for (int k = 0; k < 2; ++k) \
        acc[ai][bj][m][n] = __builtin_amdgcn_mfma_f32_16x16x32_bf16(Bt[n][k], At[m][k], acc[ai][bj][m][n], 0, 0, 0); __builtin_amdgcn_s_setprio(0); } while (0)
#define PG8_WAIT_V(n) asm volatile("s_waitcnt vmcnt(" #n ")" ::: "memory")
#define PG8_WAIT_L(n) asm volatile("s_waitcnt lgkmcnt(" #n ")" ::: "memory")
#define PG8_BAR __builtin_amdgcn_s_barrier()
#define PG8_SCHED __builtin_amdgcn_sched_barrier(0)
    Unit cur, nxt; int ui = 0;
    if (!S.next(0, cur)) return;
    f32x4 acc[2][2][4][2];
#pragma unroll
    for (int a = 0; a < 2; ++a)
#pragma unroll
        for (int b = 0; b < 2; ++b)
#pragma unroll
            for (int m = 0; m < 4; ++m)
#pragma unroll
                for (int n = 0; n < 2; ++n) acc[a][b][m][n] = (f32x4){0.f, 0.f, 0.f, 0.f};
    bf16x8 At[4][2], B0[2][2], B1[2][2];
    const char* cA = (const char*)g.A + (size_t)cur.pm * tstep; const char* cB = (const char*)g.Bt + (size_t)cur.pn * tstep;
    S.a_ready(cur);
    if constexpr (SP2) {
        PG8_STAGE(PG8_SB(0, 0), cB, voffB); PG8_STAGE(PG8_SB(0, 1), cB + hstep, voffB); PG8_STAGE(PG8_SA(0, 0), cA, voffA); PG8_STAGE(PG8_SA(0, 1), cA + hstep, voffA);
        if (wr == 1) PG8_BAR;
        PG8_WAIT_V(2); PG8_BAR;
        PG8_STAGE(PG8_SB(1, 0), cB + kstep, voffB); PG8_STAGE(PG8_SA(1, 0), cA + kstep, voffA); PG8_STAGE(PG8_SB(1, 1), cB + hstep + kstep, voffB);
        PG8_WAIT_V(6); PG8_BAR;
    } else {
        PG8_STAGE(PG8_SB(0, 0), cB, voffB); PG8_STAGE(PG8_SA(0, 0), cA, voffA); PG8_STAGE(PG8_SB(0, 1), cB + hstep, voffB); PG8_STAGE(PG8_SA(0, 1), cA + hstep, voffA);
        if (wr == 1) PG8_BAR;
        PG8_WAIT_V(4); PG8_BAR;
        PG8_STAGE(PG8_SB(1, 0), cB + kstep, voffB); PG8_STAGE(PG8_SA(1, 0), cA + kstep, voffA); PG8_STAGE(PG8_SB(1, 1), cB + hstep + kstep, voffB);
        PG8_WAIT_V(6); PG8_BAR;
    }
    for (;;) {
        const bool has_next = S.next(ui + 1, nxt);
        const char* nA = has_next ? (const char*)g.A + (size_t)nxt.pm * tstep : cA; const char* nB = has_next ? (const char*)g.Bt + (size_t)nxt.pn * tstep : cB;
        for (int t = 0; t < nt; t += 2) {
            const bool last = (t == nt - 2);
            const char* a1 = cA + (size_t)(t + 1) * kstep;
            const char* a2 = last ? nA : cA + (size_t)(t + 2) * kstep; const char* b2 = last ? nB : cB + (size_t)(t + 2) * kstep;
            const char* a3 = a2 + kstep; const char* b3 = b2 + kstep;
            if (last && has_next) S.a_ready(nxt);
            if constexpr (SP2) {
            PG8_LDB(B0, 0, 0); PG8_LDB(B1, 0, 1); PG8_SCHED; PG8_LDA(At, 0, 0); PG8_STAGE(PG8_SA(1, 1), a1 + hstep, voffA);
            PG8_WAIT_V(8); PG8_WAIT_L(0); PG8_BAR; PG8_MMA(0, 0, At, B0); PG8_MMA(0, 1, At, B1); PG8_BAR; PG8_SCHED;
            PG8_LDA(At, 0, 1); PG8_STAGE(PG8_SB(0, 0), b2, voffB); PG8_STAGE(PG8_SB(0, 1), b2 + hstep, voffB); PG8_STAGE(PG8_SA(0, 0), a2, voffA);
            PG8_WAIT_V(8); PG8_WAIT_L(0); PG8_BAR; PG8_MMA(1, 0, At, B0); PG8_MMA(1, 1, At, B1); PG8_BAR; PG8_SCHED;
            PG8_LDB(B0, 1, 0); PG8_LDB(B1, 1, 1); PG8_SCHED; PG8_LDA(At, 1, 0); PG8_STAGE(PG8_SA(0, 1), a2 + hstep, voffA);
            PG8_WAIT_V(8); PG8_WAIT_L(0); PG8_BAR; PG8_MMA(0, 0, At, B0); PG8_MMA(0, 1, At, B1); PG8_BAR; PG8_SCHED;
            PG8_LDA(At, 1, 1); PG8_STAGE(PG8_SB(1, 0), b3, voffB); PG8_STAGE(PG8_SB(1, 1), b3 + hstep, voffB); PG8_STAGE(PG8_SA(1, 0), a3, voffA);
            PG8_WAIT_V(8); PG8_WAIT_L(0); PG8_BAR; PG8_MMA(1, 0, At, B0); PG8_MMA(1, 1, At, B1); PG8_BAR; PG8_SCHED;
            } else {
            PG8_LDB(B0, 0, 0); PG8_SCHED; PG8_LDA(At, 0, 0); PG8_STAGE(PG8_SA(1, 1), a1 + hstep, voffA);
            PG8_WAIT_L(8); PG8_BAR; PG8_WAIT_L(0); PG8_MMA(0, 0, At, B0); PG8_BAR; PG8_SCHED;
            PG8_LDB(B1, 0, 1); PG8_STAGE(PG8_SB(0, 0), b2, voffB);
            PG8_BAR; PG8_WAIT_L(0); PG8_MMA(0, 1, At, B1); PG8_BAR;
            PG8_LDA(At, 0, 1); PG8_STAGE(PG8_SA(0, 0), a2, voffA);
            PG8_BAR; PG8_WAIT_L(0); PG8_MMA(1, 0, At, B0); PG8_BAR; PG8_SCHED;
            PG8_STAGE(PG8_SB(0, 1), b2 + hstep, voffB);
            PG8_WAIT_V(6); PG8_BAR; PG8_MMA(1, 1, At, B1); PG8_BAR;
            PG8_LDB(B0, 1, 0); PG8_SCHED; PG8_LDA(At, 1, 0); PG8_STAGE(PG8_SA(0, 1), a2 + hstep, voffA);
            PG8_WAIT_L(8); PG8_BAR; PG8_WAIT_L(0); PG8_MMA(0, 0, At, B0); PG8_BAR; PG8_SCHED;
            PG8_LDB(B1, 1, 1); PG8_STAGE(PG8_SB(1, 0), b3, voffB);
            PG8_BAR; PG8_WAIT_L(0); PG8_MMA(0, 1, At, B1); PG8_BAR;
            PG8_LDA(At, 1, 1); PG8_STAGE(PG8_SA(1, 0), a3, voffA);
            PG8_BAR; PG8_WAIT_L(0); PG8_MMA(1, 0, At, B0); PG8_BAR; PG8_SCHED;
            PG8_STAGE(PG8_SB(1, 1), b3 + hstep, voffB);
            PG8_WAIT_V(6); PG8_BAR; PG8_MMA(1, 1, At, B1); PG8_BAR;
            }
        }
        if constexpr (ALIGN_EPI) { if (wr == 0) PG8_BAR; }
        if constexpr (!Epi::AFTER_DRAIN) { E(acc, cur, wr, wc, fr, fq); S.done(cur); }
        if (!has_next) break;
#pragma unroll
        for (int a = 0; a < 2; ++a)
#pragma unroll
            for (int b = 0; b < 2; ++b)
#pragma unroll
                for (int m = 0; m < 4; ++m)
#pragma unroll
                    for (int n = 0; n < 2; ++n) acc[a][b][m][n] = (f32x4){0.f, 0.f, 0.f, 0.f};
        cur = nxt; cA = nA; cB = nB; ++ui;
        if constexpr (ALIGN_EPI) { if (wr == 1) PG8_BAR; }
    }
    PG8_WAIT_V(0);
    if constexpr (!ALIGN_EPI) { if (wr == 0) PG8_BAR; }
    PG8_BAR;
    if constexpr (Epi::AFTER_DRAIN) { E.fused(acc, cur, wr, wc, fr, fq, lds, wid, lane); S.done(cur); }
#undef PG8_SA
#undef PG8_SB
#undef PG8_STAGE
#undef PG8_LDA
#undef PG8_LDB
#undef PG8_MMA
#undef PG8_WAIT_V
#undef PG8_WAIT_L
#undef PG8_BAR
#undef PG8_SCHED
}
}
#define GAS __attribute__((address_space(1)))
#define LAS __attribute__((address_space(3)))
typedef unsigned short bf16;
typedef unsigned v4u __attribute__((ext_vector_type(4)));
typedef float f32x4 __attribute__((ext_vector_type(4)));
typedef short bf16x8 __attribute__((ext_vector_type(8)));
typedef GAS unsigned gu32;
typedef GAS unsigned long long gu64;
#define RLX_AGENT __ATOMIC_RELAXED, __HIP_MEMORY_SCOPE_AGENT
#define LDS_WAIT() asm volatile("s_waitcnt lgkmcnt(0)" ::: "memory")
#define VM_WAIT() asm volatile("s_waitcnt vmcnt(0)" ::: "memory")
__device__ __forceinline__ unsigned long long rt() { return __builtin_amdgcn_s_memrealtime(); }
__device__ __forceinline__ unsigned f2bf(float f) { unsigned u = __builtin_bit_cast(unsigned, f); return (u + 0x7fffu + ((u >> 16) & 1u)) >> 16; }
__device__ __forceinline__ unsigned pk2(float lo, float hi) { return f2bf(lo) | (f2bf(hi) << 16); }

#define XB_TMO      128
#define XB_XCNT(j)  (256  + 64 * (j))
#define XB_XSUB(j)  (1280 + 64 * (j))
#define XB_XGEN(j)  (2304 + 64 * (j))
#define XB_TOP      3328
#define XB_TOPGEN   3392
#define XCD_BAR_WORDS 3456
#define XB_SPIN_CAP (1u << 18)

__device__ __forceinline__ unsigned xb_ld(unsigned* p)              { return __hip_atomic_load(p, __ATOMIC_RELAXED, __HIP_MEMORY_SCOPE_AGENT); }
__device__ __forceinline__ unsigned xb_add(unsigned* p, unsigned v) { return __hip_atomic_fetch_add(p, v, __ATOMIC_RELAXED, __HIP_MEMORY_SCOPE_AGENT); }
__device__ __forceinline__ unsigned xb_xcc_id() { return (unsigned)__builtin_amdgcn_s_getreg((3 << 11) | 20) & 0xFu; }
#define XB_SPIN(cond, bar) do { unsigned _sp = 0; while (cond) { __builtin_amdgcn_s_sleep(1); \
    if ((++_sp & 255u) == 0u) { if (xb_ld(&(bar)[XB_TMO])) break; if (_sp > XB_SPIN_CAP) { atomicAdd(&(bar)[XB_TMO], 1u); break; } } } } while (0)

struct XcdBarrier {
    unsigned* bar; unsigned x;
    volatile LAS unsigned* st;
};

__device__ __forceinline__ XcdBarrier xcd_barrier_post(unsigned* bar, volatile LAS unsigned* st) {
    XcdBarrier b; b.bar = bar; b.x = xb_xcc_id(); b.st = st;
    if (threadIdx.x == 0) (void)xb_add(&bar[XB_XCNT(b.x)], 1u);
    return b;
}
__device__ __forceinline__ void xcd_barrier_complete(unsigned* bar, unsigned x, unsigned& nloc, unsigned& nx) {
    const unsigned G = gridDim.x * gridDim.y * gridDim.z;
    unsigned sum, cnt, mine, sp = 0u;
    for (;;) {
        sum = 0u; cnt = 0u; mine = 0u;
#pragma unroll
        for (unsigned j = 0; j < 16; ++j) { const unsigned c = xb_ld(&bar[XB_XCNT(j)]); sum += c; cnt += (c > 0u) ? 1u : 0u; mine = (j == x) ? c : mine; }
        if (sum == G) break;
        __builtin_amdgcn_s_sleep(1);
        if ((++sp & 255u) == 0u) { if (xb_ld(&bar[XB_TMO])) break; if (sp > XB_SPIN_CAP) { atomicAdd(&bar[XB_TMO], 1u); break; } }
    }
    nloc = mine > 0u ? mine : 1u; nx = cnt > 0u ? cnt : 1u;
}

__device__ __forceinline__ void xcd_barrier(const XcdBarrier& b) {
    asm volatile("s_waitcnt vmcnt(0)" ::: "memory");
    __syncthreads();
    if (threadIdx.x == 0) {
        unsigned* bar = b.bar;
        __builtin_amdgcn_s_waitcnt(0);
        unsigned nloc = b.st[0], nx = b.st[1];
        if (nloc == 0u) { xcd_barrier_complete(bar, b.x, nloc, nx); b.st[0] = nloc; b.st[1] = nx; }
        const unsigned old = xb_add(&bar[XB_XSUB(b.x)], 1u);
        const unsigned gen = old / nloc;
        if (old + 1u == (gen + 1u) * nloc) {
            __builtin_amdgcn_fence(__ATOMIC_RELEASE, "agent");
            asm volatile("s_waitcnt vmcnt(0)" ::: "memory");
            const unsigned og = xb_add(&bar[XB_TOP], 1u);
            const unsigned tg = og / nx;
            if (og + 1u == (tg + 1u) * nx) xb_add(&bar[XB_TOPGEN], 1u);
            else XB_SPIN(xb_ld(&bar[XB_TOPGEN]) == tg, bar);
            __builtin_amdgcn_fence(__ATOMIC_ACQUIRE, "agent");
            xb_add(&bar[XB_XGEN(b.x)], 1u);
            asm volatile("s_waitcnt vmcnt(0)" ::: "memory");
        } else {
            XB_SPIN(xb_ld(&bar[XB_XGEN(b.x)]) == gen, bar);
            __builtin_amdgcn_fence(__ATOMIC_ACQUIRE, "agent");
            asm volatile("s_waitcnt vmcnt(0)" ::: "memory");
        }
    }
    __syncthreads();
}

constexpr int NWAVES = 8;
#ifndef MK_PER_PHASE
#define MK_PER_PHASE 0
#endif
constexpr int N_PHASES = 12;

constexpr int NB = 8, S = 4096, D = 1024, FF = 2816, M = NB * S;
typedef float f32x2g __attribute__((ext_vector_type(2)));
typedef unsigned u32x2g __attribute__((ext_vector_type(2)));

constexpr size_t MiB = 1u << 20;
constexpr size_t WS_CTL = 0, CTL_ZERO_BYTES = 1 * MiB;
constexpr size_t WS_SSQ = 1 * MiB;
constexpr size_t WS_WIN0 = 2 * MiB;
constexpr size_t WS_WOUT0 = 5 * MiB;
constexpr size_t WS_WGU0 = 7 * MiB;
constexpr size_t WS_WDN0 = 18 * MiB;
constexpr size_t WS_WPQ1 = 24 * MiB;
constexpr size_t WS_WUV1 = 26 * MiB;
constexpr size_t WS_WOUT1 = 28 * MiB;
constexpr size_t WS_WGU1 = 30 * MiB;
constexpr size_t WS_WDN1 = 41 * MiB;
constexpr size_t WS_DFT = 48 * MiB;
constexpr size_t WS_XB = 112 * MiB;
constexpr size_t WS_AM = 176 * MiB;
constexpr size_t WS_H = 240 * MiB;
constexpr size_t WS_UB = WS_H, WS_PB = WS_H + 32 * MiB;
constexpr size_t WS_PQT = WS_H, WS_U1 = WS_H + 64 * MiB, WS_V1 = WS_H + 96 * MiB;
constexpr size_t WS_END = 416 * MiB;
static_assert(WS_H + (size_t)M * FF * 2 <= WS_END && WS_V1 + (size_t)M * 512 * 2 <= WS_END, "d_ws map");
constexpr int CW_BAR = 4096;

constexpr int RING_OFF = 0, RING_BYTES = 131072;
constexpr int LDSCTL_OFF = RING_BYTES, MISC_OFF = LDSCTL_OFF + 320;
constexpr int LDS_BYTES = 147456;

struct Frame {
    LAS unsigned char* lds;
    volatile LAS unsigned* MISC;
    gu32* ctl;
    int tid, lane, wave;
    int vcu, G;
};
__device__ __forceinline__ float wave_sum(float v) {
#pragma unroll
    for (int o = 1; o < 64; o <<= 1) v += __shfl_xor(v, o);
    return v;
}
__device__ __forceinline__ float bf_lo(unsigned x) { return __builtin_bit_cast(float, x << 16); }
__device__ __forceinline__ float bf_hi(unsigned x) { return __builtin_bit_cast(float, x & 0xffff0000u); }
#define WG_BAR() do { asm volatile("s_waitcnt vmcnt(0) lgkmcnt(0)" ::: "memory"); __builtin_amdgcn_s_barrier(); asm volatile("" ::: "memory"); } while (0)

__device__ __forceinline__ void p0_transpose_item(const float* W, int ldw, const float* gk, bf16* WT, int ldt, int k0, int n0, int dk0, int drow0, LAS float* scr, int lane) {
#pragma unroll 8
    for (int i = 0; i < 32; ++i) { const int kk = 2 * i + (lane >> 5); float v = W[(size_t)(k0 + kk) * ldw + n0 + (lane & 31)]; if (gk) v *= gk[k0 + kk]; scr[kk * 33 + (lane & 31)] = v; }
    LDS_WAIT(); asm volatile("" ::: "memory");
    const int c = lane & 7;
#pragma unroll
    for (int j = 0; j < 4; ++j) { const int n = (lane >> 3) + 8 * j; const LAS float* s = scr + (8 * c) * 33 + n;
        v4u o; o.x = pk2(s[0 * 33], s[1 * 33]); o.y = pk2(s[2 * 33], s[3 * 33]); o.z = pk2(s[4 * 33], s[5 * 33]); o.w = pk2(s[6 * 33], s[7 * 33]);
        *(GAS v4u*)(WT + (size_t)(drow0 + n) * ldt + dk0 + 8 * c) = o; }
    LDS_WAIT(); asm volatile("" ::: "memory");
}
__device__ __forceinline__ void p0_job(const float* W, int ldw, const float* gk, int kbeg, int kext, int ncol0, int next, bf16* WT, int ldt, int dkbase, int mode, int half_or_off,
                                       LAS float* scr, int lane, int gw, int NGW, int& cursor) {
    const int nkb = kext / 64, nnb = next / 32, nitems = nkb * nnb;
    int first = (gw - (cursor % NGW) + NGW) % NGW;
    for (int it = first; it < nitems; it += NGW) {
        const int kb = it / nnb, nb = it % nnb, nrel = 32 * nb;
        const int drow0 = (mode == 0) ? (half_or_off + nrel) : (256 * (nrel >> 7) + 128 * half_or_off + (nrel & 127));
        p0_transpose_item(W, ldw, gk, WT, ldt, kbeg + 64 * kb, ncol0 + nrel, dkbase + 64 * kb, drow0, scr, lane);
    }
    cursor += nitems;
}
__device__ __forceinline__ void p0_fold_item(const float* L, int lrow0, const float* sc, const float* Rm, bf16* out, int dk0, float scale, int dw, int lane) {
    const int d = 64 * dw + lane;
    float acc[8];
#pragma unroll
    for (int j = 0; j < 8; ++j) acc[j] = 0.f;
    for (int cp = 0; cp < 128; ++cp) {
        float r = Rm[(size_t)cp * 1024 + d]; if (sc) r *= sc[cp];
#pragma unroll
        for (int j = 0; j < 8; ++j) acc[j] = fmaf(L[(size_t)(lrow0 + j) * 128 + cp], r, acc[j]);
    }
    v4u o; o.x = pk2(acc[0] * scale, acc[1] * scale); o.y = pk2(acc[2] * scale, acc[3] * scale); o.z = pk2(acc[4] * scale, acc[5] * scale); o.w = pk2(acc[6] * scale, acc[7] * scale);
    *(GAS v4u*)(out + (size_t)d * 1024 + dk0) = o;
}
__device__ __forceinline__ void p0_pq_item(const float* Win1, const float* g1, bf16* WPQ, int h, int half, int k0, const LAS float* tab, int lane) {
    const int cp = 64 * half + lane;
    float ap[8], aq[8], gj[8];
#pragma unroll
    for (int j = 0; j < 8; ++j) { ap[j] = 0.f; aq[j] = 0.f; gj[j] = g1[k0 + j]; }
    for (int c = 0; c < 128; ++c) {
        const int ph = c * cp;
        const float cs = tab[ph & 127], sn = tab[(ph - 32) & 127];
#pragma unroll
        for (int j = 0; j < 8; ++j) { const float w = Win1[(size_t)(k0 + j) * 1536 + h * 128 + c] * gj[j]; ap[j] = fmaf(w, cs, ap[j]); aq[j] = fmaf(w, sn, aq[j]); }
    }
    v4u o; o.x = pk2(ap[0], ap[1]); o.y = pk2(ap[2], ap[3]); o.z = pk2(ap[4], ap[5]); o.w = pk2(ap[6], ap[7]);
    *(GAS v4u*)(WPQ + (size_t)(h * 128 + cp) * 1024 + k0) = o;
    o.x = pk2(aq[0], aq[1]); o.y = pk2(aq[2], aq[3]); o.z = pk2(aq[4], aq[5]); o.w = pk2(aq[6], aq[7]);
    *(GAS v4u*)(WPQ + (size_t)(512 + h * 128 + cp) * 1024 + k0) = o;
}

struct Ptrs {
    const float* in[22]; float* out; unsigned char* ws;
};

__device__ __forceinline__ void p0_prologue(Frame& F, const Ptrs& P) {
    const float* x = P.in[0]; const float* mix_g = P.in[1]; const float* ffn_g = P.in[2];
    const float* ev_w_in = P.in[3]; const float* ev_pool_w = P.in[8]; const float* ev_pool_scale = P.in[9]; const float* ev_w_out = P.in[10];
    const float* od_w_in = P.in[11]; const float* od_fourier_w = P.in[12]; const float* od_w_out = P.in[17];
    const float* w_gate = P.in[18]; const float* w_up = P.in[19]; const float* w_down = P.in[20];
    unsigned char* ws = P.ws;
    LAS float* scr = (LAS float*)(F.lds + RING_OFF + F.wave * 8448);
    LAS float* CT = (LAS float*)(F.lds + RING_OFF + 69632);
    LAS float* tab = (LAS float*)(F.lds + RING_OFF + 69632 + 16384);
    for (int i = F.tid; i < 4096; i += NWAVES * 64) CT[i] = cospif((float)i * (1.0f / 2048.0f));
    if (F.tid < 128) tab[F.tid] = cospif((float)F.tid * (1.0f / 64.0f));
    WG_BAR();
    const int gw = F.vcu * NWAVES + F.wave, NGW = F.G * NWAVES, lane = F.lane;
    { float* z = (float*)(ws + WS_SSQ) + M; const int gt = F.vcu * NWAVES * 64 + F.tid, NT = F.G * NWAVES * 64;
      for (int i = gt; i < 4 * M; i += NT) z[i] = 0.f; }
    int cur = 0;
    p0_job(ev_w_in, 1536, mix_g, 0, 1024, 0, 512, (bf16*)(ws + WS_WIN0), 1024, 0, 1, 0, scr, lane, gw, NGW, cur);
    p0_job(ev_w_in, 1536, mix_g, 0, 1024, 512, 512, (bf16*)(ws + WS_WIN0), 1024, 0, 1, 1, scr, lane, gw, NGW, cur);
    p0_job(ev_w_in, 1536, mix_g, 0, 1024, 1024, 512, (bf16*)(ws + WS_WIN0), 1024, 0, 0, 1024, scr, lane, gw, NGW, cur);
    p0_job(ev_w_out, 1024, nullptr, 0, 512, 0, 1024, (bf16*)(ws + WS_WOUT0), 1024, 0, 0, 0, scr, lane, gw, NGW, cur);
    p0_job(w_gate, FF, ffn_g, 0, 1024, 0, FF, (bf16*)(ws + WS_WGU0), 1024, 0, 1, 0, scr, lane, gw, NGW, cur);
    p0_job(w_up, FF, ffn_g, 0, 1024, 0, FF, (bf16*)(ws + WS_WGU0), 1024, 0, 1, 1, scr, lane, gw, NGW, cur);
    p0_job(w_down, 1024, nullptr, 0, FF, 0, 1024, (bf16*)(ws + WS_WDN0), FF, 0, 0, 0, scr, lane, gw, NGW, cur);
    p0_job(od_w_in, 1536, mix_g + D, 0, 1024, 512, 1024, (bf16*)(ws + WS_WUV1), 1024, 0, 0, 0, scr, lane, gw, NGW, cur);
    p0_job(od_w_out, 1024, nullptr, 512, 512, 0, 1024, (bf16*)(ws + WS_WOUT1), 1024, 512, 0, 0, scr, lane, gw, NGW, cur);
    p0_job(w_gate + (size_t)D * FF, FF, ffn_g + D, 0, 1024, 0, FF, (bf16*)(ws + WS_WGU1), 1024, 0, 1, 0, scr, lane, gw, NGW, cur);
    p0_job(w_up + (size_t)D * FF, FF, ffn_g + D, 0, 1024, 0, FF, (bf16*)(ws + WS_WGU1), 1024, 0, 1, 1, scr, lane, gw, NGW, cur);
    p0_job(w_down + (size_t)FF * D, 1024, nullptr, 0, FF, 0, 1024, (bf16*)(ws + WS_WDN1), FF, 0, 0, 0, scr, lane, gw, NGW, cur);
    {
        int first = (gw - (cur % NGW) + NGW) % NGW;
        for (int it = first; it < 1024; it += NGW) { const int g = it >> 8, cc = (it >> 4) & 15, dw = it & 15;
            p0_fold_item(ev_pool_w, g * 128 + cc * 8, ev_pool_scale + g * 128, ev_w_out + (size_t)(512 + g * 128) * 1024, (bf16*)(ws + WS_WOUT0), 512 + g * 128 + cc * 8, 1.0f, dw, lane); }
        cur += 1024;
        first = (gw - (cur % NGW) + NGW) % NGW;
        for (int it = first; it < 1024; it += NGW) { const int h = it >> 8, cc = (it >> 4) & 15, dw = it & 15;
            p0_fold_item(od_fourier_w, h * 128 + cc * 8, nullptr, od_w_out + (size_t)(h * 128) * 1024, (bf16*)(ws + WS_WOUT1), h * 128 + cc * 8, 1.0f / 724.0773439350247f, dw, lane); }
        cur += 1024;
        first = (gw - (cur % NGW) + NGW) % NGW;
        for (int it = first; it < 1024; it += NGW) { const int h = it >> 8, half = (it >> 7) & 1, kc = it & 127;
            p0_pq_item(od_w_in, mix_g + D, (bf16*)(ws + WS_WPQ1), h, half, kc * 8, tab, lane); }
        cur += 1024;
    }
    {
        bf16* Dm = (bf16*)(ws + WS_DFT);
        int first = (gw - (cur % NGW) + NGW) % NGW;
        for (int sp = first; sp < S; sp += NGW) {
#pragma unroll 2
            for (int q = 0; q < 16; ++q) {
                const int j0 = (q * 64 + lane) * 8, s0 = j0 & (S - 1), sh = (j0 >> 12) ? 1024 : 0;
                float v[8];
#pragma unroll
                for (int e = 0; e < 8; ++e) v[e] = CT[(((s0 + e) * sp) + sh) & (S - 1)];
                v4u o; o.x = pk2(v[0], v[1]); o.y = pk2(v[2], v[3]); o.z = pk2(v[4], v[5]); o.w = pk2(v[6], v[7]);
                *(GAS v4u*)(Dm + (size_t)sp * (2 * S) + j0) = o;
            }
        }
        cur += S;
    }
    {
        bf16* XB = (bf16*)(ws + WS_XB); float* ssq0 = (float*)(ws + WS_SSQ);
        for (int m = gw; m < M; m += NGW) {
            const GAS f32x4* xr = (const GAS f32x4*)(x + (size_t)m * D) + lane;
            f32x4 v[4]; float s = 0.f;
#pragma unroll
            for (int j = 0; j < 4; ++j) { v[j] = xr[64 * j]; s += (v[j].x * v[j].x + v[j].y * v[j].y) + (v[j].z * v[j].z + v[j].w * v[j].w); }
            s = wave_sum(s);
            if (lane == 0) ssq0[m] = s;
            GAS unsigned long long* o8 = (GAS unsigned long long*)(XB + (size_t)m * D) + lane;
#pragma unroll
            for (int j = 0; j < 4; ++j) o8[64 * j] = (unsigned long long)pk2(v[j].x, v[j].y) | ((unsigned long long)pk2(v[j].z, v[j].w) << 32);
        }
    }
}

__device__ __forceinline__ float reduce_scatter32(float (&v)[32], int lane) {
#pragma unroll
    for (int o = 16; o >= 1; o >>= 1) {
        const bool up = (lane & o) != 0;
#pragma unroll
        for (int i = 0; i < o; ++i) { const float send = up ? v[i] : v[i + o]; const float keep = up ? v[i + o] : v[i]; v[i] = keep + __shfl_xor(send, o); }
    }
    return v[0] + __shfl_xor(v[0], 32);
}
__device__ __forceinline__ void mix0_conv_item(Frame& F, const Ptrs& P, int item) {
    const bf16* UB = (const bf16*)(P.ws + WS_UB); bf16* AM = (bf16*)(P.ws + WS_AM);
    const float* cw = P.in[4]; const float* cb = P.in[5]; const float* lg = P.in[6]; const float* lb = P.in[7];
    const int b = item >> 6, t0 = (item & 63) * 64, rowbase = b * S;
    LAS unsigned* tile = (LAS unsigned*)(F.lds + RING_OFF);
    LAS float* red = (LAS float*)(F.lds + RING_OFF + 98304);
    LAS float* stats = (LAS float*)(F.lds + RING_OFF + 98304 + 1024);
    for (int r = F.wave; r < 94; r += NWAVES) { const int t = t0 - 15 + r; v4u v = {0u, 0u, 0u, 0u};
        if (t >= 0 && t < S) v = *(const GAS v4u*)(UB + (size_t)(rowbase + t) * 512 + F.lane * 8);
        *(LAS v4u*)(tile + r * 256 + F.lane * 4) = v; }
    WG_BAR();
    int tidl = F.tid; asm volatile("" : "+v"(tidl));
    const int rg = tidl >> 8, cp = tidl & 255, lanel = tidl & 63;
    const f32x2g bb = *(const GAS f32x2g*)(cb + 2 * cp);
    const f32x2g g2 = *(const GAS f32x2g*)(lg + 2 * cp), b2 = *(const GAS f32x2g*)(lb + 2 * cp);
#pragma unroll 1
    for (int p = 0; p < 2; ++p) {
        float a0[16], a1[16];
#pragma unroll
        for (int o = 0; o < 16; ++o) { a0[o] = bb.x; a1[o] = bb.y; }
#pragma unroll 1
        for (int th = 0; th < 2; ++th) {
            float w0[16], w1[16];
#pragma unroll
            for (int jj = 0; jj < 16; ++jj) { const int j = 16 * th + jj; f32x2g w = {0.f, 0.f}; if (j < 31) w = *(const GAS f32x2g*)(cw + j * 512 + 2 * cp); w0[jj] = w.x; w1[jj] = w.y; }
            const LAS unsigned* tp = tile + (32 * rg + 16 * p + 16 * th) * 256 + cp;
#pragma unroll
            for (int ii = 0; ii < 31; ++ii) {
                const unsigned xx = tp[ii * 256];
                const float x0 = bf_lo(xx), x1 = bf_hi(xx);
#pragma unroll
                for (int o = 0; o < 16; ++o) { const int jj = ii - o; if (jj >= 0 && jj <= 15) { a0[o] = fmaf(w0[jj], x0, a0[o]); a1[o] = fmaf(w1[jj], x1, a1[o]); } }
            }
        }
        float v[32];
#pragma unroll
        for (int o = 0; o < 16; ++o) { v[2 * o] = a0[o] + a1[o]; v[2 * o + 1] = a0[o] * a0[o] + a1[o] * a1[o]; }
        const float tot = reduce_scatter32(v, lanel);
        if (lanel < 32) red[F.wave * 32 + lanel] = tot;
        WG_BAR();
        if (cp < 16) { const int wb = rg * 4; float s = 0.f, q = 0.f;
#pragma unroll
            for (int w = 0; w < 4; ++w) { s += red[(wb + w) * 32 + 2 * cp]; q += red[(wb + w) * 32 + 2 * cp + 1]; }
            const float mean = s * (1.0f / 512.0f), var = q * (1.0f / 512.0f) - mean * mean;
            stats[(rg * 16 + cp) * 2] = mean; stats[(rg * 16 + cp) * 2 + 1] = rsqrtf(var + 1e-6f); }
        WG_BAR();
#pragma unroll
        for (int o = 0; o < 16; ++o) {
            const float mean = stats[(rg * 16 + o) * 2], rstd = stats[(rg * 16 + o) * 2 + 1];
            float y0 = (a0[o] - mean) * rstd * g2.x + b2.x, y1 = (a1[o] - mean) * rstd * g2.y + b2.y;
            y0 = y0 * __builtin_amdgcn_rcpf(1.0f + __expf(-y0)); y1 = y1 * __builtin_amdgcn_rcpf(1.0f + __expf(-y1));
            *(GAS unsigned*)(AM + (size_t)(rowbase + t0 + 32 * rg + 16 * p + o) * 1024 + 2 * cp) = pk2(y0, y1);
        }
    }
    WG_BAR();
}
__device__ __forceinline__ void mix0_pool_item(Frame& F, const Ptrs& P, int item) {
    const bf16* PB = (const bf16*)(P.ws + WS_PB); bf16* AM = (bf16*)(P.ws + WS_AM);
    const int b = item >> 6, t0 = (item & 63) * 64, rowbase = b * S;
    LAS unsigned* tile = (LAS unsigned*)(F.lds + RING_OFF);
    for (int r = F.wave; r < 79; r += NWAVES) { const int t = t0 - 8 + r; v4u v = {0u, 0u, 0u, 0u};
        if (t >= 0 && t < S) v = *(const GAS v4u*)(PB + (size_t)(rowbase + t) * 512 + F.lane * 8);
        *(LAS v4u*)(tile + r * 256 + F.lane * 4) = v; }
    WG_BAR();
    const int rg = F.tid >> 8, cp = F.tid & 255, h = 1 << (cp >> 6);
    for (int o = 0; o < 32; ++o) {
        const int tl = 32 * rg + o, t = t0 + tl, rc = tl + 8;
        float s0 = 0.f, s1 = 0.f;
        for (int r = rc - h; r < rc + h; ++r) { const unsigned xx = tile[r * 256 + cp]; s0 += bf_lo(xx); s1 += bf_hi(xx); }
        const int lo = (t - h) < 0 ? 0 : (t - h), hi = (t + h - 1) > (S - 1) ? (S - 1) : (t + h - 1);
        const float inv = 1.0f / (float)(hi - lo + 1);
        const unsigned self = tile[rc * 256 + cp];
        *(GAS unsigned*)(AM + (size_t)(rowbase + t) * 1024 + 512 + 2 * cp) = pk2(s0 * inv - bf_lo(self), s1 * inv - bf_hi(self));
    }
    WG_BAR();
}

__device__ __forceinline__ void sgu_item(Frame& F, const Ptrs& P, int item) {
    const bf16* U = (const bf16*)(P.ws + WS_U1); const bf16* V = (const bf16*)(P.ws + WS_V1); bf16* AM = (bf16*)(P.ws + WS_AM);
    const float* lng = P.in[13]; const float* lnb = P.in[14]; const float* sw = P.in[15]; const float* sb = P.in[16];
    const int h = item & 3, rowbase = (item >> 2) * 128;
    LAS bf16* vnT = (LAS bf16*)(F.lds + RING_OFF);
    const int lane = F.lane;
    {
        const f32x2g g2 = *(const GAS f32x2g*)(lng + h * 128 + 2 * lane), b2 = *(const GAS f32x2g*)(lnb + h * 128 + 2 * lane);
        for (int i = 0; i < 16; ++i) { const int k = F.wave + 8 * i;
            const unsigned xx = *(const GAS unsigned*)(V + (size_t)(rowbase + k) * 512 + h * 128 + 2 * lane);
            const float v0 = bf_lo(xx), v1 = bf_hi(xx);
            const float mean = wave_sum(v0 + v1) * (1.0f / 128.0f), d0 = v0 - mean, d1 = v1 - mean;
            const float rstd = rsqrtf(wave_sum(d0 * d0 + d1 * d1) * (1.0f / 128.0f) + 1e-6f);
            vnT[(2 * lane) * 136 + k] = (bf16)f2bf(d0 * rstd * g2.x + b2.x); vnT[(2 * lane + 1) * 136 + k] = (bf16)f2bf(d1 * rstd * g2.y + b2.y); }
    }
    WG_BAR();
    {
        const int fr = lane & 15, fq = lane >> 4, q = 16 * F.wave + fr;
        pg8::f32x4 acc[8];
#pragma unroll
        for (int nt = 0; nt < 8; ++nt) acc[nt] = (pg8::f32x4){0.f, 0.f, 0.f, 0.f};
#pragma unroll
        for (int ks = 0; ks < 4; ++ks) {
            const GAS pg8::f32x4* wp = (const GAS pg8::f32x4*)(sw + (size_t)(h * 128 + q) * 128 + ks * 32 + 8 * fq);
            const pg8::f32x4 wa = wp[0], wb = wp[1];
            pg8::u32x4 wq; wq.x = pk2(wa[0], wa[1]); wq.y = pk2(wa[2], wa[3]); wq.z = pk2(wb[0], wb[1]); wq.w = pk2(wb[2], wb[3]);
            const pg8::bf16x8 wf = __builtin_bit_cast(pg8::bf16x8, wq);
#pragma unroll
            for (int nt = 0; nt < 8; ++nt) {
                const pg8::bf16x8 vf = *(const LAS pg8::bf16x8*)(vnT + (16 * nt + fr) * 136 + ks * 32 + 8 * fq);
                acc[nt] = __builtin_amdgcn_mfma_f32_16x16x32_bf16(vf, wf, acc[nt], 0, 0, 0);
            }
        }
        const float bias = sb[h * 128 + q]; const size_t t = (size_t)(rowbase + q);
#pragma unroll
        for (int nt = 0; nt < 8; ++nt) { const int c0 = h * 128 + 16 * nt + 4 * fq;
            const u32x2g uu = *(const GAS u32x2g*)(U + t * 512 + c0);
            u32x2g o; o.x = pk2(bf_lo(uu.x) * (acc[nt][0] + bias), bf_hi(uu.x) * (acc[nt][1] + bias)); o.y = pk2(bf_lo(uu.y) * (acc[nt][2] + bias), bf_hi(uu.y) * (acc[nt][3] + bias));
            *(GAS u32x2g*)(AM + t * 1024 + 512 + c0) = o; }
    }
    WG_BAR();
}

struct Args { const float* in[22]; float* out; unsigned char* ws; int ph_lo, ph_hi, li, pad; };
__global__ void __launch_bounds__(NWAVES * 64, 2) mk_fwd(Args args) {
    extern __shared__ __attribute__((aligned(16))) unsigned char lds[];
    Frame F;
    F.lds = (LAS unsigned char*)lds;
    F.MISC = (volatile LAS unsigned*)(F.lds + MISC_OFF);
    F.tid = threadIdx.x; F.lane = F.tid & 63; F.wave = __builtin_amdgcn_readfirstlane(F.tid >> 6);
    F.G = gridDim.x; { const int bx = blockIdx.x; F.vcu = (F.G % 8 == 0) ? (bx % 8) * (F.G / 8) + bx / 8 : bx; }
    Ptrs P;
#pragma unroll
    for (int i = 0; i < 22; ++i) P.in[i] = args.in[i];
    P.out = args.out; P.ws = args.ws;
    unsigned char* ws = args.ws;
    F.ctl = (gu32*)(ws + WS_CTL);
    for (int u = F.tid; u < (LDS_BYTES - LDSCTL_OFF) / 4; u += NWAVES * 64) ((LAS unsigned*)(F.lds + LDSCTL_OFF))[u] = 0u;
    __syncthreads();
    XcdBarrier bar; bar.bar = (unsigned*)(F.ctl + CW_BAR); bar.x = 0; bar.st = nullptr;
    if (!MK_PER_PHASE) bar = xcd_barrier_post((unsigned*)(F.ctl + CW_BAR), F.MISC + 8);
    const int lo = args.ph_lo, hi = args.ph_hi;
#ifndef PH_MASK
#define PH_MASK 0xFFF
#endif
#define IN(k) ((((PH_MASK) >> (k)) & 1) && lo <= (k) && (k) < hi)
#define SEAM(k) do { if (IN(k) && IN((k) + 1)) xcd_barrier(bar); } while (0)
    float* ssq = (float*)(ws + WS_SSQ);
    bf16* XB = (bf16*)(ws + WS_XB); bf16* AM = (bf16*)(ws + WS_AM); bf16* HB = (bf16*)(ws + WS_H);
    const int bid = (int)blockIdx.x;

    if (IN(0)) { p0_prologue(F, P); } SEAM(0);
    if (IN(1)) { pg8::Gemm g{XB, (const bf16*)(ws + WS_WIN0), M, 1536, D}; pg8::StaticOrder So; So.init(M, 1536, F.G, bid);
        pg8::EpiInL0 E{(bf16*)(ws + WS_UB), (bf16*)(ws + WS_PB), ssq};
        pg8::gemm_phase<pg8::EpiInL0, pg8::StaticOrder, true, true>(F.lds + RING_OFF, g, So, E); } SEAM(1);
    if (IN(2)) { for (int it = F.vcu; it < 1024; it += F.G) {
#ifndef NO_CONV
            if (it < 512) mix0_conv_item(F, P, it);
#endif
#ifndef NO_POOL
            if (it >= 512) mix0_pool_item(F, P, it - 512);
#endif
 } } SEAM(2);
    if (IN(3)) { pg8::Gemm g{AM, (const bf16*)(ws + WS_WOUT0), M, D, D}; pg8::StaticOrder So; So.init(M, D, F.G, bid);
        pg8::EpiResid<true> E{P.in[0], P.out, XB, ssq + M};
        pg8::gemm_phase<pg8::EpiResid<true>, pg8::StaticOrder, true, true>(F.lds + RING_OFF, g, So, E); } SEAM(3);
    if (IN(4)) { pg8::Gemm g{XB, (const bf16*)(ws + WS_WGU0), M, 2 * FF, D}; pg8::StaticOrder So; So.init(M, 2 * FF, F.G, bid);
        pg8::EpiSwiGLU E{HB, ssq + M};
        pg8::gemm_phase<pg8::EpiSwiGLU, pg8::StaticOrder, true, true>(F.lds + RING_OFF, g, So, E); } SEAM(4);
    if (IN(5)) { pg8::Gemm g{HB, (const bf16*)(ws + WS_WDN0), M, D, FF}; pg8::StaticOrder So; So.init(M, D, F.G, bid);
        pg8::EpiResid<true> E{P.out, P.out, XB, ssq + 2 * M};
        pg8::gemm_phase<pg8::EpiResid<true>, pg8::StaticOrder, true, true>(F.lds + RING_OFF, g, So, E); } SEAM(5);
    if (IN(6)) {
        { pg8::Gemm g{(const bf16*)(ws + WS_WPQ1), XB, 1024, M, D}; pg8::StaticOrder So; So.init(1024, M, F.G, bid);
          pg8::EpiPQT E{(bf16*)(ws + WS_PQT), ssq + 2 * M};
          pg8::gemm_phase<pg8::EpiPQT, pg8::StaticOrder, true, true>(F.lds + RING_OFF, g, So, E); }
        { pg8::Gemm g{XB, (const bf16*)(ws + WS_WUV1), M, 1024, D}; pg8::StaticOrder So; So.init(M, 1024, F.G, bid);
          pg8::EpiGeluUV E{(bf16*)(ws + WS_U1), (bf16*)(ws + WS_V1), ssq + 2 * M};
          pg8::gemm_phase<pg8::EpiGeluUV, pg8::StaticOrder, true, true>(F.lds + RING_OFF, g, So, E); }
    } SEAM(6);
    if (IN(7)) {
        { pg8::Gemm g{(const bf16*)(ws + WS_DFT), (const bf16*)(ws + WS_PQT), S, NB * 512, 2 * S}; pg8::StaticOrder So; So.init(S, NB * 512, F.G, bid);
          pg8::EpiDFT E{AM};
          pg8::gemm_phase<pg8::EpiDFT, pg8::StaticOrder, true, true>(F.lds + RING_OFF, g, So, E); }
        for (int it = F.vcu; it < 1024; it += F.G) sgu_item(F, P, it);
    } SEAM(7);
    if (IN(8)) { pg8::Gemm g{AM, (const bf16*)(ws + WS_WOUT1), M, D, D}; pg8::StaticOrder So; So.init(M, D, F.G, bid);
        pg8::EpiResid<true> E{P.out, P.out, XB, ssq + 3 * M};
        pg8::gemm_phase<pg8::EpiResid<true>, pg8::StaticOrder, true, true>(F.lds + RING_OFF, g, So, E); } SEAM(8);
    if (IN(9)) { pg8::Gemm g{XB, (const bf16*)(ws + WS_WGU1), M, 2 * FF, D}; pg8::StaticOrder So; So.init(M, 2 * FF, F.G, bid);
        pg8::EpiSwiGLU E{HB, ssq + 3 * M};
        pg8::gemm_phase<pg8::EpiSwiGLU, pg8::StaticOrder, true, true>(F.lds + RING_OFF, g, So, E); } SEAM(9);
    if (IN(10)) { pg8::Gemm g{HB, (const bf16*)(ws + WS_WDN1), M, D, FF}; pg8::StaticOrder So; So.init(M, D, F.G, bid);
        pg8::EpiResid<false> E{P.out, P.out, XB, ssq + 4 * M};
        pg8::gemm_phase<pg8::EpiResid<false>, pg8::StaticOrder, true, true>(F.lds + RING_OFF, g, So, E); } SEAM(10);
    if (IN(11)) {
        const float* gf = P.in[21]; const float* ssq4 = ssq + 4 * M;
        const int gw = F.vcu * NWAVES + F.wave, NGW = F.G * NWAVES;
        for (int m = gw; m < M; m += NGW) {
            GAS f32x4* xr = (GAS f32x4*)(P.out + (size_t)m * D) + F.lane; const GAS f32x4* gr = (const GAS f32x4*)gf + F.lane;
            const float rs = rsqrtf(ssq4[m] * (1.0f / 1024.0f) + 1e-6f);
#pragma unroll
            for (int j = 0; j < 4; ++j) { const f32x4 v = xr[64 * j], gg = gr[64 * j]; xr[64 * j] = v * rs * gg; }
        }
    }
#undef IN
#undef SEAM
}

extern "C" void kernel_launch(void* const* d_in, const int* in_sizes, int n_in, void* d_out, int out_size, void* d_ws, size_t ws_size, hipStream_t stream) {
    static int grid = 0;
    if (grid == 0) {
        if (n_in != 22 || in_sizes[0] != M * D || out_size != M * D || ws_size < WS_END) { fprintf(stderr, "kernel_launch: unexpected shapes (n_in %d, in0 %d, out %d, ws %zu); nothing launched\n", n_in, n_in > 0 ? in_sizes[0] : -1, out_size, ws_size); grid = -1; return; }
        int dev = 0, cus = 0, per_cu = 0;
        if (hipGetDevice(&dev) != hipSuccess || hipDeviceGetAttribute(&cus, hipDeviceAttributeMultiprocessorCount, dev) != hipSuccess) { grid = -1; return; }
        if (hipFuncSetAttribute((const void*)mk_fwd, hipFuncAttributeMaxDynamicSharedMemorySize, LDS_BYTES) != hipSuccess) { fprintf(stderr, "kernel_launch: hipFuncSetAttribute failed\n"); grid = -1; return; }
        if (hipOccupancyMaxActiveBlocksPerMultiprocessor(&per_cu, (const void*)mk_fwd, NWAVES * 64, LDS_BYTES) != hipSuccess || per_cu < 1) { fprintf(stderr, "kernel_launch: occupancy query says %d blocks per CU\n", per_cu); per_cu = 1; }
        (void)hipGetLastError();
        grid = cus * 1;
    }
    if (grid < 0) return;
    if (hipMemsetAsync((char*)d_ws + WS_CTL, 0, CTL_ZERO_BYTES, stream) != hipSuccess) { fprintf(stderr, "kernel_launch: hipMemsetAsync failed\n"); return; }
    Args a{};
    for (int i = 0; i < 22; ++i) a.in[i] = (const float*)d_in[i];
    a.out = (float*)d_out; a.ws = (unsigned char*)d_ws;
#if MK_PER_PHASE
    for (int ph = 0; ph < N_PHASES; ++ph) { a.ph_lo = ph; a.ph_hi = ph + 1; a.li = ph;
        hipLaunchKernelGGL(mk_fwd, dim3(grid), dim3(NWAVES * 64), LDS_BYTES, stream, a); }
#else
    a.ph_lo = 0; a.ph_hi = N_PHASES; a.li = 0;
    void* kargs[] = {&a};
    hipError_t e = hipLaunchCooperativeKernel((const void*)mk_fwd, dim3(grid), dim3(NWAVES * 64), kargs, LDS_BYTES, stream);
    if (e != hipSuccess) fprintf(stderr, "kernel_launch: cooperative launch failed: %s (grid %d)\n", hipGetErrorString(e), grid);
#endif
}
```

```cpp
#include <hip/hip_runtime.h>
#include <cstdio>
#include <cstdint>
namespace pg8 {
#define PG8_LAS __attribute__((address_space(3)))
typedef unsigned short bf16_t;
typedef short bf16x8 __attribute__((ext_vector_type(8)));
typedef float f32x4 __attribute__((ext_vector_type(4)));
typedef unsigned u32x4 __attribute__((ext_vector_type(4)));
constexpr int BM = 256, BK = 64, HALF = 128, HTB = HALF * BK * 2  , STAGE_BYTES = 8 * HTB, NXCD = 8, WGM = 8;

__host__ __device__ __forceinline__ int lds_byte(int r, int c) { const int st = (r >> 4) * 2 + (c >> 5), rr = r & 15, cc = c & 31, ob = rr * 64 + cc * 2; return st * 1024 + (ob ^ (((ob >> 9) & 1) << 5)); }
__host__ __device__ __forceinline__ void stage_rc(int b, int& R, int& C) { const int st = b / 1024, sb = b % 1024, swz = sb ^ (((sb >> 9) & 1) << 5); R = (st >> 1) * 16 + swz / 64; C = (st & 1) * 32 + (swz % 64) / 2; }
__host__ __device__ __forceinline__ int perm32(int rho) { const int n = rho >> 4, i = rho & 15; return 8 * (i >> 2) + 4 * n + (i & 3); }

struct Unit { int pm, pn; };
struct Gemm { const bf16_t* A; const bf16_t* Bt; int M, N, K; };

struct StaticOrder {
    int nM, nN, nwg, G, c;
    __host__ __device__ void init(int M, int N, int G_, int c_) { nM = M / BM; nN = N / BM; nwg = nM * nN; G = G_; c = c_; }
    __host__ __device__ bool next(int i, Unit& u) const {
        const long L = (long)i * G + c; if (L >= nwg) return false;
        int wgid = (int)L; { const int q = nwg / NXCD, r = nwg % NXCD, xcd = wgid % NXCD, off = wgid / NXCD; wgid = (xcd < r ? xcd * (q + 1) : r * (q + 1) + (xcd - r) * q) + off; }
        const int nig = WGM * nN, gid = wgid / nig, fm = gid * WGM, gsz = (nM - fm) < WGM ? (nM - fm) : WGM;
        u.pm = fm + ((wgid % nig) % gsz); u.pn = (wgid % nig) / gsz; return true;
    }
    __device__ __forceinline__ void a_ready(const Unit&) const {}
    __device__ __forceinline__ void done(const Unit&) const {}
};

__device__ __forceinline__ unsigned cvt_pk_bf16(float lo, float hi) { unsigned r; asm volatile("v_cvt_pk_bf16_f32 %0, %1, %2" : "=v"(r) : "v"(lo), "v"(hi)); return r; }
typedef float f32x2 __attribute__((ext_vector_type(2)));
__device__ __forceinline__ f32x2 gelu_pk(f32x2 v) {
    const f32x2 av = __builtin_elementwise_abs(v), d = av * 0.2316418882f + 1.0f;
    f32x2 t; t.x = __builtin_amdgcn_rcpf(d.x); t.y = __builtin_amdgcn_rcpf(d.y);
    f32x2 q = t * 0.5307027145f + (-0.7265760135f); q = q * t + 0.7107068705f; q = q * t + (-0.142248368f); q = q * t + 0.127414796f; q = q * t;
    const f32x2 s = (v * v) * (-0.72134752044f);
    f32x2 e; e.x = __builtin_amdgcn_exp2f(s.x); e.y = __builtin_amdgcn_exp2f(s.y);
    const f32x2 m = v * (q * e), r = v - m;
    f32x2 o; o.x = v.x < 0.f ? m.x : r.x; o.y = v.y < 0.f ? m.y : r.y; return o;
}


constexpr float RMS_EPS = 1e-6f;
__device__ __forceinline__ float sigm(float x) { return __builtin_amdgcn_rcpf(1.0f + __expf(-x)); }
__device__ __forceinline__ u32x4 pack8(const f32x4 v0, const f32x4 v1) { u32x4 w; w.x = cvt_pk_bf16(v0[0], v0[1]); w.y = cvt_pk_bf16(v0[2], v0[3]); w.z = cvt_pk_bf16(v1[0], v1[1]); w.w = cvt_pk_bf16(v1[2], v1[3]); return w; }
typedef unsigned long long u64_t;
__device__ __forceinline__ float rstd_of(u64_t ssq) { return rsqrtf((float)ssq * (1.0f / (1024.0f * 1048576.0f)) + RMS_EPS); }
__device__ __forceinline__ u64_t ssq_fix(float s) { return (u64_t)(s * 1048576.0f); }

struct EpiInL0 {
    static constexpr bool PERM = true, AFTER_DRAIN = false;
    bf16_t* UB; bf16_t* PB; const u64_t* ssq;
    __device__ __forceinline__ void operator()(const f32x4 (&acc)[2][2][4][2], const Unit& u, int wr, int wc, int fr, int fq) const {
        const int row0 = u.pm * BM + wr * 64 + fr, cw = wc * 32 + 8 * fq;
#pragma unroll
        for (int ai = 0; ai < 2; ++ai)
#pragma unroll
            for (int m = 0; m < 4; ++m) {
                const int row = row0 + ai * HALF + m * 16;
                const float rs = rstd_of(ssq[row]);
                if (u.pn < 4) {
                    f32x4 o[2];
#pragma unroll
                    for (int n = 0; n < 2; ++n)
#pragma unroll
                        for (int j = 0; j < 4; ++j) { const float a = acc[ai][0][m][n][j] * rs, g = acc[ai][1][m][n][j] * rs; o[n][j] = a * sigm(g); }
                    *(u32x4*)(UB + (size_t)row * 512 + u.pn * 128 + cw) = pack8(o[0], o[1]);
                } else {
#pragma unroll
                    for (int bj = 0; bj < 2; ++bj) *(u32x4*)(PB + (size_t)row * 512 + (u.pn - 4) * 256 + bj * HALF + cw) = pack8(acc[ai][bj][m][0] * rs, acc[ai][bj][m][1] * rs);
                }
            }
    }
};
struct EpiResid {
    static constexpr bool PERM = true, AFTER_DRAIN = false;
    bf16_t* XB; u64_t* ssq;
    __device__ __forceinline__ void operator()(const f32x4 (&acc)[2][2][4][2], const Unit& u, int wr, int wc, int fr, int fq) const {
        const int row0 = u.pm * BM + wr * 64 + fr, cw = wc * 32 + 8 * fq;
#pragma unroll
        for (int ai = 0; ai < 2; ++ai)
#pragma unroll
            for (int m = 0; m < 4; ++m) {
                const int row = row0 + ai * HALF + m * 16;
                float s = 0.f;
#pragma unroll
                for (int bj = 0; bj < 2; ++bj) {
                    bf16_t* p = XB + (size_t)row * 1024 + u.pn * BM + bj * HALF + cw;
                    const u32x4 r = *(const u32x4*)p;
                    f32x4 v0, v1;
                    v0[0] = __builtin_bit_cast(float, r.x << 16) + acc[ai][bj][m][0][0]; v0[1] = __builtin_bit_cast(float, r.x & 0xffff0000u) + acc[ai][bj][m][0][1];
                    v0[2] = __builtin_bit_cast(float, r.y << 16) + acc[ai][bj][m][0][2]; v0[3] = __builtin_bit_cast(float, r.y & 0xffff0000u) + acc[ai][bj][m][0][3];
                    v1[0] = __builtin_bit_cast(float, r.z << 16) + acc[ai][bj][m][1][0]; v1[1] = __builtin_bit_cast(float, r.z & 0xffff0000u) + acc[ai][bj][m][1][1];
                    v1[2] = __builtin_bit_cast(float, r.w << 16) + acc[ai][bj][m][1][2]; v1[3] = __builtin_bit_cast(float, r.w & 0xffff0000u) + acc[ai][bj][m][1][3];
                    const u32x4 w = pack8(v0, v1);
                    *(u32x4*)p = w;
                    const float q0 = __builtin_bit_cast(float, w.x << 16), q1 = __builtin_bit_cast(float, w.x & 0xffff0000u), q2 = __builtin_bit_cast(float, w.y << 16), q3 = __builtin_bit_cast(float, w.y & 0xffff0000u);
                    const float q4 = __builtin_bit_cast(float, w.z << 16), q5 = __builtin_bit_cast(float, w.z & 0xffff0000u), q6 = __builtin_bit_cast(float, w.w << 16), q7 = __builtin_bit_cast(float, w.w & 0xffff0000u);
                    s += (q0 * q0 + q1 * q1) + (q2 * q2 + q3 * q3) + (q4 * q4 + q5 * q5) + (q6 * q6 + q7 * q7);
                }
                s += __shfl_xor(s, 16); s += __shfl_xor(s, 32);
                if (fq == 0) atomicAdd(ssq + row, ssq_fix(s));
            }
    }
};
struct EpiSwiGLU {
    static constexpr bool PERM = true, AFTER_DRAIN = false;
    bf16_t* H; const u64_t* ssq;
    __device__ __forceinline__ void operator()(const f32x4 (&acc)[2][2][4][2], const Unit& u, int wr, int wc, int fr, int fq) const {
        const int row0 = u.pm * BM + wr * 64 + fr, cw = wc * 32 + 8 * fq;
#pragma unroll
        for (int ai = 0; ai < 2; ++ai)
#pragma unroll
            for (int m = 0; m < 4; ++m) {
                const int row = row0 + ai * HALF + m * 16;
                const float rs = rstd_of(ssq[row]);
                f32x4 o[2];
#pragma unroll
                for (int n = 0; n < 2; ++n)
#pragma unroll
                    for (int j = 0; j < 4; ++j) { const float g = acc[ai][0][m][n][j] * rs, up = acc[ai][1][m][n][j] * rs; o[n][j] = g * sigm(g) * up; }
                *(u32x4*)(H + (size_t)row * 2816 + u.pn * 128 + cw) = pack8(o[0], o[1]);
            }
    }
};
struct EpiPQT {
    static constexpr bool PERM = true, AFTER_DRAIN = false;
    bf16_t* PQT; const u64_t* ssq;
    __device__ __forceinline__ void operator()(const f32x4 (&acc)[2][2][4][2], const Unit& u, int wr, int wc, int fr, int fq) const {
        const int tok0 = u.pn * BM + wc * 32 + 8 * fq, b = (u.pn * BM) >> 12;
        f32x4 rs[2][2];
#pragma unroll
        for (int bj = 0; bj < 2; ++bj)
#pragma unroll
            for (int n = 0; n < 2; ++n)
#pragma unroll
                for (int j = 0; j < 4; ++j) rs[bj][n][j] = rstd_of(ssq[tok0 + bj * HALF + 4 * n + j]);
#pragma unroll
        for (int ai = 0; ai < 2; ++ai)
#pragma unroll
            for (int m = 0; m < 4; ++m) {
                const int r = u.pm * BM + ai * HALF + wr * 64 + m * 16 + fr, pq = r >> 9, ch = r & 511;
                bf16_t* base = PQT + ((size_t)(b * 512 + ch) * 2 + pq) * 4096;
#pragma unroll
                for (int bj = 0; bj < 2; ++bj) *(u32x4*)(base + ((tok0 + bj * HALF) & 4095)) = pack8(acc[ai][bj][m][0] * rs[bj][0], acc[ai][bj][m][1] * rs[bj][1]);
            }
    }
};
struct EpiGeluUV {
    static constexpr bool PERM = true, AFTER_DRAIN = false;
    bf16_t* U; bf16_t* V; const u64_t* ssq;
    __device__ __forceinline__ void operator()(const f32x4 (&acc)[2][2][4][2], const Unit& u, int wr, int wc, int fr, int fq) const {
        const int row0 = u.pm * BM + wr * 64 + fr, cw = wc * 32 + 8 * fq;
        bf16_t* dst = (u.pn < 2) ? U : V; const int colb = (u.pn & 1) * BM;
#pragma unroll
        for (int ai = 0; ai < 2; ++ai)
#pragma unroll
            for (int m = 0; m < 4; ++m) {
                const int row = row0 + ai * HALF + m * 16;
                const float rs = rstd_of(ssq[row]);
#pragma unroll
                for (int bj = 0; bj < 2; ++bj) {
                    const f32x4 v0 = acc[ai][bj][m][0] * rs, v1 = acc[ai][bj][m][1] * rs;
                    const f32x2 a = gelu_pk((f32x2){v0[0], v0[1]}), bq = gelu_pk((f32x2){v0[2], v0[3]}), c = gelu_pk((f32x2){v1[0], v1[1]}), d = gelu_pk((f32x2){v1[2], v1[3]});
                    *(u32x4*)(dst + (size_t)row * 512 + colb + bj * HALF + cw) = pack8((f32x4){a.x, a.y, bq.x, bq.y}, (f32x4){c.x, c.y, d.x, d.y});
                }
            }
    }
};
struct EpiDFT {
    static constexpr bool PERM = true, AFTER_DRAIN = false;
    bf16_t* AM;
    __device__ __forceinline__ void operator()(const f32x4 (&acc)[2][2][4][2], const Unit& u, int wr, int wc, int fr, int fq) const {
        const int row0 = (u.pn >> 1) * 4096 + u.pm * BM + wr * 64 + fr, cw = (u.pn & 1) * BM + wc * 32 + 8 * fq;
#pragma unroll
        for (int ai = 0; ai < 2; ++ai)
#pragma unroll
            for (int m = 0; m < 4; ++m) {
                const int row = row0 + ai * HALF + m * 16;
#pragma unroll
                for (int bj = 0; bj < 2; ++bj) *(u32x4*)(AM + (size_t)row * 1024 + bj * HALF + cw) = pack8(acc[ai][bj][m][0], acc[ai][bj][m][1]);
            }
    }
};

template <class Epi, class Sched, bool ALIGN_EPI = false, bool SP2 = false>
__device__ __forceinline__ void gemm_phase(PG8_LAS unsigned char* lds, const Gemm g, const Sched& S, const Epi& E) {
    const int tid = threadIdx.x, wid = __builtin_amdgcn_readfirstlane(tid >> 6), lane = tid & 63, wr = wid >> 2, wc = wid & 3, fr = lane & 15, fq = lane >> 4;
    const int K = g.K, nt = K / BK;
    unsigned voffA[2], voffB[2];
#pragma unroll
    for (int i = 0; i < 2; ++i) { int R, C; stage_rc(tid * 16 + i * 8192, R, C); const int Rb = Epi::PERM ? ((R & ~31) + perm32(R & 31)) : R;
        voffA[i] = (unsigned)(R * K + C) * 2u; voffB[i] = (unsigned)(Rb * K + C) * 2u; }
    const size_t kstep = (size_t)(BK * 2);
    const size_t hstep = (size_t)HALF * K * 2;
    const size_t tstep = 2 * hstep;
    const unsigned ldsw = (unsigned)wid * 1024u;
    const int aoff = lds_byte(wr * 64 + fr, fq * 8), boff = lds_byte(wc * 32 + fr, fq * 8);
#define PG8_SA(b, h) (((b) * 2 + (h)) * HTB)
#define PG8_SB(b, h) ((4 + (b) * 2 + (h)) * HTB)
#define PG8_STAGE(bufoff, gbase, voff) do { _Pragma("unroll") for (int _i = 0; _i < 2; ++_i) \
        __builtin_amdgcn_global_load_lds((const unsigned*)((const char*)(gbase) + (voff)[_i]), (PG8_LAS unsigned*)(lds + (bufoff) + ldsw + _i * 8192), 16, 0, 0); } while (0)
#define PG8_LDA(dst, b, h) do { _Pragma("unroll") for (int m = 0; m < 4; ++m) _Pragma("unroll") for (int k = 0; k < 2; ++k) dst[m][k] = *(const PG8_LAS bf16x8*)(lds + PG8_SA(b, h) + aoff + m * 2048 + k * 1024); } while (0)
#define PG8_LDB(dst, b, h) do { _Pragma("unroll") for (int n = 0; n < 2; ++n) _Pragma("unroll") for (int k = 0; k < 2; ++k) dst[n][k] = *(const PG8_LAS bf16x8*)(lds + PG8_SB(b, h) + boff + n * 2048 + k * 1024); } while (0)
#define PG8_MMA(ai, bj, At, Bt) do { __builtin_amdgcn_s_setprio(1); _Pragma("unroll") for (int m = 0; m < 4; ++m) _Pragma("unroll") for (int n = 0; n < 2; ++n) _Pragma("unroll") for (int k = 0; k < 2; ++k) \
        acc[ai][bj][m][n] = __builtin_amdgcn_mfma_f32_16x16x32_bf16(Bt[n][k], At[m][k], acc[ai][bj][m][n], 0, 0, 0); __builtin_amdgcn_s_setprio(0); } while (0)
#define PG8_WAIT_V(n) asm volatile("s_waitcnt vmcnt(" #n ")" ::: "memory")
#define PG8_WAIT_L(n) asm volatile("s_waitcnt lgkmcnt(" #n ")" ::: "memory")
#define PG8_BAR __builtin_amdgcn_s_barrier()
#define PG8_SCHED __builtin_amdgcn_sched_barrier(0)
    Unit cur, nxt; int ui = 0;
    if (!S.next(0, cur)) return;
    f32x4 acc[2][2][4][2];
#pragma unroll
    for (int a = 0; a < 2; ++a)
#pragma unroll
        for (int b = 0; b < 2; ++b)
#pragma unroll
            for (int m = 0; m < 4; ++m)
#pragma unroll
                for (int n = 0; n < 2; ++n) acc[a][b][m][n] = (f32x4){0.f, 0.f, 0.f, 0.f};
    bf16x8 At[4][2], B0[2][2], B1[2][2];
    const char* cA = (const char*)g.A + (size_t)cur.pm * tstep; const char* cB = (const char*)g.Bt + (size_t)cur.pn * tstep;
    S.a_ready(cur);
    if constexpr (SP2) {
        PG8_STAGE(PG8_SB(0, 0), cB, voffB); PG8_STAGE(PG8_SB(0, 1), cB + hstep, voffB); PG8_STAGE(PG8_SA(0, 0), cA, voffA); PG8_STAGE(PG8_SA(0, 1), cA + hstep, voffA);
        if (wr == 1) PG8_BAR;
        PG8_WAIT_V(2); PG8_BAR;
        PG8_STAGE(PG8_SB(1, 0), cB + kstep, voffB); PG8_STAGE(PG8_SA(1, 0), cA + kstep, voffA); PG8_STAGE(PG8_SB(1, 1), cB + hstep + kstep, voffB);
        PG8_WAIT_V(6); PG8_BAR;
    } else {
        PG8_STAGE(PG8_SB(0, 0), cB, voffB); PG8_STAGE(PG8_SA(0, 0), cA, voffA); PG8_STAGE(PG8_SB(0, 1), cB + hstep, voffB); PG8_STAGE(PG8_SA(0, 1), cA + hstep, voffA);
        if (wr == 1) PG8_BAR;
        PG8_WAIT_V(4); PG8_BAR;
        PG8_STAGE(PG8_SB(1, 0), cB + kstep, voffB); PG8_STAGE(PG8_SA(1, 0), cA + kstep, voffA); PG8_STAGE(PG8_SB(1, 1), cB + hstep + kstep, voffB);
        PG8_WAIT_V(6); PG8_BAR;
    }
    for (;;) {
        const bool has_next = S.next(ui + 1, nxt);
        const char* nA = has_next ? (const char*)g.A + (size_t)nxt.pm * tstep : cA; const char* nB = has_next ? (const char*)g.Bt + (size_t)nxt.pn * tstep : cB;
        for (int t = 0; t < nt; t += 2) {
            const bool last = (t == nt - 2);
            const char* a1 = cA + (size_t)(t + 1) * kstep;
            const char* a2 = last ? nA : cA + (size_t)(t + 2) * kstep; const char* b2 = last ? nB : cB + (size_t)(t + 2) * kstep;
            const char* a3 = a2 + kstep; const char* b3 = b2 + kstep;
            if (last && has_next) S.a_ready(nxt);
            if constexpr (SP2) {
            PG8_LDB(B0, 0, 0); PG8_LDB(B1, 0, 1); PG8_SCHED; PG8_LDA(At, 0, 0); PG8_STAGE(PG8_SA(1, 1), a1 + hstep, voffA);
            PG8_WAIT_V(8); PG8_WAIT_L(0); PG8_BAR; PG8_MMA(0, 0, At, B0); PG8_MMA(0, 1, At, B1); PG8_BAR; PG8_SCHED;
            PG8_LDA(At, 0, 1); PG8_STAGE(PG8_SB(0, 0), b2, voffB); PG8_STAGE(PG8_SB(0, 1), b2 + hstep, voffB); PG8_STAGE(PG8_SA(0, 0), a2, voffA);
            PG8_WAIT_V(8); PG8_WAIT_L(0); PG8_BAR; PG8_MMA(1, 0, At, B0); PG8_MMA(1, 1, At, B1); PG8_BAR; PG8_SCHED;
            PG8_LDB(B0, 1, 0); PG8_LDB(B1, 1, 1); PG8_SCHED; PG8_LDA(At, 1, 0); PG8_STAGE(PG8_SA(0, 1), a2 + hstep, voffA);
            PG8_WAIT_V(8); PG8_WAIT_L(0); PG8_BAR; PG8_MMA(0, 0, At, B0); PG8_MMA(0, 1, At, B1); PG8_BAR; PG8_SCHED;
            PG8_LDA(At, 1, 1); PG8_STAGE(PG8_SB(1, 0), b3, voffB); PG8_STAGE(PG8_SB(1, 1), b3 + hstep, voffB); PG8_STAGE(PG8_SA(1, 0), a3, voffA);
            PG8_WAIT_V(8); PG8_WAIT_L(0); PG8_BAR; PG8_MMA(1, 0, At, B0); PG8_MMA(1, 1, At, B1); PG8_BAR; PG8_SCHED;
            } else {
            PG8_LDB(B0, 0, 0); PG8_SCHED; PG8_LDA(At, 0, 0); PG8_STAGE(PG8_SA(1, 1), a1 + hstep, voffA);
            PG8_WAIT_L(8); PG8_BAR; PG8_WAIT_L(0); PG8_MMA(0, 0, At, B0); PG8_BAR; PG8_SCHED;
            PG8_LDB(B1, 0, 1); PG8_STAGE(PG8_SB(0, 0), b2, voffB);
            PG8_BAR; PG8_WAIT_L(0); PG8_MMA(0, 1, At, B1); PG8_BAR;
            PG8_LDA(At, 0, 1); PG8_STAGE(PG8_SA(0, 0), a2, voffA);
            PG8_BAR; PG8_WAIT_L(0); PG8_MMA(1, 0, At, B0); PG8_BAR; PG8_SCHED;
            PG8_STAGE(PG8_SB(0, 1), b2 + hstep, voffB);
            PG8_WAIT_V(6); PG8_BAR; PG8_MMA(1, 1, At, B1); PG8_BAR;
            PG8_LDB(B0, 1, 0); PG8_SCHED; PG8_LDA(At, 1, 0); PG8_STAGE(PG8_SA(0, 1), a2 + hstep, voffA);
            PG8_WAIT_L(8); PG8_BAR; PG8_WAIT_L(0); PG8_MMA(0, 0, At, B0); PG8_BAR; PG8_SCHED;
            PG8_LDB(B1, 1, 1); PG8_STAGE(PG8_SB(1, 0), b3, voffB);
            PG8_BAR; PG8_WAIT_L(0); PG8_MMA(0, 1, At, B1); PG8_BAR;
            PG8_LDA(At, 1, 1); PG8_STAGE(PG8_SA(1, 0), a3, voffA);
            PG8_BAR; PG8_WAIT_L(0); PG8_MMA(1, 0, At, B0); PG8_BAR; PG8_SCHED;
            PG8_STAGE(PG8_SB(1, 1), b3 + hstep, voffB);
            PG8_WAIT_V(6); PG8_BAR; PG8_MMA(1, 1, At, B1); PG8_BAR;
            }
        }
        if constexpr (ALIGN_EPI) { if (wr == 0) PG8_BAR; }
        if constexpr (!Epi::AFTER_DRAIN) { E(acc, cur, wr, wc, fr, fq); S.done(cur); }
        if (!has_next) break;
#pragma unroll
        for (int a = 0; a < 2; ++a)
#pragma unroll
            for (int b = 0; b < 2; ++b)
#pragma unroll
                for (int m = 0; m < 4; ++m)
#pragma unroll
                    for (int n = 0; n < 2; ++n) acc[a][b][m][n] = (f32x4){0.f, 0.f, 0.f, 0.f};
        cur = nxt; cA = nA; cB = nB; ++ui;
        if constexpr (ALIGN_EPI) { if (wr == 1) PG8_BAR; }
    }
    PG8_WAIT_V(0);
    if constexpr (!ALIGN_EPI) { if (wr == 0) PG8_BAR; }
    PG8_BAR;
    if constexpr (Epi::AFTER_DRAIN) { E.fused(acc, cur, wr, wc, fr, fq, lds, wid, lane); S.done(cur); }
#undef PG8_SA
#undef PG8_SB
#undef PG8_STAGE
#undef PG8_LDA
#undef PG8_LDB
#undef PG8_MMA
#undef PG8_WAIT_V
#undef PG8_WAIT_L
#undef PG8_BAR
#undef PG8_SCHED
}
}
#define GAS __attribute__((address_space(1)))
#define LAS __attribute__((address_space(3)))
typedef unsigned short bf16;
typedef unsigned v4u __attribute__((ext_vector_type(4)));
typedef float f32x4 __attribute__((ext_vector_type(4)));
typedef short bf16x8 __attribute__((ext_vector_type(8)));
typedef GAS unsigned gu32;
typedef GAS unsigned long long gu64;
#define RLX_AGENT __ATOMIC_RELAXED, __HIP_MEMORY_SCOPE_AGENT
#define LDS_WAIT() asm volatile("s_waitcnt lgkmcnt(0)" ::: "memory")
#define VM_WAIT() asm volatile("s_waitcnt vmcnt(0)" ::: "memory")
__device__ __forceinline__ unsigned long long rt() { return __builtin_amdgcn_s_memrealtime(); }
__device__ __forceinline__ unsigned f2bf(float f) { unsigned u = __builtin_bit_cast(unsigned, f); return (u + 0x7fffu + ((u >> 16) & 1u)) >> 16; }
__device__ __forceinline__ unsigned pk2(float lo, float hi) { return f2bf(lo) | (f2bf(hi) << 16); }

#define XB_TMO      128
#define XB_XCNT(j)  (256  + 64 * (j))
#define XB_XSUB(j)  (1280 + 64 * (j))
#define XB_XGEN(j)  (2304 + 64 * (j))
#define XB_TOP      3328
#define XB_TOPGEN   3392
#define XCD_BAR_WORDS 3456
#define XB_SPIN_CAP (1u << 18)

__device__ __forceinline__ unsigned xb_ld(unsigned* p)              { return __hip_atomic_load(p, __ATOMIC_RELAXED, __HIP_MEMORY_SCOPE_AGENT); }
__device__ __forceinline__ unsigned xb_add(unsigned* p, unsigned v) { return __hip_atomic_fetch_add(p, v, __ATOMIC_RELAXED, __HIP_MEMORY_SCOPE_AGENT); }
__device__ __forceinline__ unsigned xb_xcc_id() { return (unsigned)__builtin_amdgcn_s_getreg((3 << 11) | 20) & 0xFu; }
#define XB_SPIN(cond, bar) do { unsigned _sp = 0; while (cond) { __builtin_amdgcn_s_sleep(1); \
    if ((++_sp & 255u) == 0u) { if (xb_ld(&(bar)[XB_TMO])) break; if (_sp > XB_SPIN_CAP) { atomicAdd(&(bar)[XB_TMO], 1u); break; } } } } while (0)

struct XcdBarrier {
    unsigned* bar; unsigned x;
    volatile LAS unsigned* st;
};

__device__ __forceinline__ XcdBarrier xcd_barrier_post(unsigned* bar, volatile LAS unsigned* st) {
    XcdBarrier b; b.bar = bar; b.x = xb_xcc_id(); b.st = st;
    if (threadIdx.x == 0) (void)xb_add(&bar[XB_XCNT(b.x)], 1u);
    return b;
}
__device__ __forceinline__ void xcd_barrier_complete(unsigned* bar, unsigned x, unsigned& nloc, unsigned& nx) {
    const unsigned G = gridDim.x * gridDim.y * gridDim.z;
    unsigned sum, cnt, mine, sp = 0u;
    for (;;) {
        sum = 0u; cnt = 0u; mine = 0u;
#pragma unroll
        for (unsigned j = 0; j < 16; ++j) { const unsigned c = xb_ld(&bar[XB_XCNT(j)]); sum += c; cnt += (c > 0u) ? 1u : 0u; mine = (j == x) ? c : mine; }
        if (sum == G) break;
        __builtin_amdgcn_s_sleep(1);
        if ((++sp & 255u) == 0u) { if (xb_ld(&bar[XB_TMO])) break; if (sp > XB_SPIN_CAP) { atomicAdd(&bar[XB_TMO], 1u); break; } }
    }
    nloc = mine > 0u ? mine : 1u; nx = cnt > 0u ? cnt : 1u;
}

__device__ __forceinline__ void xcd_barrier(const XcdBarrier& b) {
    asm volatile("s_waitcnt vmcnt(0)" ::: "memory");
    __syncthreads();
    if (threadIdx.x == 0) {
        unsigned* bar = b.bar;
        __builtin_amdgcn_s_waitcnt(0);
        unsigned nloc = b.st[0], nx = b.st[1];
        if (nloc == 0u) { xcd_barrier_complete(bar, b.x, nloc, nx); b.st[0] = nloc; b.st[1] = nx; }
        const unsigned old = xb_add(&bar[XB_XSUB(b.x)], 1u);
        const unsigned gen = old / nloc;
        if (old + 1u == (gen + 1u) * nloc) {
            __builtin_amdgcn_fence(__ATOMIC_RELEASE, "agent");
            asm volatile("s_waitcnt vmcnt(0)" ::: "memory");
            const unsigned og = xb_add(&bar[XB_TOP], 1u);
            const unsigned tg = og / nx;
            if (og + 1u == (tg + 1u) * nx) xb_add(&bar[XB_TOPGEN], 1u);
            else XB_SPIN(xb_ld(&bar[XB_TOPGEN]) == tg, bar);
            __builtin_amdgcn_fence(__ATOMIC_ACQUIRE, "agent");
            xb_add(&bar[XB_XGEN(b.x)], 1u);
            asm volatile("s_waitcnt vmcnt(0)" ::: "memory");
        } else {
            XB_SPIN(xb_ld(&bar[XB_XGEN(b.x)]) == gen, bar);
            __builtin_amdgcn_fence(__ATOMIC_ACQUIRE, "agent");
            asm volatile("s_waitcnt vmcnt(0)" ::: "memory");
        }
    }
    __syncthreads();
}

constexpr int NWAVES = 8;
#ifndef MK_PER_PHASE
#define MK_PER_PHASE 0
#endif
constexpr int N_PHASES = 12;

constexpr int NB = 8, S = 4096, D = 1024, FF = 2816, M = NB * S;
typedef float f32x2g __attribute__((ext_vector_type(2)));
typedef unsigned u32x2g __attribute__((ext_vector_type(2)));

constexpr size_t MiB = 1u << 20;
constexpr size_t WS_CTL = 0, CTL_ZERO_BYTES = 1 * MiB;
constexpr size_t WS_SSQ = 46 * MiB + 512 * 1024;
constexpr size_t WS_WIN0 = 2 * MiB;
constexpr size_t WS_WOUT0 = 5 * MiB;
constexpr size_t WS_WGU0 = 7 * MiB;
constexpr size_t WS_WDN0 = 18 * MiB;
constexpr size_t WS_WPQ1 = 24 * MiB;
constexpr size_t WS_WUV1 = 26 * MiB;
constexpr size_t WS_WOUT1 = 28 * MiB;
constexpr size_t WS_WGU1 = 30 * MiB;
constexpr size_t WS_WDN1 = 41 * MiB;
constexpr size_t WS_DFT = 48 * MiB;
constexpr size_t WS_XB = 112 * MiB;
constexpr size_t WS_AM = 176 * MiB;
constexpr size_t WS_H = 240 * MiB;
constexpr size_t WS_UB = WS_H, WS_PB = WS_H + 32 * MiB;
constexpr size_t WS_PQT = WS_H, WS_U1 = WS_H + 64 * MiB, WS_V1 = WS_H + 96 * MiB;
constexpr size_t WS_END = 416 * MiB;
static_assert(WS_H + (size_t)M * FF * 2 <= WS_END && WS_V1 + (size_t)M * 512 * 2 <= WS_END, "d_ws map");
constexpr int CW_BAR = 4096;

constexpr int RING_OFF = 0, RING_BYTES = 131072;
constexpr int LDSCTL_OFF = RING_BYTES, MISC_OFF = LDSCTL_OFF + 320;
constexpr int LDS_BYTES = 147456;

struct Frame {
    LAS unsigned char* lds;
    volatile LAS unsigned* MISC;
    gu32* ctl;
    int tid, lane, wave;
    int vcu, G;
};
__device__ __forceinline__ float wave_sum(float v) {
#pragma unroll
    for (int o = 1; o < 64; o <<= 1) v += __shfl_xor(v, o);
    return v;
}
__device__ __forceinline__ float bf_lo(unsigned x) { return __builtin_bit_cast(float, x << 16); }
__device__ __forceinline__ float bf_hi(unsigned x) { return __builtin_bit_cast(float, x & 0xffff0000u); }
#define WG_BAR() do { asm volatile("s_waitcnt vmcnt(0) lgkmcnt(0)" ::: "memory"); __builtin_amdgcn_s_barrier(); asm volatile("" ::: "memory"); } while (0)

__device__ __forceinline__ void p0_transpose_item(const float* W, int ldw, const float* gk, bf16* WT, int ldt, int k0, int n0, int dk0, int drow0, LAS float* scr, int lane) {
#pragma unroll 8
    for (int i = 0; i < 32; ++i) { const int kk = 2 * i + (lane >> 5); float v = W[(size_t)(k0 + kk) * ldw + n0 + (lane & 31)]; if (gk) v *= gk[k0 + kk]; scr[kk * 33 + (lane & 31)] = v; }
    LDS_WAIT(); asm volatile("" ::: "memory");
    const int c = lane & 7;
#pragma unroll
    for (int j = 0; j < 4; ++j) { const int n = (lane >> 3) + 8 * j; const LAS float* s = scr + (8 * c) * 33 + n;
        v4u o; o.x = pk2(s[0 * 33], s[1 * 33]); o.y = pk2(s[2 * 33], s[3 * 33]); o.z = pk2(s[4 * 33], s[5 * 33]); o.w = pk2(s[6 * 33], s[7 * 33]);
        *(GAS v4u*)(WT + (size_t)(drow0 + n) * ldt + dk0 + 8 * c) = o; }
    LDS_WAIT(); asm volatile("" ::: "memory");
}
__device__ __forceinline__ void p0_job(const float* W, int ldw, const float* gk, int kbeg, int kext, int ncol0, int next, bf16* WT, int ldt, int dkbase, int mode, int half_or_off,
                                       LAS float* scr, int lane, int gw, int NGW, int& cursor) {
    const int nkb = kext / 64, nnb = next / 32, nitems = nkb * nnb;
    int first = (gw - (cursor % NGW) + NGW) % NGW;
    for (int it = first; it < nitems; it += NGW) {
        const int kb = it / nnb, nb = it % nnb, nrel = 32 * nb;
        const int drow0 = (mode == 0) ? (half_or_off + nrel) : (256 * (nrel >> 7) + 128 * half_or_off + (nrel & 127));
        p0_transpose_item(W, ldw, gk, WT, ldt, kbeg + 64 * kb, ncol0 + nrel, dkbase + 64 * kb, drow0, scr, lane);
    }
    cursor += nitems;
}
__device__ __forceinline__ void p0_fold_item(const float* L, int lrow0, const float* sc, const float* Rm, bf16* out, int dk0, float scale, int dw, int lane) {
    const int d = 64 * dw + lane;
    float acc[8];
#pragma unroll
    for (int j = 0; j < 8; ++j) acc[j] = 0.f;
    for (int cp = 0; cp < 128; ++cp) {
        float r = Rm[(size_t)cp * 1024 + d]; if (sc) r *= sc[cp];
#pragma unroll
        for (int j = 0; j < 8; ++j) acc[j] = fmaf(L[(size_t)(lrow0 + j) * 128 + cp], r, acc[j]);
    }
    v4u o; o.x = pk2(acc[0] * scale, acc[1] * scale); o.y = pk2(acc[2] * scale, acc[3] * scale); o.z = pk2(acc[4] * scale, acc[5] * scale); o.w = pk2(acc[6] * scale, acc[7] * scale);
    *(GAS v4u*)(out + (size_t)d * 1024 + dk0) = o;
}
__device__ __forceinline__ void p0_pq_item(const float* Win1, const float* g1, bf16* WPQ, int h, int half, int k0, const LAS float* tab, int lane) {
    const int cp = 64 * half + lane;
    float ap[8], aq[8], gj[8];
#pragma unroll
    for (int j = 0; j < 8; ++j) { ap[j] = 0.f; aq[j] = 0.f; gj[j] = g1[k0 + j]; }
    for (int c = 0; c < 128; ++c) {
        const int ph = c * cp;
        const float cs = tab[ph & 127], sn = tab[(ph - 32) & 127];
#pragma unroll
        for (int j = 0; j < 8; ++j) { const float w = Win1[(size_t)(k0 + j) * 1536 + h * 128 + c] * gj[j]; ap[j] = fmaf(w, cs, ap[j]); aq[j] = fmaf(w, sn, aq[j]); }
    }
    v4u o; o.x = pk2(ap[0], ap[1]); o.y = pk2(ap[2], ap[3]); o.z = pk2(ap[4], ap[5]); o.w = pk2(ap[6], ap[7]);
    *(GAS v4u*)(WPQ + (size_t)(h * 128 + cp) * 1024 + k0) = o;
    o.x = pk2(aq[0], aq[1]); o.y = pk2(aq[2], aq[3]); o.z = pk2(aq[4], aq[5]); o.w = pk2(aq[6], aq[7]);
    *(GAS v4u*)(WPQ + (size_t)(512 + h * 128 + cp) * 1024 + k0) = o;
}

struct Ptrs {
    const float* in[22]; float* out; unsigned char* ws;
};

__device__ __forceinline__ void p0_prologue(Frame& F, const Ptrs& P) {
    const float* x = P.in[0]; const float* mix_g = P.in[1]; const float* ffn_g = P.in[2];
    const float* ev_w_in = P.in[3]; const float* ev_pool_w = P.in[8]; const float* ev_pool_scale = P.in[9]; const float* ev_w_out = P.in[10];
    const float* od_w_in = P.in[11]; const float* od_fourier_w = P.in[12]; const float* od_w_out = P.in[17];
    const float* w_gate = P.in[18]; const float* w_up = P.in[19]; const float* w_down = P.in[20];
    unsigned char* ws = P.ws;
    LAS float* scr = (LAS float*)(F.lds + RING_OFF + F.wave * 8448);
    LAS float* CT = (LAS float*)(F.lds + RING_OFF + 69632);
    LAS float* tab = (LAS float*)(F.lds + RING_OFF + 69632 + 16384);
    for (int i = F.tid; i < 4096; i += NWAVES * 64) CT[i] = cospif((float)i * (1.0f / 2048.0f));
    if (F.tid < 128) tab[F.tid] = cospif((float)F.tid * (1.0f / 64.0f));
    WG_BAR();
    const int gw = F.vcu * NWAVES + F.wave, NGW = F.G * NWAVES, lane = F.lane;
    { unsigned long long* z = (unsigned long long*)(ws + WS_SSQ) + M; const int gt = F.vcu * NWAVES * 64 + F.tid, NT = F.G * NWAVES * 64;
      for (int i = gt; i < 4 * M; i += NT) z[i] = 0ull; }
    int cur = 0;
    p0_job(ev_w_in, 1536, mix_g, 0, 1024, 0, 512, (bf16*)(ws + WS_WIN0), 1024, 0, 1, 0, scr, lane, gw, NGW, cur);
    p0_job(ev_w_in, 1536, mix_g, 0, 1024, 512, 512, (bf16*)(ws + WS_WIN0), 1024, 0, 1, 1, scr, lane, gw, NGW, cur);
    p0_job(ev_w_in, 1536, mix_g, 0, 1024, 1024, 512, (bf16*)(ws + WS_WIN0), 1024, 0, 0, 1024, scr, lane, gw, NGW, cur);
    p0_job(ev_w_out, 1024, nullptr, 0, 512, 0, 1024, (bf16*)(ws + WS_WOUT0), 1024, 0, 0, 0, scr, lane, gw, NGW, cur);
    p0_job(w_gate, FF, ffn_g, 0, 1024, 0, FF, (bf16*)(ws + WS_WGU0), 1024, 0, 1, 0, scr, lane, gw, NGW, cur);
    p0_job(w_up, FF, ffn_g, 0, 1024, 0, FF, (bf16*)(ws + WS_WGU0), 1024, 0, 1, 1, scr, lane, gw, NGW, cur);
    p0_job(w_down, 1024, nullptr, 0, FF, 0, 1024, (bf16*)(ws + WS_WDN0), FF, 0, 0, 0, scr, lane, gw, NGW, cur);
    p0_job(od_w_in, 1536, mix_g + D, 0, 1024, 512, 1024, (bf16*)(ws + WS_WUV1), 1024, 0, 0, 0, scr, lane, gw, NGW, cur);
    p0_job(od_w_out, 1024, nullptr, 512, 512, 0, 1024, (bf16*)(ws + WS_WOUT1), 1024, 512, 0, 0, scr, lane, gw, NGW, cur);
    p0_job(w_gate + (size_t)D * FF, FF, ffn_g + D, 0, 1024, 0, FF, (bf16*)(ws + WS_WGU1), 1024, 0, 1, 0, scr, lane, gw, NGW, cur);
    p0_job(w_up + (size_t)D * FF, FF, ffn_g + D, 0, 1024, 0, FF, (bf16*)(ws + WS_WGU1), 1024, 0, 1, 1, scr, lane, gw, NGW, cur);
    p0_job(w_down + (size_t)FF * D, 1024, nullptr, 0, FF, 0, 1024, (bf16*)(ws + WS_WDN1), FF, 0, 0, 0, scr, lane, gw, NGW, cur);
    {
        int first = (gw - (cur % NGW) + NGW) % NGW;
        for (int it = first; it < 1024; it += NGW) { const int g = it >> 8, cc = (it >> 4) & 15, dw = it & 15;
            p0_fold_item(ev_pool_w, g * 128 + cc * 8, ev_pool_scale + g * 128, ev_w_out + (size_t)(512 + g * 128) * 1024, (bf16*)(ws + WS_WOUT0), 512 + g * 128 + cc * 8, 1.0f, dw, lane); }
        cur += 1024;
        first = (gw - (cur % NGW) + NGW) % NGW;
        for (int it = first; it < 1024; it += NGW) { const int h = it >> 8, cc = (it >> 4) & 15, dw = it & 15;
            p0_fold_item(od_fourier_w, h * 128 + cc * 8, nullptr, od_w_out + (size_t)(h * 128) * 1024, (bf16*)(ws + WS_WOUT1), h * 128 + cc * 8, 1.0f / 724.0773439350247f, dw, lane); }
        cur += 1024;
        first = (gw - (cur % NGW) + NGW) % NGW;
        for (int it = first; it < 1024; it += NGW) { const int h = it >> 8, half = (it >> 7) & 1, kc = it & 127;
            p0_pq_item(od_w_in, mix_g + D, (bf16*)(ws + WS_WPQ1), h, half, kc * 8, tab, lane); }
        cur += 1024;
    }
    {
        bf16* Dm = (bf16*)(ws + WS_DFT);
        int first = (gw - (cur % NGW) + NGW) % NGW;
        for (int sp = first; sp < S; sp += NGW) {
#pragma unroll 2
            for (int q = 0; q < 16; ++q) {
                const int j0 = (q * 64 + lane) * 8, s0 = j0 & (S - 1), sh = (j0 >> 12) ? 1024 : 0;
                float v[8];
#pragma unroll
                for (int e = 0; e < 8; ++e) v[e] = CT[(((s0 + e) * sp) + sh) & (S - 1)];
                v4u o; o.x = pk2(v[0], v[1]); o.y = pk2(v[2], v[3]); o.z = pk2(v[4], v[5]); o.w = pk2(v[6], v[7]);
                *(GAS v4u*)(Dm + (size_t)sp * (2 * S) + j0) = o;
            }
        }
        cur += S;
    }
    {
        bf16* XB = (bf16*)(ws + WS_XB); unsigned long long* ssq0 = (unsigned long long*)(ws + WS_SSQ);
        for (int m = gw; m < M; m += NGW) {
            const GAS f32x4* xr = (const GAS f32x4*)(x + (size_t)m * D) + lane;
            f32x4 v[4]; float s = 0.f;
#pragma unroll
            for (int j = 0; j < 4; ++j) { v[j] = xr[64 * j]; s += (v[j].x * v[j].x + v[j].y * v[j].y) + (v[j].z * v[j].z + v[j].w * v[j].w); }
            s = wave_sum(s);
            if (lane == 0) ssq0[m] = pg8::ssq_fix(s);
            GAS unsigned long long* o8 = (GAS unsigned long long*)(XB + (size_t)m * D) + lane;
#pragma unroll
            for (int j = 0; j < 4; ++j) o8[64 * j] = (unsigned long long)pk2(v[j].x, v[j].y) | ((unsigned long long)pk2(v[j].z, v[j].w) << 32);
        }
    }
}

__device__ __forceinline__ float reduce_scatter32(float (&v)[32], int lane) {
#pragma unroll
    for (int o = 16; o >= 1; o >>= 1) {
        const bool up = (lane & o) != 0;
#pragma unroll
        for (int i = 0; i < o; ++i) { const float send = up ? v[i] : v[i + o]; const float keep = up ? v[i + o] : v[i]; v[i] = keep + __shfl_xor(send, o); }
    }
    return v[0] + __shfl_xor(v[0], 32);
}
__device__ __forceinline__ void mix0_conv_item(Frame& F, const Ptrs& P, int item) {
    const bf16* UB = (const bf16*)(P.ws + WS_UB); bf16* AM = (bf16*)(P.ws + WS_AM);
    const float* cw = P.in[4]; const float* cb = P.in[5]; const float* lg = P.in[6]; const float* lb = P.in[7];
    const int b = item >> 6, t0 = (item & 63) * 64, rowbase = b * S;
    LAS unsigned* tile = (LAS unsigned*)(F.lds + RING_OFF);
    LAS float* red = (LAS float*)(F.lds + RING_OFF + 98304);
    LAS float* stats = (LAS float*)(F.lds + RING_OFF + 98304 + 1024);
    for (int r = F.wave; r < 94; r += NWAVES) { const int t = t0 - 15 + r; v4u v = {0u, 0u, 0u, 0u};
        if (t >= 0 && t < S) v = *(const GAS v4u*)(UB + (size_t)(rowbase + t) * 512 + F.lane * 8);
        *(LAS v4u*)(tile + r * 256 + F.lane * 4) = v; }
    WG_BAR();
    int tidl = F.tid; asm volatile("" : "+v"(tidl));
    const int rg = tidl >> 8, cp = tidl & 255, lanel = tidl & 63;
    const f32x2g bb = *(const GAS f32x2g*)(cb + 2 * cp);
    const f32x2g g2 = *(const GAS f32x2g*)(lg + 2 * cp), b2 = *(const GAS f32x2g*)(lb + 2 * cp);
#pragma unroll 1
    for (int p = 0; p < 2; ++p) {
        float a0[16], a1[16];
#pragma unroll
        for (int o = 0; o < 16; ++o) { a0[o] = bb.x; a1[o] = bb.y; }
#pragma unroll 1
        for (int th = 0; th < 2; ++th) {
            float w0[16], w1[16];
#pragma unroll
            for (int jj = 0; jj < 16; ++jj) { const int j = 16 * th + jj; f32x2g w = {0.f, 0.f}; if (j < 31) w = *(const GAS f32x2g*)(cw + j * 512 + 2 * cp); w0[jj] = w.x; w1[jj] = w.y; }
            const LAS unsigned* tp = tile + (32 * rg + 16 * p + 16 * th) * 256 + cp;
#pragma unroll
            for (int ii = 0; ii < 31; ++ii) {
                const unsigned xx = tp[ii * 256];
                const float x0 = bf_lo(xx), x1 = bf_hi(xx);
#pragma unroll
                for (int o = 0; o < 16; ++o) { const int jj = ii - o; if (jj >= 0 && jj <= 15) { a0[o] = fmaf(w0[jj], x0, a0[o]); a1[o] = fmaf(w1[jj], x1, a1[o]); } }
            }
        }
        float v[32];
#pragma unroll
        for (int o = 0; o < 16; ++o) { v[2 * o] = a0[o] + a1[o]; v[2 * o + 1] = a0[o] * a0[o] + a1[o] * a1[o]; }
        const float tot = reduce_scatter32(v, lanel);
        if (lanel < 32) red[F.wave * 32 + lanel] = tot;
        WG_BAR();
        if (cp < 16) { const int wb = rg * 4; float s = 0.f, q = 0.f;
#pragma unroll
            for (int w = 0; w < 4; ++w) { s += red[(wb + w) * 32 + 2 * cp]; q += red[(wb + w) * 32 + 2 * cp + 1]; }
            const float mean = s * (1.0f / 512.0f), var = q * (1.0f / 512.0f) - mean * mean;
            stats[(rg * 16 + cp) * 2] = mean; stats[(rg * 16 + cp) * 2 + 1] = rsqrtf(var + 1e-6f); }
        WG_BAR();
#pragma unroll
        for (int o = 0; o < 16; ++o) {
            const float mean = stats[(rg * 16 + o) * 2], rstd = stats[(rg * 16 + o) * 2 + 1];
            float y0 = (a0[o] - mean) * rstd * g2.x + b2.x, y1 = (a1[o] - mean) * rstd * g2.y + b2.y;
            y0 = y0 * __builtin_amdgcn_rcpf(1.0f + __expf(-y0)); y1 = y1 * __builtin_amdgcn_rcpf(1.0f + __expf(-y1));
            *(GAS unsigned*)(AM + (size_t)(rowbase + t0 + 32 * rg + 16 * p + o) * 1024 + 2 * cp) = pk2(y0, y1);
        }
    }
    WG_BAR();
}
__device__ __forceinline__ void mix0_pool_item(Frame& F, const Ptrs& P, int item) {
    const bf16* PB = (const bf16*)(P.ws + WS_PB); bf16* AM = (bf16*)(P.ws + WS_AM);
    const int b = item >> 6, t0 = (item & 63) * 64, rowbase = b * S;
    LAS unsigned* tile = (LAS unsigned*)(F.lds + RING_OFF);
    for (int r = F.wave; r < 79; r += NWAVES) { const int t = t0 - 8 + r; v4u v = {0u, 0u, 0u, 0u};
        if (t >= 0 && t < S) v = *(const GAS v4u*)(PB + (size_t)(rowbase + t) * 512 + F.lane * 8);
        *(LAS v4u*)(tile + r * 256 + F.lane * 4) = v; }
    WG_BAR();
    const int rg = F.tid >> 8, cp = F.tid & 255, h = 1 << (cp >> 6);
    for (int o = 0; o < 32; ++o) {
        const int tl = 32 * rg + o, t = t0 + tl, rc = tl + 8;
        float s0 = 0.f, s1 = 0.f;
        for (int r = rc - h; r < rc + h; ++r) { const unsigned xx = tile[r * 256 + cp]; s0 += bf_lo(xx); s1 += bf_hi(xx); }
        const int lo = (t - h) < 0 ? 0 : (t - h), hi = (t + h - 1) > (S - 1) ? (S - 1) : (t + h - 1);
        const float inv = 1.0f / (float)(hi - lo + 1);
        const unsigned self = tile[rc * 256 + cp];
        *(GAS unsigned*)(AM + (size_t)(rowbase + t) * 1024 + 512 + 2 * cp) = pk2(s0 * inv - bf_lo(self), s1 * inv - bf_hi(self));
    }
    WG_BAR();
}

__device__ __forceinline__ void sgu_item(Frame& F, const Ptrs& P, int item) {
    const bf16* U = (const bf16*)(P.ws + WS_U1); const bf16* V = (const bf16*)(P.ws + WS_V1); bf16* AM = (bf16*)(P.ws + WS_AM);
    const float* lng = P.in[13]; const float* lnb = P.in[14]; const float* sw = P.in[15]; const float* sb = P.in[16];
    const int h = item & 3, rowbase = (item >> 2) * 128;
    LAS bf16* vnT = (LAS bf16*)(F.lds + RING_OFF);
    const int lane = F.lane;
    {
        const f32x2g g2 = *(const GAS f32x2g*)(lng + h * 128 + 2 * lane), b2 = *(const GAS f32x2g*)(lnb + h * 128 + 2 * lane);
        for (int i = 0; i < 16; ++i) { const int k = F.wave + 8 * i;
            const unsigned xx = *(const GAS unsigned*)(V + (size_t)(rowbase + k) * 512 + h * 128 + 2 * lane);
            const float v0 = bf_lo(xx), v1 = bf_hi(xx);
            const float mean = wave_sum(v0 + v1) * (1.0f / 128.0f), d0 = v0 - mean, d1 = v1 - mean;
            const float rstd = rsqrtf(wave_sum(d0 * d0 + d1 * d1) * (1.0f / 128.0f) + 1e-6f);
            vnT[(2 * lane) * 136 + k] = (bf16)f2bf(d0 * rstd * g2.x + b2.x); vnT[(2 * lane + 1) * 136 + k] = (bf16)f2bf(d1 * rstd * g2.y + b2.y); }
    }
    WG_BAR();
    {
        const int fr = lane & 15, fq = lane >> 4, q = 16 * F.wave + fr;
        pg8::f32x4 acc[8];
#pragma unroll
        for (int nt = 0; nt < 8; ++nt) acc[nt] = (pg8::f32x4){0.f, 0.f, 0.f, 0.f};
#pragma unroll
        for (int ks = 0; ks < 4; ++ks) {
            const GAS pg8::f32x4* wp = (const GAS pg8::f32x4*)(sw + (size_t)(h * 128 + q) * 128 + ks * 32 + 8 * fq);
            const pg8::f32x4 wa = wp[0], wb = wp[1];
            pg8::u32x4 wq; wq.x = pk2(wa[0], wa[1]); wq.y = pk2(wa[2], wa[3]); wq.z = pk2(wb[0], wb[1]); wq.w = pk2(wb[2], wb[3]);
            const pg8::bf16x8 wf = __builtin_bit_cast(pg8::bf16x8, wq);
#pragma unroll
            for (int nt = 0; nt < 8; ++nt) {
                const pg8::bf16x8 vf = *(const LAS pg8::bf16x8*)(vnT + (16 * nt + fr) * 136 + ks * 32 + 8 * fq);
                acc[nt] = __builtin_amdgcn_mfma_f32_16x16x32_bf16(vf, wf, acc[nt], 0, 0, 0);
            }
        }
        const float bias = sb[h * 128 + q]; const size_t t = (size_t)(rowbase + q);
#pragma unroll
        for (int nt = 0; nt < 8; ++nt) { const int c0 = h * 128 + 16 * nt + 4 * fq;
            const u32x2g uu = *(const GAS u32x2g*)(U + t * 512 + c0);
            u32x2g o; o.x = pk2(bf_lo(uu.x) * (acc[nt][0] + bias), bf_hi(uu.x) * (acc[nt][1] + bias)); o.y = pk2(bf_lo(uu.y) * (acc[nt][2] + bias), bf_hi(uu.y) * (acc[nt][3] + bias));
            *(GAS u32x2g*)(AM + t * 1024 + 512 + c0) = o; }
    }
    WG_BAR();
}

struct Args { const float* in[22]; float* out; unsigned char* ws; int ph_lo, ph_hi, li, pad; };
__global__ void __launch_bounds__(NWAVES * 64, 2) mk_fwd(Args args) {
    extern __shared__ __attribute__((aligned(16))) unsigned char lds[];
    Frame F;
    F.lds = (LAS unsigned char*)lds;
    F.MISC = (volatile LAS unsigned*)(F.lds + MISC_OFF);
    F.tid = threadIdx.x; F.lane = F.tid & 63; F.wave = __builtin_amdgcn_readfirstlane(F.tid >> 6);
    F.G = gridDim.x; { const int bx = blockIdx.x; F.vcu = (F.G % 8 == 0) ? (bx % 8) * (F.G / 8) + bx / 8 : bx; }
    Ptrs P;
#pragma unroll
    for (int i = 0; i < 22; ++i) P.in[i] = args.in[i];
    P.out = args.out; P.ws = args.ws;
    unsigned char* ws = args.ws;
    F.ctl = (gu32*)(ws + WS_CTL);
    for (int u = F.tid; u < (LDS_BYTES - LDSCTL_OFF) / 4; u += NWAVES * 64) ((LAS unsigned*)(F.lds + LDSCTL_OFF))[u] = 0u;
    __syncthreads();
    XcdBarrier bar; bar.bar = (unsigned*)(F.ctl + CW_BAR); bar.x = 0; bar.st = nullptr;
    if (!MK_PER_PHASE) bar = xcd_barrier_post((unsigned*)(F.ctl + CW_BAR), F.MISC + 8);
    const int lo = args.ph_lo, hi = args.ph_hi;
#ifndef PH_MASK
#define PH_MASK 0xFFF
#endif
#define IN(k) ((((PH_MASK) >> (k)) & 1) && lo <= (k) && (k) < hi)
#define SEAM(k) do { if (IN(k) && IN((k) + 1)) xcd_barrier(bar); } while (0)
    unsigned long long* ssq = (unsigned long long*)(ws + WS_SSQ);
    bf16* XB = (bf16*)(ws + WS_XB); bf16* AM = (bf16*)(ws + WS_AM); bf16* HB = (bf16*)(ws + WS_H);
    const int bid = (int)blockIdx.x;

    if (IN(0)) { p0_prologue(F, P); } SEAM(0);
    if (IN(1)) { pg8::Gemm g{XB, (const bf16*)(ws + WS_WIN0), M, 1536, D}; pg8::StaticOrder So; So.init(M, 1536, F.G, bid);
        pg8::EpiInL0 E{(bf16*)(ws + WS_UB), (bf16*)(ws + WS_PB), ssq};
        pg8::gemm_phase<pg8::EpiInL0, pg8::StaticOrder, true, true>(F.lds + RING_OFF, g, So, E); } SEAM(1);
    if (IN(2)) { for (int it = F.vcu; it < 1024; it += F.G) {
#ifndef NO_CONV
            if (it < 512) mix0_conv_item(F, P, it);
#endif
#ifndef NO_POOL
            if (it >= 512) mix0_pool_item(F, P, it - 512);
#endif
 } } SEAM(2);
    if (IN(3)) { pg8::Gemm g{AM, (const bf16*)(ws + WS_WOUT0), M, D, D}; pg8::StaticOrder So; So.init(M, D, F.G, bid);
        pg8::EpiResid E{XB, ssq + M};
        pg8::gemm_phase<pg8::EpiResid, pg8::StaticOrder, true, true>(F.lds + RING_OFF, g, So, E); } SEAM(3);
    if (IN(4)) { pg8::Gemm g{XB, (const bf16*)(ws + WS_WGU0), M, 2 * FF, D}; pg8::StaticOrder So; So.init(M, 2 * FF, F.G, bid);
        pg8::EpiSwiGLU E{HB, ssq + M};
        pg8::gemm_phase<pg8::EpiSwiGLU, pg8::StaticOrder, true, true>(F.lds + RING_OFF, g, So, E); } SEAM(4);
    if (IN(5)) { pg8::Gemm g{HB, (const bf16*)(ws + WS_WDN0), M, D, FF}; pg8::StaticOrder So; So.init(M, D, F.G, bid);
        pg8::EpiResid E{XB, ssq + 2 * M};
        pg8::gemm_phase<pg8::EpiResid, pg8::StaticOrder, true, true>(F.lds + RING_OFF, g, So, E); } SEAM(5);
    if (IN(6)) {
        { pg8::Gemm g{(const bf16*)(ws + WS_WPQ1), XB, 1024, M, D}; pg8::StaticOrder So; So.init(1024, M, F.G, bid);
          pg8::EpiPQT E{(bf16*)(ws + WS_PQT), ssq + 2 * M};
          pg8::gemm_phase<pg8::EpiPQT, pg8::StaticOrder, true, true>(F.lds + RING_OFF, g, So, E); }
        { pg8::Gemm g{XB, (const bf16*)(ws + WS_WUV1), M, 1024, D}; pg8::StaticOrder So; So.init(M, 1024, F.G, bid);
          pg8::EpiGeluUV E{(bf16*)(ws + WS_U1), (bf16*)(ws + WS_V1), ssq + 2 * M};
          pg8::gemm_phase<pg8::EpiGeluUV, pg8::StaticOrder, true, true>(F.lds + RING_OFF, g, So, E); }
    } SEAM(6);
    if (IN(7)) {
        { pg8::Gemm g{(const bf16*)(ws + WS_DFT), (const bf16*)(ws + WS_PQT), S, NB * 512, 2 * S}; pg8::StaticOrder So; So.init(S, NB * 512, F.G, bid);
          pg8::EpiDFT E{AM};
          pg8::gemm_phase<pg8::EpiDFT, pg8::StaticOrder, true, true>(F.lds + RING_OFF, g, So, E); }
        for (int it = F.vcu; it < 1024; it += F.G) sgu_item(F, P, it);
    } SEAM(7);
    if (IN(8)) { pg8::Gemm g{AM, (const bf16*)(ws + WS_WOUT1), M, D, D}; pg8::StaticOrder So; So.init(M, D, F.G, bid);
        pg8::EpiResid E{XB, ssq + 3 * M};
        pg8::gemm_phase<pg8::EpiResid, pg8::StaticOrder, true, true>(F.lds + RING_OFF, g, So, E); } SEAM(8);
    if (IN(9)) { pg8::Gemm g{XB, (const bf16*)(ws + WS_WGU1), M, 2 * FF, D}; pg8::StaticOrder So; So.init(M, 2 * FF, F.G, bid);
        pg8::EpiSwiGLU E{HB, ssq + 3 * M};
        pg8::gemm_phase<pg8::EpiSwiGLU, pg8::StaticOrder, true, true>(F.lds + RING_OFF, g, So, E); } SEAM(9);
    if (IN(10)) { pg8::Gemm g{HB, (const bf16*)(ws + WS_WDN1), M, D, FF}; pg8::StaticOrder So; So.init(M, D, F.G, bid);
        pg8::EpiResid E{XB, ssq + 4 * M};
        pg8::gemm_phase<pg8::EpiResid, pg8::StaticOrder, true, true>(F.lds + RING_OFF, g, So, E); } SEAM(10);
    if (IN(11)) {
        const float* gf = P.in[21]; const unsigned long long* ssq4 = ssq + 4 * M;
        const int gw = F.vcu * NWAVES + F.wave, NGW = F.G * NWAVES;
        for (int m = gw; m < M; m += NGW) {
            const GAS u32x2g* xr = (const GAS u32x2g*)(XB + (size_t)m * D) + F.lane; GAS f32x4* orow = (GAS f32x4*)(P.out + (size_t)m * D) + F.lane; const GAS f32x4* gr = (const GAS f32x4*)gf + F.lane;
            const float rs = pg8::rstd_of(ssq4[m]);
#pragma unroll
            for (int j = 0; j < 4; ++j) { const u32x2g xx = xr[64 * j]; const f32x4 gg = gr[64 * j];
                f32x4 v; v.x = bf_lo(xx.x); v.y = bf_hi(xx.x); v.z = bf_lo(xx.y); v.w = bf_hi(xx.y); orow[64 * j] = v * rs * gg; }
        }
    }
#undef IN
#undef SEAM
}

extern "C" void kernel_launch(void* const* d_in, const int* in_sizes, int n_in, void* d_out, int out_size, void* d_ws, size_t ws_size, hipStream_t stream) {
    static int grid = 0;
    if (grid == 0) {
        if (n_in != 22 || in_sizes[0] != M * D || out_size != M * D || ws_size < WS_END) { fprintf(stderr, "kernel_launch: unexpected shapes (n_in %d, in0 %d, out %d, ws %zu); nothing launched\n", n_in, n_in > 0 ? in_sizes[0] : -1, out_size, ws_size); grid = -1; return; }
        int dev = 0, cus = 0, per_cu = 0;
        if (hipGetDevice(&dev) != hipSuccess || hipDeviceGetAttribute(&cus, hipDeviceAttributeMultiprocessorCount, dev) != hipSuccess) { grid = -1; return; }
        if (hipFuncSetAttribute((const void*)mk_fwd, hipFuncAttributeMaxDynamicSharedMemorySize, LDS_BYTES) != hipSuccess) { fprintf(stderr, "kernel_launch: hipFuncSetAttribute failed\n"); grid = -1; return; }
        if (hipOccupancyMaxActiveBlocksPerMultiprocessor(&per_cu, (const void*)mk_fwd, NWAVES * 64, LDS_BYTES) != hipSuccess || per_cu < 1) { fprintf(stderr, "kernel_launch: occupancy query says %d blocks per CU\n", per_cu); per_cu = 1; }
        (void)hipGetLastError();
        grid = cus * 1;
    }
    if (grid < 0) return;
    if (hipMemsetAsync((char*)d_ws + WS_CTL, 0, CTL_ZERO_BYTES, stream) != hipSuccess) { fprintf(stderr, "kernel_launch: hipMemsetAsync failed\n"); return; }
    Args a{};
    for (int i = 0; i < 22; ++i) a.in[i] = (const float*)d_in[i];
    a.out = (float*)d_out; a.ws = (unsigned char*)d_ws;
#if MK_PER_PHASE
    for (int ph = 0; ph < N_PHASES; ++ph) { a.ph_lo = ph; a.ph_hi = ph + 1; a.li = ph;
        hipLaunchKernelGGL(mk_fwd, dim3(grid), dim3(NWAVES * 64), LDS_BYTES, stream, a); }
#else
    a.ph_lo = 0; a.ph_hi = N_PHASES; a.li = 0;
    void* kargs[] = {&a};
    hipError_t e = hipLaunchCooperativeKernel((const void*)mk_fwd, dim3(grid), dim3(NWAVES * 64), kargs, LDS_BYTES, stream);
    if (e != hipSuccess) fprintf(stderr, "kernel_launch: cooperative launch failed: %s (grid %d)\n", hipGetErrorString(e), grid);
#endif
}
```

```cpp
#include <hip/hip_runtime.h>
#include <cstdio>
#include <cstdint>
namespace pg8 {
#define PG8_LAS __attribute__((address_space(3)))
typedef unsigned short bf16_t;
typedef short bf16x8 __attribute__((ext_vector_type(8)));
typedef float f32x4 __attribute__((ext_vector_type(4)));
typedef unsigned u32x4 __attribute__((ext_vector_type(4)));
constexpr int BM = 256, BK = 64, HALF = 128, HTB = HALF * BK * 2  , STAGE_BYTES = 8 * HTB, NXCD = 8, WGM = 8;

__host__ __device__ __forceinline__ int lds_byte(int r, int c) { const int st = (r >> 4) * 2 + (c >> 5), rr = r & 15, cc = c & 31, ob = rr * 64 + cc * 2; return st * 1024 + (ob ^ (((ob >> 9) & 1) << 5)); }
__host__ __device__ __forceinline__ void stage_rc(int b, int& R, int& C) { const int st = b / 1024, sb = b % 1024, swz = sb ^ (((sb >> 9) & 1) << 5); R = (st >> 1) * 16 + swz / 64; C = (st & 1) * 32 + (swz % 64) / 2; }
__host__ __device__ __forceinline__ int perm32(int rho) { const int n = rho >> 4, i = rho & 15; return 8 * (i >> 2) + 4 * n + (i & 3); }

struct Unit { int pm, pn; };
struct Gemm { const bf16_t* A; const bf16_t* Bt; int M, N, K; };

struct StaticOrder {
    int nM, nN, nwg, G, c;
    __host__ __device__ void init(int M, int N, int G_, int c_) { nM = M / BM; nN = N / BM; nwg = nM * nN; G = G_; c = c_; }
    __host__ __device__ bool next(int i, Unit& u) const {
        const long L = (long)i * G + c; if (L >= nwg) return false;
        int wgid = (int)L; { const int q = nwg / NXCD, r = nwg % NXCD, xcd = wgid % NXCD, off = wgid / NXCD; wgid = (xcd < r ? xcd * (q + 1) : r * (q + 1) + (xcd - r) * q) + off; }
        const int nig = WGM * nN, gid = wgid / nig, fm = gid * WGM, gsz = (nM - fm) < WGM ? (nM - fm) : WGM;
        u.pm = fm + ((wgid % nig) % gsz); u.pn = (wgid % nig) / gsz; return true;
    }
    __device__ __forceinline__ void a_ready(const Unit&) const {}
    __device__ __forceinline__ void done(const Unit&) const {}
};

__device__ __forceinline__ unsigned cvt_pk_bf16(float lo, float hi) { unsigned r; asm volatile("v_cvt_pk_bf16_f32 %0, %1, %2" : "=v"(r) : "v"(lo), "v"(hi)); return r; }
typedef float f32x2 __attribute__((ext_vector_type(2)));
__device__ __forceinline__ f32x2 gelu_pk(f32x2 v) {
    const f32x2 av = __builtin_elementwise_abs(v), d = av * 0.2316418882f + 1.0f;
    f32x2 t; t.x = __builtin_amdgcn_rcpf(d.x); t.y = __builtin_amdgcn_rcpf(d.y);
    f32x2 q = t * 0.5307027145f + (-0.7265760135f); q = q * t + 0.7107068705f; q = q * t + (-0.142248368f); q = q * t + 0.127414796f; q = q * t;
    const f32x2 s = (v * v) * (-0.72134752044f);
    f32x2 e; e.x = __builtin_amdgcn_exp2f(s.x); e.y = __builtin_amdgcn_exp2f(s.y);
    const f32x2 m = v * (q * e), r = v - m;
    f32x2 o; o.x = v.x < 0.f ? m.x : r.x; o.y = v.y < 0.f ? m.y : r.y; return o;
}


constexpr float RMS_EPS = 1e-6f;
__device__ __forceinline__ float sigm(float x) { return __builtin_amdgcn_rcpf(1.0f + __expf(-x)); }
__device__ __forceinline__ u32x4 pack8(const f32x4 v0, const f32x4 v1) { u32x4 w; w.x = cvt_pk_bf16(v0[0], v0[1]); w.y = cvt_pk_bf16(v0[2], v0[3]); w.z = cvt_pk_bf16(v1[0], v1[1]); w.w = cvt_pk_bf16(v1[2], v1[3]); return w; }
typedef unsigned long long u64_t;
__device__ __forceinline__ float rstd_of(u64_t ssq) { return rsqrtf((float)ssq * (1.0f / (1024.0f * 1048576.0f)) + RMS_EPS); }
__device__ __forceinline__ u64_t ssq_fix(float s) { return (u64_t)(s * 1048576.0f); }

struct EpiInL0 {
    static constexpr bool PERM = true, AFTER_DRAIN = false;
    bf16_t* UB; bf16_t* PB; const u64_t* ssq;
    __device__ __forceinline__ void operator()(const f32x4 (&acc)[2][2][4][2], const Unit& u, int wr, int wc, int fr, int fq) const {
        const int row0 = u.pm * BM + wr * 64 + fr, cw = wc * 32 + 8 * fq;
#pragma unroll
        for (int ai = 0; ai < 2; ++ai)
#pragma unroll
            for (int m = 0; m < 4; ++m) {
                const int row = row0 + ai * HALF + m * 16;
                const float rs = rstd_of(ssq[row]);
                if (u.pn < 4) {
                    f32x4 o[2];
#pragma unroll
                    for (int n = 0; n < 2; ++n)
#pragma unroll
                        for (int j = 0; j < 4; ++j) { const float a = acc[ai][0][m][n][j] * rs, g = acc[ai][1][m][n][j] * rs; o[n][j] = a * sigm(g); }
                    *(u32x4*)(UB + (size_t)row * 512 + u.pn * 128 + cw) = pack8(o[0], o[1]);
                } else {
#pragma unroll
                    for (int bj = 0; bj < 2; ++bj) *(u32x4*)(PB + (size_t)row * 512 + (u.pn - 4) * 256 + bj * HALF + cw) = pack8(acc[ai][bj][m][0] * rs, acc[ai][bj][m][1] * rs);
                }
            }
    }
};
struct EpiResid {
    static constexpr bool PERM = true, AFTER_DRAIN = false;
    bf16_t* XB; u64_t* ssq; bf16_t* XBw;
    __device__ __forceinline__ void operator()(const f32x4 (&acc)[2][2][4][2], const Unit& u, int wr, int wc, int fr, int fq) const {
        const int row0 = u.pm * BM + wr * 64 + fr, cw = wc * 32 + 8 * fq;
#pragma unroll
        for (int ai = 0; ai < 2; ++ai)
#pragma unroll
            for (int m = 0; m < 4; ++m) {
                const int row = row0 + ai * HALF + m * 16;
                float s = 0.f;
#pragma unroll
                for (int bj = 0; bj < 2; ++bj) {
                    bf16_t* p = XB + (size_t)row * 1024 + u.pn * BM + bj * HALF + cw;
                    const u32x4 r = *(const u32x4*)p;
                    f32x4 v0, v1;
                    v0[0] = __builtin_bit_cast(float, r.x << 16) + acc[ai][bj][m][0][0]; v0[1] = __builtin_bit_cast(float, r.x & 0xffff0000u) + acc[ai][bj][m][0][1];
                    v0[2] = __builtin_bit_cast(float, r.y << 16) + acc[ai][bj][m][0][2]; v0[3] = __builtin_bit_cast(float, r.y & 0xffff0000u) + acc[ai][bj][m][0][3];
                    v1[0] = __builtin_bit_cast(float, r.z << 16) + acc[ai][bj][m][1][0]; v1[1] = __builtin_bit_cast(float, r.z & 0xffff0000u) + acc[ai][bj][m][1][1];
                    v1[2] = __builtin_bit_cast(float, r.w << 16) + acc[ai][bj][m][1][2]; v1[3] = __builtin_bit_cast(float, r.w & 0xffff0000u) + acc[ai][bj][m][1][3];
                    const u32x4 w = pack8(v0, v1);
                    *(u32x4*)(XBw + ((size_t)row * 1024 + u.pn * BM + bj * HALF + cw)) = w;
                    const float q0 = __builtin_bit_cast(float, w.x << 16), q1 = __builtin_bit_cast(float, w.x & 0xffff0000u), q2 = __builtin_bit_cast(float, w.y << 16), q3 = __builtin_bit_cast(float, w.y & 0xffff0000u);
                    const float q4 = __builtin_bit_cast(float, w.z << 16), q5 = __builtin_bit_cast(float, w.z & 0xffff0000u), q6 = __builtin_bit_cast(float, w.w << 16), q7 = __builtin_bit_cast(float, w.w & 0xffff0000u);
                    s += (q0 * q0 + q1 * q1) + (q2 * q2 + q3 * q3) + (q4 * q4 + q5 * q5) + (q6 * q6 + q7 * q7);
                }
                s += __shfl_xor(s, 16); s += __shfl_xor(s, 32);
                if (fq == 0) atomicAdd(ssq + row, ssq_fix(s));
            }
    }
};
struct EpiSwiGLU {
    static constexpr bool PERM = true, AFTER_DRAIN = false;
    bf16_t* H; const u64_t* ssq;
    __device__ __forceinline__ void operator()(const f32x4 (&acc)[2][2][4][2], const Unit& u, int wr, int wc, int fr, int fq) const {
        const int row0 = u.pm * BM + wr * 64 + fr, cw = wc * 32 + 8 * fq;
#pragma unroll
        for (int ai = 0; ai < 2; ++ai)
#pragma unroll
            for (int m = 0; m < 4; ++m) {
                const int row = row0 + ai * HALF + m * 16;
                const float rs = rstd_of(ssq[row]);
                f32x4 o[2];
#pragma unroll
                for (int n = 0; n < 2; ++n)
#pragma unroll
                    for (int j = 0; j < 4; ++j) { const float g = acc[ai][0][m][n][j] * rs, up = acc[ai][1][m][n][j] * rs; o[n][j] = g * sigm(g) * up; }
                *(u32x4*)(H + (size_t)row * 2816 + u.pn * 128 + cw) = pack8(o[0], o[1]);
            }
    }
};
struct EpiPQT {
    static constexpr bool PERM = true, AFTER_DRAIN = false;
    bf16_t* PQT; const u64_t* ssq;
    __device__ __forceinline__ void operator()(const f32x4 (&acc)[2][2][4][2], const Unit& u, int wr, int wc, int fr, int fq) const {
        const int tok0 = u.pn * BM + wc * 32 + 8 * fq, b = (u.pn * BM) >> 12;
        f32x4 rs[2][2];
#pragma unroll
        for (int bj = 0; bj < 2; ++bj)
#pragma unroll
            for (int n = 0; n < 2; ++n)
#pragma unroll
                for (int j = 0; j < 4; ++j) rs[bj][n][j] = rstd_of(ssq[tok0 + bj * HALF + 4 * n + j]);
#pragma unroll
        for (int ai = 0; ai < 2; ++ai)
#pragma unroll
            for (int m = 0; m < 4; ++m) {
                const int r = u.pm * BM + ai * HALF + wr * 64 + m * 16 + fr, pq = r >> 9, ch = r & 511;
                bf16_t* base = PQT + ((size_t)(b * 512 + ch) * 2 + pq) * 4096;
#pragma unroll
                for (int bj = 0; bj < 2; ++bj) *(u32x4*)(base + ((tok0 + bj * HALF) & 4095)) = pack8(acc[ai][bj][m][0] * rs[bj][0], acc[ai][bj][m][1] * rs[bj][1]);
            }
    }
};
struct EpiGeluUV {
    static constexpr bool PERM = true, AFTER_DRAIN = false;
    bf16_t* U; bf16_t* V; const u64_t* ssq;
    __device__ __forceinline__ void operator()(const f32x4 (&acc)[2][2][4][2], const Unit& u, int wr, int wc, int fr, int fq) const {
        const int row0 = u.pm * BM + wr * 64 + fr, cw = wc * 32 + 8 * fq;
        bf16_t* dst = (u.pn < 2) ? U : V; const int colb = (u.pn & 1) * BM;
#pragma unroll
        for (int ai = 0; ai < 2; ++ai)
#pragma unroll
            for (int m = 0; m < 4; ++m) {
                const int row = row0 + ai * HALF + m * 16;
                const float rs = rstd_of(ssq[row]);
#pragma unroll
                for (int bj = 0; bj < 2; ++bj) {
                    const f32x4 v0 = acc[ai][bj][m][0] * rs, v1 = acc[ai][bj][m][1] * rs;
                    const f32x2 a = gelu_pk((f32x2){v0[0], v0[1]}), bq = gelu_pk((f32x2){v0[2], v0[3]}), c = gelu_pk((f32x2){v1[0], v1[1]}), d = gelu_pk((f32x2){v1[2], v1[3]});
                    *(u32x4*)(dst + (size_t)row * 512 + colb + bj * HALF + cw) = pack8((f32x4){a.x, a.y, bq.x, bq.y}, (f32x4){c.x, c.y, d.x, d.y});
                }
            }
    }
};
struct EpiDFT {
    static constexpr bool PERM = true, AFTER_DRAIN = false;
    bf16_t* AM;
    __device__ __forceinline__ void operator()(const f32x4 (&acc)[2][2][4][2], const Unit& u, int wr, int wc, int fr, int fq) const {
        const int row0 = (u.pn >> 1) * 4096 + u.pm * BM + wr * 64 + fr, cw = (u.pn & 1) * BM + wc * 32 + 8 * fq;
#pragma unroll
        for (int ai = 0; ai < 2; ++ai)
#pragma unroll
            for (int m = 0; m < 4; ++m) {
                const int row = row0 + ai * HALF + m * 16;
#pragma unroll
                for (int bj = 0; bj < 2; ++bj) *(u32x4*)(AM + (size_t)row * 1024 + bj * HALF + cw) = pack8(acc[ai][bj][m][0], acc[ai][bj][m][1]);
            }
    }
};

template <class Epi, class Sched, bool ALIGN_EPI = false, bool SP2 = false>
__device__ __forceinline__ void gemm_phase(PG8_LAS unsigned char* lds, const Gemm g, const Sched& S, const Epi& E) {
    const int tid = threadIdx.x, wid = __builtin_amdgcn_readfirstlane(tid >> 6), lane = tid & 63, wr = wid >> 2, wc = wid & 3, fr = lane & 15, fq = lane >> 4;
    const int K = g.K, nt = K / BK;
    unsigned voffA[2], voffB[2];
#pragma unroll
    for (int i = 0; i < 2; ++i) { int R, C; stage_rc(tid * 16 + i * 8192, R, C); const int Rb = Epi::PERM ? ((R & ~31) + perm32(R & 31)) : R;
        voffA[i] = (unsigned)(R * K + C) * 2u; voffB[i] = (unsigned)(Rb * K + C) * 2u; }
    const size_t kstep = (size_t)(BK * 2);
    const size_t hstep = (size_t)HALF * K * 2;
    const size_t tstep = 2 * hstep;
    const unsigned ldsw = (unsigned)wid * 1024u;
    const int aoff = lds_byte(wr * 64 + fr, fq * 8), boff = lds_byte(wc * 32 + fr, fq * 8);
#define PG8_SA(b, h) (((b) * 2 + (h)) * HTB)
#define PG8_SB(b, h) ((4 + (b) * 2 + (h)) * HTB)
#define PG8_STAGE(bufoff, gbase, voff) do { _Pragma("unroll") for (int _i = 0; _i < 2; ++_i) \
        __builtin_amdgcn_global_load_lds((const unsigned*)((const char*)(gbase) + (voff)[_i]), (PG8_LAS unsigned*)(lds + (bufoff) + ldsw + _i * 8192), 16, 0, 0); } while (0)
#define PG8_LDA(dst, b, h) do { _Pragma("unroll") for (int m = 0; m < 4; ++m) _Pragma("unroll") for (int k = 0; k < 2; ++k) dst[m][k] = *(const PG8_LAS bf16x8*)(lds + PG8_SA(b, h) + aoff + m * 2048 + k * 1024); } while (0)
#define PG8_LDB(dst, b, h) do { _Pragma("unroll") for (int n = 0; n < 2; ++n) _Pragma("unroll") for (int k = 0; k < 2; ++k) dst[n][k] = *(const PG8_LAS bf16x8*)(lds + PG8_SB(b, h) + boff + n * 2048 + k * 1024); } while (0)
#define PG8_MMA(ai, bj, At, Bt) do { __builtin_amdgcn_s_setprio(1); _Pragma("unroll") for (int m = 0; m < 4; ++m) _Pragma("unroll") for (int n = 0; n < 2; ++n) _Pragma("unroll") for (int k = 0; k < 2; ++k) \
        acc[ai][bj][m][n] = __builtin_amdgcn_mfma_f32_16x16x32_bf16(Bt[n][k], At[m][k], acc[ai][bj][m][n], 0, 0, 0); __builtin_amdgcn_s_setprio(0); } while (0)
#define PG8_WAIT_V(n) asm volatile("s_waitcnt vmcnt(" #n ")" ::: "memory")
#define PG8_WAIT_L(n) asm volatile("s_waitcnt lgkmcnt(" #n ")" ::: "memory")
#define PG8_BAR __builtin_amdgcn_s_barrier()
#define PG8_SCHED __builtin_amdgcn_sched_barrier(0)
    Unit cur, nxt; int ui = 0;
    if (!S.next(0, cur)) return;
    f32x4 acc[2][2][4][2];
#pragma unroll
    for (int a = 0; a < 2; ++a)
#pragma unroll
        for (int b = 0; b < 2; ++b)
#pragma unroll
            for (int m = 0; m < 4; ++m)
#pragma unroll
                for (int n = 0; n < 2; ++n) acc[a][b][m][n] = (f32x4){0.f, 0.f, 0.f, 0.f};
    bf16x8 At[4][2], B0[2][2], B1[2][2];
    const char* cA = (const char*)g.A + (size_t)cur.pm * tstep; const char* cB = (const char*)g.Bt + (size_t)cur.pn * tstep;
    S.a_ready(cur);
    if constexpr (SP2) {
        PG8_STAGE(PG8_SB(0, 0), cB, voffB); PG8_STAGE(PG8_SB(0, 1), cB + hstep, voffB); PG8_STAGE(PG8_SA(0, 0), cA, voffA); PG8_STAGE(PG8_SA(0, 1), cA + hstep, voffA);
        if (wr == 1) PG8_BAR;
        PG8_WAIT_V(2); PG8_BAR;
        PG8_STAGE(PG8_SB(1, 0), cB + kstep, voffB); PG8_STAGE(PG8_SA(1, 0), cA + kstep, voffA); PG8_STAGE(PG8_SB(1, 1), cB + hstep + kstep, voffB);
        PG8_WAIT_V(6); PG8_BAR;
    } else {
        PG8_STAGE(PG8_SB(0, 0), cB, voffB); PG8_STAGE(PG8_SA(0, 0), cA, voffA); PG8_STAGE(PG8_SB(0, 1), cB + hstep, voffB); PG8_STAGE(PG8_SA(0, 1), cA + hstep, voffA);
        if (wr == 1) PG8_BAR;
        PG8_WAIT_V(4); PG8_BAR;
        PG8_STAGE(PG8_SB(1, 0), cB + kstep, voffB); PG8_STAGE(PG8_SA(1, 0), cA + kstep, voffA); PG8_STAGE(PG8_SB(1, 1), cB + hstep + kstep, voffB);
        PG8_WAIT_V(6); PG8_BAR;
    }
    for (;;) {
        const bool has_next = S.next(ui + 1, nxt);
        const char* nA = has_next ? (const char*)g.A + (size_t)nxt.pm * tstep : cA; const char* nB = has_next ? (const char*)g.Bt + (size_t)nxt.pn * tstep : cB;
        for (int t = 0; t < nt; t += 2) {
            const bool last = (t == nt - 2);
            const char* a1 = cA + (size_t)(t + 1) * kstep;
            const char* a2 = last ? nA : cA + (size_t)(t + 2) * kstep; const char* b2 = last ? nB : cB + (size_t)(t + 2) * kstep;
            const char* a3 = a2 + kstep; const char* b3 = b2 + kstep;
            if (last && has_next) S.a_ready(nxt);
            if constexpr (SP2) {
            PG8_LDB(B0, 0, 0); PG8_LDB(B1, 0, 1); PG8_SCHED; PG8_LDA(At, 0, 0); PG8_STAGE(PG8_SA(1, 1), a1 + hstep, voffA);
            PG8_WAIT_V(8); PG8_WAIT_L(0); PG8_BAR; PG8_MMA(0, 0, At, B0); PG8_MMA(0, 1, At, B1); PG8_BAR; PG8_SCHED;
            PG8_LDA(At, 0, 1); PG8_STAGE(PG8_SB(0, 0), b2, voffB); PG8_STAGE(PG8_SB(0, 1), b2 + hstep, voffB); PG8_STAGE(PG8_SA(0, 0), a2, voffA);
            PG8_WAIT_V(8); PG8_WAIT_L(0); PG8_BAR; PG8_MMA(1, 0, At, B0); PG8_MMA(1, 1, At, B1); PG8_BAR; PG8_SCHED;
            PG8_LDB(B0, 1, 0); PG8_LDB(B1, 1, 1); PG8_SCHED; PG8_LDA(At, 1, 0); PG8_STAGE(PG8_SA(0, 1), a2 + hstep, voffA);
            PG8_WAIT_V(8); PG8_WAIT_L(0); PG8_BAR; PG8_MMA(0, 0, At, B0); PG8_MMA(0, 1, At, B1); PG8_BAR; PG8_SCHED;
            PG8_LDA(At, 1, 1); PG8_STAGE(PG8_SB(1, 0), b3, voffB); PG8_STAGE(PG8_SB(1, 1), b3 + hstep, voffB); PG8_STAGE(PG8_SA(1, 0), a3, voffA);
            PG8_WAIT_V(8); PG8_WAIT_L(0); PG8_BAR; PG8_MMA(1, 0, At, B0); PG8_MMA(1, 1, At, B1); PG8_BAR; PG8_SCHED;
            } else {
            PG8_LDB(B0, 0, 0); PG8_SCHED; PG8_LDA(At, 0, 0); PG8_STAGE(PG8_SA(1, 1), a1 + hstep, voffA);
            PG8_WAIT_L(8); PG8_BAR; PG8_WAIT_L(0); PG8_MMA(0, 0, At, B0); PG8_BAR; PG8_SCHED;
            PG8_LDB(B1, 0, 1); PG8_STAGE(PG8_SB(0, 0), b2, voffB);
            PG8_BAR; PG8_WAIT_L(0); PG8_MMA(0, 1, At, B1); PG8_BAR;
            PG8_LDA(At, 0, 1); PG8_STAGE(PG8_SA(0, 0), a2, voffA);
            PG8_BAR; PG8_WAIT_L(0); PG8_MMA(1, 0, At, B0); PG8_BAR; PG8_SCHED;
            PG8_STAGE(PG8_SB(0, 1), b2 + hstep, voffB);
            PG8_WAIT_V(6); PG8_BAR; PG8_MMA(1, 1, At, B1); PG8_BAR;
            PG8_LDB(B0, 1, 0); PG8_SCHED; PG8_LDA(At, 1, 0); PG8_STAGE(PG8_SA(0, 1), a2 + hstep, voffA);
            PG8_WAIT_L(8); PG8_BAR; PG8_WAIT_L(0); PG8_MMA(0, 0, At, B0); PG8_BAR; PG8_SCHED;
            PG8_LDB(B1, 1, 1); PG8_STAGE(PG8_SB(1, 0), b3, voffB);
            PG8_BAR; PG8_WAIT_L(0); PG8_MMA(0, 1, At, B1); PG8_BAR;
            PG8_LDA(At, 1, 1); PG8_STAGE(PG8_SA(1, 0), a3, voffA);
            PG8_BAR; PG8_WAIT_L(0); PG8_MMA(1, 0, At, B0); PG8_BAR; PG8_SCHED;
            PG8_STAGE(PG8_SB(1, 1), b3 + hstep, voffB);
            PG8_WAIT_V(6); PG8_BAR; PG8_MMA(1, 1, At, B1); PG8_BAR;
            }
        }
        if constexpr (ALIGN_EPI) { if (wr == 0) PG8_BAR; }
        if constexpr (!Epi::AFTER_DRAIN) { E(acc, cur, wr, wc, fr, fq); S.done(cur); }
        if (!has_next) break;
#pragma unroll
        for (int a = 0; a < 2; ++a)
#pragma unroll
            for (int b = 0; b < 2; ++b)
#pragma unroll
                for (int m = 0; m < 4; ++m)
#pragma unroll
                    for (int n = 0; n < 2; ++n) acc[a][b][m][n] = (f32x4){0.f, 0.f, 0.f, 0.f};
        cur = nxt; cA = nA; cB = nB; ++ui;
        if constexpr (ALIGN_EPI) { if (wr == 1) PG8_BAR; }
    }
    PG8_WAIT_V(0);
    if constexpr (!ALIGN_EPI) { if (wr == 0) PG8_BAR; }
    PG8_BAR;
    if constexpr (Epi::AFTER_DRAIN) { E.fused(acc, cur, wr, wc, fr, fq, lds, wid, lane); S.done(cur); }
#undef PG8_SA
#undef PG8_SB
#undef PG8_STAGE
#undef PG8_LDA
#undef PG8_LDB
#undef PG8_MMA
#undef PG8_WAIT_V
#undef PG8_WAIT_L
#undef PG8_BAR
#undef PG8_SCHED
}
}
#define GAS __attribute__((address_space(1)))
#define LAS __attribute__((address_space(3)))
typedef unsigned short bf16;
typedef unsigned v4u __attribute__((ext_vector_type(4)));
typedef float f32x4 __attribute__((ext_vector_type(4)));
typedef short bf16x8 __attribute__((ext_vector_type(8)));
typedef GAS unsigned gu32;
typedef GAS unsigned long long gu64;
#define RLX_AGENT __ATOMIC_RELAXED, __HIP_MEMORY_SCOPE_AGENT
#define LDS_WAIT() asm volatile("s_waitcnt lgkmcnt(0)" ::: "memory")
#define VM_WAIT() asm volatile("s_waitcnt vmcnt(0)" ::: "memory")
__device__ __forceinline__ unsigned long long rt() { return __builtin_amdgcn_s_memrealtime(); }
__device__ __forceinline__ unsigned f2bf(float f) { unsigned u = __builtin_bit_cast(unsigned, f); return (u + 0x7fffu + ((u >> 16) & 1u)) >> 16; }
__device__ __forceinline__ unsigned pk2(float lo, float hi) { return f2bf(lo) | (f2bf(hi) << 16); }

#define XB_TMO      128
#define XB_XCNT(j)  (256  + 64 * (j))
#define XB_XSUB(j)  (1280 + 64 * (j))
#define XB_XGEN(j)  (2304 + 64 * (j))
#define XB_TOP      3328
#define XB_TOPGEN   3392
#define XCD_BAR_WORDS 3456
#define XB_SPIN_CAP (1u << 18)

__device__ __forceinline__ unsigned xb_ld(unsigned* p)              { return __hip_atomic_load(p, __ATOMIC_RELAXED, __HIP_MEMORY_SCOPE_AGENT); }
__device__ __forceinline__ unsigned xb_add(unsigned* p, unsigned v) { return __hip_atomic_fetch_add(p, v, __ATOMIC_RELAXED, __HIP_MEMORY_SCOPE_AGENT); }
__device__ __forceinline__ unsigned xb_xcc_id() { return (unsigned)__builtin_amdgcn_s_getreg((3 << 11) | 20) & 0xFu; }
#define XB_SPIN(cond, bar) do { unsigned _sp = 0; while (cond) { __builtin_amdgcn_s_sleep(1); \
    if ((++_sp & 255u) == 0u) { if (xb_ld(&(bar)[XB_TMO])) break; if (_sp > XB_SPIN_CAP) { atomicAdd(&(bar)[XB_TMO], 1u); break; } } } } while (0)

struct XcdBarrier {
    unsigned* bar; unsigned x;
    volatile LAS unsigned* st;
};

__device__ __forceinline__ XcdBarrier xcd_barrier_post(unsigned* bar, volatile LAS unsigned* st) {
    XcdBarrier b; b.bar = bar; b.x = xb_xcc_id(); b.st = st;
    if (threadIdx.x == 0) (void)xb_add(&bar[XB_XCNT(b.x)], 1u);
    return b;
}
__device__ __forceinline__ void xcd_barrier_complete(unsigned* bar, unsigned x, unsigned& nloc, unsigned& nx) {
    const unsigned G = gridDim.x * gridDim.y * gridDim.z;
    unsigned sum, cnt, mine, sp = 0u;
    for (;;) {
        sum = 0u; cnt = 0u; mine = 0u;
#pragma unroll
        for (unsigned j = 0; j < 16; ++j) { const unsigned c = xb_ld(&bar[XB_XCNT(j)]); sum += c; cnt += (c > 0u) ? 1u : 0u; mine = (j == x) ? c : mine; }
        if (sum == G) break;
        __builtin_amdgcn_s_sleep(1);
        if ((++sp & 255u) == 0u) { if (xb_ld(&bar[XB_TMO])) break; if (sp > XB_SPIN_CAP) { atomicAdd(&bar[XB_TMO], 1u); break; } }
    }
    nloc = mine > 0u ? mine : 1u; nx = cnt > 0u ? cnt : 1u;
}

__device__ __forceinline__ void xcd_barrier(const XcdBarrier& b) {
    asm volatile("s_waitcnt vmcnt(0)" ::: "memory");
    __syncthreads();
    if (threadIdx.x == 0) {
        unsigned* bar = b.bar;
        __builtin_amdgcn_s_waitcnt(0);
        unsigned nloc = b.st[0], nx = b.st[1];
        if (nloc == 0u) { xcd_barrier_complete(bar, b.x, nloc, nx); b.st[0] = nloc; b.st[1] = nx; }
        const unsigned old = xb_add(&bar[XB_XSUB(b.x)], 1u);
        const unsigned gen = old / nloc;
        if (old + 1u == (gen + 1u) * nloc) {
            __builtin_amdgcn_fence(__ATOMIC_RELEASE, "agent");
            asm volatile("s_waitcnt vmcnt(0)" ::: "memory");
            const unsigned og = xb_add(&bar[XB_TOP], 1u);
            const unsigned tg = og / nx;
            if (og + 1u == (tg + 1u) * nx) xb_add(&bar[XB_TOPGEN], 1u);
            else XB_SPIN(xb_ld(&bar[XB_TOPGEN]) == tg, bar);
            __builtin_amdgcn_fence(__ATOMIC_ACQUIRE, "agent");
            xb_add(&bar[XB_XGEN(b.x)], 1u);
            asm volatile("s_waitcnt vmcnt(0)" ::: "memory");
        } else {
            XB_SPIN(xb_ld(&bar[XB_XGEN(b.x)]) == gen, bar);
            __builtin_amdgcn_fence(__ATOMIC_ACQUIRE, "agent");
            asm volatile("s_waitcnt vmcnt(0)" ::: "memory");
        }
    }
    __syncthreads();
}

constexpr int NWAVES = 8;
#ifndef MK_PER_PHASE
#define MK_PER_PHASE 0
#endif
constexpr int N_PHASES = 12;

constexpr int NB = 8, S = 4096, D = 1024, FF = 2816, M = NB * S;
typedef float f32x2g __attribute__((ext_vector_type(2)));
typedef unsigned u32x2g __attribute__((ext_vector_type(2)));

constexpr size_t MiB = 1u << 20;
constexpr size_t WS_CTL = 0, CTL_ZERO_BYTES = 1 * MiB;
constexpr size_t WS_SSQ = 46 * MiB + 512 * 1024;
constexpr size_t WS_WIN0 = 2 * MiB;
constexpr size_t WS_WOUT0 = 5 * MiB;
constexpr size_t WS_WGU0 = 7 * MiB;
constexpr size_t WS_WDN0 = 18 * MiB;
constexpr size_t WS_WPQ1 = 24 * MiB;
constexpr size_t WS_WUV1 = 26 * MiB;
constexpr size_t WS_WOUT1 = 28 * MiB;
constexpr size_t WS_WGU1 = 30 * MiB;
constexpr size_t WS_WDN1 = 41 * MiB;
constexpr size_t WS_DFT = 48 * MiB;
constexpr size_t WS_XB = 112 * MiB;
constexpr size_t WS_AM = 176 * MiB;
constexpr size_t WS_H = 240 * MiB;
constexpr size_t WS_UB = WS_H, WS_PB = WS_H + 32 * MiB;
constexpr size_t WS_PQT = WS_H, WS_U1 = WS_H + 64 * MiB, WS_V1 = WS_H + 96 * MiB;
constexpr size_t WS_END = 416 * MiB;
static_assert(WS_H + (size_t)M * FF * 2 <= WS_END && WS_V1 + (size_t)M * 512 * 2 <= WS_END, "d_ws map");
constexpr int CW_BAR = 4096;

constexpr int RING_OFF = 0, RING_BYTES = 131072;
constexpr int LDSCTL_OFF = RING_BYTES, MISC_OFF = LDSCTL_OFF + 320;
constexpr int LDS_BYTES = 147456;

struct Frame {
    LAS unsigned char* lds;
    volatile LAS unsigned* MISC;
    gu32* ctl;
    int tid, lane, wave;
    int vcu, G;
};
__device__ __forceinline__ float wave_sum(float v) {
#pragma unroll
    for (int o = 1; o < 64; o <<= 1) v += __shfl_xor(v, o);
    return v;
}
__device__ __forceinline__ float bf_lo(unsigned x) { return __builtin_bit_cast(float, x << 16); }
__device__ __forceinline__ float bf_hi(unsigned x) { return __builtin_bit_cast(float, x & 0xffff0000u); }
#define WG_BAR() do { asm volatile("s_waitcnt vmcnt(0) lgkmcnt(0)" ::: "memory"); __builtin_amdgcn_s_barrier(); asm volatile("" ::: "memory"); } while (0)

__device__ __forceinline__ void p0_transpose_item(const float* W, int ldw, const float* gk, bf16* WT, int ldt, int k0, int n0, int dk0, int drow0, LAS float* scr, int lane) {
    float v[32];
    const float* wp = W + (size_t)(k0 + (lane >> 5)) * ldw + n0 + (lane & 31);
#pragma unroll
    for (int i = 0; i < 32; ++i) v[i] = wp[(size_t)(2 * i) * ldw];
    const int c = lane & 7;
    f32x4 g0 = {1.f, 1.f, 1.f, 1.f}, g1 = {1.f, 1.f, 1.f, 1.f};
    if (gk) { g0 = *(const GAS f32x4*)(gk + k0 + 8 * c); g1 = *(const GAS f32x4*)(gk + k0 + 8 * c + 4); }
#pragma unroll
    for (int i = 0; i < 32; ++i) scr[(2 * i + (lane >> 5)) * 33 + (lane & 31)] = v[i];
    LDS_WAIT(); asm volatile("" ::: "memory");
#pragma unroll
    for (int j = 0; j < 4; ++j) { const int n = (lane >> 3) + 8 * j; const LAS float* s = scr + (8 * c) * 33 + n;
        v4u o; o.x = pk2(s[0 * 33] * g0.x, s[1 * 33] * g0.y); o.y = pk2(s[2 * 33] * g0.z, s[3 * 33] * g0.w); o.z = pk2(s[4 * 33] * g1.x, s[5 * 33] * g1.y); o.w = pk2(s[6 * 33] * g1.z, s[7 * 33] * g1.w);
        *(GAS v4u*)(WT + (size_t)(drow0 + n) * ldt + dk0 + 8 * c) = o; }
    LDS_WAIT(); asm volatile("" ::: "memory");
}
__device__ __forceinline__ void p0_job(const float* W, int ldw, const float* gk, int kbeg, int kext, int ncol0, int next, bf16* WT, int ldt, int dkbase, int mode, int half_or_off,
                                       LAS float* scr, int lane, int gw, int NGW, int& cursor) {
    const int nkb = kext / 64, nnb = next / 32, nitems = nkb * nnb;
    int first = (gw - (cursor % NGW) + NGW) % NGW;
    for (int it = first; it < nitems; it += NGW) {
        const int kb = it / nnb, nb = it % nnb, nrel = 32 * nb;
        const int drow0 = (mode == 0) ? (half_or_off + nrel) : (256 * (nrel >> 7) + 128 * half_or_off + (nrel & 127));
        p0_transpose_item(W, ldw, gk, WT, ldt, kbeg + 64 * kb, ncol0 + nrel, dkbase + 64 * kb, drow0, scr, lane);
    }
    cursor += nitems;
}
__device__ __forceinline__ void p0_fold_item(const float* L, int lrow0, const float* sc, const float* Rm, bf16* out, int dk0, float scale, int dw, int lane) {
    const int d = 64 * dw + lane;
    float l0[8], l1[8];
    { const float s0 = sc ? sc[lane] : 1.f, s1 = sc ? sc[64 + lane] : 1.f;
#pragma unroll
      for (int j = 0; j < 8; ++j) { l0[j] = L[(size_t)(lrow0 + j) * 128 + lane] * s0; l1[j] = L[(size_t)(lrow0 + j) * 128 + 64 + lane] * s1; } }
    float acc[8];
#pragma unroll
    for (int j = 0; j < 8; ++j) acc[j] = 0.f;
#pragma unroll
    for (int cb = 0; cb < 4; ++cb) {
        float r[32];
#pragma unroll
        for (int i = 0; i < 32; ++i) r[i] = Rm[(size_t)(cb * 32 + i) * 1024 + d];
#pragma unroll
        for (int i = 0; i < 32; ++i) { const int cp = cb * 32 + i;
#pragma unroll
            for (int j = 0; j < 8; ++j) { const float lv = __builtin_bit_cast(float, __builtin_amdgcn_readlane(__builtin_bit_cast(int, cp < 64 ? l0[j] : l1[j]), cp & 63)); acc[j] = fmaf(lv, r[i], acc[j]); } }
    }
    v4u o; o.x = pk2(acc[0] * scale, acc[1] * scale); o.y = pk2(acc[2] * scale, acc[3] * scale); o.z = pk2(acc[4] * scale, acc[5] * scale); o.w = pk2(acc[6] * scale, acc[7] * scale);
    *(GAS v4u*)(out + (size_t)d * 1024 + dk0) = o;
}
__device__ __forceinline__ void p0_pq_item(const float* Win1, const float* g1, bf16* WPQ, int h, int half, int k0, const LAS float* tab, int lane) {
    const int cp = 64 * half + lane;
    float ap[8], aq[8], w0[8], w1[8];
#pragma unroll
    for (int j = 0; j < 8; ++j) { const float g = g1[k0 + j]; ap[j] = 0.f; aq[j] = 0.f; w0[j] = Win1[(size_t)(k0 + j) * 1536 + h * 128 + lane] * g; w1[j] = Win1[(size_t)(k0 + j) * 1536 + h * 128 + 64 + lane] * g; }
#pragma unroll 8
    for (int c = 0; c < 128; ++c) {
        const int ph = c * cp;
        const float cs = tab[ph & 127], sn = tab[(ph - 32) & 127];
#pragma unroll
        for (int j = 0; j < 8; ++j) { const float w = __builtin_bit_cast(float, __builtin_amdgcn_readlane(__builtin_bit_cast(int, c < 64 ? w0[j] : w1[j]), c & 63)); ap[j] = fmaf(w, cs, ap[j]); aq[j] = fmaf(w, sn, aq[j]); }
    }
    v4u o; o.x = pk2(ap[0], ap[1]); o.y = pk2(ap[2], ap[3]); o.z = pk2(ap[4], ap[5]); o.w = pk2(ap[6], ap[7]);
    *(GAS v4u*)(WPQ + (size_t)(h * 128 + cp) * 1024 + k0) = o;
    o.x = pk2(aq[0], aq[1]); o.y = pk2(aq[2], aq[3]); o.z = pk2(aq[4], aq[5]); o.w = pk2(aq[6], aq[7]);
    *(GAS v4u*)(WPQ + (size_t)(512 + h * 128 + cp) * 1024 + k0) = o;
}

struct Ptrs {
    const float* in[22]; float* out; unsigned char* ws;
};

__device__ __forceinline__ void p0_prologue(Frame& F, const Ptrs& P) {
    const float* x = P.in[0]; const float* mix_g = P.in[1]; const float* ffn_g = P.in[2];
    const float* ev_w_in = P.in[3]; const float* ev_pool_w = P.in[8]; const float* ev_pool_scale = P.in[9]; const float* ev_w_out = P.in[10];
    const float* od_w_in = P.in[11]; const float* od_fourier_w = P.in[12]; const float* od_w_out = P.in[17];
    const float* w_gate = P.in[18]; const float* w_up = P.in[19]; const float* w_down = P.in[20];
    unsigned char* ws = P.ws;
    LAS float* scr = (LAS float*)(F.lds + RING_OFF + F.wave * 8448);
    LAS float* CT = (LAS float*)(F.lds + RING_OFF + 69632);
    LAS float* tab = (LAS float*)(F.lds + RING_OFF + 69632 + 16384);
    for (int i = F.tid; i < 4096; i += NWAVES * 64) CT[i] = cospif((float)i * (1.0f / 2048.0f));
    if (F.tid < 128) tab[F.tid] = cospif((float)F.tid * (1.0f / 64.0f));
    WG_BAR();
    const int gw = F.vcu * NWAVES + F.wave, NGW = F.G * NWAVES, lane = F.lane;
    { unsigned long long* z = (unsigned long long*)(ws + WS_SSQ) + M; const int gt = F.vcu * NWAVES * 64 + F.tid, NT = F.G * NWAVES * 64;
      for (int i = gt; i < 4 * M; i += NT) z[i] = 0ull; }
    int cur = 0;
    p0_job(ev_w_in, 1536, mix_g, 0, 1024, 0, 512, (bf16*)(ws + WS_WIN0), 1024, 0, 1, 0, scr, lane, gw, NGW, cur);
    p0_job(ev_w_in, 1536, mix_g, 0, 1024, 512, 512, (bf16*)(ws + WS_WIN0), 1024, 0, 1, 1, scr, lane, gw, NGW, cur);
    p0_job(ev_w_in, 1536, mix_g, 0, 1024, 1024, 512, (bf16*)(ws + WS_WIN0), 1024, 0, 0, 1024, scr, lane, gw, NGW, cur);
    p0_job(ev_w_out, 1024, nullptr, 0, 512, 0, 1024, (bf16*)(ws + WS_WOUT0), 1024, 0, 0, 0, scr, lane, gw, NGW, cur);
    p0_job(w_gate, FF, ffn_g, 0, 1024, 0, FF, (bf16*)(ws + WS_WGU0), 1024, 0, 1, 0, scr, lane, gw, NGW, cur);
    p0_job(w_up, FF, ffn_g, 0, 1024, 0, FF, (bf16*)(ws + WS_WGU0), 1024, 0, 1, 1, scr, lane, gw, NGW, cur);
    p0_job(w_down, 1024, nullptr, 0, FF, 0, 1024, (bf16*)(ws + WS_WDN0), FF, 0, 0, 0, scr, lane, gw, NGW, cur);
    p0_job(od_w_in, 1536, mix_g + D, 0, 1024, 512, 1024, (bf16*)(ws + WS_WUV1), 1024, 0, 0, 0, scr, lane, gw, NGW, cur);
    p0_job(od_w_out, 1024, nullptr, 512, 512, 0, 1024, (bf16*)(ws + WS_WOUT1), 1024, 512, 0, 0, scr, lane, gw, NGW, cur);
    p0_job(w_gate + (size_t)D * FF, FF, ffn_g + D, 0, 1024, 0, FF, (bf16*)(ws + WS_WGU1), 1024, 0, 1, 0, scr, lane, gw, NGW, cur);
    p0_job(w_up + (size_t)D * FF, FF, ffn_g + D, 0, 1024, 0, FF, (bf16*)(ws + WS_WGU1), 1024, 0, 1, 1, scr, lane, gw, NGW, cur);
    p0_job(w_down + (size_t)FF * D, 1024, nullptr, 0, FF, 0, 1024, (bf16*)(ws + WS_WDN1), FF, 0, 0, 0, scr, lane, gw, NGW, cur);
    {
        int first = (gw - (cur % NGW) + NGW) % NGW;
        for (int it = first; it < 1024; it += NGW) { const int g = it >> 8, cc = (it >> 4) & 15, dw = it & 15;
            p0_fold_item(ev_pool_w, g * 128 + cc * 8, ev_pool_scale + g * 128, ev_w_out + (size_t)(512 + g * 128) * 1024, (bf16*)(ws + WS_WOUT0), 512 + g * 128 + cc * 8, 1.0f, dw, lane); }
        cur += 1024;
        first = (gw - (cur % NGW) + NGW) % NGW;
        for (int it = first; it < 1024; it += NGW) { const int h = it >> 8, cc = (it >> 4) & 15, dw = it & 15;
            p0_fold_item(od_fourier_w, h * 128 + cc * 8, nullptr, od_w_out + (size_t)(h * 128) * 1024, (bf16*)(ws + WS_WOUT1), h * 128 + cc * 8, 1.0f / 724.0773439350247f, dw, lane); }
        cur += 1024;
        first = (gw - (cur % NGW) + NGW) % NGW;
        for (int it = first; it < 1024; it += NGW) { const int h = it >> 8, half = (it >> 7) & 1, kc = it & 127;
            p0_pq_item(od_w_in, mix_g + D, (bf16*)(ws + WS_WPQ1), h, half, kc * 8, tab, lane); }
        cur += 1024;
    }
    {
        bf16* Dm = (bf16*)(ws + WS_DFT);
        int first = (gw - (cur % NGW) + NGW) % NGW;
        for (int sp = first; sp < S; sp += NGW) {
#pragma unroll 2
            for (int q = 0; q < 16; ++q) {
                const int j0 = (q * 64 + lane) * 8, s0 = j0 & (S - 1), sh = (j0 >> 12) ? 1024 : 0;
                float v[8];
#pragma unroll
                for (int e = 0; e < 8; ++e) v[e] = CT[(((s0 + e) * sp) + sh) & (S - 1)];
                v4u o; o.x = pk2(v[0], v[1]); o.y = pk2(v[2], v[3]); o.z = pk2(v[4], v[5]); o.w = pk2(v[6], v[7]);
                *(GAS v4u*)(Dm + (size_t)sp * (2 * S) + j0) = o;
            }
        }
        cur += S;
    }
    {
        bf16* XB = (bf16*)(ws + WS_XB); unsigned long long* ssq0 = (unsigned long long*)(ws + WS_SSQ);
        for (int m0 = 4 * gw; m0 < M; m0 += 4 * NGW) {
            f32x4 v[4][4];
#pragma unroll
            for (int r = 0; r < 4; ++r) { const GAS f32x4* xr = (const GAS f32x4*)(x + (size_t)(m0 + r) * D) + lane;
#pragma unroll
                for (int j = 0; j < 4; ++j) v[r][j] = xr[64 * j]; }
#pragma unroll
            for (int r = 0; r < 4; ++r) { float s = 0.f;
#pragma unroll
                for (int j = 0; j < 4; ++j) s += (v[r][j].x * v[r][j].x + v[r][j].y * v[r][j].y) + (v[r][j].z * v[r][j].z + v[r][j].w * v[r][j].w);
                s = wave_sum(s);
                if (lane == 0) ssq0[m0 + r] = pg8::ssq_fix(s);
                GAS unsigned long long* o8 = (GAS unsigned long long*)(XB + (size_t)(m0 + r) * D) + lane;
#pragma unroll
                for (int j = 0; j < 4; ++j) o8[64 * j] = (unsigned long long)pk2(v[r][j].x, v[r][j].y) | ((unsigned long long)pk2(v[r][j].z, v[r][j].w) << 32); }
        }
    }
}

__device__ __forceinline__ float reduce_scatter32(float (&v)[32], int lane) {
#pragma unroll
    for (int o = 16; o >= 1; o >>= 1) {
        const bool up = (lane & o) != 0;
#pragma unroll
        for (int i = 0; i < o; ++i) { const float send = up ? v[i] : v[i + o]; const float keep = up ? v[i + o] : v[i]; v[i] = keep + __shfl_xor(send, o); }
    }
    return v[0] + __shfl_xor(v[0], 32);
}
__device__ __forceinline__ void mix0_conv_item(Frame& F, const Ptrs& P, int item) {
    const bf16* UB = (const bf16*)(P.ws + WS_UB); bf16* AM = (bf16*)(P.ws + WS_AM);
    const float* cw = P.in[4]; const float* cb = P.in[5]; const float* lg = P.in[6]; const float* lb = P.in[7];
    const int b = item >> 6, t0 = (item & 63) * 64, rowbase = b * S;
    LAS unsigned* tile = (LAS unsigned*)(F.lds + RING_OFF);
    LAS float* red = (LAS float*)(F.lds + RING_OFF + 98304);
    LAS float* stats = (LAS float*)(F.lds + RING_OFF + 98304 + 1024);
    { v4u tv[12];
#pragma unroll
      for (int i = 0; i < 12; ++i) { const int t = t0 - 15 + F.wave + NWAVES * i, tc = t < 0 ? 0 : (t > S - 1 ? S - 1 : t);
          tv[i] = *(const GAS v4u*)(UB + (size_t)(rowbase + tc) * 512 + F.lane * 8); }
#pragma unroll
      for (int i = 0; i < 12; ++i) { const int r = F.wave + NWAVES * i, t = t0 - 15 + r; const bool ok = (t >= 0 && t < S);
          v4u w = tv[i]; w.x = ok ? w.x : 0u; w.y = ok ? w.y : 0u; w.z = ok ? w.z : 0u; w.w = ok ? w.w : 0u;
          *(LAS v4u*)(tile + r * 256 + F.lane * 4) = w; } }
    WG_BAR();
    int tidl = F.tid; asm volatile("" : "+v"(tidl));
    const int rg = tidl >> 8, cp = tidl & 255, lanel = tidl & 63;
    const f32x2g bb = *(const GAS f32x2g*)(cb + 2 * cp);
    const f32x2g g2 = *(const GAS f32x2g*)(lg + 2 * cp), b2 = *(const GAS f32x2g*)(lb + 2 * cp);
#pragma unroll 1
    for (int p = 0; p < 2; ++p) {
        float a0[16], a1[16];
#pragma unroll
        for (int o = 0; o < 16; ++o) { a0[o] = bb.x; a1[o] = bb.y; }
#pragma unroll 1
        for (int th = 0; th < 2; ++th) {
            float w0[16], w1[16];
#pragma unroll
            for (int jj = 0; jj < 16; ++jj) { const int j = 16 * th + jj; f32x2g w = {0.f, 0.f}; if (j < 31) w = *(const GAS f32x2g*)(cw + j * 512 + 2 * cp); w0[jj] = w.x; w1[jj] = w.y; }
            const LAS unsigned* tp = tile + (32 * rg + 16 * p + 16 * th) * 256 + cp;
#pragma unroll
            for (int ii = 0; ii < 31; ++ii) {
                const unsigned xx = tp[ii * 256];
                const float x0 = bf_lo(xx), x1 = bf_hi(xx);
#pragma unroll
                for (int o = 0; o < 16; ++o) { const int jj = ii - o; if (jj >= 0 && jj <= 15) { a0[o] = fmaf(w0[jj], x0, a0[o]); a1[o] = fmaf(w1[jj], x1, a1[o]); } }
            }
        }
        float v[32];
#pragma unroll
        for (int o = 0; o < 16; ++o) { v[2 * o] = a0[o] + a1[o]; v[2 * o + 1] = a0[o] * a0[o] + a1[o] * a1[o]; }
        const float tot = reduce_scatter32(v, lanel);
        if (lanel < 32) red[F.wave * 32 + lanel] = tot;
        WG_BAR();
        if (cp < 16) { const int wb = rg * 4; float s = 0.f, q = 0.f;
#pragma unroll
            for (int w = 0; w < 4; ++w) { s += red[(wb + w) * 32 + 2 * cp]; q += red[(wb + w) * 32 + 2 * cp + 1]; }
            const float mean = s * (1.0f / 512.0f), var = q * (1.0f / 512.0f) - mean * mean;
            stats[(rg * 16 + cp) * 2] = mean; stats[(rg * 16 + cp) * 2 + 1] = rsqrtf(var + 1e-6f); }
        WG_BAR();
#pragma unroll
        for (int o = 0; o < 16; ++o) {
            const float mean = stats[(rg * 16 + o) * 2], rstd = stats[(rg * 16 + o) * 2 + 1];
            float y0 = (a0[o] - mean) * rstd * g2.x + b2.x, y1 = (a1[o] - mean) * rstd * g2.y + b2.y;
            y0 = y0 * __builtin_amdgcn_rcpf(1.0f + __expf(-y0)); y1 = y1 * __builtin_amdgcn_rcpf(1.0f + __expf(-y1));
            *(GAS unsigned*)(AM + (size_t)(rowbase + t0 + 32 * rg + 16 * p + o) * 1024 + 2 * cp) = pk2(y0, y1);
        }
    }
    WG_BAR();
}
template <int H> __device__ __forceinline__ void pool_rows(const LAS unsigned* tp  , bf16* orow  , int tfirst) {
    unsigned x[32 + 2 * H];
#pragma unroll
    for (int i = 0; i < 32 + 2 * H; ++i) x[i] = tp[i * 256];
    float s0 = 0.f, s1 = 0.f;
#pragma unroll
    for (int i = 0; i < 2 * H; ++i) { s0 += bf_lo(x[i]); s1 += bf_hi(x[i]); }
#pragma unroll
    for (int o = 0; o < 32; ++o) {
        const int t = tfirst + o;
        const int lo = (t - H) < 0 ? 0 : (t - H), hi = (t + H - 1) > (S - 1) ? (S - 1) : (t + H - 1);
        const float inv = 1.0f / (float)(hi - lo + 1);
        *(GAS unsigned*)(orow + (size_t)o * 1024) = pk2(s0 * inv - bf_lo(x[o + H]), s1 * inv - bf_hi(x[o + H]));
        if (o < 31) { s0 += bf_lo(x[o + 2 * H]) - bf_lo(x[o]); s1 += bf_hi(x[o + 2 * H]) - bf_hi(x[o]); }
    }
}
__device__ __forceinline__ void mix0_pool_item(Frame& F, const Ptrs& P, int item) {
    const bf16* PB = (const bf16*)(P.ws + WS_PB); bf16* AM = (bf16*)(P.ws + WS_AM);
    const int b = item >> 6, t0 = (item & 63) * 64, rowbase = b * S;
    LAS unsigned* tile = (LAS unsigned*)(F.lds + RING_OFF);
    { v4u tv[10];
#pragma unroll
      for (int i = 0; i < 10; ++i) { const int t = t0 - 8 + F.wave + NWAVES * i, tc = t < 0 ? 0 : (t > S - 1 ? S - 1 : t);
          tv[i] = *(const GAS v4u*)(PB + (size_t)(rowbase + tc) * 512 + F.lane * 8); }
#pragma unroll
      for (int i = 0; i < 10; ++i) { const int r = F.wave + NWAVES * i, t = t0 - 8 + r; const bool ok = (t >= 0 && t < S);
          v4u w = tv[i]; w.x = ok ? w.x : 0u; w.y = ok ? w.y : 0u; w.z = ok ? w.z : 0u; w.w = ok ? w.w : 0u;
          *(LAS v4u*)(tile + r * 256 + F.lane * 4) = w; } }
    WG_BAR();
    const int rg = F.tid >> 8, cp = F.tid & 255, g = __builtin_amdgcn_readfirstlane(cp >> 6);
    bf16* orow = AM + (size_t)(rowbase + t0 + 32 * rg) * 1024 + 512 + 2 * cp;
    const int tfirst = t0 + 32 * rg;
    if (g == 0) pool_rows<1>(tile + (32 * rg + 8 - 1) * 256 + cp, orow, tfirst);
    else if (g == 1) pool_rows<2>(tile + (32 * rg + 8 - 2) * 256 + cp, orow, tfirst);
    else if (g == 2) pool_rows<4>(tile + (32 * rg + 8 - 4) * 256 + cp, orow, tfirst);
    else pool_rows<8>(tile + (32 * rg + 8 - 8) * 256 + cp, orow, tfirst);
    WG_BAR();
}

__device__ __forceinline__ void sgu_item(Frame& F, const Ptrs& P, int item) {
    const bf16* U = (const bf16*)(P.ws + WS_U1); const bf16* V = (const bf16*)(P.ws + WS_V1); bf16* AM = (bf16*)(P.ws + WS_AM);
    const float* lng = P.in[13]; const float* lnb = P.in[14]; const float* sw = P.in[15]; const float* sb = P.in[16];
    const int h = item & 3, rowbase = (item >> 2) * 128;
    LAS bf16* vnT = (LAS bf16*)(F.lds + RING_OFF);
    const int lane = F.lane;
    {
        const f32x2g g2 = *(const GAS f32x2g*)(lng + h * 128 + 2 * lane), b2 = *(const GAS f32x2g*)(lnb + h * 128 + 2 * lane);
        unsigned xv[16];
#pragma unroll
        for (int i = 0; i < 16; ++i) xv[i] = *(const GAS unsigned*)(V + (size_t)(rowbase + F.wave + 8 * i) * 512 + h * 128 + 2 * lane);
#pragma unroll
        for (int i = 0; i < 16; ++i) { const int k = F.wave + 8 * i;
            const float v0 = bf_lo(xv[i]), v1 = bf_hi(xv[i]);
            const float mean = wave_sum(v0 + v1) * (1.0f / 128.0f), d0 = v0 - mean, d1 = v1 - mean;
            const float rstd = rsqrtf(wave_sum(d0 * d0 + d1 * d1) * (1.0f / 128.0f) + 1e-6f);
            vnT[(2 * lane) * 136 + k] = (bf16)f2bf(d0 * rstd * g2.x + b2.x); vnT[(2 * lane + 1) * 136 + k] = (bf16)f2bf(d1 * rstd * g2.y + b2.y); }
    }
    WG_BAR();
    {
        const int fr = lane & 15, fq = lane >> 4, q = 16 * F.wave + fr;
        pg8::f32x4 acc[8];
#pragma unroll
        for (int nt = 0; nt < 8; ++nt) acc[nt] = (pg8::f32x4){0.f, 0.f, 0.f, 0.f};
#pragma unroll
        for (int ks = 0; ks < 4; ++ks) {
            const GAS pg8::f32x4* wp = (const GAS pg8::f32x4*)(sw + (size_t)(h * 128 + q) * 128 + ks * 32 + 8 * fq);
            const pg8::f32x4 wa = wp[0], wb = wp[1];
            pg8::u32x4 wq; wq.x = pk2(wa[0], wa[1]); wq.y = pk2(wa[2], wa[3]); wq.z = pk2(wb[0], wb[1]); wq.w = pk2(wb[2], wb[3]);
            const pg8::bf16x8 wf = __builtin_bit_cast(pg8::bf16x8, wq);
#pragma unroll
            for (int nt = 0; nt < 8; ++nt) {
                const pg8::bf16x8 vf = *(const LAS pg8::bf16x8*)(vnT + (16 * nt + fr) * 136 + ks * 32 + 8 * fq);
                acc[nt] = __builtin_amdgcn_mfma_f32_16x16x32_bf16(vf, wf, acc[nt], 0, 0, 0);
            }
        }
        const float bias = sb[h * 128 + q]; const size_t t = (size_t)(rowbase + q);
#pragma unroll
        for (int nt = 0; nt < 8; ++nt) { const int c0 = h * 128 + 16 * nt + 4 * fq;
            const u32x2g uu = *(const GAS u32x2g*)(U + t * 512 + c0);
            u32x2g o; o.x = pk2(bf_lo(uu.x) * (acc[nt][0] + bias), bf_hi(uu.x) * (acc[nt][1] + bias)); o.y = pk2(bf_lo(uu.y) * (acc[nt][2] + bias), bf_hi(uu.y) * (acc[nt][3] + bias));
            *(GAS u32x2g*)(AM + t * 1024 + 512 + c0) = o; }
    }
    WG_BAR();
}

struct Args { const float* in[22]; float* out; unsigned char* ws; int ph_lo, ph_hi, li, pad; };
__global__ void __launch_bounds__(NWAVES * 64, 2) mk_fwd(Args args) {
    extern __shared__ __attribute__((aligned(16))) unsigned char lds[];
    Frame F;
    F.lds = (LAS unsigned char*)lds;
    F.MISC = (volatile LAS unsigned*)(F.lds + MISC_OFF);
    F.tid = threadIdx.x; F.lane = F.tid & 63; F.wave = __builtin_amdgcn_readfirstlane(F.tid >> 6);
    F.G = gridDim.x; { const int bx = blockIdx.x; F.vcu = (F.G % 8 == 0) ? (bx % 8) * (F.G / 8) + bx / 8 : bx; }
    Ptrs P;
#pragma unroll
    for (int i = 0; i < 22; ++i) P.in[i] = args.in[i];
    P.out = args.out; P.ws = args.ws;
    unsigned char* ws = args.ws;
    F.ctl = (gu32*)(ws + WS_CTL);
    for (int u = F.tid; u < (LDS_BYTES - LDSCTL_OFF) / 4; u += NWAVES * 64) ((LAS unsigned*)(F.lds + LDSCTL_OFF))[u] = 0u;
    __syncthreads();
    XcdBarrier bar; bar.bar = (unsigned*)(F.ctl + CW_BAR); bar.x = 0; bar.st = nullptr;
    if (!MK_PER_PHASE) bar = xcd_barrier_post((unsigned*)(F.ctl + CW_BAR), F.MISC + 8);
    const int lo = args.ph_lo, hi = args.ph_hi;
#ifndef PH_MASK
#define PH_MASK 0xFFF
#endif
#define IN(k) ((((PH_MASK) >> (k)) & 1) && lo <= (k) && (k) < hi)
#ifndef PROBE_DUP
#define PROBE_DUP 0
#endif
#define REP(k) for (int rep = 0; rep < 1 + (((PROBE_DUP) >> (k)) & 1); ++rep)
#define SEAM(k) do { if (IN(k) && IN((k) + 1)) xcd_barrier(bar); } while (0)
    unsigned long long* ssq = (unsigned long long*)(ws + WS_SSQ);
    bf16* XB = (bf16*)(ws + WS_XB); bf16* AM = (bf16*)(ws + WS_AM); bf16* HB = (bf16*)(ws + WS_H);
    const int bid = (int)blockIdx.x;
    bf16* TRX = (bf16*)(ws + WS_END); unsigned long long* TRS = (unsigned long long*)(ws + WS_END + 64 * MiB);

    if (IN(0)) REP(0) { p0_prologue(F, P); } SEAM(0);
    if (IN(1)) REP(1) { pg8::Gemm g{XB, (const bf16*)(ws + WS_WIN0), M, 1536, D}; pg8::StaticOrder So; So.init(M, 1536, F.G, bid);
        pg8::EpiInL0 E{(bf16*)(ws + WS_UB), (bf16*)(ws + WS_PB), ssq};
        pg8::gemm_phase<pg8::EpiInL0, pg8::StaticOrder, true, true>(F.lds + RING_OFF, g, So, E); } SEAM(1);
    if (IN(2)) REP(2) { for (int it = F.vcu; it < 1024; it += F.G) {
#ifndef NO_CONV
            if (it < 512) mix0_conv_item(F, P, it);
#endif
#ifndef NO_POOL
            if (it >= 512) mix0_pool_item(F, P, it - 512);
#endif
 } } SEAM(2);
    if (IN(3)) REP(3) { pg8::Gemm g{AM, (const bf16*)(ws + WS_WOUT0), M, D, D}; pg8::StaticOrder So; So.init(M, D, F.G, bid);
        pg8::EpiResid E{XB, rep ? TRS : ssq + M, rep ? TRX : XB};
        pg8::gemm_phase<pg8::EpiResid, pg8::StaticOrder, true, true>(F.lds + RING_OFF, g, So, E); } SEAM(3);
    if (IN(4)) REP(4) { pg8::Gemm g{XB, (const bf16*)(ws + WS_WGU0), M, 2 * FF, D}; pg8::StaticOrder So; So.init(M, 2 * FF, F.G, bid);
        pg8::EpiSwiGLU E{HB, ssq + M};
        pg8::gemm_phase<pg8::EpiSwiGLU, pg8::StaticOrder, true, true>(F.lds + RING_OFF, g, So, E); } SEAM(4);
    if (IN(5)) REP(5) { pg8::Gemm g{HB, (const bf16*)(ws + WS_WDN0), M, D, FF}; pg8::StaticOrder So; So.init(M, D, F.G, bid);
        pg8::EpiResid E{XB, rep ? TRS : ssq + 2 * M, rep ? TRX : XB};
        pg8::gemm_phase<pg8::EpiResid, pg8::StaticOrder, true, true>(F.lds + RING_OFF, g, So, E); } SEAM(5);
    if (IN(6)) {
        REP(6) { pg8::Gemm g{(const bf16*)(ws + WS_WPQ1), XB, 1024, M, D}; pg8::StaticOrder So; So.init(1024, M, F.G, bid);
          pg8::EpiPQT E{(bf16*)(ws + WS_PQT), ssq + 2 * M};
          pg8::gemm_phase<pg8::EpiPQT, pg8::StaticOrder, true, true>(F.lds + RING_OFF, g, So, E); }
        REP(12) { pg8::Gemm g{XB, (const bf16*)(ws + WS_WUV1), M, 1024, D}; pg8::StaticOrder So; So.init(M, 1024, F.G, bid);
          pg8::EpiGeluUV E{(bf16*)(ws + WS_U1), (bf16*)(ws + WS_V1), ssq + 2 * M};
          pg8::gemm_phase<pg8::EpiGeluUV, pg8::StaticOrder, true, true>(F.lds + RING_OFF, g, So, E); }
    } SEAM(6);
    if (IN(7)) {
        REP(7) { pg8::Gemm g{(const bf16*)(ws + WS_DFT), (const bf16*)(ws + WS_PQT), S, NB * 512, 2 * S}; pg8::StaticOrder So; So.init(S, NB * 512, F.G, bid);
          pg8::EpiDFT E{AM};
          pg8::gemm_phase<pg8::EpiDFT, pg8::StaticOrder, true, true>(F.lds + RING_OFF, g, So, E); }
        REP(13) { for (int it = F.vcu; it < 1024; it += F.G) sgu_item(F, P, it); }
    } SEAM(7);
    if (IN(8)) REP(8) { pg8::Gemm g{AM, (const bf16*)(ws + WS_WOUT1), M, D, D}; pg8::StaticOrder So; So.init(M, D, F.G, bid);
        pg8::EpiResid E{XB, rep ? TRS : ssq + 3 * M, rep ? TRX : XB};
        pg8::gemm_phase<pg8::EpiResid, pg8::StaticOrder, true, true>(F.lds + RING_OFF, g, So, E); } SEAM(8);
    if (IN(9)) REP(9) { pg8::Gemm g{XB, (const bf16*)(ws + WS_WGU1), M, 2 * FF, D}; pg8::StaticOrder So; So.init(M, 2 * FF, F.G, bid);
        pg8::EpiSwiGLU E{HB, ssq + 3 * M};
        pg8::gemm_phase<pg8::EpiSwiGLU, pg8::StaticOrder, true, true>(F.lds + RING_OFF, g, So, E); } SEAM(9);
    if (IN(10)) REP(10) { pg8::Gemm g{HB, (const bf16*)(ws + WS_WDN1), M, D, FF}; pg8::StaticOrder So; So.init(M, D, F.G, bid);
        pg8::EpiResid E{XB, rep ? TRS : ssq + 4 * M, rep ? TRX : XB};
        pg8::gemm_phase<pg8::EpiResid, pg8::StaticOrder, true, true>(F.lds + RING_OFF, g, So, E); } SEAM(10);
    if (IN(11)) REP(11) {
        const float* gf = P.in[21]; const unsigned long long* ssq4 = ssq + 4 * M;
        const int gw = F.vcu * NWAVES + F.wave, NGW = F.G * NWAVES;
        for (int m = gw; m < M; m += NGW) {
            const GAS u32x2g* xr = (const GAS u32x2g*)(XB + (size_t)m * D) + F.lane; GAS f32x4* orow = (GAS f32x4*)(P.out + (size_t)m * D) + F.lane; const GAS f32x4* gr = (const GAS f32x4*)gf + F.lane;
            const float rs = pg8::rstd_of(ssq4[m]);
#pragma unroll
            for (int j = 0; j < 4; ++j) { const u32x2g xx = xr[64 * j]; const f32x4 gg = gr[64 * j];
                f32x4 v; v.x = bf_lo(xx.x); v.y = bf_hi(xx.x); v.z = bf_lo(xx.y); v.w = bf_hi(xx.y); orow[64 * j] = v * rs * gg; }
        }
    }
#undef IN
#undef SEAM
}

extern "C" void kernel_launch(void* const* d_in, const int* in_sizes, int n_in, void* d_out, int out_size, void* d_ws, size_t ws_size, hipStream_t stream) {
    static int grid = 0;
    if (grid == 0) {
        if (n_in != 22 || in_sizes[0] != M * D || out_size != M * D || ws_size < WS_END) { fprintf(stderr, "kernel_launch: unexpected shapes (n_in %d, in0 %d, out %d, ws %zu); nothing launched\n", n_in, n_in > 0 ? in_sizes[0] : -1, out_size, ws_size); grid = -1; return; }
        int dev = 0, cus = 0, per_cu = 0;
        if (hipGetDevice(&dev) != hipSuccess || hipDeviceGetAttribute(&cus, hipDeviceAttributeMultiprocessorCount, dev) != hipSuccess) { grid = -1; return; }
        if (hipFuncSetAttribute((const void*)mk_fwd, hipFuncAttributeMaxDynamicSharedMemorySize, LDS_BYTES) != hipSuccess) { fprintf(stderr, "kernel_launch: hipFuncSetAttribute failed\n"); grid = -1; return; }
        if (hipOccupancyMaxActiveBlocksPerMultiprocessor(&per_cu, (const void*)mk_fwd, NWAVES * 64, LDS_BYTES) != hipSuccess || per_cu < 1) { fprintf(stderr, "kernel_launch: occupancy query says %d blocks per CU\n", per_cu); per_cu = 1; }
        (void)hipGetLastError();
        grid = cus * 1;
    }
    if (grid < 0) return;
    if (hipMemsetAsync((char*)d_ws + WS_CTL, 0, CTL_ZERO_BYTES, stream) != hipSuccess) { fprintf(stderr, "kernel_launch: hipMemsetAsync failed\n"); return; }
    Args a{};
    for (int i = 0; i < 22; ++i) a.in[i] = (const float*)d_in[i];
    a.out = (float*)d_out; a.ws = (unsigned char*)d_ws;
#if MK_PER_PHASE
    for (int ph = 0; ph < N_PHASES; ++ph) { a.ph_lo = ph; a.ph_hi = ph + 1; a.li = ph;
        hipLaunchKernelGGL(mk_fwd, dim3(grid), dim3(NWAVES * 64), LDS_BYTES, stream, a); }
#else
    a.ph_lo = 0; a.ph_hi = N_PHASES; a.li = 0;
    void* kargs[] = {&a};
    hipError_t e = hipLaunchCooperativeKernel((const void*)mk_fwd, dim3(grid), dim3(NWAVES * 64), kargs, LDS_BYTES, stream);
    if (e != hipSuccess) fprintf(stderr, "kernel_launch: cooperative launch failed: %s (grid %d)\n", hipGetErrorString(e), grid);
#endif
}
```

```cpp
#include <hip/hip_runtime.h>
#include <cstdio>
#include <cstdint>
namespace pg8 {
#define PG8_LAS __attribute__((address_space(3)))
typedef unsigned short bf16_t;
typedef short bf16x8 __attribute__((ext_vector_type(8)));
typedef float f32x4 __attribute__((ext_vector_type(4)));
typedef unsigned u32x4 __attribute__((ext_vector_type(4)));
constexpr int BM = 256, BK = 64, HALF = 128, HTB = HALF * BK * 2  , STAGE_BYTES = 8 * HTB, NXCD = 8, WGM = 8;

__host__ __device__ __forceinline__ int lds_byte(int r, int c) { const int st = (r >> 4) * 2 + (c >> 5), rr = r & 15, cc = c & 31, ob = rr * 64 + cc * 2; return st * 1024 + (ob ^ (((ob >> 9) & 1) << 5)); }
__host__ __device__ __forceinline__ void stage_rc(int b, int& R, int& C) { const int st = b / 1024, sb = b % 1024, swz = sb ^ (((sb >> 9) & 1) << 5); R = (st >> 1) * 16 + swz / 64; C = (st & 1) * 32 + (swz % 64) / 2; }
__host__ __device__ __forceinline__ int perm32(int rho) { const int n = rho >> 4, i = rho & 15; return 8 * (i >> 2) + 4 * n + (i & 3); }

struct Unit { int pm, pn; };
struct Gemm { const bf16_t* A; const bf16_t* Bt; int M, N, K; };

struct StaticOrder {
    int nM, nN, nwg, G, c;
    __host__ __device__ void init(int M, int N, int G_, int c_) { nM = M / BM; nN = N / BM; nwg = nM * nN; G = G_; c = c_; }
    __host__ __device__ bool next(int i, Unit& u) const {
        const long L = (long)i * G + c; if (L >= nwg) return false;
        int wgid = (int)L; { const int q = nwg / NXCD, r = nwg % NXCD, xcd = wgid % NXCD, off = wgid / NXCD; wgid = (xcd < r ? xcd * (q + 1) : r * (q + 1) + (xcd - r) * q) + off; }
        const int nig = WGM * nN, gid = wgid / nig, fm = gid * WGM, gsz = (nM - fm) < WGM ? (nM - fm) : WGM;
        u.pm = fm + ((wgid % nig) % gsz); u.pn = (wgid % nig) / gsz; return true;
    }
    __device__ __forceinline__ void a_ready(const Unit&) const {}
    __device__ __forceinline__ void done(const Unit&) const {}
};

__device__ __forceinline__ unsigned cvt_pk_bf16(float lo, float hi) { unsigned r; asm volatile("v_cvt_pk_bf16_f32 %0, %1, %2" : "=v"(r) : "v"(lo), "v"(hi)); return r; }
typedef float f32x2 __attribute__((ext_vector_type(2)));
__device__ __forceinline__ f32x2 gelu_pk(f32x2 v) {
    const f32x2 av = __builtin_elementwise_abs(v), d = av * 0.2316418882f + 1.0f;
    f32x2 t; t.x = __builtin_amdgcn_rcpf(d.x); t.y = __builtin_amdgcn_rcpf(d.y);
    f32x2 q = t * 0.5307027145f + (-0.7265760135f); q = q * t + 0.7107068705f; q = q * t + (-0.142248368f); q = q * t + 0.127414796f; q = q * t;
    const f32x2 s = (v * v) * (-0.72134752044f);
    f32x2 e; e.x = __builtin_amdgcn_exp2f(s.x); e.y = __builtin_amdgcn_exp2f(s.y);
    const f32x2 m = v * (q * e), r = v - m;
    f32x2 o; o.x = v.x < 0.f ? m.x : r.x; o.y = v.y < 0.f ? m.y : r.y; return o;
}


constexpr float RMS_EPS = 1e-6f;
__device__ __forceinline__ float sigm(float x) { return __builtin_amdgcn_rcpf(1.0f + __expf(-x)); }
__device__ __forceinline__ u32x4 pack8(const f32x4 v0, const f32x4 v1) { u32x4 w; w.x = cvt_pk_bf16(v0[0], v0[1]); w.y = cvt_pk_bf16(v0[2], v0[3]); w.z = cvt_pk_bf16(v1[0], v1[1]); w.w = cvt_pk_bf16(v1[2], v1[3]); return w; }
typedef unsigned long long u64_t;
__device__ __forceinline__ float rstd_of(u64_t ssq) { return rsqrtf((float)ssq * (1.0f / (1024.0f * 1048576.0f)) + RMS_EPS); }
__device__ __forceinline__ u64_t ssq_fix(float s) { return (u64_t)(s * 1048576.0f); }

struct EpiInL0 {
    static constexpr bool PERM = true, AFTER_DRAIN = false;
    bf16_t* UB; bf16_t* PB; const u64_t* ssq;
    __device__ __forceinline__ void operator()(const f32x4 (&acc)[2][2][4][2], const Unit& u, int wr, int wc, int fr, int fq) const {
        const int row0 = u.pm * BM + wr * 64 + fr, cw = wc * 32 + 8 * fq;
#pragma unroll
        for (int ai = 0; ai < 2; ++ai)
#pragma unroll
            for (int m = 0; m < 4; ++m) {
                const int row = row0 + ai * HALF + m * 16;
                const float rs = rstd_of(ssq[row]);
                if (u.pn < 4) {
                    f32x4 o[2];
#pragma unroll
                    for (int n = 0; n < 2; ++n)
#pragma unroll
                        for (int j = 0; j < 4; ++j) { const float a = acc[ai][0][m][n][j] * rs, g = acc[ai][1][m][n][j] * rs; o[n][j] = a * sigm(g); }
                    *(u32x4*)(UB + (size_t)row * 512 + u.pn * 128 + cw) = pack8(o[0], o[1]);
                } else {
#pragma unroll
                    for (int bj = 0; bj < 2; ++bj) *(u32x4*)(PB + (size_t)row * 512 + (u.pn - 4) * 256 + bj * HALF + cw) = pack8(acc[ai][bj][m][0] * rs, acc[ai][bj][m][1] * rs);
                }
            }
    }
};
struct EpiResid {
    static constexpr bool PERM = true, AFTER_DRAIN = false;
    bf16_t* XB; u64_t* ssq; bf16_t* XBw;
    __device__ __forceinline__ void operator()(const f32x4 (&acc)[2][2][4][2], const Unit& u, int wr, int wc, int fr, int fq) const {
        const int row0 = u.pm * BM + wr * 64 + fr, cw = wc * 32 + 8 * fq;
#pragma unroll
        for (int ai = 0; ai < 2; ++ai)
#pragma unroll
            for (int m = 0; m < 4; ++m) {
                const int row = row0 + ai * HALF + m * 16;
                float s = 0.f;
#pragma unroll
                for (int bj = 0; bj < 2; ++bj) {
                    bf16_t* p = XB + (size_t)row * 1024 + u.pn * BM + bj * HALF + cw;
                    const u32x4 r = *(const u32x4*)p;
                    f32x4 v0, v1;
                    v0[0] = __builtin_bit_cast(float, r.x << 16) + acc[ai][bj][m][0][0]; v0[1] = __builtin_bit_cast(float, r.x & 0xffff0000u) + acc[ai][bj][m][0][1];
                    v0[2] = __builtin_bit_cast(float, r.y << 16) + acc[ai][bj][m][0][2]; v0[3] = __builtin_bit_cast(float, r.y & 0xffff0000u) + acc[ai][bj][m][0][3];
                    v1[0] = __builtin_bit_cast(float, r.z << 16) + acc[ai][bj][m][1][0]; v1[1] = __builtin_bit_cast(float, r.z & 0xffff0000u) + acc[ai][bj][m][1][1];
                    v1[2] = __builtin_bit_cast(float, r.w << 16) + acc[ai][bj][m][1][2]; v1[3] = __builtin_bit_cast(float, r.w & 0xffff0000u) + acc[ai][bj][m][1][3];
                    const u32x4 w = pack8(v0, v1);
                    *(u32x4*)(XBw + ((size_t)row * 1024 + u.pn * BM + bj * HALF + cw)) = w;
                    const float q0 = __builtin_bit_cast(float, w.x << 16), q1 = __builtin_bit_cast(float, w.x & 0xffff0000u), q2 = __builtin_bit_cast(float, w.y << 16), q3 = __builtin_bit_cast(float, w.y & 0xffff0000u);
                    const float q4 = __builtin_bit_cast(float, w.z << 16), q5 = __builtin_bit_cast(float, w.z & 0xffff0000u), q6 = __builtin_bit_cast(float, w.w << 16), q7 = __builtin_bit_cast(float, w.w & 0xffff0000u);
                    s += (q0 * q0 + q1 * q1) + (q2 * q2 + q3 * q3) + (q4 * q4 + q5 * q5) + (q6 * q6 + q7 * q7);
                }
                s += __shfl_xor(s, 16); s += __shfl_xor(s, 32);
                if (fq == 0) atomicAdd(ssq + row, ssq_fix(s));
            }
    }
};
struct EpiSwiGLU {
    static constexpr bool PERM = true, AFTER_DRAIN = false;
    bf16_t* H; const u64_t* ssq;
    __device__ __forceinline__ void operator()(const f32x4 (&acc)[2][2][4][2], const Unit& u, int wr, int wc, int fr, int fq) const {
        const int row0 = u.pm * BM + wr * 64 + fr, cw = wc * 32 + 8 * fq;
#pragma unroll
        for (int ai = 0; ai < 2; ++ai)
#pragma unroll
            for (int m = 0; m < 4; ++m) {
                const int row = row0 + ai * HALF + m * 16;
                const float rs = rstd_of(ssq[row]);
                f32x4 o[2];
#pragma unroll
                for (int n = 0; n < 2; ++n)
#pragma unroll
                    for (int j = 0; j < 4; ++j) { const float g = acc[ai][0][m][n][j] * rs, up = acc[ai][1][m][n][j] * rs; o[n][j] = g * sigm(g) * up; }
                *(u32x4*)(H + (size_t)row * 2816 + u.pn * 128 + cw) = pack8(o[0], o[1]);
            }
    }
};
struct EpiPQT {
    static constexpr bool PERM = true, AFTER_DRAIN = false;
    bf16_t* PQT; const u64_t* ssq;
    __device__ __forceinline__ void operator()(const f32x4 (&acc)[2][2][4][2], const Unit& u, int wr, int wc, int fr, int fq) const {
        const int tok0 = u.pn * BM + wc * 32 + 8 * fq, b = (u.pn * BM) >> 12;
        f32x4 rs[2][2];
#pragma unroll
        for (int bj = 0; bj < 2; ++bj)
#pragma unroll
            for (int n = 0; n < 2; ++n)
#pragma unroll
                for (int j = 0; j < 4; ++j) rs[bj][n][j] = rstd_of(ssq[tok0 + bj * HALF + 4 * n + j]);
#pragma unroll
        for (int ai = 0; ai < 2; ++ai)
#pragma unroll
            for (int m = 0; m < 4; ++m) {
                const int r = u.pm * BM + ai * HALF + wr * 64 + m * 16 + fr, pq = r >> 9, ch = r & 511;
                bf16_t* base = PQT + ((size_t)(b * 512 + ch) * 2 + pq) * 4096;
#pragma unroll
                for (int bj = 0; bj < 2; ++bj) *(u32x4*)(base + ((tok0 + bj * HALF) & 4095)) = pack8(acc[ai][bj][m][0] * rs[bj][0], acc[ai][bj][m][1] * rs[bj][1]);
            }
    }
};
struct EpiGeluUV {
    static constexpr bool PERM = true, AFTER_DRAIN = false;
    bf16_t* U; bf16_t* V; const u64_t* ssq;
    __device__ __forceinline__ void operator()(const f32x4 (&acc)[2][2][4][2], const Unit& u, int wr, int wc, int fr, int fq) const {
        const int row0 = u.pm * BM + wr * 64 + fr, cw = wc * 32 + 8 * fq;
        bf16_t* dst = (u.pn < 2) ? U : V; const int colb = (u.pn & 1) * BM;
#pragma unroll
        for (int ai = 0; ai < 2; ++ai)
#pragma unroll
            for (int m = 0; m < 4; ++m) {
                const int row = row0 + ai * HALF + m * 16;
                const float rs = rstd_of(ssq[row]);
#pragma unroll
                for (int bj = 0; bj < 2; ++bj) {
                    const f32x4 v0 = acc[ai][bj][m][0] * rs, v1 = acc[ai][bj][m][1] * rs;
                    const f32x2 a = gelu_pk((f32x2){v0[0], v0[1]}), bq = gelu_pk((f32x2){v0[2], v0[3]}), c = gelu_pk((f32x2){v1[0], v1[1]}), d = gelu_pk((f32x2){v1[2], v1[3]});
                    *(u32x4*)(dst + (size_t)row * 512 + colb + bj * HALF + cw) = pack8((f32x4){a.x, a.y, bq.x, bq.y}, (f32x4){c.x, c.y, d.x, d.y});
                }
            }
    }
};
struct EpiDFT {
    static constexpr bool PERM = true, AFTER_DRAIN = false;
    bf16_t* AM;
    __device__ __forceinline__ void operator()(const f32x4 (&acc)[2][2][4][2], const Unit& u, int wr, int wc, int fr, int fq) const {
        const int row0 = (u.pn >> 1) * 4096 + u.pm * BM + wr * 64 + fr, cw = (u.pn & 1) * BM + wc * 32 + 8 * fq;
#pragma unroll
        for (int ai = 0; ai < 2; ++ai)
#pragma unroll
            for (int m = 0; m < 4; ++m) {
                const int row = row0 + ai * HALF + m * 16;
#pragma unroll
                for (int bj = 0; bj < 2; ++bj) *(u32x4*)(AM + (size_t)row * 1024 + bj * HALF + cw) = pack8(acc[ai][bj][m][0], acc[ai][bj][m][1]);
            }
    }
};

template <class Epi, class Sched, bool ALIGN_EPI = false, bool SP2 = false>
__device__ __forceinline__ void gemm_phase(PG8_LAS unsigned char* lds, const Gemm g, const Sched& S, const Epi& E) {
    const int tid = threadIdx.x, wid = __builtin_amdgcn_readfirstlane(tid >> 6), lane = tid & 63, wr = wid >> 2, wc = wid & 3, fr = lane & 15, fq = lane >> 4;
    const int K = g.K, nt = K / BK;
    unsigned voffA[2], voffB[2];
#pragma unroll
    for (int i = 0; i < 2; ++i) { int R, C; stage_rc(tid * 16 + i * 8192, R, C); const int Rb = Epi::PERM ? ((R & ~31) + perm32(R & 31)) : R;
        voffA[i] = (unsigned)(R * K + C) * 2u; voffB[i] = (unsigned)(Rb * K + C) * 2u; }
    const size_t kstep = (size_t)(BK * 2);
    const size_t hstep = (size_t)HALF * K * 2;
    const size_t tstep = 2 * hstep;
    const unsigned ldsw = (unsigned)wid * 1024u;
    const int aoff = lds_byte(wr * 64 + fr, fq * 8), boff = lds_byte(wc * 32 + fr, fq * 8);
#define PG8_SA(b, h) (((b) * 2 + (h)) * HTB)
#define PG8_SB(b, h) ((4 + (b) * 2 + (h)) * HTB)
#define PG8_STAGE(bufoff, gbase, voff) do { _Pragma("unroll") for (int _i = 0; _i < 2; ++_i) \
        __builtin_amdgcn_global_load_lds((const unsigned*)((const char*)(gbase) + (voff)[_i]), (PG8_LAS unsigned*)(lds + (bufoff) + ldsw + _i * 8192), 16, 0, 0); } while (0)
#define PG8_LDA(dst, b, h) do { _Pragma("unroll") for (int m = 0; m < 4; ++m) _Pragma("unroll") for (int k = 0; k < 2; ++k) dst[m][k] = *(const PG8_LAS bf16x8*)(lds + PG8_SA(b, h) + aoff + m * 2048 + k * 1024); } while (0)
#define PG8_LDB(dst, b, h) do { _Pragma("unroll") for (int n = 0; n < 2; ++n) _Pragma("unroll") for (int k = 0; k < 2; ++k) dst[n][k] = *(const PG8_LAS bf16x8*)(lds + PG8_SB(b, h) + boff + n * 2048 + k * 1024); } while (0)
#define PG8_MMA(ai, bj, At, Bt) do { __builtin_amdgcn_s_setprio(1); _Pragma("unroll") for (int m = 0; m < 4; ++m) _Pragma("unroll") for (int n = 0; n < 2; ++n) _Pragma("unroll") for (int k = 0; k < 2; ++k) \
        acc[ai][bj][m][n] = __builtin_amdgcn_mfma_f32_16x16x32_bf16(Bt[n][k], At[m][k], acc[ai][bj][m][n], 0, 0, 0); __builtin_amdgcn_s_setprio(0); } while (0)
#define PG8_WAIT_V(n) asm volatile("s_waitcnt vmcnt(" #n ")" ::: "memory")
#define PG8_WAIT_L(n) asm volatile("s_waitcnt lgkmcnt(" #n ")" ::: "memory")
#define PG8_BAR __builtin_amdgcn_s_barrier()
#define PG8_SCHED __builtin_amdgcn_sched_barrier(0)
    Unit cur, nxt; int ui = 0;
    if (!S.next(0, cur)) return;
    f32x4 acc[2][2][4][2];
#pragma unroll
    for (int a = 0; a < 2; ++a)
#pragma unroll
        for (int b = 0; b < 2; ++b)
#pragma unroll
            for (int m = 0; m < 4; ++m)
#pragma unroll
                for (int n = 0; n < 2; ++n) acc[a][b][m][n] = (f32x4){0.f, 0.f, 0.f, 0.f};
    bf16x8 At[4][2], B0[2][2], B1[2][2];
    const char* cA = (const char*)g.A + (size_t)cur.pm * tstep; const char* cB = (const char*)g.Bt + (size_t)cur.pn * tstep;
    S.a_ready(cur);
    if constexpr (SP2) {
        PG8_STAGE(PG8_SB(0, 0), cB, voffB); PG8_STAGE(PG8_SB(0, 1), cB + hstep, voffB); PG8_STAGE(PG8_SA(0, 0), cA, voffA); PG8_STAGE(PG8_SA(0, 1), cA + hstep, voffA);
        if (wr == 1) PG8_BAR;
        PG8_WAIT_V(2); PG8_BAR;
        PG8_STAGE(PG8_SB(1, 0), cB + kstep, voffB); PG8_STAGE(PG8_SA(1, 0), cA + kstep, voffA); PG8_STAGE(PG8_SB(1, 1), cB + hstep + kstep, voffB);
        PG8_WAIT_V(6); PG8_BAR;
    } else {
        PG8_STAGE(PG8_SB(0, 0), cB, voffB); PG8_STAGE(PG8_SA(0, 0), cA, voffA); PG8_STAGE(PG8_SB(0, 1), cB + hstep, voffB); PG8_STAGE(PG8_SA(0, 1), cA + hstep, voffA);
        if (wr == 1) PG8_BAR;
        PG8_WAIT_V(4); PG8_BAR;
        PG8_STAGE(PG8_SB(1, 0), cB + kstep, voffB); PG8_STAGE(PG8_SA(1, 0), cA + kstep, voffA); PG8_STAGE(PG8_SB(1, 1), cB + hstep + kstep, voffB);
        PG8_WAIT_V(6); PG8_BAR;
    }
    for (;;) {
        const bool has_next = S.next(ui + 1, nxt);
        const char* nA = has_next ? (const char*)g.A + (size_t)nxt.pm * tstep : cA; const char* nB = has_next ? (const char*)g.Bt + (size_t)nxt.pn * tstep : cB;
        for (int t = 0; t < nt; t += 2) {
            const bool last = (t == nt - 2);
            const char* a1 = cA + (size_t)(t + 1) * kstep;
            const char* a2 = last ? nA : cA + (size_t)(t + 2) * kstep; const char* b2 = last ? nB : cB + (size_t)(t + 2) * kstep;
            const char* a3 = a2 + kstep; const char* b3 = b2 + kstep;
            if (last && has_next) S.a_ready(nxt);
            if constexpr (SP2) {
            PG8_LDB(B0, 0, 0); PG8_LDB(B1, 0, 1); PG8_SCHED; PG8_LDA(At, 0, 0); PG8_STAGE(PG8_SA(1, 1), a1 + hstep, voffA);
            PG8_WAIT_V(8); PG8_WAIT_L(0); PG8_BAR; PG8_MMA(0, 0, At, B0); PG8_MMA(0, 1, At, B1); PG8_BAR; PG8_SCHED;
            PG8_LDA(At, 0, 1); PG8_STAGE(PG8_SB(0, 0), b2, voffB); PG8_STAGE(PG8_SB(0, 1), b2 + hstep, voffB); PG8_STAGE(PG8_SA(0, 0), a2, voffA);
            PG8_WAIT_V(8); PG8_WAIT_L(0); PG8_BAR; PG8_MMA(1, 0, At, B0); PG8_MMA(1, 1, At, B1); PG8_BAR; PG8_SCHED;
            PG8_LDB(B0, 1, 0); PG8_LDB(B1, 1, 1); PG8_SCHED; PG8_LDA(At, 1, 0); PG8_STAGE(PG8_SA(0, 1), a2 + hstep, voffA);
            PG8_WAIT_V(8); PG8_WAIT_L(0); PG8_BAR; PG8_MMA(0, 0, At, B0); PG8_MMA(0, 1, At, B1); PG8_BAR; PG8_SCHED;
            PG8_LDA(At, 1, 1); PG8_STAGE(PG8_SB(1, 0), b3, voffB); PG8_STAGE(PG8_SB(1, 1), b3 + hstep, voffB); PG8_STAGE(PG8_SA(1, 0), a3, voffA);
            PG8_WAIT_V(8); PG8_WAIT_L(0); PG8_BAR; PG8_MMA(1, 0, At, B0); PG8_MMA(1, 1, At, B1); PG8_BAR; PG8_SCHED;
            } else {
            PG8_LDB(B0, 0, 0); PG8_SCHED; PG8_LDA(At, 0, 0); PG8_STAGE(PG8_SA(1, 1), a1 + hstep, voffA);
            PG8_WAIT_L(8); PG8_BAR; PG8_WAIT_L(0); PG8_MMA(0, 0, At, B0); PG8_BAR; PG8_SCHED;
            PG8_LDB(B1, 0, 1); PG8_STAGE(PG8_SB(0, 0), b2, voffB);
            PG8_BAR; PG8_WAIT_L(0); PG8_MMA(0, 1, At, B1); PG8_BAR;
            PG8_LDA(At, 0, 1); PG8_STAGE(PG8_SA(0, 0), a2, voffA);
            PG8_BAR; PG8_WAIT_L(0); PG8_MMA(1, 0, At, B0); PG8_BAR; PG8_SCHED;
            PG8_STAGE(PG8_SB(0, 1), b2 + hstep, voffB);
            PG8_WAIT_V(6); PG8_BAR; PG8_MMA(1, 1, At, B1); PG8_BAR;
            PG8_LDB(B0, 1, 0); PG8_SCHED; PG8_LDA(At, 1, 0); PG8_STAGE(PG8_SA(0, 1), a2 + hstep, voffA);
            PG8_WAIT_L(8); PG8_BAR; PG8_WAIT_L(0); PG8_MMA(0, 0, At, B0); PG8_BAR; PG8_SCHED;
            PG8_LDB(B1, 1, 1); PG8_STAGE(PG8_SB(1, 0), b3, voffB);
            PG8_BAR; PG8_WAIT_L(0); PG8_MMA(0, 1, At, B1); PG8_BAR;
            PG8_LDA(At, 1, 1); PG8_STAGE(PG8_SA(1, 0), a3, voffA);
            PG8_BAR; PG8_WAIT_L(0); PG8_MMA(1, 0, At, B0); PG8_BAR; PG8_SCHED;
            PG8_STAGE(PG8_SB(1, 1), b3 + hstep, voffB);
            PG8_WAIT_V(6); PG8_BAR; PG8_MMA(1, 1, At, B1); PG8_BAR;
            }
        }
        if constexpr (ALIGN_EPI) { if (wr == 0) PG8_BAR; }
        if constexpr (!Epi::AFTER_DRAIN) { E(acc, cur, wr, wc, fr, fq); S.done(cur); }
        if (!has_next) break;
#pragma unroll
        for (int a = 0; a < 2; ++a)
#pragma unroll
            for (int b = 0; b < 2; ++b)
#pragma unroll
                for (int m = 0; m < 4; ++m)
#pragma unroll
                    for (int n = 0; n < 2; ++n) acc[a][b][m][n] = (f32x4){0.f, 0.f, 0.f, 0.f};
        cur = nxt; cA = nA; cB = nB; ++ui;
        if constexpr (ALIGN_EPI) { if (wr == 1) PG8_BAR; }
    }
    PG8_WAIT_V(0);
    if constexpr (!ALIGN_EPI) { if (wr == 0) PG8_BAR; }
    PG8_BAR;
    if constexpr (Epi::AFTER_DRAIN) { E.fused(acc, cur, wr, wc, fr, fq, lds, wid, lane); S.done(cur); }
#undef PG8_SA
#undef PG8_SB
#undef PG8_STAGE
#undef PG8_LDA
#undef PG8_LDB
#undef PG8_MMA
#undef PG8_WAIT_V
#undef PG8_WAIT_L
#undef PG8_BAR
#undef PG8_SCHED
}
}
#define GAS __attribute__((address_space(1)))
#define LAS __attribute__((address_space(3)))
typedef unsigned short bf16;
typedef unsigned v4u __attribute__((ext_vector_type(4)));
typedef float f32x4 __attribute__((ext_vector_type(4)));
typedef short bf16x8 __attribute__((ext_vector_type(8)));
typedef GAS unsigned gu32;
typedef GAS unsigned long long gu64;
#define RLX_AGENT __ATOMIC_RELAXED, __HIP_MEMORY_SCOPE_AGENT
#define LDS_WAIT() asm volatile("s_waitcnt lgkmcnt(0)" ::: "memory")
#define VM_WAIT() asm volatile("s_waitcnt vmcnt(0)" ::: "memory")
__device__ __forceinline__ unsigned long long rt() { return __builtin_amdgcn_s_memrealtime(); }
__device__ __forceinline__ unsigned f2bf(float f) { unsigned u = __builtin_bit_cast(unsigned, f); return (u + 0x7fffu + ((u >> 16) & 1u)) >> 16; }
__device__ __forceinline__ unsigned pk2(float lo, float hi) { return f2bf(lo) | (f2bf(hi) << 16); }

#define XB_TMO      128
#define XB_XCNT(j)  (256  + 64 * (j))
#define XB_XSUB(j)  (1280 + 64 * (j))
#define XB_XGEN(j)  (2304 + 64 * (j))
#define XB_TOP      3328
#define XB_TOPGEN   3392
#define XCD_BAR_WORDS 3456
#define XB_SPIN_CAP (1u << 18)

__device__ __forceinline__ unsigned xb_ld(unsigned* p)              { return __hip_atomic_load(p, __ATOMIC_RELAXED, __HIP_MEMORY_SCOPE_AGENT); }
__device__ __forceinline__ unsigned xb_add(unsigned* p, unsigned v) { return __hip_atomic_fetch_add(p, v, __ATOMIC_RELAXED, __HIP_MEMORY_SCOPE_AGENT); }
__device__ __forceinline__ unsigned xb_xcc_id() { return (unsigned)__builtin_amdgcn_s_getreg((3 << 11) | 20) & 0xFu; }
#define XB_SPIN(cond, bar) do { unsigned _sp = 0; while (cond) { __builtin_amdgcn_s_sleep(1); \
    if ((++_sp & 255u) == 0u) { if (xb_ld(&(bar)[XB_TMO])) break; if (_sp > XB_SPIN_CAP) { atomicAdd(&(bar)[XB_TMO], 1u); break; } } } } while (0)

struct XcdBarrier {
    unsigned* bar; unsigned x;
    volatile LAS unsigned* st;
};

__device__ __forceinline__ XcdBarrier xcd_barrier_post(unsigned* bar, volatile LAS unsigned* st) {
    XcdBarrier b; b.bar = bar; b.x = xb_xcc_id(); b.st = st;
    if (threadIdx.x == 0) (void)xb_add(&bar[XB_XCNT(b.x)], 1u);
    return b;
}
__device__ __forceinline__ void xcd_barrier_complete(unsigned* bar, unsigned x, unsigned& nloc, unsigned& nx) {
    const unsigned G = gridDim.x * gridDim.y * gridDim.z;
    unsigned sum, cnt, mine, sp = 0u;
    for (;;) {
        sum = 0u; cnt = 0u; mine = 0u;
#pragma unroll
        for (unsigned j = 0; j < 16; ++j) { const unsigned c = xb_ld(&bar[XB_XCNT(j)]); sum += c; cnt += (c > 0u) ? 1u : 0u; mine = (j == x) ? c : mine; }
        if (sum == G) break;
        __builtin_amdgcn_s_sleep(1);
        if ((++sp & 255u) == 0u) { if (xb_ld(&bar[XB_TMO])) break; if (sp > XB_SPIN_CAP) { atomicAdd(&bar[XB_TMO], 1u); break; } }
    }
    nloc = mine > 0u ? mine : 1u; nx = cnt > 0u ? cnt : 1u;
}

__device__ __forceinline__ void xcd_barrier(const XcdBarrier& b) {
    asm volatile("s_waitcnt vmcnt(0)" ::: "memory");
    __syncthreads();
    if (threadIdx.x == 0) {
        unsigned* bar = b.bar;
        __builtin_amdgcn_s_waitcnt(0);
        unsigned nloc = b.st[0], nx = b.st[1];
        if (nloc == 0u) { xcd_barrier_complete(bar, b.x, nloc, nx); b.st[0] = nloc; b.st[1] = nx; }
        const unsigned old = xb_add(&bar[XB_XSUB(b.x)], 1u);
        const unsigned gen = old / nloc;
        if (old + 1u == (gen + 1u) * nloc) {
            __builtin_amdgcn_fence(__ATOMIC_RELEASE, "agent");
            asm volatile("s_waitcnt vmcnt(0)" ::: "memory");
            const unsigned og = xb_add(&bar[XB_TOP], 1u);
            const unsigned tg = og / nx;
            if (og + 1u == (tg + 1u) * nx) xb_add(&bar[XB_TOPGEN], 1u);
            else XB_SPIN(xb_ld(&bar[XB_TOPGEN]) == tg, bar);
            __builtin_amdgcn_fence(__ATOMIC_ACQUIRE, "agent");
            xb_add(&bar[XB_XGEN(b.x)], 1u);
            asm volatile("s_waitcnt vmcnt(0)" ::: "memory");
        } else {
            XB_SPIN(xb_ld(&bar[XB_XGEN(b.x)]) == gen, bar);
            __builtin_amdgcn_fence(__ATOMIC_ACQUIRE, "agent");
            asm volatile("s_waitcnt vmcnt(0)" ::: "memory");
        }
    }
    __syncthreads();
}

constexpr int NWAVES = 8;
#ifndef MK_PER_PHASE
#define MK_PER_PHASE 0
#endif
constexpr int N_PHASES = 13;

constexpr int NB = 8, S = 4096, D = 1024, FF = 2816, M = NB * S;
typedef float f32x2g __attribute__((ext_vector_type(2)));
typedef unsigned u32x2g __attribute__((ext_vector_type(2)));

constexpr size_t MiB = 1u << 20;
constexpr size_t WS_CTL = 0, CTL_ZERO_BYTES = 1 * MiB;
constexpr size_t WS_SSQ = 46 * MiB + 512 * 1024;
constexpr size_t WS_WIN0 = 2 * MiB;
constexpr size_t WS_WOUT0 = 5 * MiB;
constexpr size_t WS_WGU0 = 7 * MiB;
constexpr size_t WS_WDN0 = 18 * MiB;
constexpr size_t WS_WPQ1 = 24 * MiB;
constexpr size_t WS_WUV1 = 26 * MiB;
constexpr size_t WS_WOUT1 = 28 * MiB;
constexpr size_t WS_WGU1 = 30 * MiB;
constexpr size_t WS_WDN1 = 41 * MiB;
constexpr size_t WS_DFT = 48 * MiB;
constexpr size_t WS_XB = 112 * MiB;
constexpr size_t WS_AM = 176 * MiB;
constexpr size_t WS_H = 240 * MiB;
constexpr size_t WS_UB = WS_H, WS_PB = WS_H + 32 * MiB;
constexpr size_t WS_PQT = WS_H, WS_U1 = WS_H + 64 * MiB, WS_V1 = WS_H + 96 * MiB, WS_PQF = WS_H + 128 * MiB;
constexpr size_t WS_END = 416 * MiB;
static_assert(WS_H + (size_t)M * FF * 2 <= WS_END && WS_V1 + (size_t)M * 512 * 2 <= WS_END, "d_ws map");
constexpr int CW_BAR = 4096;

constexpr int RING_OFF = 0, RING_BYTES = 131072;
constexpr int LDSCTL_OFF = RING_BYTES, MISC_OFF = LDSCTL_OFF + 320;
constexpr int LDS_BYTES = 147456;

struct Frame {
    LAS unsigned char* lds;
    volatile LAS unsigned* MISC;
    gu32* ctl;
    int tid, lane, wave;
    int vcu, G;
};
__device__ __forceinline__ float wave_sum(float v) {
#pragma unroll
    for (int o = 1; o < 64; o <<= 1) v += __shfl_xor(v, o);
    return v;
}
__device__ __forceinline__ float bf_lo(unsigned x) { return __builtin_bit_cast(float, x << 16); }
__device__ __forceinline__ float bf_hi(unsigned x) { return __builtin_bit_cast(float, x & 0xffff0000u); }
#define WG_BAR() do { asm volatile("s_waitcnt vmcnt(0) lgkmcnt(0)" ::: "memory"); __builtin_amdgcn_s_barrier(); asm volatile("" ::: "memory"); } while (0)

__device__ __forceinline__ void p0_transpose_item(const float* W, int ldw, const float* gk, bf16* WT, int ldt, int k0, int n0, int dk0, int drow0, LAS float* scr, int lane) {
    float v[32];
    const float* wp = W + (size_t)(k0 + (lane >> 5)) * ldw + n0 + (lane & 31);
#pragma unroll
    for (int i = 0; i < 32; ++i) v[i] = wp[(size_t)(2 * i) * ldw];
    const int c = lane & 7;
    f32x4 g0 = {1.f, 1.f, 1.f, 1.f}, g1 = {1.f, 1.f, 1.f, 1.f};
    if (gk) { g0 = *(const GAS f32x4*)(gk + k0 + 8 * c); g1 = *(const GAS f32x4*)(gk + k0 + 8 * c + 4); }
#pragma unroll
    for (int i = 0; i < 32; ++i) scr[(2 * i + (lane >> 5)) * 33 + (lane & 31)] = v[i];
    LDS_WAIT(); asm volatile("" ::: "memory");
#pragma unroll
    for (int j = 0; j < 4; ++j) { const int n = (lane >> 3) + 8 * j; const LAS float* s = scr + (8 * c) * 33 + n;
        v4u o; o.x = pk2(s[0 * 33] * g0.x, s[1 * 33] * g0.y); o.y = pk2(s[2 * 33] * g0.z, s[3 * 33] * g0.w); o.z = pk2(s[4 * 33] * g1.x, s[5 * 33] * g1.y); o.w = pk2(s[6 * 33] * g1.z, s[7 * 33] * g1.w);
        *(GAS v4u*)(WT + (size_t)(drow0 + n) * ldt + dk0 + 8 * c) = o; }
    LDS_WAIT(); asm volatile("" ::: "memory");
}
__device__ __forceinline__ void p0_job(const float* W, int ldw, const float* gk, int kbeg, int kext, int ncol0, int next, bf16* WT, int ldt, int dkbase, int mode, int half_or_off,
                                       LAS float* scr, int lane, int gw, int NGW, int& cursor) {
    const int nkb = kext / 64, nnb = next / 32, nitems = nkb * nnb;
    int first = (gw - (cursor % NGW) + NGW) % NGW;
    for (int it = first; it < nitems; it += NGW) {
        const int kb = it / nnb, nb = it % nnb, nrel = 32 * nb;
        const int drow0 = (mode == 0) ? (half_or_off + nrel) : (256 * (nrel >> 7) + 128 * half_or_off + (nrel & 127));
        p0_transpose_item(W, ldw, gk, WT, ldt, kbeg + 64 * kb, ncol0 + nrel, dkbase + 64 * kb, drow0, scr, lane);
    }
    cursor += nitems;
}
__device__ __forceinline__ void p0_fold_item(const float* L, int lrow0, const float* sc, const float* Rm, bf16* out, int dk0, float scale, int dw, int lane) {
    const int d = 64 * dw + lane;
    float l0[8], l1[8];
    { const float s0 = sc ? sc[lane] : 1.f, s1 = sc ? sc[64 + lane] : 1.f;
#pragma unroll
      for (int j = 0; j < 8; ++j) { l0[j] = L[(size_t)(lrow0 + j) * 128 + lane] * s0; l1[j] = L[(size_t)(lrow0 + j) * 128 + 64 + lane] * s1; } }
    float acc[8];
#pragma unroll
    for (int j = 0; j < 8; ++j) acc[j] = 0.f;
#pragma unroll
    for (int cb = 0; cb < 4; ++cb) {
        float r[32];
#pragma unroll
        for (int i = 0; i < 32; ++i) r[i] = Rm[(size_t)(cb * 32 + i) * 1024 + d];
#pragma unroll
        for (int i = 0; i < 32; ++i) { const int cp = cb * 32 + i;
#pragma unroll
            for (int j = 0; j < 8; ++j) { const float lv = __builtin_bit_cast(float, __builtin_amdgcn_readlane(__builtin_bit_cast(int, cp < 64 ? l0[j] : l1[j]), cp & 63)); acc[j] = fmaf(lv, r[i], acc[j]); } }
    }
    v4u o; o.x = pk2(acc[0] * scale, acc[1] * scale); o.y = pk2(acc[2] * scale, acc[3] * scale); o.z = pk2(acc[4] * scale, acc[5] * scale); o.w = pk2(acc[6] * scale, acc[7] * scale);
    *(GAS v4u*)(out + (size_t)d * 1024 + dk0) = o;
}
__device__ __forceinline__ void p0_pq_item(const float* Win1, const float* g1, bf16* WPQ, int h, int half, int k0, const LAS float* tab, int lane) {
    const int cp = 64 * half + lane;
    float ap[8], aq[8], w0[8], w1[8];
#pragma unroll
    for (int j = 0; j < 8; ++j) { const float g = g1[k0 + j]; ap[j] = 0.f; aq[j] = 0.f; w0[j] = Win1[(size_t)(k0 + j) * 1536 + h * 128 + lane] * g; w1[j] = Win1[(size_t)(k0 + j) * 1536 + h * 128 + 64 + lane] * g; }
#pragma unroll 8
    for (int c = 0; c < 128; ++c) {
        const int ph = c * cp;
        const float cs = tab[ph & 127], sn = tab[(ph - 32) & 127];
#pragma unroll
        for (int j = 0; j < 8; ++j) { const float w = __builtin_bit_cast(float, __builtin_amdgcn_readlane(__builtin_bit_cast(int, c < 64 ? w0[j] : w1[j]), c & 63)); ap[j] = fmaf(w, cs, ap[j]); aq[j] = fmaf(w, sn, aq[j]); }
    }
    v4u o; o.x = pk2(ap[0], ap[1]); o.y = pk2(ap[2], ap[3]); o.z = pk2(ap[4], ap[5]); o.w = pk2(ap[6], ap[7]);
    *(GAS v4u*)(WPQ + (size_t)(h * 128 + cp) * 1024 + k0) = o;
    o.x = pk2(aq[0], aq[1]); o.y = pk2(aq[2], aq[3]); o.z = pk2(aq[4], aq[5]); o.w = pk2(aq[6], aq[7]);
    *(GAS v4u*)(WPQ + (size_t)(512 + h * 128 + cp) * 1024 + k0) = o;
}

struct Ptrs {
    const float* in[22]; float* out; unsigned char* ws;
};

__device__ __forceinline__ void p0_prologue(Frame& F, const Ptrs& P) {
    const float* x = P.in[0]; const float* mix_g = P.in[1]; const float* ffn_g = P.in[2];
    const float* ev_w_in = P.in[3]; const float* ev_pool_w = P.in[8]; const float* ev_pool_scale = P.in[9]; const float* ev_w_out = P.in[10];
    const float* od_w_in = P.in[11]; const float* od_fourier_w = P.in[12]; const float* od_w_out = P.in[17];
    const float* w_gate = P.in[18]; const float* w_up = P.in[19]; const float* w_down = P.in[20];
    unsigned char* ws = P.ws;
    LAS float* scr = (LAS float*)(F.lds + RING_OFF + F.wave * 8448);
    LAS float* CT = (LAS float*)(F.lds + RING_OFF + 69632);
    LAS float* tab = (LAS float*)(F.lds + RING_OFF + 69632 + 16384);
    for (int i = F.tid; i < 4096; i += NWAVES * 64) CT[i] = cospif((float)i * (1.0f / 2048.0f));
    if (F.tid < 128) tab[F.tid] = cospif((float)F.tid * (1.0f / 64.0f));
    WG_BAR();
    const int gw = F.vcu * NWAVES + F.wave, NGW = F.G * NWAVES, lane = F.lane;
    { unsigned long long* z = (unsigned long long*)(ws + WS_SSQ) + M; const int gt = F.vcu * NWAVES * 64 + F.tid, NT = F.G * NWAVES * 64;
      for (int i = gt; i < 4 * M; i += NT) z[i] = 0ull; }
    int cur = 0;
    p0_job(ev_w_in, 1536, mix_g, 0, 1024, 0, 512, (bf16*)(ws + WS_WIN0), 1024, 0, 1, 0, scr, lane, gw, NGW, cur);
    p0_job(ev_w_in, 1536, mix_g, 0, 1024, 512, 512, (bf16*)(ws + WS_WIN0), 1024, 0, 1, 1, scr, lane, gw, NGW, cur);
    p0_job(ev_w_in, 1536, mix_g, 0, 1024, 1024, 512, (bf16*)(ws + WS_WIN0), 1024, 0, 0, 1024, scr, lane, gw, NGW, cur);
    p0_job(ev_w_out, 1024, nullptr, 0, 512, 0, 1024, (bf16*)(ws + WS_WOUT0), 1024, 0, 0, 0, scr, lane, gw, NGW, cur);
    p0_job(w_gate, FF, ffn_g, 0, 1024, 0, FF, (bf16*)(ws + WS_WGU0), 1024, 0, 1, 0, scr, lane, gw, NGW, cur);
    p0_job(w_up, FF, ffn_g, 0, 1024, 0, FF, (bf16*)(ws + WS_WGU0), 1024, 0, 1, 1, scr, lane, gw, NGW, cur);
    p0_job(w_down, 1024, nullptr, 0, FF, 0, 1024, (bf16*)(ws + WS_WDN0), FF, 0, 0, 0, scr, lane, gw, NGW, cur);
    p0_job(od_w_in, 1536, mix_g + D, 0, 1024, 512, 1024, (bf16*)(ws + WS_WUV1), 1024, 0, 0, 0, scr, lane, gw, NGW, cur);
    p0_job(od_w_out, 1024, nullptr, 512, 512, 0, 1024, (bf16*)(ws + WS_WOUT1), 1024, 512, 0, 0, scr, lane, gw, NGW, cur);
    p0_job(w_gate + (size_t)D * FF, FF, ffn_g + D, 0, 1024, 0, FF, (bf16*)(ws + WS_WGU1), 1024, 0, 1, 0, scr, lane, gw, NGW, cur);
    p0_job(w_up + (size_t)D * FF, FF, ffn_g + D, 0, 1024, 0, FF, (bf16*)(ws + WS_WGU1), 1024, 0, 1, 1, scr, lane, gw, NGW, cur);
    p0_job(w_down + (size_t)FF * D, 1024, nullptr, 0, FF, 0, 1024, (bf16*)(ws + WS_WDN1), FF, 0, 0, 0, scr, lane, gw, NGW, cur);
    {
        int first = (gw - (cur % NGW) + NGW) % NGW;
        for (int it = first; it < 1024; it += NGW) { const int g = it >> 8, cc = (it >> 4) & 15, dw = it & 15;
            p0_fold_item(ev_pool_w, g * 128 + cc * 8, ev_pool_scale + g * 128, ev_w_out + (size_t)(512 + g * 128) * 1024, (bf16*)(ws + WS_WOUT0), 512 + g * 128 + cc * 8, 1.0f, dw, lane); }
        cur += 1024;
        first = (gw - (cur % NGW) + NGW) % NGW;
        for (int it = first; it < 1024; it += NGW) { const int h = it >> 8, cc = (it >> 4) & 15, dw = it & 15;
            p0_fold_item(od_fourier_w, h * 128 + cc * 8, nullptr, od_w_out + (size_t)(h * 128) * 1024, (bf16*)(ws + WS_WOUT1), h * 128 + cc * 8, 1.0f / 724.0773439350247f, dw, lane); }
        cur += 1024;
        first = (gw - (cur % NGW) + NGW) % NGW;
        for (int it = first; it < 1024; it += NGW) { const int h = it >> 8, half = (it >> 7) & 1, kc = it & 127;
            p0_pq_item(od_w_in, mix_g + D, (bf16*)(ws + WS_WPQ1), h, half, kc * 8, tab, lane); }
        cur += 1024;
    }
    {
        bf16* Dm = (bf16*)(ws + WS_DFT);
        int first = (gw - (cur % NGW) + NGW) % NGW;
        for (int t = first; t < S; t += NGW) {
#pragma unroll 2
            for (int q = 0; q < 8; ++q) {
                const int k0 = (q * 64 + lane) * 8, s0 = k0 & (S / 2 - 1), sinpart = k0 >> 11;
                float v[8];
#pragma unroll
                for (int e = 0; e < 8; ++e) { int idx = (s0 + e) * t + (sinpart ? 1024 : 0); if (sinpart && s0 + e == 0) idx = 2048 * t; v[e] = CT[idx & (S - 1)]; }
                v4u o; o.x = pk2(v[0], v[1]); o.y = pk2(v[2], v[3]); o.z = pk2(v[4], v[5]); o.w = pk2(v[6], v[7]);
                *(GAS v4u*)(Dm + (size_t)t * S + k0) = o;
            }
        }
        cur += S;
    }
    {
        bf16* XB = (bf16*)(ws + WS_XB); unsigned long long* ssq0 = (unsigned long long*)(ws + WS_SSQ);
        for (int m0 = 4 * gw; m0 < M; m0 += 4 * NGW) {
            f32x4 v[4][4];
#pragma unroll
            for (int r = 0; r < 4; ++r) { const GAS f32x4* xr = (const GAS f32x4*)(x + (size_t)(m0 + r) * D) + lane;
#pragma unroll
                for (int j = 0; j < 4; ++j) v[r][j] = xr[64 * j]; }
#pragma unroll
            for (int r = 0; r < 4; ++r) { float s = 0.f;
#pragma unroll
                for (int j = 0; j < 4; ++j) s += (v[r][j].x * v[r][j].x + v[r][j].y * v[r][j].y) + (v[r][j].z * v[r][j].z + v[r][j].w * v[r][j].w);
                s = wave_sum(s);
                if (lane == 0) ssq0[m0 + r] = pg8::ssq_fix(s);
                GAS unsigned long long* o8 = (GAS unsigned long long*)(XB + (size_t)(m0 + r) * D) + lane;
#pragma unroll
                for (int j = 0; j < 4; ++j) o8[64 * j] = (unsigned long long)pk2(v[r][j].x, v[r][j].y) | ((unsigned long long)pk2(v[r][j].z, v[r][j].w) << 32); }
        }
    }
}

__device__ __forceinline__ float reduce_scatter32(float (&v)[32], int lane) {
#pragma unroll
    for (int o = 16; o >= 1; o >>= 1) {
        const bool up = (lane & o) != 0;
#pragma unroll
        for (int i = 0; i < o; ++i) { const float send = up ? v[i] : v[i + o]; const float keep = up ? v[i + o] : v[i]; v[i] = keep + __shfl_xor(send, o); }
    }
    return v[0] + __shfl_xor(v[0], 32);
}
__device__ __forceinline__ void mix0_conv_item(Frame& F, const Ptrs& P, int item) {
    const bf16* UB = (const bf16*)(P.ws + WS_UB); bf16* AM = (bf16*)(P.ws + WS_AM);
    const float* cw = P.in[4]; const float* cb = P.in[5]; const float* lg = P.in[6]; const float* lb = P.in[7];
    const int b = item >> 6, t0 = (item & 63) * 64, rowbase = b * S;
    LAS unsigned* tile = (LAS unsigned*)(F.lds + RING_OFF);
    LAS float* red = (LAS float*)(F.lds + RING_OFF + 98304);
    LAS float* stats = (LAS float*)(F.lds + RING_OFF + 98304 + 1024);
    { v4u tv[12];
#pragma unroll
      for (int i = 0; i < 12; ++i) { const int t = t0 - 15 + F.wave + NWAVES * i, tc = t < 0 ? 0 : (t > S - 1 ? S - 1 : t);
          tv[i] = *(const GAS v4u*)(UB + (size_t)(rowbase + tc) * 512 + F.lane * 8); }
#pragma unroll
      for (int i = 0; i < 12; ++i) { const int r = F.wave + NWAVES * i, t = t0 - 15 + r; const bool ok = (t >= 0 && t < S);
          v4u w = tv[i]; w.x = ok ? w.x : 0u; w.y = ok ? w.y : 0u; w.z = ok ? w.z : 0u; w.w = ok ? w.w : 0u;
          *(LAS v4u*)(tile + r * 256 + F.lane * 4) = w; } }
    WG_BAR();
    int tidl = F.tid; asm volatile("" : "+v"(tidl));
    const int rg = tidl >> 8, cp = tidl & 255, lanel = tidl & 63;
    const f32x2g bb = *(const GAS f32x2g*)(cb + 2 * cp);
    const f32x2g g2 = *(const GAS f32x2g*)(lg + 2 * cp), b2 = *(const GAS f32x2g*)(lb + 2 * cp);
#pragma unroll 1
    for (int p = 0; p < 2; ++p) {
        float a0[16], a1[16];
#pragma unroll
        for (int o = 0; o < 16; ++o) { a0[o] = bb.x; a1[o] = bb.y; }
#pragma unroll 1
        for (int th = 0; th < 2; ++th) {
            float w0[16], w1[16];
#pragma unroll
            for (int jj = 0; jj < 16; ++jj) { const int j = 16 * th + jj; f32x2g w = {0.f, 0.f}; if (j < 31) w = *(const GAS f32x2g*)(cw + j * 512 + 2 * cp); w0[jj] = w.x; w1[jj] = w.y; }
            const LAS unsigned* tp = tile + (32 * rg + 16 * p + 16 * th) * 256 + cp;
#pragma unroll
            for (int ii = 0; ii < 31; ++ii) {
                const unsigned xx = tp[ii * 256];
                const float x0 = bf_lo(xx), x1 = bf_hi(xx);
#pragma unroll
                for (int o = 0; o < 16; ++o) { const int jj = ii - o; if (jj >= 0 && jj <= 15) { a0[o] = fmaf(w0[jj], x0, a0[o]); a1[o] = fmaf(w1[jj], x1, a1[o]); } }
            }
        }
        float v[32];
#pragma unroll
        for (int o = 0; o < 16; ++o) { v[2 * o] = a0[o] + a1[o]; v[2 * o + 1] = a0[o] * a0[o] + a1[o] * a1[o]; }
        const float tot = reduce_scatter32(v, lanel);
        if (lanel < 32) red[F.wave * 32 + lanel] = tot;
        WG_BAR();
        if (cp < 16) { const int wb = rg * 4; float s = 0.f, q = 0.f;
#pragma unroll
            for (int w = 0; w < 4; ++w) { s += red[(wb + w) * 32 + 2 * cp]; q += red[(wb + w) * 32 + 2 * cp + 1]; }
            const float mean = s * (1.0f / 512.0f), var = q * (1.0f / 512.0f) - mean * mean;
            stats[(rg * 16 + cp) * 2] = mean; stats[(rg * 16 + cp) * 2 + 1] = rsqrtf(var + 1e-6f); }
        WG_BAR();
#pragma unroll
        for (int o = 0; o < 16; ++o) {
            const float mean = stats[(rg * 16 + o) * 2], rstd = stats[(rg * 16 + o) * 2 + 1];
            float y0 = (a0[o] - mean) * rstd * g2.x + b2.x, y1 = (a1[o] - mean) * rstd * g2.y + b2.y;
            y0 = y0 * __builtin_amdgcn_rcpf(1.0f + __expf(-y0)); y1 = y1 * __builtin_amdgcn_rcpf(1.0f + __expf(-y1));
            *(GAS unsigned*)(AM + (size_t)(rowbase + t0 + 32 * rg + 16 * p + o) * 1024 + 2 * cp) = pk2(y0, y1);
        }
    }
    WG_BAR();
}
template <int H> __device__ __forceinline__ void pool_rows(const LAS unsigned* tp  , bf16* orow  , int tfirst) {
    unsigned x[32 + 2 * H];
#pragma unroll
    for (int i = 0; i < 32 + 2 * H; ++i) x[i] = tp[i * 256];
    float s0 = 0.f, s1 = 0.f;
#pragma unroll
    for (int i = 0; i < 2 * H; ++i) { s0 += bf_lo(x[i]); s1 += bf_hi(x[i]); }
#pragma unroll
    for (int o = 0; o < 32; ++o) {
        const int t = tfirst + o;
        const int lo = (t - H) < 0 ? 0 : (t - H), hi = (t + H - 1) > (S - 1) ? (S - 1) : (t + H - 1);
        const float inv = 1.0f / (float)(hi - lo + 1);
        *(GAS unsigned*)(orow + (size_t)o * 1024) = pk2(s0 * inv - bf_lo(x[o + H]), s1 * inv - bf_hi(x[o + H]));
        if (o < 31) { s0 += bf_lo(x[o + 2 * H]) - bf_lo(x[o]); s1 += bf_hi(x[o + 2 * H]) - bf_hi(x[o]); }
    }
}
__device__ __forceinline__ void mix0_pool_item(Frame& F, const Ptrs& P, int item) {
    const bf16* PB = (const bf16*)(P.ws + WS_PB); bf16* AM = (bf16*)(P.ws + WS_AM);
    const int b = item >> 6, t0 = (item & 63) * 64, rowbase = b * S;
    LAS unsigned* tile = (LAS unsigned*)(F.lds + RING_OFF);
    { v4u tv[10];
#pragma unroll
      for (int i = 0; i < 10; ++i) { const int t = t0 - 8 + F.wave + NWAVES * i, tc = t < 0 ? 0 : (t > S - 1 ? S - 1 : t);
          tv[i] = *(const GAS v4u*)(PB + (size_t)(rowbase + tc) * 512 + F.lane * 8); }
#pragma unroll
      for (int i = 0; i < 10; ++i) { const int r = F.wave + NWAVES * i, t = t0 - 8 + r; const bool ok = (t >= 0 && t < S);
          v4u w = tv[i]; w.x = ok ? w.x : 0u; w.y = ok ? w.y : 0u; w.z = ok ? w.z : 0u; w.w = ok ? w.w : 0u;
          *(LAS v4u*)(tile + r * 256 + F.lane * 4) = w; } }
    WG_BAR();
    const int rg = F.tid >> 8, cp = F.tid & 255, g = __builtin_amdgcn_readfirstlane(cp >> 6);
    bf16* orow = AM + (size_t)(rowbase + t0 + 32 * rg) * 1024 + 512 + 2 * cp;
    const int tfirst = t0 + 32 * rg;
    if (g == 0) pool_rows<1>(tile + (32 * rg + 8 - 1) * 256 + cp, orow, tfirst);
    else if (g == 1) pool_rows<2>(tile + (32 * rg + 8 - 2) * 256 + cp, orow, tfirst);
    else if (g == 2) pool_rows<4>(tile + (32 * rg + 8 - 4) * 256 + cp, orow, tfirst);
    else pool_rows<8>(tile + (32 * rg + 8 - 8) * 256 + cp, orow, tfirst);
    WG_BAR();
}

__device__ __forceinline__ void sgu_item(Frame& F, const Ptrs& P, int item) {
    const bf16* U = (const bf16*)(P.ws + WS_U1); const bf16* V = (const bf16*)(P.ws + WS_V1); bf16* AM = (bf16*)(P.ws + WS_AM);
    const float* lng = P.in[13]; const float* lnb = P.in[14]; const float* sw = P.in[15]; const float* sb = P.in[16];
    const int h = item & 3, rowbase = (item >> 2) * 128;
    LAS bf16* vnT = (LAS bf16*)(F.lds + RING_OFF);
    const int lane = F.lane;
    {
        const f32x2g g2 = *(const GAS f32x2g*)(lng + h * 128 + 2 * lane), b2 = *(const GAS f32x2g*)(lnb + h * 128 + 2 * lane);
        unsigned xv[16];
#pragma unroll
        for (int i = 0; i < 16; ++i) xv[i] = *(const GAS unsigned*)(V + (size_t)(rowbase + F.wave + 8 * i) * 512 + h * 128 + 2 * lane);
#pragma unroll
        for (int i = 0; i < 16; ++i) { const int k = F.wave + 8 * i;
            const float v0 = bf_lo(xv[i]), v1 = bf_hi(xv[i]);
            const float mean = wave_sum(v0 + v1) * (1.0f / 128.0f), d0 = v0 - mean, d1 = v1 - mean;
            const float rstd = rsqrtf(wave_sum(d0 * d0 + d1 * d1) * (1.0f / 128.0f) + 1e-6f);
            vnT[(2 * lane) * 136 + k] = (bf16)f2bf(d0 * rstd * g2.x + b2.x); vnT[(2 * lane + 1) * 136 + k] = (bf16)f2bf(d1 * rstd * g2.y + b2.y); }
    }
    WG_BAR();
    {
        const int fr = lane & 15, fq = lane >> 4, q = 16 * F.wave + fr;
        pg8::f32x4 acc[8];
#pragma unroll
        for (int nt = 0; nt < 8; ++nt) acc[nt] = (pg8::f32x4){0.f, 0.f, 0.f, 0.f};
#pragma unroll
        for (int ks = 0; ks < 4; ++ks) {
            const GAS pg8::f32x4* wp = (const GAS pg8::f32x4*)(sw + (size_t)(h * 128 + q) * 128 + ks * 32 + 8 * fq);
            const pg8::f32x4 wa = wp[0], wb = wp[1];
            pg8::u32x4 wq; wq.x = pk2(wa[0], wa[1]); wq.y = pk2(wa[2], wa[3]); wq.z = pk2(wb[0], wb[1]); wq.w = pk2(wb[2], wb[3]);
            const pg8::bf16x8 wf = __builtin_bit_cast(pg8::bf16x8, wq);
#pragma unroll
            for (int nt = 0; nt < 8; ++nt) {
                const pg8::bf16x8 vf = *(const LAS pg8::bf16x8*)(vnT + (16 * nt + fr) * 136 + ks * 32 + 8 * fq);
                acc[nt] = __builtin_amdgcn_mfma_f32_16x16x32_bf16(vf, wf, acc[nt], 0, 0, 0);
            }
        }
        const float bias = sb[h * 128 + q]; const size_t t = (size_t)(rowbase + q);
#pragma unroll
        for (int nt = 0; nt < 8; ++nt) { const int c0 = h * 128 + 16 * nt + 4 * fq;
            const u32x2g uu = *(const GAS u32x2g*)(U + t * 512 + c0);
            u32x2g o; o.x = pk2(bf_lo(uu.x) * (acc[nt][0] + bias), bf_hi(uu.x) * (acc[nt][1] + bias)); o.y = pk2(bf_lo(uu.y) * (acc[nt][2] + bias), bf_hi(uu.y) * (acc[nt][3] + bias));
            *(GAS u32x2g*)(AM + t * 1024 + 512 + c0) = o; }
    }
    WG_BAR();
}

__device__ __forceinline__ void fold_rows(Frame& F, const Ptrs& P) {
    const bf16* PQT = (const bf16*)(P.ws + WS_PQT); bf16* PQF = (bf16*)(P.ws + WS_PQF);
    LAS unsigned short* buf = (LAS unsigned short*)(F.lds + RING_OFF + F.wave * 16384);
    const int gw = F.vcu * NWAVES + F.wave, NGW = F.G * NWAVES, lane = F.lane;
    for (int row = gw; row < NB * 512; row += NGW) {
        const GAS v4u* src = (const GAS v4u*)(PQT + (size_t)row * 2 * S) + lane;
        v4u t[16];
#pragma unroll
        for (int i = 0; i < 16; ++i) t[i] = src[64 * i];
#pragma unroll
        for (int i = 0; i < 16; ++i) *(LAS v4u*)(buf + (size_t)(64 * i + lane) * 8) = t[i];
        LDS_WAIT(); asm volatile("" ::: "memory");
        GAS v4u* dst = (GAS v4u*)(PQF + (size_t)row * S) + lane;
#pragma unroll
        for (int q = 0; q < 8; ++q) {
            const int k0 = (q * 64 + lane) * 8, sinpart = k0 >> 11, s0 = k0 & (S / 2 - 1);
            const LAS unsigned short* pr = buf + (sinpart ? S : 0);
            float v[8];
#pragma unroll
            for (int e = 0; e < 8; ++e) { const int sidx = s0 + e;
                const float a = __builtin_bit_cast(float, (unsigned)pr[sidx] << 16), bm = __builtin_bit_cast(float, (unsigned)pr[(S - sidx) & (S - 1)] << 16);
                v[e] = sinpart ? (a - bm) : (a + bm);
                if (sidx == 0) v[e] = sinpart ? __builtin_bit_cast(float, (unsigned)buf[S / 2] << 16) : a; }
            v4u o; o.x = pk2(v[0], v[1]); o.y = pk2(v[2], v[3]); o.z = pk2(v[4], v[5]); o.w = pk2(v[6], v[7]);
            dst[64 * q] = o;
        }
        LDS_WAIT(); asm volatile("" ::: "memory");
    }
}

struct Args { const float* in[22]; float* out; unsigned char* ws; int ph_lo, ph_hi, li, pad; };
__global__ void __launch_bounds__(NWAVES * 64, 2) mk_fwd(Args args) {
    extern __shared__ __attribute__((aligned(16))) unsigned char lds[];
    Frame F;
    F.lds = (LAS unsigned char*)lds;
    F.MISC = (volatile LAS unsigned*)(F.lds + MISC_OFF);
    F.tid = threadIdx.x; F.lane = F.tid & 63; F.wave = __builtin_amdgcn_readfirstlane(F.tid >> 6);
    F.G = gridDim.x; { const int bx = blockIdx.x; F.vcu = (F.G % 8 == 0) ? (bx % 8) * (F.G / 8) + bx / 8 : bx; }
    Ptrs P;
#pragma unroll
    for (int i = 0; i < 22; ++i) P.in[i] = args.in[i];
    P.out = args.out; P.ws = args.ws;
    unsigned char* ws = args.ws;
    F.ctl = (gu32*)(ws + WS_CTL);
    for (int u = F.tid; u < (LDS_BYTES - LDSCTL_OFF) / 4; u += NWAVES * 64) ((LAS unsigned*)(F.lds + LDSCTL_OFF))[u] = 0u;
    __syncthreads();
    XcdBarrier bar; bar.bar = (unsigned*)(F.ctl + CW_BAR); bar.x = 0; bar.st = nullptr;
    if (!MK_PER_PHASE) bar = xcd_barrier_post((unsigned*)(F.ctl + CW_BAR), F.MISC + 8);
    const int lo = args.ph_lo, hi = args.ph_hi;
#ifndef PH_MASK
#define PH_MASK 0x1FFF
#endif
#define IN(k) ((((PH_MASK) >> (k)) & 1) && lo <= (k) && (k) < hi)
#ifndef PROBE_DUP
#define PROBE_DUP 0
#endif
#define REP(k) for (int rep = 0; rep < 1 + (((PROBE_DUP) >> (k)) & 1); ++rep)
#ifndef PROBE_BARX
#define PROBE_BARX 1
#endif
#define SEAM(k) do { if (IN(k) && IN((k) + 1)) { for (int bx_ = 0; bx_ < PROBE_BARX; ++bx_) xcd_barrier(bar); } } while (0)
    unsigned long long* ssq = (unsigned long long*)(ws + WS_SSQ);
    bf16* XB = (bf16*)(ws + WS_XB); bf16* AM = (bf16*)(ws + WS_AM); bf16* HB = (bf16*)(ws + WS_H);
    const int bid = (int)blockIdx.x;
    bf16* TRX = (bf16*)(ws + WS_END); unsigned long long* TRS = (unsigned long long*)(ws + WS_END + 64 * MiB);

    if (IN(0)) REP(0) { p0_prologue(F, P); } SEAM(0);
    if (IN(1)) REP(1) { pg8::Gemm g{XB, (const bf16*)(ws + WS_WIN0), M, 1536, D}; pg8::StaticOrder So; So.init(M, 1536, F.G, bid);
        pg8::EpiInL0 E{(bf16*)(ws + WS_UB), (bf16*)(ws + WS_PB), ssq};
        pg8::gemm_phase<pg8::EpiInL0, pg8::StaticOrder, true, true>(F.lds + RING_OFF, g, So, E); } SEAM(1);
    if (IN(2)) REP(2) { for (int it = F.vcu; it < 1024; it += F.G) {
#ifndef NO_CONV
            if (it < 512) mix0_conv_item(F, P, it);
#endif
#ifndef NO_POOL
            if (it >= 512) mix0_pool_item(F, P, it - 512);
#endif
 } } SEAM(2);
    if (IN(3)) REP(3) { pg8::Gemm g{AM, (const bf16*)(ws + WS_WOUT0), M, D, D}; pg8::StaticOrder So; So.init(M, D, F.G, bid);
        pg8::EpiResid E{XB, rep ? TRS : ssq + M, rep ? TRX : XB};
        pg8::gemm_phase<pg8::EpiResid, pg8::StaticOrder, true, true>(F.lds + RING_OFF, g, So, E); } SEAM(3);
    if (IN(4)) REP(4) { pg8::Gemm g{XB, (const bf16*)(ws + WS_WGU0), M, 2 * FF, D}; pg8::StaticOrder So; So.init(M, 2 * FF, F.G, bid);
        pg8::EpiSwiGLU E{HB, ssq + M};
        pg8::gemm_phase<pg8::EpiSwiGLU, pg8::StaticOrder, true, true>(F.lds + RING_OFF, g, So, E); } SEAM(4);
    if (IN(5)) REP(5) { pg8::Gemm g{HB, (const bf16*)(ws + WS_WDN0), M, D, FF}; pg8::StaticOrder So; So.init(M, D, F.G, bid);
        pg8::EpiResid E{XB, rep ? TRS : ssq + 2 * M, rep ? TRX : XB};
        pg8::gemm_phase<pg8::EpiResid, pg8::StaticOrder, true, true>(F.lds + RING_OFF, g, So, E); } SEAM(5);
    if (IN(6)) {
        REP(6) { pg8::Gemm g{(const bf16*)(ws + WS_WPQ1), XB, 1024, M, D}; pg8::StaticOrder So; So.init(1024, M, F.G, bid);
          pg8::EpiPQT E{(bf16*)(ws + WS_PQT), ssq + 2 * M};
          pg8::gemm_phase<pg8::EpiPQT, pg8::StaticOrder, true, true>(F.lds + RING_OFF, g, So, E); }
        REP(14) { pg8::Gemm g{XB, (const bf16*)(ws + WS_WUV1), M, 1024, D}; pg8::StaticOrder So; So.init(M, 1024, F.G, bid);
          pg8::EpiGeluUV E{(bf16*)(ws + WS_U1), (bf16*)(ws + WS_V1), ssq + 2 * M};
          pg8::gemm_phase<pg8::EpiGeluUV, pg8::StaticOrder, true, true>(F.lds + RING_OFF, g, So, E); }
    } SEAM(6);
    if (IN(7)) {
        REP(7) { fold_rows(F, P); }
        REP(13) { for (int it = F.vcu; it < 1024; it += F.G) sgu_item(F, P, it); }
    } SEAM(7);
    if (IN(8)) REP(8) { pg8::Gemm g{(const bf16*)(ws + WS_DFT), (const bf16*)(ws + WS_PQF), S, NB * 512, S}; pg8::StaticOrder So; So.init(S, NB * 512, F.G, bid);
        pg8::EpiDFT E{AM};
        pg8::gemm_phase<pg8::EpiDFT, pg8::StaticOrder, true, true>(F.lds + RING_OFF, g, So, E); } SEAM(8);
    if (IN(9)) REP(9) { pg8::Gemm g{AM, (const bf16*)(ws + WS_WOUT1), M, D, D}; pg8::StaticOrder So; So.init(M, D, F.G, bid);
        pg8::EpiResid E{XB, rep ? TRS : ssq + 3 * M, rep ? TRX : XB};
        pg8::gemm_phase<pg8::EpiResid, pg8::StaticOrder, true, true>(F.lds + RING_OFF, g, So, E); } SEAM(9);
    if (IN(10)) REP(10) { pg8::Gemm g{XB, (const bf16*)(ws + WS_WGU1), M, 2 * FF, D}; pg8::StaticOrder So; So.init(M, 2 * FF, F.G, bid);
        pg8::EpiSwiGLU E{HB, ssq + 3 * M};
        pg8::gemm_phase<pg8::EpiSwiGLU, pg8::StaticOrder, true, true>(F.lds + RING_OFF, g, So, E); } SEAM(10);
    if (IN(11)) REP(11) { pg8::Gemm g{HB, (const bf16*)(ws + WS_WDN1), M, D, FF}; pg8::StaticOrder So; So.init(M, D, F.G, bid);
        pg8::EpiResid E{XB, rep ? TRS : ssq + 4 * M, rep ? TRX : XB};
        pg8::gemm_phase<pg8::EpiResid, pg8::StaticOrder, true, true>(F.lds + RING_OFF, g, So, E); } SEAM(11);
    if (IN(12)) REP(12) {
        const float* gf = P.in[21]; const unsigned long long* ssq4 = ssq + 4 * M;
        const int gw = F.vcu * NWAVES + F.wave, NGW = F.G * NWAVES;
        for (int m = gw; m < M; m += NGW) {
            const GAS u32x2g* xr = (const GAS u32x2g*)(XB + (size_t)m * D) + F.lane; GAS f32x4* orow = (GAS f32x4*)(P.out + (size_t)m * D) + F.lane; const GAS f32x4* gr = (const GAS f32x4*)gf + F.lane;
            const float rs = pg8::rstd_of(ssq4[m]);
#pragma unroll
            for (int j = 0; j < 4; ++j) { const u32x2g xx = xr[64 * j]; const f32x4 gg = gr[64 * j];
                f32x4 v; v.x = bf_lo(xx.x); v.y = bf_hi(xx.x); v.z = bf_lo(xx.y); v.w = bf_hi(xx.y); orow[64 * j] = v * rs * gg; }
        }
    }
#undef IN
#undef SEAM
}

extern "C" void kernel_launch(void* const* d_in, const int* in_sizes, int n_in, void* d_out, int out_size, void* d_ws, size_t ws_size, hipStream_t stream) {
    static int grid = 0;
    if (grid == 0) {
        if (n_in != 22 || in_sizes[0] != M * D || out_size != M * D || ws_size < WS_END) { fprintf(stderr, "kernel_launch: unexpected shapes (n_in %d, in0 %d, out %d, ws %zu); nothing launched\n", n_in, n_in > 0 ? in_sizes[0] : -1, out_size, ws_size); grid = -1; return; }
        int dev = 0, cus = 0, per_cu = 0;
        if (hipGetDevice(&dev) != hipSuccess || hipDeviceGetAttribute(&cus, hipDeviceAttributeMultiprocessorCount, dev) != hipSuccess) { grid = -1; return; }
        if (hipFuncSetAttribute((const void*)mk_fwd, hipFuncAttributeMaxDynamicSharedMemorySize, LDS_BYTES) != hipSuccess) { fprintf(stderr, "kernel_launch: hipFuncSetAttribute failed\n"); grid = -1; return; }
        if (hipOccupancyMaxActiveBlocksPerMultiprocessor(&per_cu, (const void*)mk_fwd, NWAVES * 64, LDS_BYTES) != hipSuccess || per_cu < 1) { fprintf(stderr, "kernel_launch: occupancy query says %d blocks per CU\n", per_cu); per_cu = 1; }
        (void)hipGetLastError();
        grid = cus * 1;
    }
    if (grid < 0) return;
    if (hipMemsetAsync((char*)d_ws + WS_CTL, 0, CTL_ZERO_BYTES, stream) != hipSuccess) { fprintf(stderr, "kernel_launch: hipMemsetAsync failed\n"); return; }
    Args a{};
    for (int i = 0; i < 22; ++i) a.in[i] = (const float*)d_in[i];
    a.out = (float*)d_out; a.ws = (unsigned char*)d_ws;
#if MK_PER_PHASE
    for (int ph = 0; ph < N_PHASES; ++ph) { a.ph_lo = ph; a.ph_hi = ph + 1; a.li = ph;
        hipLaunchKernelGGL(mk_fwd, dim3(grid), dim3(NWAVES * 64), LDS_BYTES, stream, a); }
#else
    a.ph_lo = 0; a.ph_hi = N_PHASES; a.li = 0;
#ifdef MK_PLAIN_LAUNCH
    hipLaunchKernelGGL(mk_fwd, dim3(grid), dim3(NWAVES * 64), LDS_BYTES, stream, a);
#else
    void* kargs[] = {&a};
    hipError_t e = hipLaunchCooperativeKernel((const void*)mk_fwd, dim3(grid), dim3(NWAVES * 64), kargs, LDS_BYTES, stream);
    if (e != hipSuccess) fprintf(stderr, "kernel_launch: cooperative launch failed: %s (grid %d)\n", hipGetErrorString(e), grid);
#endif
#endif
}
```

```cpp
#include <hip/hip_runtime.h>
#include <cstdio>
#include <cstdint>
namespace pg8 {
#define PG8_LAS __attribute__((address_space(3)))
typedef unsigned short bf16_t;
typedef short bf16x8 __attribute__((ext_vector_type(8)));
typedef float f32x4 __attribute__((ext_vector_type(4)));
typedef unsigned u32x4 __attribute__((ext_vector_type(4)));
constexpr int BM = 256, BK = 64, HALF = 128, HTB = HALF * BK * 2  , STAGE_BYTES = 8 * HTB, NXCD = 8, WGM = 8;

__host__ __device__ __forceinline__ int lds_byte(int r, int c) { const int st = (r >> 4) * 2 + (c >> 5), rr = r & 15, cc = c & 31, ob = rr * 64 + cc * 2; return st * 1024 + (ob ^ (((ob >> 9) & 1) << 5)); }
__host__ __device__ __forceinline__ void stage_rc(int b, int& R, int& C) { const int st = b / 1024, sb = b % 1024, swz = sb ^ (((sb >> 9) & 1) << 5); R = (st >> 1) * 16 + swz / 64; C = (st & 1) * 32 + (swz % 64) / 2; }
__host__ __device__ __forceinline__ int perm32(int rho) { const int n = rho >> 4, i = rho & 15; return 8 * (i >> 2) + 4 * n + (i & 3); }

struct Unit { int pm, pn; };
struct Gemm { const bf16_t* A; const bf16_t* Bt; int M, N, K; };

struct StaticOrder {
    int nM, nN, nwg, G, c;
    __host__ __device__ void init(int M, int N, int G_, int c_) { nM = M / BM; nN = N / BM; nwg = nM * nN; G = G_; c = c_; }
    __host__ __device__ bool next(int i, Unit& u) const {
        const long L = (long)i * G + c; if (L >= nwg) return false;
        int wgid = (int)L; { const int q = nwg / NXCD, r = nwg % NXCD, xcd = wgid % NXCD, off = wgid / NXCD; wgid = (xcd < r ? xcd * (q + 1) : r * (q + 1) + (xcd - r) * q) + off; }
        const int nig = WGM * nN, gid = wgid / nig, fm = gid * WGM, gsz = (nM - fm) < WGM ? (nM - fm) : WGM;
        u.pm = fm + ((wgid % nig) % gsz); u.pn = (wgid % nig) / gsz; return true;
    }
    __device__ __forceinline__ void a_ready(const Unit&) const {}
    __device__ __forceinline__ void done(const Unit&) const {}
};

__device__ __forceinline__ unsigned cvt_pk_bf16(float lo, float hi) { unsigned r; asm volatile("v_cvt_pk_bf16_f32 %0, %1, %2" : "=v"(r) : "v"(lo), "v"(hi)); return r; }
typedef float f32x2 __attribute__((ext_vector_type(2)));
__device__ __forceinline__ f32x2 gelu_pk(f32x2 v) {
    const f32x2 av = __builtin_elementwise_abs(v), d = av * 0.2316418882f + 1.0f;
    f32x2 t; t.x = __builtin_amdgcn_rcpf(d.x); t.y = __builtin_amdgcn_rcpf(d.y);
    f32x2 q = t * 0.5307027145f + (-0.7265760135f); q = q * t + 0.7107068705f; q = q * t + (-0.142248368f); q = q * t + 0.127414796f; q = q * t;
    const f32x2 s = (v * v) * (-0.72134752044f);
    f32x2 e; e.x = __builtin_amdgcn_exp2f(s.x); e.y = __builtin_amdgcn_exp2f(s.y);
    const f32x2 m = v * (q * e), r = v - m;
    f32x2 o; o.x = v.x < 0.f ? m.x : r.x; o.y = v.y < 0.f ? m.y : r.y; return o;
}


constexpr float RMS_EPS = 1e-6f;
__device__ __forceinline__ float sigm(float x) { return __builtin_amdgcn_rcpf(1.0f + __expf(-x)); }
__device__ __forceinline__ u32x4 pack8(const f32x4 v0, const f32x4 v1) { u32x4 w; w.x = cvt_pk_bf16(v0[0], v0[1]); w.y = cvt_pk_bf16(v0[2], v0[3]); w.z = cvt_pk_bf16(v1[0], v1[1]); w.w = cvt_pk_bf16(v1[2], v1[3]); return w; }
typedef unsigned long long u64_t;
__device__ __forceinline__ float rstd_of(u64_t ssq) { return rsqrtf((float)ssq * (1.0f / (1024.0f * 1048576.0f)) + RMS_EPS); }
__device__ __forceinline__ u64_t ssq_fix(float s) { return (u64_t)(s * 1048576.0f); }

struct EpiInL0 {
    static constexpr bool PERM = true, AFTER_DRAIN = false;
    bf16_t* UB; bf16_t* PB; const u64_t* ssq;
    __device__ __forceinline__ void operator()(const f32x4 (&acc)[2][2][4][2], const Unit& u, int wr, int wc, int fr, int fq) const {
        const int row0 = u.pm * BM + wr * 64 + fr, cw = wc * 32 + 8 * fq;
#pragma unroll
        for (int ai = 0; ai < 2; ++ai)
#pragma unroll
            for (int m = 0; m < 4; ++m) {
                const int row = row0 + ai * HALF + m * 16;
                const float rs = rstd_of(ssq[row]);
                if (u.pn < 4) {
                    f32x4 o[2];
#pragma unroll
                    for (int n = 0; n < 2; ++n)
#pragma unroll
                        for (int j = 0; j < 4; ++j) { const float a = acc[ai][0][m][n][j] * rs, g = acc[ai][1][m][n][j] * rs; o[n][j] = a * sigm(g); }
                    *(u32x4*)(UB + (size_t)row * 512 + u.pn * 128 + cw) = pack8(o[0], o[1]);
                } else {
#pragma unroll
                    for (int bj = 0; bj < 2; ++bj) *(u32x4*)(PB + (size_t)row * 512 + (u.pn - 4) * 256 + bj * HALF + cw) = pack8(acc[ai][bj][m][0] * rs, acc[ai][bj][m][1] * rs);
                }
            }
    }
};
struct EpiResid {
    static constexpr bool PERM = true, AFTER_DRAIN = false;
    bf16_t* XB; u64_t* ssq; bf16_t* XBw;
    __device__ __forceinline__ void operator()(const f32x4 (&acc)[2][2][4][2], const Unit& u, int wr, int wc, int fr, int fq) const {
        const int row0 = u.pm * BM + wr * 64 + fr, cw = wc * 32 + 8 * fq;
#pragma unroll
        for (int ai = 0; ai < 2; ++ai)
#pragma unroll
            for (int m = 0; m < 4; ++m) {
                const int row = row0 + ai * HALF + m * 16;
                float s = 0.f;
#pragma unroll
                for (int bj = 0; bj < 2; ++bj) {
                    bf16_t* p = XB + (size_t)row * 1024 + u.pn * BM + bj * HALF + cw;
                    const u32x4 r = *(const u32x4*)p;
                    f32x4 v0, v1;
                    v0[0] = __builtin_bit_cast(float, r.x << 16) + acc[ai][bj][m][0][0]; v0[1] = __builtin_bit_cast(float, r.x & 0xffff0000u) + acc[ai][bj][m][0][1];
                    v0[2] = __builtin_bit_cast(float, r.y << 16) + acc[ai][bj][m][0][2]; v0[3] = __builtin_bit_cast(float, r.y & 0xffff0000u) + acc[ai][bj][m][0][3];
                    v1[0] = __builtin_bit_cast(float, r.z << 16) + acc[ai][bj][m][1][0]; v1[1] = __builtin_bit_cast(float, r.z & 0xffff0000u) + acc[ai][bj][m][1][1];
                    v1[2] = __builtin_bit_cast(float, r.w << 16) + acc[ai][bj][m][1][2]; v1[3] = __builtin_bit_cast(float, r.w & 0xffff0000u) + acc[ai][bj][m][1][3];
                    const u32x4 w = pack8(v0, v1);
                    *(u32x4*)(XBw + ((size_t)row * 1024 + u.pn * BM + bj * HALF + cw)) = w;
                    const float q0 = __builtin_bit_cast(float, w.x << 16), q1 = __builtin_bit_cast(float, w.x & 0xffff0000u), q2 = __builtin_bit_cast(float, w.y << 16), q3 = __builtin_bit_cast(float, w.y & 0xffff0000u);
                    const float q4 = __builtin_bit_cast(float, w.z << 16), q5 = __builtin_bit_cast(float, w.z & 0xffff0000u), q6 = __builtin_bit_cast(float, w.w << 16), q7 = __builtin_bit_cast(float, w.w & 0xffff0000u);
                    s += (q0 * q0 + q1 * q1) + (q2 * q2 + q3 * q3) + (q4 * q4 + q5 * q5) + (q6 * q6 + q7 * q7);
                }
                s += __shfl_xor(s, 16); s += __shfl_xor(s, 32);
                if (fq == 0) atomicAdd(ssq + row, ssq_fix(s));
            }
    }
};
struct EpiSwiGLU {
    static constexpr bool PERM = true, AFTER_DRAIN = false;
    bf16_t* H; const u64_t* ssq;
    __device__ __forceinline__ void operator()(const f32x4 (&acc)[2][2][4][2], const Unit& u, int wr, int wc, int fr, int fq) const {
        const int row0 = u.pm * BM + wr * 64 + fr, cw = wc * 32 + 8 * fq;
#pragma unroll
        for (int ai = 0; ai < 2; ++ai)
#pragma unroll
            for (int m = 0; m < 4; ++m) {
                const int row = row0 + ai * HALF + m * 16;
                const float rs = rstd_of(ssq[row]);
                f32x4 o[2];
#pragma unroll
                for (int n = 0; n < 2; ++n)
#pragma unroll
                    for (int j = 0; j < 4; ++j) { const float g = acc[ai][0][m][n][j] * rs, up = acc[ai][1][m][n][j] * rs; o[n][j] = g * sigm(g) * up; }
                *(u32x4*)(H + (size_t)row * 2816 + u.pn * 128 + cw) = pack8(o[0], o[1]);
            }
    }
};
struct EpiPQT {
    static constexpr bool PERM = true, AFTER_DRAIN = false;
    bf16_t* PQT; const u64_t* ssq;
    __device__ __forceinline__ void operator()(const f32x4 (&acc)[2][2][4][2], const Unit& u, int wr, int wc, int fr, int fq) const {
        const int tok0 = u.pn * BM + wc * 32 + 8 * fq, b = (u.pn * BM) >> 12;
        f32x4 rs[2][2];
#pragma unroll
        for (int bj = 0; bj < 2; ++bj)
#pragma unroll
            for (int n = 0; n < 2; ++n)
#pragma unroll
                for (int j = 0; j < 4; ++j) rs[bj][n][j] = rstd_of(ssq[tok0 + bj * HALF + 4 * n + j]);
#pragma unroll
        for (int ai = 0; ai < 2; ++ai)
#pragma unroll
            for (int m = 0; m < 4; ++m) {
                const int r = u.pm * BM + ai * HALF + wr * 64 + m * 16 + fr, pq = r >> 9, ch = r & 511;
                bf16_t* base = PQT + ((size_t)(b * 512 + ch) * 2 + pq) * 4096;
#pragma unroll
                for (int bj = 0; bj < 2; ++bj) *(u32x4*)(base + ((tok0 + bj * HALF) & 4095)) = pack8(acc[ai][bj][m][0] * rs[bj][0], acc[ai][bj][m][1] * rs[bj][1]);
            }
    }
};
struct EpiGeluUV {
    static constexpr bool PERM = true, AFTER_DRAIN = false;
    bf16_t* U; bf16_t* V; const u64_t* ssq;
    __device__ __forceinline__ void operator()(const f32x4 (&acc)[2][2][4][2], const Unit& u, int wr, int wc, int fr, int fq) const {
        const int row0 = u.pm * BM + wr * 64 + fr, cw = wc * 32 + 8 * fq;
        bf16_t* dst = (u.pn < 2) ? U : V; const int colb = (u.pn & 1) * BM;
#pragma unroll
        for (int ai = 0; ai < 2; ++ai)
#pragma unroll
            for (int m = 0; m < 4; ++m) {
                const int row = row0 + ai * HALF + m * 16;
                const float rs = rstd_of(ssq[row]);
#pragma unroll
                for (int bj = 0; bj < 2; ++bj) {
                    const f32x4 v0 = acc[ai][bj][m][0] * rs, v1 = acc[ai][bj][m][1] * rs;
                    const f32x2 a = gelu_pk((f32x2){v0[0], v0[1]}), bq = gelu_pk((f32x2){v0[2], v0[3]}), c = gelu_pk((f32x2){v1[0], v1[1]}), d = gelu_pk((f32x2){v1[2], v1[3]});
                    *(u32x4*)(dst + (size_t)row * 512 + colb + bj * HALF + cw) = pack8((f32x4){a.x, a.y, bq.x, bq.y}, (f32x4){c.x, c.y, d.x, d.y});
                }
            }
    }
};
struct EpiDFT {
    static constexpr bool PERM = true, AFTER_DRAIN = false;
    bf16_t* AM;
    __device__ __forceinline__ void operator()(const f32x4 (&acc)[2][2][4][2], const Unit& u, int wr, int wc, int fr, int fq) const {
        const int row0 = (u.pn >> 1) * 4096 + u.pm * BM + wr * 64 + fr, cw = (u.pn & 1) * BM + wc * 32 + 8 * fq;
#pragma unroll
        for (int ai = 0; ai < 2; ++ai)
#pragma unroll
            for (int m = 0; m < 4; ++m) {
                const int row = row0 + ai * HALF + m * 16;
#pragma unroll
                for (int bj = 0; bj < 2; ++bj) *(u32x4*)(AM + (size_t)row * 1024 + bj * HALF + cw) = pack8(acc[ai][bj][m][0], acc[ai][bj][m][1]);
            }
    }
};

template <class Epi, class Sched, bool ALIGN_EPI = false, bool SP2 = false>
__device__ __forceinline__ void gemm_phase(PG8_LAS unsigned char* lds, const Gemm g, const Sched& S, const Epi& E) {
    const int tid = threadIdx.x, wid = __builtin_amdgcn_readfirstlane(tid >> 6), lane = tid & 63, wr = wid >> 2, wc = wid & 3, fr = lane & 15, fq = lane >> 4;
    const int K = g.K, nt = K / BK;
    unsigned voffA[2], voffB[2];
#pragma unroll
    for (int i = 0; i < 2; ++i) { int R, C; stage_rc(tid * 16 + i * 8192, R, C); const int Rb = Epi::PERM ? ((R & ~31) + perm32(R & 31)) : R;
        voffA[i] = (unsigned)(R * K + C) * 2u; voffB[i] = (unsigned)(Rb * K + C) * 2u; }
    const size_t kstep = (size_t)(BK * 2);
    const size_t hstep = (size_t)HALF * K * 2;
    const size_t tstep = 2 * hstep;
    const unsigned ldsw = (unsigned)wid * 1024u;
    const int aoff = lds_byte(wr * 64 + fr, fq * 8), boff = lds_byte(wc * 32 + fr, fq * 8);
#define PG8_SA(b, h) (((b) * 2 + (h)) * HTB)
#define PG8_SB(b, h) ((4 + (b) * 2 + (h)) * HTB)
#define PG8_STAGE(bufoff, gbase, voff) do { _Pragma("unroll") for (int _i = 0; _i < 2; ++_i) \
        __builtin_amdgcn_global_load_lds((const unsigned*)((const char*)(gbase) + (voff)[_i]), (PG8_LAS unsigned*)(lds + (bufoff) + ldsw + _i * 8192), 16, 0, 0); } while (0)
#define PG8_LDA(dst, b, h) do { _Pragma("unroll") for (int m = 0; m < 4; ++m) _Pragma("unroll") for (int k = 0; k < 2; ++k) dst[m][k] = *(const PG8_LAS bf16x8*)(lds + PG8_SA(b, h) + aoff + m * 2048 + k * 1024); } while (0)
#define PG8_LDB(dst, b, h) do { _Pragma("unroll") for (int n = 0; n < 2; ++n) _Pragma("unroll") for (int k = 0; k < 2; ++k) dst[n][k] = *(const PG8_LAS bf16x8*)(lds + PG8_SB(b, h) + boff + n * 2048 + k * 1024); } while (0)
#define PG8_MMA(ai, bj, At, Bt) do { __builtin_amdgcn_s_setprio(1); _Pragma("unroll") for (int m = 0; m < 4; ++m) _Pragma("unroll") for (int n = 0; n < 2; ++n) _Pragma("unroll") for (int k = 0; k < 2; ++k) \
        acc[ai][bj][m][n] = __builtin_amdgcn_mfma_f32_16x16x32_bf16(Bt[n][k], At[m][k], acc[ai][bj][m][n], 0, 0, 0); __builtin_amdgcn_s_setprio(0); } while (0)
#define PG8_WAIT_V(n) asm volatile("s_waitcnt vmcnt(" #n ")" ::: "memory")
#define PG8_WAIT_L(n) asm volatile("s_waitcnt lgkmcnt(" #n ")" ::: "memory")
#define PG8_BAR __builtin_amdgcn_s_barrier()
#define PG8_SCHED __builtin_amdgcn_sched_barrier(0)
    Unit cur, nxt; int ui = 0;
    if (!S.next(0, cur)) return;
    f32x4 acc[2][2][4][2];
#pragma unroll
    for (int a = 0; a < 2; ++a)
#pragma unroll
        for (int b = 0; b < 2; ++b)
#pragma unroll
            for (int m = 0; m < 4; ++m)
#pragma unroll
                for (int n = 0; n < 2; ++n) acc[a][b][m][n] = (f32x4){0.f, 0.f, 0.f, 0.f};
    bf16x8 At[4][2], B0[2][2], B1[2][2];
    const char* cA = (const char*)g.A + (size_t)cur.pm * tstep; const char* cB = (const char*)g.Bt + (size_t)cur.pn * tstep;
    S.a_ready(cur);
    if constexpr (SP2) {
        PG8_STAGE(PG8_SB(0, 0), cB, voffB); PG8_STAGE(PG8_SB(0, 1), cB + hstep, voffB); PG8_STAGE(PG8_SA(0, 0), cA, voffA); PG8_STAGE(PG8_SA(0, 1), cA + hstep, voffA);
        if (wr == 1) PG8_BAR;
        PG8_WAIT_V(2); PG8_BAR;
        PG8_STAGE(PG8_SB(1, 0), cB + kstep, voffB); PG8_STAGE(PG8_SA(1, 0), cA + kstep, voffA); PG8_STAGE(PG8_SB(1, 1), cB + hstep + kstep, voffB);
        PG8_WAIT_V(6); PG8_BAR;
    } else {
        PG8_STAGE(PG8_SB(0, 0), cB, voffB); PG8_STAGE(PG8_SA(0, 0), cA, voffA); PG8_STAGE(PG8_SB(0, 1), cB + hstep, voffB); PG8_STAGE(PG8_SA(0, 1), cA + hstep, voffA);
        if (wr == 1) PG8_BAR;
        PG8_WAIT_V(4); PG8_BAR;
        PG8_STAGE(PG8_SB(1, 0), cB + kstep, voffB); PG8_STAGE(PG8_SA(1, 0), cA + kstep, voffA); PG8_STAGE(PG8_SB(1, 1), cB + hstep + kstep, voffB);
        PG8_WAIT_V(6); PG8_BAR;
    }
    for (;;) {
        const bool has_next = S.next(ui + 1, nxt);
        const char* nA = has_next ? (const char*)g.A + (size_t)nxt.pm * tstep : cA; const char* nB = has_next ? (const char*)g.Bt + (size_t)nxt.pn * tstep : cB;
        for (int t = 0; t < nt; t += 2) {
            const bool last = (t == nt - 2);
            const char* a1 = cA + (size_t)(t + 1) * kstep;
            const char* a2 = last ? nA : cA + (size_t)(t + 2) * kstep; const char* b2 = last ? nB : cB + (size_t)(t + 2) * kstep;
            const char* a3 = a2 + kstep; const char* b3 = b2 + kstep;
            if (last && has_next) S.a_ready(nxt);
            if constexpr (SP2) {
            PG8_LDB(B0, 0, 0); PG8_LDB(B1, 0, 1); PG8_SCHED; PG8_LDA(At, 0, 0); PG8_STAGE(PG8_SA(1, 1), a1 + hstep, voffA);
            PG8_WAIT_V(8); PG8_WAIT_L(0); PG8_BAR; PG8_MMA(0, 0, At, B0); PG8_MMA(0, 1, At, B1); PG8_BAR; PG8_SCHED;
            PG8_LDA(At, 0, 1); PG8_STAGE(PG8_SB(0, 0), b2, voffB); PG8_STAGE(PG8_SB(0, 1), b2 + hstep, voffB); PG8_STAGE(PG8_SA(0, 0), a2, voffA);
            PG8_WAIT_V(8); PG8_WAIT_L(0); PG8_BAR; PG8_MMA(1, 0, At, B0); PG8_MMA(1, 1, At, B1); PG8_BAR; PG8_SCHED;
            PG8_LDB(B0, 1, 0); PG8_LDB(B1, 1, 1); PG8_SCHED; PG8_LDA(At, 1, 0); PG8_STAGE(PG8_SA(0, 1), a2 + hstep, voffA);
            PG8_WAIT_V(8); PG8_WAIT_L(0); PG8_BAR; PG8_MMA(0, 0, At, B0); PG8_MMA(0, 1, At, B1); PG8_BAR; PG8_SCHED;
            PG8_LDA(At, 1, 1); PG8_STAGE(PG8_SB(1, 0), b3, voffB); PG8_STAGE(PG8_SB(1, 1), b3 + hstep, voffB); PG8_STAGE(PG8_SA(1, 0), a3, voffA);
            PG8_WAIT_V(8); PG8_WAIT_L(0); PG8_BAR; PG8_MMA(1, 0, At, B0); PG8_MMA(1, 1, At, B1); PG8_BAR; PG8_SCHED;
            } else {
            PG8_LDB(B0, 0, 0); PG8_SCHED; PG8_LDA(At, 0, 0); PG8_STAGE(PG8_SA(1, 1), a1 + hstep, voffA);
            PG8_WAIT_L(8); PG8_BAR; PG8_WAIT_L(0); PG8_MMA(0, 0, At, B0); PG8_BAR; PG8_SCHED;
            PG8_LDB(B1, 0, 1); PG8_STAGE(PG8_SB(0, 0), b2, voffB);
            PG8_BAR; PG8_WAIT_L(0); PG8_MMA(0, 1, At, B1); PG8_BAR;
            PG8_LDA(At, 0, 1); PG8_STAGE(PG8_SA(0, 0), a2, voffA);
            PG8_BAR; PG8_WAIT_L(0); PG8_MMA(1, 0, At, B0); PG8_BAR; PG8_SCHED;
            PG8_STAGE(PG8_SB(0, 1), b2 + hstep, voffB);
            PG8_WAIT_V(6); PG8_BAR; PG8_MMA(1, 1, At, B1); PG8_BAR;
            PG8_LDB(B0, 1, 0); PG8_SCHED; PG8_LDA(At, 1, 0); PG8_STAGE(PG8_SA(0, 1), a2 + hstep, voffA);
            PG8_WAIT_L(8); PG8_BAR; PG8_WAIT_L(0); PG8_MMA(0, 0, At, B0); PG8_BAR; PG8_SCHED;
            PG8_LDB(B1, 1, 1); PG8_STAGE(PG8_SB(1, 0), b3, voffB);
            PG8_BAR; PG8_WAIT_L(0); PG8_MMA(0, 1, At, B1); PG8_BAR;
            PG8_LDA(At, 1, 1); PG8_STAGE(PG8_SA(1, 0), a3, voffA);
            PG8_BAR; PG8_WAIT_L(0); PG8_MMA(1, 0, At, B0); PG8_BAR; PG8_SCHED;
            PG8_STAGE(PG8_SB(1, 1), b3 + hstep, voffB);
            PG8_WAIT_V(6); PG8_BAR; PG8_MMA(1, 1, At, B1); PG8_BAR;
            }
        }
        if constexpr (ALIGN_EPI) { if (wr == 0) PG8_BAR; }
        if constexpr (!Epi::AFTER_DRAIN) { E(acc, cur, wr, wc, fr, fq); S.done(cur); }
        if (!has_next) break;
#pragma unroll
        for (int a = 0; a < 2; ++a)
#pragma unroll
            for (int b = 0; b < 2; ++b)
#pragma unroll
                for (int m = 0; m < 4; ++m)
#pragma unroll
                    for (int n = 0; n < 2; ++n) acc[a][b][m][n] = (f32x4){0.f, 0.f, 0.f, 0.f};
        cur = nxt; cA = nA; cB = nB; ++ui;
        if constexpr (ALIGN_EPI) { if (wr == 1) PG8_BAR; }
    }
    PG8_WAIT_V(0);
    if constexpr (!ALIGN_EPI) { if (wr == 0) PG8_BAR; }
    PG8_BAR;
    if constexpr (Epi::AFTER_DRAIN) { E.fused(acc, cur, wr, wc, fr, fq, lds, wid, lane); S.done(cur); }
#undef PG8_SA
#undef PG8_SB
#undef PG8_STAGE
#undef PG8_LDA
#undef PG8_LDB
#undef PG8_MMA
#undef PG8_WAIT_V
#undef PG8_WAIT_L
#undef PG8_BAR
#undef PG8_SCHED
}
}
#define GAS __attribute__((address_space(1)))
#define LAS __attribute__((address_space(3)))
typedef unsigned short bf16;
typedef unsigned v4u __attribute__((ext_vector_type(4)));
typedef float f32x4 __attribute__((ext_vector_type(4)));
typedef short bf16x8 __attribute__((ext_vector_type(8)));
typedef GAS unsigned gu32;
typedef GAS unsigned long long gu64;
#define RLX_AGENT __ATOMIC_RELAXED, __HIP_MEMORY_SCOPE_AGENT
#define LDS_WAIT() asm volatile("s_waitcnt lgkmcnt(0)" ::: "memory")
#define VM_WAIT() asm volatile("s_waitcnt vmcnt(0)" ::: "memory")
__device__ __forceinline__ unsigned long long rt() { return __builtin_amdgcn_s_memrealtime(); }
__device__ __forceinline__ unsigned f2bf(float f) { unsigned u = __builtin_bit_cast(unsigned, f); return (u + 0x7fffu + ((u >> 16) & 1u)) >> 16; }
__device__ __forceinline__ unsigned pk2(float lo, float hi) { return f2bf(lo) | (f2bf(hi) << 16); }

#define XB_TMO      128
#define XB_XCNT(j)  (256  + 64 * (j))
#define XB_XSUB(j)  (1280 + 64 * (j))
#define XB_XGEN(j)  (2304 + 64 * (j))
#define XB_TOP      3328
#define XB_TOPGEN   3392
#define XCD_BAR_WORDS 3456
#define XB_SPIN_CAP (1u << 18)

__device__ __forceinline__ unsigned xb_ld(unsigned* p)              { return __hip_atomic_load(p, __ATOMIC_RELAXED, __HIP_MEMORY_SCOPE_AGENT); }
__device__ __forceinline__ unsigned xb_add(unsigned* p, unsigned v) { return __hip_atomic_fetch_add(p, v, __ATOMIC_RELAXED, __HIP_MEMORY_SCOPE_AGENT); }
__device__ __forceinline__ unsigned xb_xcc_id() { return (unsigned)__builtin_amdgcn_s_getreg((3 << 11) | 20) & 0xFu; }
#define XB_SPIN(cond, bar) do { unsigned _sp = 0; while (cond) { __builtin_amdgcn_s_sleep(1); \
    if ((++_sp & 255u) == 0u) { if (xb_ld(&(bar)[XB_TMO])) break; if (_sp > XB_SPIN_CAP) { atomicAdd(&(bar)[XB_TMO], 1u); break; } } } } while (0)

struct XcdBarrier {
    unsigned* bar; unsigned x;
    volatile LAS unsigned* st;
};

__device__ __forceinline__ XcdBarrier xcd_barrier_post(unsigned* bar, volatile LAS unsigned* st) {
    XcdBarrier b; b.bar = bar; b.x = xb_xcc_id(); b.st = st;
    if (threadIdx.x == 0) (void)xb_add(&bar[XB_XCNT(b.x)], 1u);
    return b;
}
__device__ __forceinline__ void xcd_barrier_complete(unsigned* bar, unsigned x, unsigned& nloc, unsigned& nx) {
    const unsigned G = gridDim.x * gridDim.y * gridDim.z;
    unsigned sum, cnt, mine, sp = 0u;
    for (;;) {
        sum = 0u; cnt = 0u; mine = 0u;
#pragma unroll
        for (unsigned j = 0; j < 16; ++j) { const unsigned c = xb_ld(&bar[XB_XCNT(j)]); sum += c; cnt += (c > 0u) ? 1u : 0u; mine = (j == x) ? c : mine; }
        if (sum == G) break;
        __builtin_amdgcn_s_sleep(1);
        if ((++sp & 255u) == 0u) { if (xb_ld(&bar[XB_TMO])) break; if (sp > XB_SPIN_CAP) { atomicAdd(&bar[XB_TMO], 1u); break; } }
    }
    nloc = mine > 0u ? mine : 1u; nx = cnt > 0u ? cnt : 1u;
}

__device__ __forceinline__ void xcd_barrier(const XcdBarrier& b) {
    asm volatile("s_waitcnt vmcnt(0)" ::: "memory");
    __syncthreads();
    if (threadIdx.x == 0) {
        unsigned* bar = b.bar;
        __builtin_amdgcn_s_waitcnt(0);
        unsigned nloc = b.st[0], nx = b.st[1];
        if (nloc == 0u) { xcd_barrier_complete(bar, b.x, nloc, nx); b.st[0] = nloc; b.st[1] = nx; }
        const unsigned old = xb_add(&bar[XB_XSUB(b.x)], 1u);
        const unsigned gen = old / nloc;
        if (old + 1u == (gen + 1u) * nloc) {
            __builtin_amdgcn_fence(__ATOMIC_RELEASE, "agent");
            asm volatile("s_waitcnt vmcnt(0)" ::: "memory");
            const unsigned og = xb_add(&bar[XB_TOP], 1u);
            const unsigned tg = og / nx;
            if (og + 1u == (tg + 1u) * nx) xb_add(&bar[XB_TOPGEN], 1u);
            else XB_SPIN(xb_ld(&bar[XB_TOPGEN]) == tg, bar);
            __builtin_amdgcn_fence(__ATOMIC_ACQUIRE, "agent");
            xb_add(&bar[XB_XGEN(b.x)], 1u);
            asm volatile("s_waitcnt vmcnt(0)" ::: "memory");
        } else {
            XB_SPIN(xb_ld(&bar[XB_XGEN(b.x)]) == gen, bar);
            __builtin_amdgcn_fence(__ATOMIC_ACQUIRE, "agent");
            asm volatile("s_waitcnt vmcnt(0)" ::: "memory");
        }
    }
    __syncthreads();
}

constexpr int NWAVES = 8;
#ifndef MK_PER_PHASE
#define MK_PER_PHASE 0
#endif
constexpr int N_PHASES = 13;

constexpr int NB = 8, S = 4096, D = 1024, FF = 2816, M = NB * S;
typedef float f32x2g __attribute__((ext_vector_type(2)));
typedef unsigned u32x2g __attribute__((ext_vector_type(2)));

constexpr size_t MiB = 1u << 20;
constexpr size_t WS_CTL = 0, CTL_ZERO_BYTES = 1 * MiB;
constexpr size_t WS_SSQ = 46 * MiB + 512 * 1024;
constexpr size_t WS_WIN0 = 2 * MiB;
constexpr size_t WS_WOUT0 = 5 * MiB;
constexpr size_t WS_WGU0 = 7 * MiB;
constexpr size_t WS_WDN0 = 18 * MiB;
constexpr size_t WS_WPQ1 = 24 * MiB;
constexpr size_t WS_WUV1 = 26 * MiB;
constexpr size_t WS_WOUT1 = 28 * MiB;
constexpr size_t WS_WGU1 = 30 * MiB;
constexpr size_t WS_WDN1 = 41 * MiB;
constexpr size_t WS_DFT = 48 * MiB;
constexpr size_t WS_XB = 112 * MiB;
constexpr size_t WS_AM = 176 * MiB;
constexpr size_t WS_H = 240 * MiB;
constexpr size_t WS_UB = WS_H, WS_PB = WS_H + 32 * MiB;
constexpr size_t WS_PQT = WS_H, WS_U1 = WS_H + 64 * MiB, WS_V1 = WS_H + 96 * MiB, WS_PQF = WS_H + 128 * MiB;
constexpr size_t WS_END = 416 * MiB;
static_assert(WS_H + (size_t)M * FF * 2 <= WS_END && WS_V1 + (size_t)M * 512 * 2 <= WS_END, "d_ws map");
constexpr int CW_BAR = 4096;

constexpr int RING_OFF = 0, RING_BYTES = 131072;
constexpr int LDSCTL_OFF = RING_BYTES, MISC_OFF = LDSCTL_OFF + 320;
constexpr int LDS_BYTES = 147456;

struct Frame {
    LAS unsigned char* lds;
    volatile LAS unsigned* MISC;
    gu32* ctl;
    int tid, lane, wave;
    int vcu, G;
};
__device__ __forceinline__ float wave_sum(float v) {
#pragma unroll
    for (int o = 1; o < 64; o <<= 1) v += __shfl_xor(v, o);
    return v;
}
__device__ __forceinline__ float bf_lo(unsigned x) { return __builtin_bit_cast(float, x << 16); }
__device__ __forceinline__ float bf_hi(unsigned x) { return __builtin_bit_cast(float, x & 0xffff0000u); }
#define WG_BAR() do { asm volatile("s_waitcnt vmcnt(0) lgkmcnt(0)" ::: "memory"); __builtin_amdgcn_s_barrier(); asm volatile("" ::: "memory"); } while (0)

__device__ __forceinline__ void p0_transpose_item(const float* W, int ldw, const float* gk, bf16* WT, int ldt, int k0, int n0, int dk0, int drow0, LAS float* scr, int lane) {
    float v[32];
    const float* wp = W + (size_t)(k0 + (lane >> 5)) * ldw + n0 + (lane & 31);
#pragma unroll
    for (int i = 0; i < 32; ++i) v[i] = wp[(size_t)(2 * i) * ldw];
    const int c = lane & 7;
    f32x4 g0 = {1.f, 1.f, 1.f, 1.f}, g1 = {1.f, 1.f, 1.f, 1.f};
    if (gk) { g0 = *(const GAS f32x4*)(gk + k0 + 8 * c); g1 = *(const GAS f32x4*)(gk + k0 + 8 * c + 4); }
#pragma unroll
    for (int i = 0; i < 32; ++i) scr[(2 * i + (lane >> 5)) * 33 + (lane & 31)] = v[i];
    LDS_WAIT(); asm volatile("" ::: "memory");
#pragma unroll
    for (int j = 0; j < 4; ++j) { const int n = (lane >> 3) + 8 * j; const LAS float* s = scr + (8 * c) * 33 + n;
        v4u o; o.x = pk2(s[0 * 33] * g0.x, s[1 * 33] * g0.y); o.y = pk2(s[2 * 33] * g0.z, s[3 * 33] * g0.w); o.z = pk2(s[4 * 33] * g1.x, s[5 * 33] * g1.y); o.w = pk2(s[6 * 33] * g1.z, s[7 * 33] * g1.w);
        *(GAS v4u*)(WT + (size_t)(drow0 + n) * ldt + dk0 + 8 * c) = o; }
    LDS_WAIT(); asm volatile("" ::: "memory");
}
__device__ __forceinline__ void p0_job(const float* W, int ldw, const float* gk, int kbeg, int kext, int ncol0, int next, bf16* WT, int ldt, int dkbase, int mode, int half_or_off,
                                       LAS float* scr, int lane, int gw, int NGW, int& cursor) {
    const int nkb = kext / 64, nnb = next / 32, nitems = nkb * nnb;
    int first = (gw - (cursor % NGW) + NGW) % NGW;
    for (int it = first; it < nitems; it += NGW) {
        const int kb = it / nnb, nb = it % nnb, nrel = 32 * nb;
        const int drow0 = (mode == 0) ? (half_or_off + nrel) : (256 * (nrel >> 7) + 128 * half_or_off + (nrel & 127));
        p0_transpose_item(W, ldw, gk, WT, ldt, kbeg + 64 * kb, ncol0 + nrel, dkbase + 64 * kb, drow0, scr, lane);
    }
    cursor += nitems;
}
__device__ __forceinline__ void p0_fold_item(const float* L, int lrow0, const float* sc, const float* Rm, bf16* out, int dk0, float scale, int dw, int lane) {
    const int d = 64 * dw + lane;
    float l0[8], l1[8];
    { const float s0 = sc ? sc[lane] : 1.f, s1 = sc ? sc[64 + lane] : 1.f;
#pragma unroll
      for (int j = 0; j < 8; ++j) { l0[j] = L[(size_t)(lrow0 + j) * 128 + lane] * s0; l1[j] = L[(size_t)(lrow0 + j) * 128 + 64 + lane] * s1; } }
    float acc[8];
#pragma unroll
    for (int j = 0; j < 8; ++j) acc[j] = 0.f;
#pragma unroll
    for (int cb = 0; cb < 4; ++cb) {
        float r[32];
#pragma unroll
        for (int i = 0; i < 32; ++i) r[i] = Rm[(size_t)(cb * 32 + i) * 1024 + d];
#pragma unroll
        for (int i = 0; i < 32; ++i) { const int cp = cb * 32 + i;
#pragma unroll
            for (int j = 0; j < 8; ++j) { const float lv = __builtin_bit_cast(float, __builtin_amdgcn_readlane(__builtin_bit_cast(int, cp < 64 ? l0[j] : l1[j]), cp & 63)); acc[j] = fmaf(lv, r[i], acc[j]); } }
    }
    v4u o; o.x = pk2(acc[0] * scale, acc[1] * scale); o.y = pk2(acc[2] * scale, acc[3] * scale); o.z = pk2(acc[4] * scale, acc[5] * scale); o.w = pk2(acc[6] * scale, acc[7] * scale);
    *(GAS v4u*)(out + (size_t)d * 1024 + dk0) = o;
}
__device__ __forceinline__ void p0_pq_item(const float* Win1, const float* g1, bf16* WPQ, int h, int half, int k0, const LAS float* tab, int lane) {
    const int cp = 64 * half + lane;
    float ap[8], aq[8], w0[8], w1[8];
#pragma unroll
    for (int j = 0; j < 8; ++j) { const float g = g1[k0 + j]; ap[j] = 0.f; aq[j] = 0.f; w0[j] = Win1[(size_t)(k0 + j) * 1536 + h * 128 + lane] * g; w1[j] = Win1[(size_t)(k0 + j) * 1536 + h * 128 + 64 + lane] * g; }
#pragma unroll 8
    for (int c = 0; c < 128; ++c) {
        const int ph = c * cp;
        const float cs = tab[ph & 127], sn = tab[(ph - 32) & 127];
#pragma unroll
        for (int j = 0; j < 8; ++j) { const float w = __builtin_bit_cast(float, __builtin_amdgcn_readlane(__builtin_bit_cast(int, c < 64 ? w0[j] : w1[j]), c & 63)); ap[j] = fmaf(w, cs, ap[j]); aq[j] = fmaf(w, sn, aq[j]); }
    }
    v4u o; o.x = pk2(ap[0], ap[1]); o.y = pk2(ap[2], ap[3]); o.z = pk2(ap[4], ap[5]); o.w = pk2(ap[6], ap[7]);
    *(GAS v4u*)(WPQ + (size_t)(h * 128 + cp) * 1024 + k0) = o;
    o.x = pk2(aq[0], aq[1]); o.y = pk2(aq[2], aq[3]); o.z = pk2(aq[4], aq[5]); o.w = pk2(aq[6], aq[7]);
    *(GAS v4u*)(WPQ + (size_t)(512 + h * 128 + cp) * 1024 + k0) = o;
}

struct Ptrs {
    const float* in[22]; float* out; unsigned char* ws;
};

__device__ __forceinline__ void p0_prologue(Frame& F, const Ptrs& P) {
    const float* x = P.in[0]; const float* mix_g = P.in[1]; const float* ffn_g = P.in[2];
    const float* ev_w_in = P.in[3]; const float* ev_pool_w = P.in[8]; const float* ev_pool_scale = P.in[9]; const float* ev_w_out = P.in[10];
    const float* od_w_in = P.in[11]; const float* od_fourier_w = P.in[12]; const float* od_w_out = P.in[17];
    const float* w_gate = P.in[18]; const float* w_up = P.in[19]; const float* w_down = P.in[20];
    unsigned char* ws = P.ws;
    LAS float* scr = (LAS float*)(F.lds + RING_OFF + F.wave * 8448);
    LAS float* CT = (LAS float*)(F.lds + RING_OFF + 69632);
    LAS float* tab = (LAS float*)(F.lds + RING_OFF + 69632 + 16384);
    for (int i = F.tid; i < 4096; i += NWAVES * 64) CT[i] = cospif((float)i * (1.0f / 2048.0f));
    if (F.tid < 128) tab[F.tid] = cospif((float)F.tid * (1.0f / 64.0f));
    WG_BAR();
    const int gw = F.vcu * NWAVES + F.wave, NGW = F.G * NWAVES, lane = F.lane;
    { unsigned long long* z = (unsigned long long*)(ws + WS_SSQ) + M; const int gt = F.vcu * NWAVES * 64 + F.tid, NT = F.G * NWAVES * 64;
      for (int i = gt; i < 4 * M; i += NT) z[i] = 0ull; }
    int cur = 0;
    p0_job(ev_w_in, 1536, mix_g, 0, 1024, 0, 512, (bf16*)(ws + WS_WIN0), 1024, 0, 1, 0, scr, lane, gw, NGW, cur);
    p0_job(ev_w_in, 1536, mix_g, 0, 1024, 512, 512, (bf16*)(ws + WS_WIN0), 1024, 0, 1, 1, scr, lane, gw, NGW, cur);
    p0_job(ev_w_in, 1536, mix_g, 0, 1024, 1024, 512, (bf16*)(ws + WS_WIN0), 1024, 0, 0, 1024, scr, lane, gw, NGW, cur);
    p0_job(ev_w_out, 1024, nullptr, 0, 512, 0, 1024, (bf16*)(ws + WS_WOUT0), 1024, 0, 0, 0, scr, lane, gw, NGW, cur);
    p0_job(w_gate, FF, ffn_g, 0, 1024, 0, FF, (bf16*)(ws + WS_WGU0), 1024, 0, 1, 0, scr, lane, gw, NGW, cur);
    p0_job(w_up, FF, ffn_g, 0, 1024, 0, FF, (bf16*)(ws + WS_WGU0), 1024, 0, 1, 1, scr, lane, gw, NGW, cur);
    p0_job(w_down, 1024, nullptr, 0, FF, 0, 1024, (bf16*)(ws + WS_WDN0), FF, 0, 0, 0, scr, lane, gw, NGW, cur);
    p0_job(od_w_in, 1536, mix_g + D, 0, 1024, 512, 1024, (bf16*)(ws + WS_WUV1), 1024, 0, 0, 0, scr, lane, gw, NGW, cur);
    p0_job(od_w_out, 1024, nullptr, 512, 512, 0, 1024, (bf16*)(ws + WS_WOUT1), 1024, 512, 0, 0, scr, lane, gw, NGW, cur);
    p0_job(w_gate + (size_t)D * FF, FF, ffn_g + D, 0, 1024, 0, FF, (bf16*)(ws + WS_WGU1), 1024, 0, 1, 0, scr, lane, gw, NGW, cur);
    p0_job(w_up + (size_t)D * FF, FF, ffn_g + D, 0, 1024, 0, FF, (bf16*)(ws + WS_WGU1), 1024, 0, 1, 1, scr, lane, gw, NGW, cur);
    p0_job(w_down + (size_t)FF * D, 1024, nullptr, 0, FF, 0, 1024, (bf16*)(ws + WS_WDN1), FF, 0, 0, 0, scr, lane, gw, NGW, cur);
    {
        int first = (gw - (cur % NGW) + NGW) % NGW;
        for (int it = first; it < 1024; it += NGW) { const int g = it >> 8, cc = (it >> 4) & 15, dw = it & 15;
            p0_fold_item(ev_pool_w, g * 128 + cc * 8, ev_pool_scale + g * 128, ev_w_out + (size_t)(512 + g * 128) * 1024, (bf16*)(ws + WS_WOUT0), 512 + g * 128 + cc * 8, 1.0f, dw, lane); }
        cur += 1024;
        first = (gw - (cur % NGW) + NGW) % NGW;
        for (int it = first; it < 1024; it += NGW) { const int h = it >> 8, cc = (it >> 4) & 15, dw = it & 15;
            p0_fold_item(od_fourier_w, h * 128 + cc * 8, nullptr, od_w_out + (size_t)(h * 128) * 1024, (bf16*)(ws + WS_WOUT1), h * 128 + cc * 8, 1.0f / 724.0773439350247f, dw, lane); }
        cur += 1024;
        first = (gw - (cur % NGW) + NGW) % NGW;
        for (int it = first; it < 1024; it += NGW) { const int h = it >> 8, half = (it >> 7) & 1, kc = it & 127;
            p0_pq_item(od_w_in, mix_g + D, (bf16*)(ws + WS_WPQ1), h, half, kc * 8, tab, lane); }
        cur += 1024;
    }
    {
        bf16* Dm = (bf16*)(ws + WS_DFT);
        int first = (gw - (cur % NGW) + NGW) % NGW;
        for (int t = first; t < S; t += NGW) {
#pragma unroll 2
            for (int q = 0; q < 8; ++q) {
                const int k0 = (q * 64 + lane) * 8, s0 = k0 & (S / 2 - 1), sinpart = k0 >> 11;
                float v[8];
#pragma unroll
                for (int e = 0; e < 8; ++e) { int idx = (s0 + e) * t + (sinpart ? 1024 : 0); if (sinpart && s0 + e == 0) idx = 2048 * t; v[e] = CT[idx & (S - 1)]; }
                v4u o; o.x = pk2(v[0], v[1]); o.y = pk2(v[2], v[3]); o.z = pk2(v[4], v[5]); o.w = pk2(v[6], v[7]);
                *(GAS v4u*)(Dm + (size_t)t * S + k0) = o;
            }
        }
        cur += S;
    }
    {
        bf16* XB = (bf16*)(ws + WS_XB); unsigned long long* ssq0 = (unsigned long long*)(ws + WS_SSQ);
        for (int m0 = 4 * gw; m0 < M; m0 += 4 * NGW) {
            f32x4 v[4][4];
#pragma unroll
            for (int r = 0; r < 4; ++r) { const GAS f32x4* xr = (const GAS f32x4*)(x + (size_t)(m0 + r) * D) + lane;
#pragma unroll
                for (int j = 0; j < 4; ++j) v[r][j] = xr[64 * j]; }
#pragma unroll
            for (int r = 0; r < 4; ++r) { float s = 0.f;
#pragma unroll
                for (int j = 0; j < 4; ++j) s += (v[r][j].x * v[r][j].x + v[r][j].y * v[r][j].y) + (v[r][j].z * v[r][j].z + v[r][j].w * v[r][j].w);
                s = wave_sum(s);
                if (lane == 0) ssq0[m0 + r] = pg8::ssq_fix(s);
                GAS unsigned long long* o8 = (GAS unsigned long long*)(XB + (size_t)(m0 + r) * D) + lane;
#pragma unroll
                for (int j = 0; j < 4; ++j) o8[64 * j] = (unsigned long long)pk2(v[r][j].x, v[r][j].y) | ((unsigned long long)pk2(v[r][j].z, v[r][j].w) << 32); }
        }
    }
}

__device__ __forceinline__ float reduce_scatter16(float (&v)[16], int lane) {
#pragma unroll
    for (int o = 8; o >= 1; o >>= 1) {
        const bool up = (lane & o) != 0;
#pragma unroll
        for (int i = 0; i < o; ++i) { const float send = up ? v[i] : v[i + o]; const float keep = up ? v[i + o] : v[i]; v[i] = keep + __shfl_xor(send, o); }
    }
    float t = v[0] + __shfl_xor(v[0], 16);
    return t + __shfl_xor(t, 32);
}
__device__ __forceinline__ void mix0_conv_item(Frame& F, const Ptrs& P, int item) {
    const bf16* UB = (const bf16*)(P.ws + WS_UB); bf16* AM = (bf16*)(P.ws + WS_AM);
    const float* cw = P.in[4]; const float* cb = P.in[5]; const float* lg = P.in[6]; const float* lb = P.in[7];
    const int b = item >> 6, t0 = (item & 63) * 64, rowbase = b * S;
    LAS unsigned* tile = (LAS unsigned*)(F.lds + RING_OFF);
    LAS float* red = (LAS float*)(F.lds + RING_OFF + 98304);
    LAS float* stats = (LAS float*)(F.lds + RING_OFF + 98304 + 1024);
    { v4u tv[12];
#pragma unroll
      for (int i = 0; i < 12; ++i) { const int t = t0 - 15 + F.wave + NWAVES * i, tc = t < 0 ? 0 : (t > S - 1 ? S - 1 : t);
          tv[i] = *(const GAS v4u*)(UB + (size_t)(rowbase + tc) * 512 + F.lane * 8); }
#pragma unroll
      for (int i = 0; i < 12; ++i) { const int r = F.wave + NWAVES * i, t = t0 - 15 + r; const bool ok = (t >= 0 && t < S);
          v4u w = tv[i]; w.x = ok ? w.x : 0u; w.y = ok ? w.y : 0u; w.z = ok ? w.z : 0u; w.w = ok ? w.w : 0u;
          *(LAS v4u*)(tile + r * 256 + F.lane * 4) = w; } }
    WG_BAR();
    int tidl = F.tid; asm volatile("" : "+v"(tidl));
    const int rg = tidl >> 8, cp = tidl & 255, lanel = tidl & 63;
    const f32x2g bb = *(const GAS f32x2g*)(cb + 2 * cp);
    const f32x2g g2 = *(const GAS f32x2g*)(lg + 2 * cp), b2 = *(const GAS f32x2g*)(lb + 2 * cp);
#pragma unroll 1
    for (int p = 0; p < 4; ++p) {
        float a0[8], a1[8];
#pragma unroll
        for (int o = 0; o < 8; ++o) { a0[o] = bb.x; a1[o] = bb.y; }
#pragma unroll 1
        for (int th = 0; th < 2; ++th) {
            float w0[16], w1[16];
#pragma unroll
            for (int jj = 0; jj < 16; ++jj) { const int j = 16 * th + jj; f32x2g w = {0.f, 0.f}; if (j < 31) w = *(const GAS f32x2g*)(cw + j * 512 + 2 * cp); w0[jj] = w.x; w1[jj] = w.y; }
            const LAS unsigned* tp = tile + (32 * rg + 8 * p + 16 * th) * 256 + cp;
#pragma unroll
            for (int ii = 0; ii < 23; ++ii) {
                const unsigned xx = tp[ii * 256];
                const float x0 = bf_lo(xx), x1 = bf_hi(xx);
#pragma unroll
                for (int o = 0; o < 8; ++o) { const int jj = ii - o; if (jj >= 0 && jj <= 15) { a0[o] = fmaf(w0[jj], x0, a0[o]); a1[o] = fmaf(w1[jj], x1, a1[o]); } }
            }
        }
        float v[16];
#pragma unroll
        for (int o = 0; o < 8; ++o) { v[2 * o] = a0[o] + a1[o]; v[2 * o + 1] = a0[o] * a0[o] + a1[o] * a1[o]; }
        const float tot = reduce_scatter16(v, lanel);
        if (lanel < 16) red[F.wave * 16 + lanel] = tot;
        WG_BAR();
        if (cp < 8) { const int wb = rg * 4; float s = 0.f, q = 0.f;
#pragma unroll
            for (int w = 0; w < 4; ++w) { s += red[(wb + w) * 16 + 2 * cp]; q += red[(wb + w) * 16 + 2 * cp + 1]; }
            const float mean = s * (1.0f / 512.0f), var = q * (1.0f / 512.0f) - mean * mean;
            stats[(rg * 8 + cp) * 2] = mean; stats[(rg * 8 + cp) * 2 + 1] = rsqrtf(var + 1e-6f); }
        WG_BAR();
#pragma unroll
        for (int o = 0; o < 8; ++o) {
            const float mean = stats[(rg * 8 + o) * 2], rstd = stats[(rg * 8 + o) * 2 + 1];
            float y0 = (a0[o] - mean) * rstd * g2.x + b2.x, y1 = (a1[o] - mean) * rstd * g2.y + b2.y;
            y0 = y0 * __builtin_amdgcn_rcpf(1.0f + __expf(-y0)); y1 = y1 * __builtin_amdgcn_rcpf(1.0f + __expf(-y1));
            *(GAS unsigned*)(AM + (size_t)(rowbase + t0 + 32 * rg + 8 * p + o) * 1024 + 2 * cp) = pk2(y0, y1);
        }
    }
    WG_BAR();
}
template <int H> __device__ __forceinline__ void pool_rows(const LAS unsigned* tp  , bf16* orow  , int tfirst) {
    unsigned x[32 + 2 * H];
#pragma unroll
    for (int i = 0; i < 32 + 2 * H; ++i) x[i] = tp[i * 256];
    float s0 = 0.f, s1 = 0.f;
#pragma unroll
    for (int i = 0; i < 2 * H; ++i) { s0 += bf_lo(x[i]); s1 += bf_hi(x[i]); }
#pragma unroll
    for (int o = 0; o < 32; ++o) {
        const int t = tfirst + o;
        const int lo = (t - H) < 0 ? 0 : (t - H), hi = (t + H - 1) > (S - 1) ? (S - 1) : (t + H - 1);
        const float inv = 1.0f / (float)(hi - lo + 1);
        *(GAS unsigned*)(orow + (size_t)o * 1024) = pk2(s0 * inv - bf_lo(x[o + H]), s1 * inv - bf_hi(x[o + H]));
        if (o < 31) { s0 += bf_lo(x[o + 2 * H]) - bf_lo(x[o]); s1 += bf_hi(x[o + 2 * H]) - bf_hi(x[o]); }
    }
}
__device__ __forceinline__ void mix0_pool_item(Frame& F, const Ptrs& P, int item) {
    const bf16* PB = (const bf16*)(P.ws + WS_PB); bf16* AM = (bf16*)(P.ws + WS_AM);
    const int b = item >> 6, t0 = (item & 63) * 64, rowbase = b * S;
    LAS unsigned* tile = (LAS unsigned*)(F.lds + RING_OFF);
    { v4u tv[10];
#pragma unroll
      for (int i = 0; i < 10; ++i) { const int t = t0 - 8 + F.wave + NWAVES * i, tc = t < 0 ? 0 : (t > S - 1 ? S - 1 : t);
          tv[i] = *(const GAS v4u*)(PB + (size_t)(rowbase + tc) * 512 + F.lane * 8); }
#pragma unroll
      for (int i = 0; i < 10; ++i) { const int r = F.wave + NWAVES * i, t = t0 - 8 + r; const bool ok = (t >= 0 && t < S);
          v4u w = tv[i]; w.x = ok ? w.x : 0u; w.y = ok ? w.y : 0u; w.z = ok ? w.z : 0u; w.w = ok ? w.w : 0u;
          *(LAS v4u*)(tile + r * 256 + F.lane * 4) = w; } }
    WG_BAR();
    const int rg = F.tid >> 8, cp = F.tid & 255, g = __builtin_amdgcn_readfirstlane(cp >> 6);
    bf16* orow = AM + (size_t)(rowbase + t0 + 32 * rg) * 1024 + 512 + 2 * cp;
    const int tfirst = t0 + 32 * rg;
    if (g == 0) pool_rows<1>(tile + (32 * rg + 8 - 1) * 256 + cp, orow, tfirst);
    else if (g == 1) pool_rows<2>(tile + (32 * rg + 8 - 2) * 256 + cp, orow, tfirst);
    else if (g == 2) pool_rows<4>(tile + (32 * rg + 8 - 4) * 256 + cp, orow, tfirst);
    else pool_rows<8>(tile + (32 * rg + 8 - 8) * 256 + cp, orow, tfirst);
    WG_BAR();
}

__device__ __forceinline__ void sgu_item(Frame& F, const Ptrs& P, int item) {
    const bf16* U = (const bf16*)(P.ws + WS_U1); const bf16* V = (const bf16*)(P.ws + WS_V1); bf16* AM = (bf16*)(P.ws + WS_AM);
    const float* lng = P.in[13]; const float* lnb = P.in[14]; const float* sw = P.in[15]; const float* sb = P.in[16];
    const int h = item & 3, rowbase = (item >> 2) * 128;
    LAS bf16* vnT = (LAS bf16*)(F.lds + RING_OFF);
    const int lane = F.lane;
    {
        const f32x2g g2 = *(const GAS f32x2g*)(lng + h * 128 + 2 * lane), b2 = *(const GAS f32x2g*)(lnb + h * 128 + 2 * lane);
        unsigned xv[16];
#pragma unroll
        for (int i = 0; i < 16; ++i) xv[i] = *(const GAS unsigned*)(V + (size_t)(rowbase + F.wave + 8 * i) * 512 + h * 128 + 2 * lane);
#pragma unroll
        for (int i = 0; i < 16; ++i) { const int k = F.wave + 8 * i;
            const float v0 = bf_lo(xv[i]), v1 = bf_hi(xv[i]);
            const float mean = wave_sum(v0 + v1) * (1.0f / 128.0f), d0 = v0 - mean, d1 = v1 - mean;
            const float rstd = rsqrtf(wave_sum(d0 * d0 + d1 * d1) * (1.0f / 128.0f) + 1e-6f);
            vnT[(2 * lane) * 136 + k] = (bf16)f2bf(d0 * rstd * g2.x + b2.x); vnT[(2 * lane + 1) * 136 + k] = (bf16)f2bf(d1 * rstd * g2.y + b2.y); }
    }
    WG_BAR();
    {
        const int fr = lane & 15, fq = lane >> 4, q = 16 * F.wave + fr;
        pg8::f32x4 acc[8];
#pragma unroll
        for (int nt = 0; nt < 8; ++nt) acc[nt] = (pg8::f32x4){0.f, 0.f, 0.f, 0.f};
#pragma unroll
        for (int ks = 0; ks < 4; ++ks) {
            const GAS pg8::f32x4* wp = (const GAS pg8::f32x4*)(sw + (size_t)(h * 128 + q) * 128 + ks * 32 + 8 * fq);
            const pg8::f32x4 wa = wp[0], wb = wp[1];
            pg8::u32x4 wq; wq.x = pk2(wa[0], wa[1]); wq.y = pk2(wa[2], wa[3]); wq.z = pk2(wb[0], wb[1]); wq.w = pk2(wb[2], wb[3]);
            const pg8::bf16x8 wf = __builtin_bit_cast(pg8::bf16x8, wq);
#pragma unroll
            for (int nt = 0; nt < 8; ++nt) {
                const pg8::bf16x8 vf = *(const LAS pg8::bf16x8*)(vnT + (16 * nt + fr) * 136 + ks * 32 + 8 * fq);
                acc[nt] = __builtin_amdgcn_mfma_f32_16x16x32_bf16(vf, wf, acc[nt], 0, 0, 0);
            }
        }
        const float bias = sb[h * 128 + q]; const size_t t = (size_t)(rowbase + q);
#pragma unroll
        for (int nt = 0; nt < 8; ++nt) { const int c0 = h * 128 + 16 * nt + 4 * fq;
            const u32x2g uu = *(const GAS u32x2g*)(U + t * 512 + c0);
            u32x2g o; o.x = pk2(bf_lo(uu.x) * (acc[nt][0] + bias), bf_hi(uu.x) * (acc[nt][1] + bias)); o.y = pk2(bf_lo(uu.y) * (acc[nt][2] + bias), bf_hi(uu.y) * (acc[nt][3] + bias));
            *(GAS u32x2g*)(AM + t * 1024 + 512 + c0) = o; }
    }
    WG_BAR();
}

__device__ __forceinline__ void fold_rows(Frame& F, const Ptrs& P) {
    const bf16* PQT = (const bf16*)(P.ws + WS_PQT); bf16* PQF = (bf16*)(P.ws + WS_PQF);
    LAS unsigned short* buf = (LAS unsigned short*)(F.lds + RING_OFF + F.wave * 16384);
    const int gw = F.vcu * NWAVES + F.wave, NGW = F.G * NWAVES, lane = F.lane;
    for (int row = gw; row < NB * 512; row += NGW) {
        const GAS v4u* src = (const GAS v4u*)(PQT + (size_t)row * 2 * S) + lane;
        v4u t[16];
#pragma unroll
        for (int i = 0; i < 16; ++i) t[i] = src[64 * i];
#pragma unroll
        for (int i = 0; i < 16; ++i) *(LAS v4u*)(buf + (size_t)(64 * i + lane) * 8) = t[i];
        LDS_WAIT(); asm volatile("" ::: "memory");
        GAS v4u* dst = (GAS v4u*)(PQF + (size_t)row * S) + lane;
#pragma unroll
        for (int q = 0; q < 8; ++q) {
            const int k0 = (q * 64 + lane) * 8, sinpart = k0 >> 11, s0 = k0 & (S / 2 - 1);
            const LAS unsigned short* pr = buf + (sinpart ? S : 0);
            float v[8];
#pragma unroll
            for (int e = 0; e < 8; ++e) { const int sidx = s0 + e;
                const float a = __builtin_bit_cast(float, (unsigned)pr[sidx] << 16), bm = __builtin_bit_cast(float, (unsigned)pr[(S - sidx) & (S - 1)] << 16);
                v[e] = sinpart ? (a - bm) : (a + bm);
                if (sidx == 0) v[e] = sinpart ? __builtin_bit_cast(float, (unsigned)buf[S / 2] << 16) : a; }
            v4u o; o.x = pk2(v[0], v[1]); o.y = pk2(v[2], v[3]); o.z = pk2(v[4], v[5]); o.w = pk2(v[6], v[7]);
            dst[64 * q] = o;
        }
        LDS_WAIT(); asm volatile("" ::: "memory");
    }
}

struct Args { const float* in[22]; float* out; unsigned char* ws; int ph_lo, ph_hi, li, pad; };
__global__ void __launch_bounds__(NWAVES * 64, 2) mk_fwd(Args args) {
    extern __shared__ __attribute__((aligned(16))) unsigned char lds[];
    Frame F;
    F.lds = (LAS unsigned char*)lds;
    F.MISC = (volatile LAS unsigned*)(F.lds + MISC_OFF);
    F.tid = threadIdx.x; F.lane = F.tid & 63; F.wave = __builtin_amdgcn_readfirstlane(F.tid >> 6);
    F.G = gridDim.x; { const int bx = blockIdx.x; F.vcu = (F.G % 8 == 0) ? (bx % 8) * (F.G / 8) + bx / 8 : bx; }
    Ptrs P;
#pragma unroll
    for (int i = 0; i < 22; ++i) P.in[i] = args.in[i];
    P.out = args.out; P.ws = args.ws;
    unsigned char* ws = args.ws;
    F.ctl = (gu32*)(ws + WS_CTL);
    for (int u = F.tid; u < (LDS_BYTES - LDSCTL_OFF) / 4; u += NWAVES * 64) ((LAS unsigned*)(F.lds + LDSCTL_OFF))[u] = 0u;
    __syncthreads();
    XcdBarrier bar; bar.bar = (unsigned*)(F.ctl + CW_BAR); bar.x = 0; bar.st = nullptr;
    if (!MK_PER_PHASE) bar = xcd_barrier_post((unsigned*)(F.ctl + CW_BAR), F.MISC + 8);
    const int lo = args.ph_lo, hi = args.ph_hi;
#ifndef PH_MASK
#define PH_MASK 0x1FFF
#endif
#define IN(k) ((((PH_MASK) >> (k)) & 1) && lo <= (k) && (k) < hi)
#ifndef PROBE_BARX
#define PROBE_BARX 1
#endif
#define SEAM(k) do { if (IN(k) && IN((k) + 1)) { for (int bx_ = 0; bx_ < PROBE_BARX; ++bx_) xcd_barrier(bar); } } while (0)
    unsigned long long* ssq = (unsigned long long*)(ws + WS_SSQ);
    bf16* XB = (bf16*)(ws + WS_XB); bf16* AM = (bf16*)(ws + WS_AM); bf16* HB = (bf16*)(ws + WS_H);
    const int bid = (int)blockIdx.x;
    const bool dup = args.pad != 0;
    bf16* TRX = (bf16*)(ws + WS_END); unsigned long long* TRS = (unsigned long long*)(ws + WS_END + 64 * MiB);

    if (IN(0)) { p0_prologue(F, P); } SEAM(0);
    if (IN(1)) { pg8::Gemm g{XB, (const bf16*)(ws + WS_WIN0), M, 1536, D}; pg8::StaticOrder So; So.init(M, 1536, F.G, bid);
        pg8::EpiInL0 E{(bf16*)(ws + WS_UB), (bf16*)(ws + WS_PB), ssq};
        pg8::gemm_phase<pg8::EpiInL0, pg8::StaticOrder, true, true>(F.lds + RING_OFF, g, So, E); } SEAM(1);
    if (IN(2)) { for (int it = F.vcu; it < 1024; it += F.G) {
#ifndef NO_CONV
            if (it < 512) mix0_conv_item(F, P, it);
#endif
#ifndef NO_POOL
            if (it >= 512) mix0_pool_item(F, P, it - 512);
#endif
 } } SEAM(2);
    if (IN(3)) { pg8::Gemm g{AM, (const bf16*)(ws + WS_WOUT0), M, D, D}; pg8::StaticOrder So; So.init(M, D, F.G, bid);
        pg8::EpiResid E{XB, dup ? TRS : ssq + M, dup ? TRX : XB};
        pg8::gemm_phase<pg8::EpiResid, pg8::StaticOrder, true, true>(F.lds + RING_OFF, g, So, E); } SEAM(3);
    if (IN(4)) { pg8::Gemm g{XB, (const bf16*)(ws + WS_WGU0), M, 2 * FF, D}; pg8::StaticOrder So; So.init(M, 2 * FF, F.G, bid);
        pg8::EpiSwiGLU E{HB, ssq + M};
        pg8::gemm_phase<pg8::EpiSwiGLU, pg8::StaticOrder, true, true>(F.lds + RING_OFF, g, So, E); } SEAM(4);
    if (IN(5)) { pg8::Gemm g{HB, (const bf16*)(ws + WS_WDN0), M, D, FF}; pg8::StaticOrder So; So.init(M, D, F.G, bid);
        pg8::EpiResid E{XB, dup ? TRS : ssq + 2 * M, dup ? TRX : XB};
        pg8::gemm_phase<pg8::EpiResid, pg8::StaticOrder, true, true>(F.lds + RING_OFF, g, So, E); } SEAM(5);
    if (IN(6)) {
        { pg8::Gemm g{(const bf16*)(ws + WS_WPQ1), XB, 1024, M, D}; pg8::StaticOrder So; So.init(1024, M, F.G, bid);
          pg8::EpiPQT E{(bf16*)(ws + WS_PQT), ssq + 2 * M};
          pg8::gemm_phase<pg8::EpiPQT, pg8::StaticOrder, true, true>(F.lds + RING_OFF, g, So, E); }
        { pg8::Gemm g{XB, (const bf16*)(ws + WS_WUV1), M, 1024, D}; pg8::StaticOrder So; So.init(M, 1024, F.G, bid);
          pg8::EpiGeluUV E{(bf16*)(ws + WS_U1), (bf16*)(ws + WS_V1), ssq + 2 * M};
          pg8::gemm_phase<pg8::EpiGeluUV, pg8::StaticOrder, true, true>(F.lds + RING_OFF, g, So, E); }
    } SEAM(6);
    if (IN(7)) {
        { fold_rows(F, P); }
        { for (int it = F.vcu; it < 1024; it += F.G) sgu_item(F, P, it); }
    } SEAM(7);
    if (IN(8)) { pg8::Gemm g{(const bf16*)(ws + WS_DFT), (const bf16*)(ws + WS_PQF), S, NB * 512, S}; pg8::StaticOrder So; So.init(S, NB * 512, F.G, bid);
        pg8::EpiDFT E{AM};
        pg8::gemm_phase<pg8::EpiDFT, pg8::StaticOrder, true, true>(F.lds + RING_OFF, g, So, E); } SEAM(8);
    if (IN(9)) { pg8::Gemm g{AM, (const bf16*)(ws + WS_WOUT1), M, D, D}; pg8::StaticOrder So; So.init(M, D, F.G, bid);
        pg8::EpiResid E{XB, dup ? TRS : ssq + 3 * M, dup ? TRX : XB};
        pg8::gemm_phase<pg8::EpiResid, pg8::StaticOrder, true, true>(F.lds + RING_OFF, g, So, E); } SEAM(9);
    if (IN(10)) { pg8::Gemm g{XB, (const bf16*)(ws + WS_WGU1), M, 2 * FF, D}; pg8::StaticOrder So; So.init(M, 2 * FF, F.G, bid);
        pg8::EpiSwiGLU E{HB, ssq + 3 * M};
        pg8::gemm_phase<pg8::EpiSwiGLU, pg8::StaticOrder, true, true>(F.lds + RING_OFF, g, So, E); } SEAM(10);
    if (IN(11)) { pg8::Gemm g{HB, (const bf16*)(ws + WS_WDN1), M, D, FF}; pg8::StaticOrder So; So.init(M, D, F.G, bid);
        pg8::EpiResid E{XB, dup ? TRS : ssq + 4 * M, dup ? TRX : XB};
        pg8::gemm_phase<pg8::EpiResid, pg8::StaticOrder, true, true>(F.lds + RING_OFF, g, So, E); } SEAM(11);
    if (IN(12)) {
        const float* gf = P.in[21]; const unsigned long long* ssq4 = ssq + 4 * M;
        const int gw = F.vcu * NWAVES + F.wave, NGW = F.G * NWAVES;
        for (int m = gw; m < M; m += NGW) {
            const GAS u32x2g* xr = (const GAS u32x2g*)(XB + (size_t)m * D) + F.lane; GAS f32x4* orow = (GAS f32x4*)(P.out + (size_t)m * D) + F.lane; const GAS f32x4* gr = (const GAS f32x4*)gf + F.lane;
            const float rs = pg8::rstd_of(ssq4[m]);
#pragma unroll
            for (int j = 0; j < 4; ++j) { const u32x2g xx = xr[64 * j]; const f32x4 gg = gr[64 * j];
                f32x4 v; v.x = bf_lo(xx.x); v.y = bf_hi(xx.x); v.z = bf_lo(xx.y); v.w = bf_hi(xx.y); orow[64 * j] = v * rs * gg; }
        }
    }
#undef IN
#undef SEAM
}

extern "C" void kernel_launch(void* const* d_in, const int* in_sizes, int n_in, void* d_out, int out_size, void* d_ws, size_t ws_size, hipStream_t stream) {
    static int grid = 0;
    if (grid == 0) {
        if (n_in != 22 || in_sizes[0] != M * D || out_size != M * D || ws_size < WS_END) { fprintf(stderr, "kernel_launch: unexpected shapes (n_in %d, in0 %d, out %d, ws %zu); nothing launched\n", n_in, n_in > 0 ? in_sizes[0] : -1, out_size, ws_size); grid = -1; return; }
        int dev = 0, cus = 0, per_cu = 0;
        if (hipGetDevice(&dev) != hipSuccess || hipDeviceGetAttribute(&cus, hipDeviceAttributeMultiprocessorCount, dev) != hipSuccess) { grid = -1; return; }
        if (hipFuncSetAttribute((const void*)mk_fwd, hipFuncAttributeMaxDynamicSharedMemorySize, LDS_BYTES) != hipSuccess) { fprintf(stderr, "kernel_launch: hipFuncSetAttribute failed\n"); grid = -1; return; }
        if (hipOccupancyMaxActiveBlocksPerMultiprocessor(&per_cu, (const void*)mk_fwd, NWAVES * 64, LDS_BYTES) != hipSuccess || per_cu < 1) { fprintf(stderr, "kernel_launch: occupancy query says %d blocks per CU\n", per_cu); per_cu = 1; }
        (void)hipGetLastError();
        grid = cus * 1;
    }
    if (grid < 0) return;
    if (hipMemsetAsync((char*)d_ws + WS_CTL, 0, CTL_ZERO_BYTES, stream) != hipSuccess) { fprintf(stderr, "kernel_launch: hipMemsetAsync failed\n"); return; }
    Args a{};
    for (int i = 0; i < 22; ++i) a.in[i] = (const float*)d_in[i];
    a.out = (float*)d_out; a.ws = (unsigned char*)d_ws;
#if MK_PER_PHASE
    for (int ph = 0; ph < N_PHASES; ++ph) { a.ph_lo = ph; a.ph_hi = ph + 1; a.li = ph;
        hipLaunchKernelGGL(mk_fwd, dim3(grid), dim3(NWAVES * 64), LDS_BYTES, stream, a); }
#else
    a.ph_lo = 0; a.ph_hi = N_PHASES; a.li = 0;
#ifdef PROBE_PHASE
    { void* kargs0[] = {&a};
      hipError_t e0 = hipLaunchCooperativeKernel((const void*)mk_fwd, dim3(grid), dim3(NWAVES * 64), kargs0, LDS_BYTES, stream);
      if (e0 != hipSuccess) fprintf(stderr, "kernel_launch: cooperative launch failed: %s (grid %d)\n", hipGetErrorString(e0), grid);
      Args a2 = a; a2.ph_lo = PROBE_PHASE; a2.ph_hi = PROBE_PHASE + 1; a2.pad = 1;
      hipLaunchKernelGGL(mk_fwd, dim3(grid), dim3(NWAVES * 64), LDS_BYTES, stream, a2); }
#elif defined(MK_PLAIN_LAUNCH)
    hipLaunchKernelGGL(mk_fwd, dim3(grid), dim3(NWAVES * 64), LDS_BYTES, stream, a);
#else
    void* kargs[] = {&a};
    hipError_t e = hipLaunchCooperativeKernel((const void*)mk_fwd, dim3(grid), dim3(NWAVES * 64), kargs, LDS_BYTES, stream);
    if (e != hipSuccess) fprintf(stderr, "kernel_launch: cooperative launch failed: %s (grid %d)\n", hipGetErrorString(e), grid);
#endif
#endif
}
```

```cpp
#include <hip/hip_runtime.h>
#include <cstdio>
#include <cstdint>
namespace pg8 {
#define PG8_LAS __attribute__((address_space(3)))
typedef unsigned short bf16_t;
typedef short bf16x8 __attribute__((ext_vector_type(8)));
typedef float f32x4 __attribute__((ext_vector_type(4)));
typedef unsigned u32x4 __attribute__((ext_vector_type(4)));
constexpr int BM = 256, BK = 64, HALF = 128, HTB = HALF * BK * 2  , STAGE_BYTES = 8 * HTB, NXCD = 8, WGM = 8;

__host__ __device__ __forceinline__ int lds_byte(int r, int c) { const int st = (r >> 4) * 2 + (c >> 5), rr = r & 15, cc = c & 31, ob = rr * 64 + cc * 2; return st * 1024 + (ob ^ (((ob >> 9) & 1) << 5)); }
__host__ __device__ __forceinline__ void stage_rc(int b, int& R, int& C) { const int st = b / 1024, sb = b % 1024, swz = sb ^ (((sb >> 9) & 1) << 5); R = (st >> 1) * 16 + swz / 64; C = (st & 1) * 32 + (swz % 64) / 2; }
__host__ __device__ __forceinline__ int perm32(int rho) { const int n = rho >> 4, i = rho & 15; return 8 * (i >> 2) + 4 * n + (i & 3); }

struct Unit { int pm, pn; };
struct Gemm { const bf16_t* A; const bf16_t* Bt; int M, N, K; };

struct StaticOrder {
    int nM, nN, nwg, G, c;
    __host__ __device__ void init(int M, int N, int G_, int c_) { nM = M / BM; nN = N / BM; nwg = nM * nN; G = G_; c = c_; }
    __host__ __device__ bool next(int i, Unit& u) const {
        const long L = (long)i * G + c; if (L >= nwg) return false;
        int wgid = (int)L; { const int q = nwg / NXCD, r = nwg % NXCD, xcd = wgid % NXCD, off = wgid / NXCD; wgid = (xcd < r ? xcd * (q + 1) : r * (q + 1) + (xcd - r) * q) + off; }
        const int nig = WGM * nN, gid = wgid / nig, fm = gid * WGM, gsz = (nM - fm) < WGM ? (nM - fm) : WGM;
        u.pm = fm + ((wgid % nig) % gsz); u.pn = (wgid % nig) / gsz; return true;
    }
    __device__ __forceinline__ void a_ready(const Unit&) const {}
    __device__ __forceinline__ void done(const Unit&) const {}
};

__device__ __forceinline__ unsigned cvt_pk_bf16(float lo, float hi) { unsigned r; asm volatile("v_cvt_pk_bf16_f32 %0, %1, %2" : "=v"(r) : "v"(lo), "v"(hi)); return r; }
typedef float f32x2 __attribute__((ext_vector_type(2)));
__device__ __forceinline__ f32x2 gelu_pk(f32x2 v) {
    const f32x2 av = __builtin_elementwise_abs(v), d = av * 0.2316418882f + 1.0f;
    f32x2 t; t.x = __builtin_amdgcn_rcpf(d.x); t.y = __builtin_amdgcn_rcpf(d.y);
    f32x2 q = t * 0.5307027145f + (-0.7265760135f); q = q * t + 0.7107068705f; q = q * t + (-0.142248368f); q = q * t + 0.127414796f; q = q * t;
    const f32x2 s = (v * v) * (-0.72134752044f);
    f32x2 e; e.x = __builtin_amdgcn_exp2f(s.x); e.y = __builtin_amdgcn_exp2f(s.y);
    const f32x2 m = v * (q * e), r = v - m;
    f32x2 o; o.x = v.x < 0.f ? m.x : r.x; o.y = v.y < 0.f ? m.y : r.y; return o;
}


constexpr float RMS_EPS = 1e-6f;
__device__ __forceinline__ float sigm(float x) { return __builtin_amdgcn_rcpf(1.0f + __expf(-x)); }
__device__ __forceinline__ u32x4 pack8(const f32x4 v0, const f32x4 v1) { u32x4 w; w.x = cvt_pk_bf16(v0[0], v0[1]); w.y = cvt_pk_bf16(v0[2], v0[3]); w.z = cvt_pk_bf16(v1[0], v1[1]); w.w = cvt_pk_bf16(v1[2], v1[3]); return w; }
typedef unsigned long long u64_t;
__device__ __forceinline__ float rstd_of(u64_t ssq) { return rsqrtf((float)ssq * (1.0f / (1024.0f * 1048576.0f)) + RMS_EPS); }
__device__ __forceinline__ u64_t ssq_fix(float s) { return (u64_t)(s * 1048576.0f); }

struct EpiInL0 {
    static constexpr bool PERM = true, AFTER_DRAIN = false;
    bf16_t* UB; bf16_t* PB; const u64_t* ssq;
    __device__ __forceinline__ void operator()(const f32x4 (&acc)[2][2][4][2], const Unit& u, int wr, int wc, int fr, int fq) const {
        const int row0 = u.pm * BM + wr * 64 + fr, cw = wc * 32 + 8 * fq;
        u64_t q[2][4];
#pragma unroll
        for (int ai = 0; ai < 2; ++ai)
#pragma unroll
            for (int m = 0; m < 4; ++m) q[ai][m] = ssq[row0 + ai * HALF + m * 16];
#pragma unroll
        for (int ai = 0; ai < 2; ++ai)
#pragma unroll
            for (int m = 0; m < 4; ++m) {
                const int row = row0 + ai * HALF + m * 16;
                const float rs = rstd_of(q[ai][m]);
                if (u.pn < 4) {
                    f32x4 o[2];
#pragma unroll
                    for (int n = 0; n < 2; ++n)
#pragma unroll
                        for (int j = 0; j < 4; ++j) { const float a = acc[ai][0][m][n][j] * rs, g = acc[ai][1][m][n][j] * rs; o[n][j] = a * sigm(g); }
                    *(u32x4*)(UB + (size_t)row * 512 + u.pn * 128 + cw) = pack8(o[0], o[1]);
                } else {
#pragma unroll
                    for (int bj = 0; bj < 2; ++bj) *(u32x4*)(PB + (size_t)row * 512 + (u.pn - 4) * 256 + bj * HALF + cw) = pack8(acc[ai][bj][m][0] * rs, acc[ai][bj][m][1] * rs);
                }
            }
    }
};
struct EpiResid {
    static constexpr bool PERM = true, AFTER_DRAIN = false;
    bf16_t* XB; u64_t* ssq; bf16_t* XBw;
    __device__ __forceinline__ void operator()(const f32x4 (&acc)[2][2][4][2], const Unit& u, int wr, int wc, int fr, int fq) const {
        const int row0 = u.pm * BM + wr * 64 + fr, cw = u.pn * BM + wc * 32 + 8 * fq;
        u32x4 r[2][4][2];
#pragma unroll
        for (int ai = 0; ai < 2; ++ai)
#pragma unroll
            for (int m = 0; m < 4; ++m)
#pragma unroll
                for (int bj = 0; bj < 2; ++bj) r[ai][m][bj] = *(const u32x4*)(XB + (size_t)(row0 + ai * HALF + m * 16) * 1024 + bj * HALF + cw);
#pragma unroll
        for (int ai = 0; ai < 2; ++ai)
#pragma unroll
            for (int m = 0; m < 4; ++m) {
                const int row = row0 + ai * HALF + m * 16;
                float s = 0.f;
#pragma unroll
                for (int bj = 0; bj < 2; ++bj) {
                    const u32x4 rr = r[ai][m][bj];
                    f32x4 v0, v1;
                    v0[0] = __builtin_bit_cast(float, rr.x << 16) + acc[ai][bj][m][0][0]; v0[1] = __builtin_bit_cast(float, rr.x & 0xffff0000u) + acc[ai][bj][m][0][1];
                    v0[2] = __builtin_bit_cast(float, rr.y << 16) + acc[ai][bj][m][0][2]; v0[3] = __builtin_bit_cast(float, rr.y & 0xffff0000u) + acc[ai][bj][m][0][3];
                    v1[0] = __builtin_bit_cast(float, rr.z << 16) + acc[ai][bj][m][1][0]; v1[1] = __builtin_bit_cast(float, rr.z & 0xffff0000u) + acc[ai][bj][m][1][1];
                    v1[2] = __builtin_bit_cast(float, rr.w << 16) + acc[ai][bj][m][1][2]; v1[3] = __builtin_bit_cast(float, rr.w & 0xffff0000u) + acc[ai][bj][m][1][3];
                    const u32x4 w = pack8(v0, v1);
                    *(u32x4*)(XBw + ((size_t)row * 1024 + bj * HALF + cw)) = w;
                    const float q0 = __builtin_bit_cast(float, w.x << 16), q1 = __builtin_bit_cast(float, w.x & 0xffff0000u), q2 = __builtin_bit_cast(float, w.y << 16), q3 = __builtin_bit_cast(float, w.y & 0xffff0000u);
                    const float q4 = __builtin_bit_cast(float, w.z << 16), q5 = __builtin_bit_cast(float, w.z & 0xffff0000u), q6 = __builtin_bit_cast(float, w.w << 16), q7 = __builtin_bit_cast(float, w.w & 0xffff0000u);
                    s += (q0 * q0 + q1 * q1) + (q2 * q2 + q3 * q3) + (q4 * q4 + q5 * q5) + (q6 * q6 + q7 * q7);
                }
                s += __shfl_xor(s, 16); s += __shfl_xor(s, 32);
                if (fq == 0) atomicAdd(ssq + row, ssq_fix(s));
            }
    }
};
struct EpiSwiGLU {
    static constexpr bool PERM = true, AFTER_DRAIN = false;
    bf16_t* H; const u64_t* ssq; int probe_mode;
    __device__ __forceinline__ void operator()(const f32x4 (&acc)[2][2][4][2], const Unit& u, int wr, int wc, int fr, int fq) const {
        const int row0 = u.pm * BM + wr * 64 + fr, cw = wc * 32 + 8 * fq;
        if (probe_mode == 2) { if (acc[0][0][0][0][0] == 123.456f) H[0] = 1; return; }
        u64_t q[2][4];
#pragma unroll
        for (int ai = 0; ai < 2; ++ai)
#pragma unroll
            for (int m = 0; m < 4; ++m) q[ai][m] = ssq[row0 + ai * HALF + m * 16];
#pragma unroll
        for (int ai = 0; ai < 2; ++ai)
#pragma unroll
            for (int m = 0; m < 4; ++m) {
                const int row = row0 + ai * HALF + m * 16;
                const float rs = rstd_of(q[ai][m]);
                f32x4 o[2];
#pragma unroll
                for (int n = 0; n < 2; ++n)
#pragma unroll
                    for (int j = 0; j < 4; ++j) { const float g = acc[ai][0][m][n][j] * rs, up = acc[ai][1][m][n][j] * rs; o[n][j] = g * sigm(g) * up; }
                *(u32x4*)(H + (size_t)row * 2816 + u.pn * 128 + cw) = pack8(o[0], o[1]);
            }
    }
};
struct EpiPQT {
    static constexpr bool PERM = true, AFTER_DRAIN = false;
    bf16_t* PQT; const u64_t* ssq;
    __device__ __forceinline__ void operator()(const f32x4 (&acc)[2][2][4][2], const Unit& u, int wr, int wc, int fr, int fq) const {
        const int tok0 = u.pn * BM + wc * 32 + 8 * fq, b = (u.pn * BM) >> 12;
        f32x4 rs[2][2];
#pragma unroll
        for (int bj = 0; bj < 2; ++bj)
#pragma unroll
            for (int n = 0; n < 2; ++n)
#pragma unroll
                for (int j = 0; j < 4; ++j) rs[bj][n][j] = rstd_of(ssq[tok0 + bj * HALF + 4 * n + j]);
#pragma unroll
        for (int ai = 0; ai < 2; ++ai)
#pragma unroll
            for (int m = 0; m < 4; ++m) {
                const int r = u.pm * BM + ai * HALF + wr * 64 + m * 16 + fr, pq = r >> 9, ch = r & 511;
                bf16_t* base = PQT + ((size_t)(b * 512 + ch) * 2 + pq) * 4096;
#pragma unroll
                for (int bj = 0; bj < 2; ++bj) *(u32x4*)(base + ((tok0 + bj * HALF) & 4095)) = pack8(acc[ai][bj][m][0] * rs[bj][0], acc[ai][bj][m][1] * rs[bj][1]);
            }
    }
};
struct EpiGeluUV {
    static constexpr bool PERM = true, AFTER_DRAIN = false;
    bf16_t* U; bf16_t* V; const u64_t* ssq;
    __device__ __forceinline__ void operator()(const f32x4 (&acc)[2][2][4][2], const Unit& u, int wr, int wc, int fr, int fq) const {
        const int row0 = u.pm * BM + wr * 64 + fr, cw = wc * 32 + 8 * fq;
        bf16_t* dst = (u.pn < 2) ? U : V; const int colb = (u.pn & 1) * BM;
        u64_t q[2][4];
#pragma unroll
        for (int ai = 0; ai < 2; ++ai)
#pragma unroll
            for (int m = 0; m < 4; ++m) q[ai][m] = ssq[row0 + ai * HALF + m * 16];
#pragma unroll
        for (int ai = 0; ai < 2; ++ai)
#pragma unroll
            for (int m = 0; m < 4; ++m) {
                const int row = row0 + ai * HALF + m * 16;
                const float rs = rstd_of(q[ai][m]);
#pragma unroll
                for (int bj = 0; bj < 2; ++bj) {
                    const f32x4 v0 = acc[ai][bj][m][0] * rs, v1 = acc[ai][bj][m][1] * rs;
                    const f32x2 a = gelu_pk((f32x2){v0[0], v0[1]}), bq = gelu_pk((f32x2){v0[2], v0[3]}), c = gelu_pk((f32x2){v1[0], v1[1]}), d = gelu_pk((f32x2){v1[2], v1[3]});
                    *(u32x4*)(dst + (size_t)row * 512 + colb + bj * HALF + cw) = pack8((f32x4){a.x, a.y, bq.x, bq.y}, (f32x4){c.x, c.y, d.x, d.y});
                }
            }
    }
};
struct EpiDFT {
    static constexpr bool PERM = true, AFTER_DRAIN = false;
    bf16_t* AM;
    __device__ __forceinline__ void operator()(const f32x4 (&acc)[2][2][4][2], const Unit& u, int wr, int wc, int fr, int fq) const {
        const int row0 = (u.pn >> 1) * 4096 + u.pm * BM + wr * 64 + fr, cw = (u.pn & 1) * BM + wc * 32 + 8 * fq;
#pragma unroll
        for (int ai = 0; ai < 2; ++ai)
#pragma unroll
            for (int m = 0; m < 4; ++m) {
                const int row = row0 + ai * HALF + m * 16;
#pragma unroll
                for (int bj = 0; bj < 2; ++bj) *(u32x4*)(AM + (size_t)row * 1024 + bj * HALF + cw) = pack8(acc[ai][bj][m][0], acc[ai][bj][m][1]);
            }
    }
};

template <class Epi, class Sched, bool ALIGN_EPI = false, bool SP2 = false>
__device__ __forceinline__ void gemm_phase(PG8_LAS unsigned char* lds, const Gemm g, const Sched& S, const Epi& E) {
    const int tid = threadIdx.x, wid = __builtin_amdgcn_readfirstlane(tid >> 6), lane = tid & 63, wr = wid >> 2, wc = wid & 3, fr = lane & 15, fq = lane >> 4;
    const int K = g.K, nt = K / BK;
    unsigned voffA[2], voffB[2];
#pragma unroll
    for (int i = 0; i < 2; ++i) { int R, C; stage_rc(tid * 16 + i * 8192, R, C); const int Rb = Epi::PERM ? ((R & ~31) + perm32(R & 31)) : R;
        voffA[i] = (unsigned)(R * K + C) * 2u; voffB[i] = (unsigned)(Rb * K + C) * 2u; }
    const size_t kstep = (size_t)(BK * 2);
    const size_t hstep = (size_t)HALF * K * 2;
    const size_t tstep = 2 * hstep;
    const unsigned ldsw = (unsigned)wid * 1024u;
    const int aoff = lds_byte(wr * 64 + fr, fq * 8), boff = lds_byte(wc * 32 + fr, fq * 8);
#define PG8_SA(b, h) (((b) * 2 + (h)) * HTB)
#define PG8_SB(b, h) ((4 + (b) * 2 + (h)) * HTB)
#define PG8_STAGE(bufoff, gbase, voff) do { _Pragma("unroll") for (int _i = 0; _i < 2; ++_i) \
        __builtin_amdgcn_global_load_lds((const unsigned*)((const char*)(gbase) + (voff)[_i]), (PG8_LAS unsigned*)(lds + (bufoff) + ldsw + _i * 8192), 16, 0, 0); } while (0)
#define PG8_LDA(dst, b, h) do { _Pragma("unroll") for (int m = 0; m < 4; ++m) _Pragma("unroll") for (int k = 0; k < 2; ++k) dst[m][k] = *(const PG8_LAS bf16x8*)(lds + PG8_SA(b, h) + aoff + m * 2048 + k * 1024); } while (0)
#define PG8_LDB(dst, b, h) do { _Pragma("unroll") for (int n = 0; n < 2; ++n) _Pragma("unroll") for (int k = 0; k < 2; ++k) dst[n][k] = *(const PG8_LAS bf16x8*)(lds + PG8_SB(b, h) + boff + n * 2048 + k * 1024); } while (0)
#define PG8_MMA(ai, bj, At, Bt) do { __builtin_amdgcn_s_setprio(1); _Pragma("unroll") for (int m = 0; m < 4; ++m) _Pragma("unroll") for (int n = 0; n < 2; ++n) _Pragma("unroll") for (int k = 0; k < 2; ++k) \
        acc[ai][bj][m][n] = __builtin_amdgcn_mfma_f32_16x16x32_bf16(Bt[n][k], At[m][k], acc[ai][bj][m][n], 0, 0, 0); __builtin_amdgcn_s_setprio(0); } while (0)
#define PG8_WAIT_V(n) asm volatile("s_waitcnt vmcnt(" #n ")" ::: "memory")
#define PG8_WAIT_L(n) asm volatile("s_waitcnt lgkmcnt(" #n ")" ::: "memory")
#define PG8_BAR __builtin_amdgcn_s_barrier()
#define PG8_SCHED __builtin_amdgcn_sched_barrier(0)
    Unit cur, nxt; int ui = 0;
    if (!S.next(0, cur)) return;
    f32x4 acc[2][2][4][2];
#pragma unroll
    for (int a = 0; a < 2; ++a)
#pragma unroll
        for (int b = 0; b < 2; ++b)
#pragma unroll
            for (int m = 0; m < 4; ++m)
#pragma unroll
                for (int n = 0; n < 2; ++n) acc[a][b][m][n] = (f32x4){0.f, 0.f, 0.f, 0.f};
    bf16x8 At[4][2], B0[2][2], B1[2][2];
    const char* cA = (const char*)g.A + (size_t)cur.pm * tstep; const char* cB = (const char*)g.Bt + (size_t)cur.pn * tstep;
    S.a_ready(cur);
    if constexpr (SP2) {
        PG8_STAGE(PG8_SB(0, 0), cB, voffB); PG8_STAGE(PG8_SB(0, 1), cB + hstep, voffB); PG8_STAGE(PG8_SA(0, 0), cA, voffA); PG8_STAGE(PG8_SA(0, 1), cA + hstep, voffA);
        if (wr == 1) PG8_BAR;
        PG8_WAIT_V(2); PG8_BAR;
        PG8_STAGE(PG8_SB(1, 0), cB + kstep, voffB); PG8_STAGE(PG8_SA(1, 0), cA + kstep, voffA); PG8_STAGE(PG8_SB(1, 1), cB + hstep + kstep, voffB);
        PG8_WAIT_V(6); PG8_BAR;
    } else {
        PG8_STAGE(PG8_SB(0, 0), cB, voffB); PG8_STAGE(PG8_SA(0, 0), cA, voffA); PG8_STAGE(PG8_SB(0, 1), cB + hstep, voffB); PG8_STAGE(PG8_SA(0, 1), cA + hstep, voffA);
        if (wr == 1) PG8_BAR;
        PG8_WAIT_V(4); PG8_BAR;
        PG8_STAGE(PG8_SB(1, 0), cB + kstep, voffB); PG8_STAGE(PG8_SA(1, 0), cA + kstep, voffA); PG8_STAGE(PG8_SB(1, 1), cB + hstep + kstep, voffB);
        PG8_WAIT_V(6); PG8_BAR;
    }
    for (;;) {
        const bool has_next = S.next(ui + 1, nxt);
        const char* nA = has_next ? (const char*)g.A + (size_t)nxt.pm * tstep : cA; const char* nB = has_next ? (const char*)g.Bt + (size_t)nxt.pn * tstep : cB;
        for (int t = 0; t < nt; t += 2) {
            const bool last = (t == nt - 2);
            const char* a1 = cA + (size_t)(t + 1) * kstep;
            const char* a2 = last ? nA : cA + (size_t)(t + 2) * kstep; const char* b2 = last ? nB : cB + (size_t)(t + 2) * kstep;
            const char* a3 = a2 + kstep; const char* b3 = b2 + kstep;
            if (last && has_next) S.a_ready(nxt);
            if constexpr (SP2) {
            PG8_LDB(B0, 0, 0); PG8_LDB(B1, 0, 1); PG8_SCHED; PG8_LDA(At, 0, 0); PG8_STAGE(PG8_SA(1, 1), a1 + hstep, voffA);
            PG8_WAIT_V(8); PG8_WAIT_L(0); PG8_BAR; PG8_MMA(0, 0, At, B0); PG8_MMA(0, 1, At, B1); PG8_BAR; PG8_SCHED;
            PG8_LDA(At, 0, 1); PG8_STAGE(PG8_SB(0, 0), b2, voffB); PG8_STAGE(PG8_SB(0, 1), b2 + hstep, voffB); PG8_STAGE(PG8_SA(0, 0), a2, voffA);
            PG8_WAIT_V(8); PG8_WAIT_L(0); PG8_BAR; PG8_MMA(1, 0, At, B0); PG8_MMA(1, 1, At, B1); PG8_BAR; PG8_SCHED;
            PG8_LDB(B0, 1, 0); PG8_LDB(B1, 1, 1); PG8_SCHED; PG8_LDA(At, 1, 0); PG8_STAGE(PG8_SA(0, 1), a2 + hstep, voffA);
            PG8_WAIT_V(8); PG8_WAIT_L(0); PG8_BAR; PG8_MMA(0, 0, At, B0); PG8_MMA(0, 1, At, B1); PG8_BAR; PG8_SCHED;
            PG8_LDA(At, 1, 1); PG8_STAGE(PG8_SB(1, 0), b3, voffB); PG8_STAGE(PG8_SB(1, 1), b3 + hstep, voffB); PG8_STAGE(PG8_SA(1, 0), a3, voffA);
            PG8_WAIT_V(8); PG8_WAIT_L(0); PG8_BAR; PG8_MMA(1, 0, At, B0); PG8_MMA(1, 1, At, B1); PG8_BAR; PG8_SCHED;
            } else {
            PG8_LDB(B0, 0, 0); PG8_SCHED; PG8_LDA(At, 0, 0); PG8_STAGE(PG8_SA(1, 1), a1 + hstep, voffA);
            PG8_WAIT_L(8); PG8_BAR; PG8_WAIT_L(0); PG8_MMA(0, 0, At, B0); PG8_BAR; PG8_SCHED;
            PG8_LDB(B1, 0, 1); PG8_STAGE(PG8_SB(0, 0), b2, voffB);
            PG8_BAR; PG8_WAIT_L(0); PG8_MMA(0, 1, At, B1); PG8_BAR;
            PG8_LDA(At, 0, 1); PG8_STAGE(PG8_SA(0, 0), a2, voffA);
            PG8_BAR; PG8_WAIT_L(0); PG8_MMA(1, 0, At, B0); PG8_BAR; PG8_SCHED;
            PG8_STAGE(PG8_SB(0, 1), b2 + hstep, voffB);
            PG8_WAIT_V(6); PG8_BAR; PG8_MMA(1, 1, At, B1); PG8_BAR;
            PG8_LDB(B0, 1, 0); PG8_SCHED; PG8_LDA(At, 1, 0); PG8_STAGE(PG8_SA(0, 1), a2 + hstep, voffA);
            PG8_WAIT_L(8); PG8_BAR; PG8_WAIT_L(0); PG8_MMA(0, 0, At, B0); PG8_BAR; PG8_SCHED;
            PG8_LDB(B1, 1, 1); PG8_STAGE(PG8_SB(1, 0), b3, voffB);
            PG8_BAR; PG8_WAIT_L(0); PG8_MMA(0, 1, At, B1); PG8_BAR;
            PG8_LDA(At, 1, 1); PG8_STAGE(PG8_SA(1, 0), a3, voffA);
            PG8_BAR; PG8_WAIT_L(0); PG8_MMA(1, 0, At, B0); PG8_BAR; PG8_SCHED;
            PG8_STAGE(PG8_SB(1, 1), b3 + hstep, voffB);
            PG8_WAIT_V(6); PG8_BAR; PG8_MMA(1, 1, At, B1); PG8_BAR;
            }
        }
        if constexpr (ALIGN_EPI) { if (wr == 0) PG8_BAR; }
        if constexpr (!Epi::AFTER_DRAIN) { E(acc, cur, wr, wc, fr, fq); S.done(cur); }
        if (!has_next) break;
#pragma unroll
        for (int a = 0; a < 2; ++a)
#pragma unroll
            for (int b = 0; b < 2; ++b)
#pragma unroll
                for (int m = 0; m < 4; ++m)
#pragma unroll
                    for (int n = 0; n < 2; ++n) acc[a][b][m][n] = (f32x4){0.f, 0.f, 0.f, 0.f};
        cur = nxt; cA = nA; cB = nB; ++ui;
        if constexpr (ALIGN_EPI) { if (wr == 1) PG8_BAR; }
    }
    PG8_WAIT_V(0);
    if constexpr (!ALIGN_EPI) { if (wr == 0) PG8_BAR; }
    PG8_BAR;
    if constexpr (Epi::AFTER_DRAIN) { E.fused(acc, cur, wr, wc, fr, fq, lds, wid, lane); S.done(cur); }
#undef PG8_SA
#undef PG8_SB
#undef PG8_STAGE
#undef PG8_LDA
#undef PG8_LDB
#undef PG8_MMA
#undef PG8_WAIT_V
#undef PG8_WAIT_L
#undef PG8_BAR
#undef PG8_SCHED
}
}
#define GAS __attribute__((address_space(1)))
#define LAS __attribute__((address_space(3)))
typedef unsigned short bf16;
typedef unsigned v4u __attribute__((ext_vector_type(4)));
typedef float f32x4 __attribute__((ext_vector_type(4)));
typedef short bf16x8 __attribute__((ext_vector_type(8)));
typedef GAS unsigned gu32;
typedef GAS unsigned long long gu64;
#define RLX_AGENT __ATOMIC_RELAXED, __HIP_MEMORY_SCOPE_AGENT
#define LDS_WAIT() asm volatile("s_waitcnt lgkmcnt(0)" ::: "memory")
#define VM_WAIT() asm volatile("s_waitcnt vmcnt(0)" ::: "memory")
__device__ __forceinline__ unsigned long long rt() { return __builtin_amdgcn_s_memrealtime(); }
__device__ __forceinline__ unsigned f2bf(float f) { unsigned u = __builtin_bit_cast(unsigned, f); return (u + 0x7fffu + ((u >> 16) & 1u)) >> 16; }
__device__ __forceinline__ unsigned pk2(float lo, float hi) { return f2bf(lo) | (f2bf(hi) << 16); }

#define XB_TMO      128
#define XB_XCNT(j)  (256  + 64 * (j))
#define XB_XSUB(j)  (1280 + 64 * (j))
#define XB_XGEN(j)  (2304 + 64 * (j))
#define XB_TOP      3328
#define XB_TOPGEN   3392
#define XCD_BAR_WORDS 3456
#define XB_SPIN_CAP (1u << 18)

__device__ __forceinline__ unsigned xb_ld(unsigned* p)              { return __hip_atomic_load(p, __ATOMIC_RELAXED, __HIP_MEMORY_SCOPE_AGENT); }
__device__ __forceinline__ unsigned xb_add(unsigned* p, unsigned v) { return __hip_atomic_fetch_add(p, v, __ATOMIC_RELAXED, __HIP_MEMORY_SCOPE_AGENT); }
__device__ __forceinline__ unsigned xb_xcc_id() { return (unsigned)__builtin_amdgcn_s_getreg((3 << 11) | 20) & 0xFu; }
#define XB_SPIN(cond, bar) do { unsigned _sp = 0; while (cond) { __builtin_amdgcn_s_sleep(1); \
    if ((++_sp & 255u) == 0u) { if (xb_ld(&(bar)[XB_TMO])) break; if (_sp > XB_SPIN_CAP) { atomicAdd(&(bar)[XB_TMO], 1u); break; } } } } while (0)

struct XcdBarrier {
    unsigned* bar; unsigned x;
    volatile LAS unsigned* st;
};

__device__ __forceinline__ XcdBarrier xcd_barrier_post(unsigned* bar, volatile LAS unsigned* st) {
    XcdBarrier b; b.bar = bar; b.x = xb_xcc_id(); b.st = st;
    if (threadIdx.x == 0) (void)xb_add(&bar[XB_XCNT(b.x)], 1u);
    return b;
}
__device__ __forceinline__ void xcd_barrier_complete(unsigned* bar, unsigned x, unsigned& nloc, unsigned& nx) {
    const unsigned G = gridDim.x * gridDim.y * gridDim.z;
    unsigned sum, cnt, mine, sp = 0u;
    for (;;) {
        sum = 0u; cnt = 0u; mine = 0u;
#pragma unroll
        for (unsigned j = 0; j < 16; ++j) { const unsigned c = xb_ld(&bar[XB_XCNT(j)]); sum += c; cnt += (c > 0u) ? 1u : 0u; mine = (j == x) ? c : mine; }
        if (sum == G) break;
        __builtin_amdgcn_s_sleep(1);
        if ((++sp & 255u) == 0u) { if (xb_ld(&bar[XB_TMO])) break; if (sp > XB_SPIN_CAP) { atomicAdd(&bar[XB_TMO], 1u); break; } }
    }
    nloc = mine > 0u ? mine : 1u; nx = cnt > 0u ? cnt : 1u;
}

__device__ __forceinline__ void xcd_barrier(const XcdBarrier& b) {
    asm volatile("s_waitcnt vmcnt(0)" ::: "memory");
    __syncthreads();
    if (threadIdx.x == 0) {
        unsigned* bar = b.bar;
        __builtin_amdgcn_s_waitcnt(0);
        unsigned nloc = b.st[0], nx = b.st[1];
        if (nloc == 0u) { xcd_barrier_complete(bar, b.x, nloc, nx); b.st[0] = nloc; b.st[1] = nx; }
        const unsigned old = xb_add(&bar[XB_XSUB(b.x)], 1u);
        const unsigned gen = old / nloc;
        if (old + 1u == (gen + 1u) * nloc) {
            __builtin_amdgcn_fence(__ATOMIC_RELEASE, "agent");
            asm volatile("s_waitcnt vmcnt(0)" ::: "memory");
            const unsigned og = xb_add(&bar[XB_TOP], 1u);
            const unsigned tg = og / nx;
            if (og + 1u == (tg + 1u) * nx) xb_add(&bar[XB_TOPGEN], 1u);
            else XB_SPIN(xb_ld(&bar[XB_TOPGEN]) == tg, bar);
            __builtin_amdgcn_fence(__ATOMIC_ACQUIRE, "agent");
            xb_add(&bar[XB_XGEN(b.x)], 1u);
            asm volatile("s_waitcnt vmcnt(0)" ::: "memory");
        } else {
            XB_SPIN(xb_ld(&bar[XB_XGEN(b.x)]) == gen, bar);
            __builtin_amdgcn_fence(__ATOMIC_ACQUIRE, "agent");
            asm volatile("s_waitcnt vmcnt(0)" ::: "memory");
        }
    }
    __syncthreads();
}

constexpr int NWAVES = 8;
#ifndef MK_PER_PHASE
#define MK_PER_PHASE 0
#endif
constexpr int N_PHASES = 13;

constexpr int NB = 8, S = 4096, D = 1024, FF = 2816, M = NB * S;
typedef float f32x2g __attribute__((ext_vector_type(2)));
typedef unsigned u32x2g __attribute__((ext_vector_type(2)));

constexpr size_t MiB = 1u << 20;
constexpr size_t WS_CTL = 0, CTL_ZERO_BYTES = 1 * MiB;
constexpr size_t WS_SSQ = 46 * MiB + 512 * 1024;
constexpr size_t WS_WIN0 = 2 * MiB;
constexpr size_t WS_WOUT0 = 5 * MiB;
constexpr size_t WS_WGU0 = 7 * MiB;
constexpr size_t WS_WDN0 = 18 * MiB;
constexpr size_t WS_WPQ1 = 24 * MiB;
constexpr size_t WS_WUV1 = 26 * MiB;
constexpr size_t WS_WOUT1 = 28 * MiB;
constexpr size_t WS_WGU1 = 30 * MiB;
constexpr size_t WS_WDN1 = 41 * MiB;
constexpr size_t WS_DFT = 48 * MiB;
constexpr size_t WS_XB = 112 * MiB;
constexpr size_t WS_AM = 176 * MiB;
constexpr size_t WS_H = 240 * MiB;
constexpr size_t WS_UB = WS_H, WS_PB = WS_H + 32 * MiB;
constexpr size_t WS_PQT = WS_H, WS_U1 = WS_H + 64 * MiB, WS_V1 = WS_H + 96 * MiB, WS_PQF = WS_H + 128 * MiB;
constexpr size_t WS_END = 416 * MiB;
static_assert(WS_H + (size_t)M * FF * 2 <= WS_END && WS_V1 + (size_t)M * 512 * 2 <= WS_END, "d_ws map");
constexpr int CW_BAR = 4096;

constexpr int RING_OFF = 0, RING_BYTES = 131072;
constexpr int LDSCTL_OFF = RING_BYTES, MISC_OFF = LDSCTL_OFF + 320;
constexpr int LDS_BYTES = 147456;

struct Frame {
    LAS unsigned char* lds;
    volatile LAS unsigned* MISC;
    gu32* ctl;
    int tid, lane, wave;
    int vcu, G;
};
__device__ __forceinline__ float wave_sum(float v) {
#pragma unroll
    for (int o = 1; o < 64; o <<= 1) v += __shfl_xor(v, o);
    return v;
}
__device__ __forceinline__ float bf_lo(unsigned x) { return __builtin_bit_cast(float, x << 16); }
__device__ __forceinline__ float bf_hi(unsigned x) { return __builtin_bit_cast(float, x & 0xffff0000u); }
#define WG_BAR() do { asm volatile("s_waitcnt vmcnt(0) lgkmcnt(0)" ::: "memory"); __builtin_amdgcn_s_barrier(); asm volatile("" ::: "memory"); } while (0)

__device__ __forceinline__ void p0_transpose_item(const float* W, int ldw, const float* gk, bf16* WT, int ldt, int k0, int n0, int dk0, int drow0, LAS float* scr, int lane) {
    float v[32];
    const float* wp = W + (size_t)(k0 + (lane >> 5)) * ldw + n0 + (lane & 31);
#pragma unroll
    for (int i = 0; i < 32; ++i) v[i] = wp[(size_t)(2 * i) * ldw];
    const int c = lane & 7;
    f32x4 g0 = {1.f, 1.f, 1.f, 1.f}, g1 = {1.f, 1.f, 1.f, 1.f};
    if (gk) { g0 = *(const GAS f32x4*)(gk + k0 + 8 * c); g1 = *(const GAS f32x4*)(gk + k0 + 8 * c + 4); }
#pragma unroll
    for (int i = 0; i < 32; ++i) scr[(2 * i + (lane >> 5)) * 33 + (lane & 31)] = v[i];
    LDS_WAIT(); asm volatile("" ::: "memory");
#pragma unroll
    for (int j = 0; j < 4; ++j) { const int n = (lane >> 3) + 8 * j; const LAS float* s = scr + (8 * c) * 33 + n;
        v4u o; o.x = pk2(s[0 * 33] * g0.x, s[1 * 33] * g0.y); o.y = pk2(s[2 * 33] * g0.z, s[3 * 33] * g0.w); o.z = pk2(s[4 * 33] * g1.x, s[5 * 33] * g1.y); o.w = pk2(s[6 * 33] * g1.z, s[7 * 33] * g1.w);
        *(GAS v4u*)(WT + (size_t)(drow0 + n) * ldt + dk0 + 8 * c) = o; }
    LDS_WAIT(); asm volatile("" ::: "memory");
}
__device__ __forceinline__ void p0_job(const float* W, int ldw, const float* gk, int kbeg, int kext, int ncol0, int next, bf16* WT, int ldt, int dkbase, int mode, int half_or_off,
                                       LAS float* scr, int lane, int gw, int NGW, int& cursor) {
    const int nkb = kext / 64, nnb = next / 32, nitems = nkb * nnb;
    int first = (gw - (cursor % NGW) + NGW) % NGW;
    for (int it = first; it < nitems; it += NGW) {
        const int kb = it / nnb, nb = it % nnb, nrel = 32 * nb;
        const int drow0 = (mode == 0) ? (half_or_off + nrel) : (256 * (nrel >> 7) + 128 * half_or_off + (nrel & 127));
        p0_transpose_item(W, ldw, gk, WT, ldt, kbeg + 64 * kb, ncol0 + nrel, dkbase + 64 * kb, drow0, scr, lane);
    }
    cursor += nitems;
}
__device__ __forceinline__ void p0_fold_item(const float* L, int lrow0, const float* sc, const float* Rm, bf16* out, int dk0, float scale, int dw, int lane) {
    const int d = 64 * dw + lane;
    float l0[8], l1[8];
    { const float s0 = sc ? sc[lane] : 1.f, s1 = sc ? sc[64 + lane] : 1.f;
#pragma unroll
      for (int j = 0; j < 8; ++j) { l0[j] = L[(size_t)(lrow0 + j) * 128 + lane] * s0; l1[j] = L[(size_t)(lrow0 + j) * 128 + 64 + lane] * s1; } }
    float acc[8];
#pragma unroll
    for (int j = 0; j < 8; ++j) acc[j] = 0.f;
#pragma unroll
    for (int cb = 0; cb < 4; ++cb) {
        float r[32];
#pragma unroll
        for (int i = 0; i < 32; ++i) r[i] = Rm[(size_t)(cb * 32 + i) * 1024 + d];
#pragma unroll
        for (int i = 0; i < 32; ++i) { const int cp = cb * 32 + i;
#pragma unroll
            for (int j = 0; j < 8; ++j) { const float lv = __builtin_bit_cast(float, __builtin_amdgcn_readlane(__builtin_bit_cast(int, cp < 64 ? l0[j] : l1[j]), cp & 63)); acc[j] = fmaf(lv, r[i], acc[j]); } }
    }
    v4u o; o.x = pk2(acc[0] * scale, acc[1] * scale); o.y = pk2(acc[2] * scale, acc[3] * scale); o.z = pk2(acc[4] * scale, acc[5] * scale); o.w = pk2(acc[6] * scale, acc[7] * scale);
    *(GAS v4u*)(out + (size_t)d * 1024 + dk0) = o;
}
__device__ __forceinline__ void p0_pq_item(const float* Win1, const float* g1, bf16* WPQ, int h, int half, int k0, const LAS float* tab, int lane) {
    const int cp = 64 * half + lane;
    float ap[8], aq[8], w0[8], w1[8];
#pragma unroll
    for (int j = 0; j < 8; ++j) { const float g = g1[k0 + j]; ap[j] = 0.f; aq[j] = 0.f; w0[j] = Win1[(size_t)(k0 + j) * 1536 + h * 128 + lane] * g; w1[j] = Win1[(size_t)(k0 + j) * 1536 + h * 128 + 64 + lane] * g; }
#pragma unroll 8
    for (int c = 0; c < 128; ++c) {
        const int ph = c * cp;
        const float cs = tab[ph & 127], sn = tab[(ph - 32) & 127];
#pragma unroll
        for (int j = 0; j < 8; ++j) { const float w = __builtin_bit_cast(float, __builtin_amdgcn_readlane(__builtin_bit_cast(int, c < 64 ? w0[j] : w1[j]), c & 63)); ap[j] = fmaf(w, cs, ap[j]); aq[j] = fmaf(w, sn, aq[j]); }
    }
    v4u o; o.x = pk2(ap[0], ap[1]); o.y = pk2(ap[2], ap[3]); o.z = pk2(ap[4], ap[5]); o.w = pk2(ap[6], ap[7]);
    *(GAS v4u*)(WPQ + (size_t)(h * 128 + cp) * 1024 + k0) = o;
    o.x = pk2(aq[0], aq[1]); o.y = pk2(aq[2], aq[3]); o.z = pk2(aq[4], aq[5]); o.w = pk2(aq[6], aq[7]);
    *(GAS v4u*)(WPQ + (size_t)(512 + h * 128 + cp) * 1024 + k0) = o;
}

struct Ptrs {
    const float* in[22]; float* out; unsigned char* ws;
};

__device__ __forceinline__ void p0_prologue(Frame& F, const Ptrs& P) {
    const float* x = P.in[0]; const float* mix_g = P.in[1]; const float* ffn_g = P.in[2];
    const float* ev_w_in = P.in[3]; const float* ev_pool_w = P.in[8]; const float* ev_pool_scale = P.in[9]; const float* ev_w_out = P.in[10];
    const float* od_w_in = P.in[11]; const float* od_fourier_w = P.in[12]; const float* od_w_out = P.in[17];
    const float* w_gate = P.in[18]; const float* w_up = P.in[19]; const float* w_down = P.in[20];
    unsigned char* ws = P.ws;
    LAS float* scr = (LAS float*)(F.lds + RING_OFF + F.wave * 8448);
    LAS float* CT = (LAS float*)(F.lds + RING_OFF + 69632);
    LAS float* tab = (LAS float*)(F.lds + RING_OFF + 69632 + 16384);
    for (int i = F.tid; i < 4096; i += NWAVES * 64) CT[i] = cospif((float)i * (1.0f / 2048.0f));
    if (F.tid < 128) tab[F.tid] = cospif((float)F.tid * (1.0f / 64.0f));
    WG_BAR();
    const int gw = F.vcu * NWAVES + F.wave, NGW = F.G * NWAVES, lane = F.lane;
    { unsigned long long* z = (unsigned long long*)(ws + WS_SSQ) + M; const int gt = F.vcu * NWAVES * 64 + F.tid, NT = F.G * NWAVES * 64;
      for (int i = gt; i < 4 * M; i += NT) z[i] = 0ull; }
    int cur = 0;
    p0_job(ev_w_in, 1536, mix_g, 0, 1024, 0, 512, (bf16*)(ws + WS_WIN0), 1024, 0, 1, 0, scr, lane, gw, NGW, cur);
    p0_job(ev_w_in, 1536, mix_g, 0, 1024, 512, 512, (bf16*)(ws + WS_WIN0), 1024, 0, 1, 1, scr, lane, gw, NGW, cur);
    p0_job(ev_w_in, 1536, mix_g, 0, 1024, 1024, 512, (bf16*)(ws + WS_WIN0), 1024, 0, 0, 1024, scr, lane, gw, NGW, cur);
    p0_job(ev_w_out, 1024, nullptr, 0, 512, 0, 1024, (bf16*)(ws + WS_WOUT0), 1024, 0, 0, 0, scr, lane, gw, NGW, cur);
    p0_job(w_gate, FF, ffn_g, 0, 1024, 0, FF, (bf16*)(ws + WS_WGU0), 1024, 0, 1, 0, scr, lane, gw, NGW, cur);
    p0_job(w_up, FF, ffn_g, 0, 1024, 0, FF, (bf16*)(ws + WS_WGU0), 1024, 0, 1, 1, scr, lane, gw, NGW, cur);
    p0_job(w_down, 1024, nullptr, 0, FF, 0, 1024, (bf16*)(ws + WS_WDN0), FF, 0, 0, 0, scr, lane, gw, NGW, cur);
    p0_job(od_w_in, 1536, mix_g + D, 0, 1024, 512, 1024, (bf16*)(ws + WS_WUV1), 1024, 0, 0, 0, scr, lane, gw, NGW, cur);
    p0_job(od_w_out, 1024, nullptr, 512, 512, 0, 1024, (bf16*)(ws + WS_WOUT1), 1024, 512, 0, 0, scr, lane, gw, NGW, cur);
    p0_job(w_gate + (size_t)D * FF, FF, ffn_g + D, 0, 1024, 0, FF, (bf16*)(ws + WS_WGU1), 1024, 0, 1, 0, scr, lane, gw, NGW, cur);
    p0_job(w_up + (size_t)D * FF, FF, ffn_g + D, 0, 1024, 0, FF, (bf16*)(ws + WS_WGU1), 1024, 0, 1, 1, scr, lane, gw, NGW, cur);
    p0_job(w_down + (size_t)FF * D, 1024, nullptr, 0, FF, 0, 1024, (bf16*)(ws + WS_WDN1), FF, 0, 0, 0, scr, lane, gw, NGW, cur);
    {
        int first = (gw - (cur % NGW) + NGW) % NGW;
        for (int it = first; it < 1024; it += NGW) { const int g = it >> 8, cc = (it >> 4) & 15, dw = it & 15;
            p0_fold_item(ev_pool_w, g * 128 + cc * 8, ev_pool_scale + g * 128, ev_w_out + (size_t)(512 + g * 128) * 1024, (bf16*)(ws + WS_WOUT0), 512 + g * 128 + cc * 8, 1.0f, dw, lane); }
        cur += 1024;
        first = (gw - (cur % NGW) + NGW) % NGW;
        for (int it = first; it < 1024; it += NGW) { const int h = it >> 8, cc = (it >> 4) & 15, dw = it & 15;
            p0_fold_item(od_fourier_w, h * 128 + cc * 8, nullptr, od_w_out + (size_t)(h * 128) * 1024, (bf16*)(ws + WS_WOUT1), h * 128 + cc * 8, 1.0f / 724.0773439350247f, dw, lane); }
        cur += 1024;
        first = (gw - (cur % NGW) + NGW) % NGW;
        for (int it = first; it < 1024; it += NGW) { const int h = it >> 8, half = (it >> 7) & 1, kc = it & 127;
            p0_pq_item(od_w_in, mix_g + D, (bf16*)(ws + WS_WPQ1), h, half, kc * 8, tab, lane); }
        cur += 1024;
    }
    {
        bf16* Dm = (bf16*)(ws + WS_DFT);
        int first = (gw - (cur % NGW) + NGW) % NGW;
        for (int t = first; t < S; t += NGW) {
#pragma unroll 2
            for (int q = 0; q < 8; ++q) {
                const int k0 = (q * 64 + lane) * 8, s0 = k0 & (S / 2 - 1), sinpart = k0 >> 11;
                float v[8];
#pragma unroll
                for (int e = 0; e < 8; ++e) { int idx = (s0 + e) * t + (sinpart ? 1024 : 0); if (sinpart && s0 + e == 0) idx = 2048 * t; v[e] = CT[idx & (S - 1)]; }
                v4u o; o.x = pk2(v[0], v[1]); o.y = pk2(v[2], v[3]); o.z = pk2(v[4], v[5]); o.w = pk2(v[6], v[7]);
                *(GAS v4u*)(Dm + (size_t)t * S + k0) = o;
            }
        }
        cur += S;
    }
    {
        bf16* XB = (bf16*)(ws + WS_XB); unsigned long long* ssq0 = (unsigned long long*)(ws + WS_SSQ);
        for (int m0 = 4 * gw; m0 < M; m0 += 4 * NGW) {
            f32x4 v[4][4];
#pragma unroll
            for (int r = 0; r < 4; ++r) { const GAS f32x4* xr = (const GAS f32x4*)(x + (size_t)(m0 + r) * D) + lane;
#pragma unroll
                for (int j = 0; j < 4; ++j) v[r][j] = xr[64 * j]; }
#pragma unroll
            for (int r = 0; r < 4; ++r) { float s = 0.f;
#pragma unroll
                for (int j = 0; j < 4; ++j) s += (v[r][j].x * v[r][j].x + v[r][j].y * v[r][j].y) + (v[r][j].z * v[r][j].z + v[r][j].w * v[r][j].w);
                s = wave_sum(s);
                if (lane == 0) ssq0[m0 + r] = pg8::ssq_fix(s);
                GAS unsigned long long* o8 = (GAS unsigned long long*)(XB + (size_t)(m0 + r) * D) + lane;
#pragma unroll
                for (int j = 0; j < 4; ++j) o8[64 * j] = (unsigned long long)pk2(v[r][j].x, v[r][j].y) | ((unsigned long long)pk2(v[r][j].z, v[r][j].w) << 32); }
        }
    }
}

__device__ __forceinline__ float reduce_scatter16(float (&v)[16], int lane) {
#pragma unroll
    for (int o = 8; o >= 1; o >>= 1) {
        const bool up = (lane & o) != 0;
#pragma unroll
        for (int i = 0; i < o; ++i) { const float send = up ? v[i] : v[i + o]; const float keep = up ? v[i + o] : v[i]; v[i] = keep + __shfl_xor(send, o); }
    }
    float t = v[0] + __shfl_xor(v[0], 16);
    return t + __shfl_xor(t, 32);
}
__device__ __forceinline__ void mix0_conv_item(Frame& F, const Ptrs& P, int item) {
    const bf16* UB = (const bf16*)(P.ws + WS_UB); bf16* AM = (bf16*)(P.ws + WS_AM);
    const float* cw = P.in[4]; const float* cb = P.in[5]; const float* lg = P.in[6]; const float* lb = P.in[7];
    const int b = item >> 6, t0 = (item & 63) * 64, rowbase = b * S;
    LAS unsigned* tile = (LAS unsigned*)(F.lds + RING_OFF);
    LAS float* red = (LAS float*)(F.lds + RING_OFF + 98304);
    LAS float* stats = (LAS float*)(F.lds + RING_OFF + 98304 + 1024);
    { v4u tv[12];
#pragma unroll
      for (int i = 0; i < 12; ++i) { const int t = t0 - 15 + F.wave + NWAVES * i, tc = t < 0 ? 0 : (t > S - 1 ? S - 1 : t);
          tv[i] = *(const GAS v4u*)(UB + (size_t)(rowbase + tc) * 512 + F.lane * 8); }
#pragma unroll
      for (int i = 0; i < 12; ++i) { const int r = F.wave + NWAVES * i, t = t0 - 15 + r; const bool ok = (t >= 0 && t < S);
          v4u w = tv[i]; w.x = ok ? w.x : 0u; w.y = ok ? w.y : 0u; w.z = ok ? w.z : 0u; w.w = ok ? w.w : 0u;
          *(LAS v4u*)(tile + r * 256 + F.lane * 4) = w; } }
    WG_BAR();
    int tidl = F.tid; asm volatile("" : "+v"(tidl));
    const int rg = tidl >> 8, cp = tidl & 255, lanel = tidl & 63;
    const f32x2g bb = *(const GAS f32x2g*)(cb + 2 * cp);
    const f32x2g g2 = *(const GAS f32x2g*)(lg + 2 * cp), b2 = *(const GAS f32x2g*)(lb + 2 * cp);
    float w0[31], w1[31];
#pragma unroll
    for (int j = 0; j < 31; ++j) { const f32x2g w = *(const GAS f32x2g*)(cw + j * 512 + 2 * cp); w0[j] = w.x; w1[j] = w.y; }
#pragma unroll 1
    for (int p = 0; p < 4; ++p) {
        float a0[8], a1[8];
#pragma unroll
        for (int o = 0; o < 8; ++o) { a0[o] = bb.x; a1[o] = bb.y; }
        const LAS unsigned* tp = tile + (32 * rg + 8 * p) * 256 + cp;
#pragma unroll
        for (int ii = 0; ii < 38; ++ii) {
            const unsigned xx = tp[ii * 256];
            const float x0 = bf_lo(xx), x1 = bf_hi(xx);
#pragma unroll
            for (int o = 0; o < 8; ++o) { const int j = ii - o; if (j >= 0 && j <= 30) { a0[o] = fmaf(w0[j], x0, a0[o]); a1[o] = fmaf(w1[j], x1, a1[o]); } }
        }
        float v[16];
#pragma unroll
        for (int o = 0; o < 8; ++o) { v[2 * o] = a0[o] + a1[o]; v[2 * o + 1] = a0[o] * a0[o] + a1[o] * a1[o]; }
        const float tot = reduce_scatter16(v, lanel);
        if (lanel < 16) red[F.wave * 16 + lanel] = tot;
        WG_BAR();
        if (cp < 8) { const int wb = rg * 4; float s = 0.f, q = 0.f;
#pragma unroll
            for (int w = 0; w < 4; ++w) { s += red[(wb + w) * 16 + 2 * cp]; q += red[(wb + w) * 16 + 2 * cp + 1]; }
            const float mean = s * (1.0f / 512.0f), var = q * (1.0f / 512.0f) - mean * mean;
            stats[(rg * 8 + cp) * 2] = mean; stats[(rg * 8 + cp) * 2 + 1] = rsqrtf(var + 1e-6f); }
        WG_BAR();
#pragma unroll
        for (int o = 0; o < 8; ++o) {
            const float mean = stats[(rg * 8 + o) * 2], rstd = stats[(rg * 8 + o) * 2 + 1];
            float y0 = (a0[o] - mean) * rstd * g2.x + b2.x, y1 = (a1[o] - mean) * rstd * g2.y + b2.y;
            y0 = y0 * __builtin_amdgcn_rcpf(1.0f + __expf(-y0)); y1 = y1 * __builtin_amdgcn_rcpf(1.0f + __expf(-y1));
            *(GAS unsigned*)(AM + (size_t)(rowbase + t0 + 32 * rg + 8 * p + o) * 1024 + 2 * cp) = pk2(y0, y1);
        }
    }
    WG_BAR();
}
template <int H> __device__ __forceinline__ void pool_rows(const LAS unsigned* tp  , bf16* orow  , int tfirst) {
    unsigned x[32 + 2 * H];
#pragma unroll
    for (int i = 0; i < 32 + 2 * H; ++i) x[i] = tp[i * 256];
    float s0 = 0.f, s1 = 0.f;
#pragma unroll
    for (int i = 0; i < 2 * H; ++i) { s0 += bf_lo(x[i]); s1 += bf_hi(x[i]); }
#pragma unroll
    for (int o = 0; o < 32; ++o) {
        const int t = tfirst + o;
        const int lo = (t - H) < 0 ? 0 : (t - H), hi = (t + H - 1) > (S - 1) ? (S - 1) : (t + H - 1);
        const float inv = 1.0f / (float)(hi - lo + 1);
        *(GAS unsigned*)(orow + (size_t)o * 1024) = pk2(s0 * inv - bf_lo(x[o + H]), s1 * inv - bf_hi(x[o + H]));
        if (o < 31) { s0 += bf_lo(x[o + 2 * H]) - bf_lo(x[o]); s1 += bf_hi(x[o + 2 * H]) - bf_hi(x[o]); }
    }
}
__device__ __forceinline__ void mix0_pool_item(Frame& F, const Ptrs& P, int item) {
    const bf16* PB = (const bf16*)(P.ws + WS_PB); bf16* AM = (bf16*)(P.ws + WS_AM);
    const int b = item >> 6, t0 = (item & 63) * 64, rowbase = b * S;
    LAS unsigned* tile = (LAS unsigned*)(F.lds + RING_OFF);
    { v4u tv[10];
#pragma unroll
      for (int i = 0; i < 10; ++i) { const int t = t0 - 8 + F.wave + NWAVES * i, tc = t < 0 ? 0 : (t > S - 1 ? S - 1 : t);
          tv[i] = *(const GAS v4u*)(PB + (size_t)(rowbase + tc) * 512 + F.lane * 8); }
#pragma unroll
      for (int i = 0; i < 10; ++i) { const int r = F.wave + NWAVES * i, t = t0 - 8 + r; const bool ok = (t >= 0 && t < S);
          v4u w = tv[i]; w.x = ok ? w.x : 0u; w.y = ok ? w.y : 0u; w.z = ok ? w.z : 0u; w.w = ok ? w.w : 0u;
          *(LAS v4u*)(tile + r * 256 + F.lane * 4) = w; } }
    WG_BAR();
    const int rg = F.tid >> 8, cp = F.tid & 255, g = __builtin_amdgcn_readfirstlane(cp >> 6);
    bf16* orow = AM + (size_t)(rowbase + t0 + 32 * rg) * 1024 + 512 + 2 * cp;
    const int tfirst = t0 + 32 * rg;
    if (g == 0) pool_rows<1>(tile + (32 * rg + 8 - 1) * 256 + cp, orow, tfirst);
    else if (g == 1) pool_rows<2>(tile + (32 * rg + 8 - 2) * 256 + cp, orow, tfirst);
    else if (g == 2) pool_rows<4>(tile + (32 * rg + 8 - 4) * 256 + cp, orow, tfirst);
    else pool_rows<8>(tile + (32 * rg + 8 - 8) * 256 + cp, orow, tfirst);
    WG_BAR();
}

__device__ __forceinline__ void sgu_item(Frame& F, const Ptrs& P, int item) {
    const bf16* U = (const bf16*)(P.ws + WS_U1); const bf16* V = (const bf16*)(P.ws + WS_V1); bf16* AM = (bf16*)(P.ws + WS_AM);
    const float* lng = P.in[13]; const float* lnb = P.in[14]; const float* sw = P.in[15]; const float* sb = P.in[16];
    const int h = item & 3, rowbase = (item >> 2) * 128;
    LAS bf16* vnT = (LAS bf16*)(F.lds + RING_OFF);
    const int lane = F.lane;
    {
        const f32x2g g2 = *(const GAS f32x2g*)(lng + h * 128 + 2 * lane), b2 = *(const GAS f32x2g*)(lnb + h * 128 + 2 * lane);
        unsigned xv[16];
#pragma unroll
        for (int i = 0; i < 16; ++i) xv[i] = *(const GAS unsigned*)(V + (size_t)(rowbase + F.wave + 8 * i) * 512 + h * 128 + 2 * lane);
#pragma unroll
        for (int i = 0; i < 16; ++i) { const int k = F.wave + 8 * i;
            const float v0 = bf_lo(xv[i]), v1 = bf_hi(xv[i]);
            const float mean = wave_sum(v0 + v1) * (1.0f / 128.0f), d0 = v0 - mean, d1 = v1 - mean;
            const float rstd = rsqrtf(wave_sum(d0 * d0 + d1 * d1) * (1.0f / 128.0f) + 1e-6f);
            vnT[(2 * lane) * 136 + k] = (bf16)f2bf(d0 * rstd * g2.x + b2.x); vnT[(2 * lane + 1) * 136 + k] = (bf16)f2bf(d1 * rstd * g2.y + b2.y); }
    }
    WG_BAR();
    {
        const int fr = lane & 15, fq = lane >> 4, q = 16 * F.wave + fr;
        pg8::f32x4 acc[8];
#pragma unroll
        for (int nt = 0; nt < 8; ++nt) acc[nt] = (pg8::f32x4){0.f, 0.f, 0.f, 0.f};
#pragma unroll
        for (int ks = 0; ks < 4; ++ks) {
            const GAS pg8::f32x4* wp = (const GAS pg8::f32x4*)(sw + (size_t)(h * 128 + q) * 128 + ks * 32 + 8 * fq);
            const pg8::f32x4 wa = wp[0], wb = wp[1];
            pg8::u32x4 wq; wq.x = pk2(wa[0], wa[1]); wq.y = pk2(wa[2], wa[3]); wq.z = pk2(wb[0], wb[1]); wq.w = pk2(wb[2], wb[3]);
            const pg8::bf16x8 wf = __builtin_bit_cast(pg8::bf16x8, wq);
#pragma unroll
            for (int nt = 0; nt < 8; ++nt) {
                const pg8::bf16x8 vf = *(const LAS pg8::bf16x8*)(vnT + (16 * nt + fr) * 136 + ks * 32 + 8 * fq);
                acc[nt] = __builtin_amdgcn_mfma_f32_16x16x32_bf16(vf, wf, acc[nt], 0, 0, 0);
            }
        }
        const float bias = sb[h * 128 + q]; const size_t t = (size_t)(rowbase + q);
#pragma unroll
        for (int nt = 0; nt < 8; ++nt) { const int c0 = h * 128 + 16 * nt + 4 * fq;
            const u32x2g uu = *(const GAS u32x2g*)(U + t * 512 + c0);
            u32x2g o; o.x = pk2(bf_lo(uu.x) * (acc[nt][0] + bias), bf_hi(uu.x) * (acc[nt][1] + bias)); o.y = pk2(bf_lo(uu.y) * (acc[nt][2] + bias), bf_hi(uu.y) * (acc[nt][3] + bias));
            *(GAS u32x2g*)(AM + t * 1024 + 512 + c0) = o; }
    }
    WG_BAR();
}

__device__ __forceinline__ void fold_rows(Frame& F, const Ptrs& P) {
    const bf16* PQT = (const bf16*)(P.ws + WS_PQT); bf16* PQF = (bf16*)(P.ws + WS_PQF);
    LAS unsigned short* buf = (LAS unsigned short*)(F.lds + RING_OFF + F.wave * 16384);
    const int gw = F.vcu * NWAVES + F.wave, NGW = F.G * NWAVES, lane = F.lane;
    for (int row = gw; row < NB * 512; row += NGW) {
        const GAS v4u* src = (const GAS v4u*)(PQT + (size_t)row * 2 * S) + lane;
        v4u t[16];
#pragma unroll
        for (int i = 0; i < 16; ++i) t[i] = src[64 * i];
#pragma unroll
        for (int i = 0; i < 16; ++i) *(LAS v4u*)(buf + (size_t)(64 * i + lane) * 8) = t[i];
        LDS_WAIT(); asm volatile("" ::: "memory");
        GAS v4u* dst = (GAS v4u*)(PQF + (size_t)row * S) + lane;
#pragma unroll
        for (int q = 0; q < 8; ++q) {
            const int k0 = (q * 64 + lane) * 8, sinpart = k0 >> 11, s0 = k0 & (S / 2 - 1);
            const LAS unsigned short* pr = buf + (sinpart ? S : 0);
            float v[8];
#pragma unroll
            for (int e = 0; e < 8; ++e) { const int sidx = s0 + e;
                const float a = __builtin_bit_cast(float, (unsigned)pr[sidx] << 16), bm = __builtin_bit_cast(float, (unsigned)pr[(S - sidx) & (S - 1)] << 16);
                v[e] = sinpart ? (a - bm) : (a + bm);
                if (sidx == 0) v[e] = sinpart ? __builtin_bit_cast(float, (unsigned)buf[S / 2] << 16) : a; }
            v4u o; o.x = pk2(v[0], v[1]); o.y = pk2(v[2], v[3]); o.z = pk2(v[4], v[5]); o.w = pk2(v[6], v[7]);
            dst[64 * q] = o;
        }
        LDS_WAIT(); asm volatile("" ::: "memory");
    }
}

struct Args { const float* in[22]; float* out; unsigned char* ws; int ph_lo, ph_hi, li, pad; };
__global__ void __launch_bounds__(NWAVES * 64, 2) mk_fwd(Args args) {
    extern __shared__ __attribute__((aligned(16))) unsigned char lds[];
    Frame F;
    F.lds = (LAS unsigned char*)lds;
    F.MISC = (volatile LAS unsigned*)(F.lds + MISC_OFF);
    F.tid = threadIdx.x; F.lane = F.tid & 63; F.wave = __builtin_amdgcn_readfirstlane(F.tid >> 6);
    F.G = gridDim.x; { const int bx = blockIdx.x; F.vcu = (F.G % 8 == 0) ? (bx % 8) * (F.G / 8) + bx / 8 : bx; }
    Ptrs P;
#pragma unroll
    for (int i = 0; i < 22; ++i) P.in[i] = args.in[i];
    P.out = args.out; P.ws = args.ws;
    unsigned char* ws = args.ws;
    F.ctl = (gu32*)(ws + WS_CTL);
    for (int u = F.tid; u < (LDS_BYTES - LDSCTL_OFF) / 4; u += NWAVES * 64) ((LAS unsigned*)(F.lds + LDSCTL_OFF))[u] = 0u;
    __syncthreads();
    XcdBarrier bar; bar.bar = (unsigned*)(F.ctl + CW_BAR); bar.x = 0; bar.st = nullptr;
    if (!MK_PER_PHASE) bar = xcd_barrier_post((unsigned*)(F.ctl + CW_BAR), F.MISC + 8);
    const int lo = args.ph_lo, hi = args.ph_hi;
#ifndef PH_MASK
#define PH_MASK 0x1FFF
#endif
#define IN(k) ((((PH_MASK) >> (k)) & 1) && lo <= (k) && (k) < hi)
#ifndef PROBE_BARX
#define PROBE_BARX 1
#endif
#define SEAM(k) do { if (IN(k) && IN((k) + 1)) { for (int bx_ = 0; bx_ < PROBE_BARX; ++bx_) xcd_barrier(bar); } } while (0)
    unsigned long long* ssq = (unsigned long long*)(ws + WS_SSQ);
    bf16* XB = (bf16*)(ws + WS_XB); bf16* AM = (bf16*)(ws + WS_AM); bf16* HB = (bf16*)(ws + WS_H);
    const int bid = (int)blockIdx.x;
    const bool dup = args.pad != 0;
    bf16* TRX = (bf16*)(ws + WS_END); unsigned long long* TRS = (unsigned long long*)(ws + WS_END + 64 * MiB);

    if (IN(0)) { p0_prologue(F, P); } SEAM(0);
    if (IN(1)) { pg8::Gemm g{XB, (const bf16*)(ws + WS_WIN0), M, 1536, D}; pg8::StaticOrder So; So.init(M, 1536, F.G, bid);
        pg8::EpiInL0 E{(bf16*)(ws + WS_UB), (bf16*)(ws + WS_PB), ssq};
        pg8::gemm_phase<pg8::EpiInL0, pg8::StaticOrder, true, true>(F.lds + RING_OFF, g, So, E); } SEAM(1);
    if (IN(2)) { for (int it = F.vcu; it < 1024; it += F.G) {
#ifndef NO_CONV
            if (it < 512) mix0_conv_item(F, P, it);
#endif
#ifndef NO_POOL
            if (it >= 512) mix0_pool_item(F, P, it - 512);
#endif
 } } SEAM(2);
    if (IN(3)) { pg8::Gemm g{AM, (const bf16*)(ws + WS_WOUT0), M, D, D}; pg8::StaticOrder So; So.init(M, D, F.G, bid);
        pg8::EpiResid E{XB, dup ? TRS : ssq + M, dup ? TRX : XB};
        pg8::gemm_phase<pg8::EpiResid, pg8::StaticOrder, true, true>(F.lds + RING_OFF, g, So, E); } SEAM(3);
    if (IN(4)) { pg8::Gemm g{XB, (const bf16*)(ws + WS_WGU0), M, 2 * FF, D}; pg8::StaticOrder So; So.init(M, 2 * FF, F.G, bid);
        pg8::EpiSwiGLU E{HB, ssq + M, args.pad};
        pg8::gemm_phase<pg8::EpiSwiGLU, pg8::StaticOrder, true, true>(F.lds + RING_OFF, g, So, E); } SEAM(4);
    if (IN(5)) { pg8::Gemm g{HB, (const bf16*)(ws + WS_WDN0), M, D, FF}; pg8::StaticOrder So; So.init(M, D, F.G, bid);
        pg8::EpiResid E{XB, dup ? TRS : ssq + 2 * M, dup ? TRX : XB};
        pg8::gemm_phase<pg8::EpiResid, pg8::StaticOrder, true, true>(F.lds + RING_OFF, g, So, E); } SEAM(5);
    if (IN(6)) {
        { pg8::Gemm g{(const bf16*)(ws + WS_WPQ1), XB, 1024, M, D}; pg8::StaticOrder So; So.init(1024, M, F.G, bid);
          pg8::EpiPQT E{(bf16*)(ws + WS_PQT), ssq + 2 * M};
          pg8::gemm_phase<pg8::EpiPQT, pg8::StaticOrder, true, true>(F.lds + RING_OFF, g, So, E); }
        { pg8::Gemm g{XB, (const bf16*)(ws + WS_WUV1), M, 1024, D}; pg8::StaticOrder So; So.init(M, 1024, F.G, bid);
          pg8::EpiGeluUV E{(bf16*)(ws + WS_U1), (bf16*)(ws + WS_V1), ssq + 2 * M};
          pg8::gemm_phase<pg8::EpiGeluUV, pg8::StaticOrder, true, true>(F.lds + RING_OFF, g, So, E); }
    } SEAM(6);
    if (IN(7)) {
        { fold_rows(F, P); }
        { for (int it = F.vcu; it < 1024; it += F.G) sgu_item(F, P, it); }
    } SEAM(7);
    if (IN(8)) { pg8::Gemm g{(const bf16*)(ws + WS_DFT), (const bf16*)(ws + WS_PQF), S, NB * 512, S}; pg8::StaticOrder So; So.init(S, NB * 512, F.G, bid);
        pg8::EpiDFT E{AM};
        pg8::gemm_phase<pg8::EpiDFT, pg8::StaticOrder, true, true>(F.lds + RING_OFF, g, So, E); } SEAM(8);
    if (IN(9)) { pg8::Gemm g{AM, (const bf16*)(ws + WS_WOUT1), M, D, D}; pg8::StaticOrder So; So.init(M, D, F.G, bid);
        pg8::EpiResid E{XB, dup ? TRS : ssq + 3 * M, dup ? TRX : XB};
        pg8::gemm_phase<pg8::EpiResid, pg8::StaticOrder, true, true>(F.lds + RING_OFF, g, So, E); } SEAM(9);
    if (IN(10)) { pg8::Gemm g{XB, (const bf16*)(ws + WS_WGU1), M, 2 * FF, D}; pg8::StaticOrder So; So.init(M, 2 * FF, F.G, bid);
        pg8::EpiSwiGLU E{HB, ssq + 3 * M, args.pad};
        pg8::gemm_phase<pg8::EpiSwiGLU, pg8::StaticOrder, true, true>(F.lds + RING_OFF, g, So, E); } SEAM(10);
    if (IN(11)) { pg8::Gemm g{HB, (const bf16*)(ws + WS_WDN1), M, D, FF}; pg8::StaticOrder So; So.init(M, D, F.G, bid);
        pg8::EpiResid E{XB, dup ? TRS : ssq + 4 * M, dup ? TRX : XB};
        pg8::gemm_phase<pg8::EpiResid, pg8::StaticOrder, true, true>(F.lds + RING_OFF, g, So, E); } SEAM(11);
    if (IN(12)) {
        const float* gf = P.in[21]; const unsigned long long* ssq4 = ssq + 4 * M;
        const int gw = F.vcu * NWAVES + F.wave, NGW = F.G * NWAVES;
        for (int m = gw; m < M; m += NGW) {
            const GAS u32x2g* xr = (const GAS u32x2g*)(XB + (size_t)m * D) + F.lane; GAS f32x4* orow = (GAS f32x4*)(P.out + (size_t)m * D) + F.lane; const GAS f32x4* gr = (const GAS f32x4*)gf + F.lane;
            const float rs = pg8::rstd_of(ssq4[m]);
#pragma unroll
            for (int j = 0; j < 4; ++j) { const u32x2g xx = xr[64 * j]; const f32x4 gg = gr[64 * j];
                f32x4 v; v.x = bf_lo(xx.x); v.y = bf_hi(xx.x); v.z = bf_lo(xx.y); v.w = bf_hi(xx.y); orow[64 * j] = v * rs * gg; }
        }
    }
#undef IN
#undef SEAM
}

extern "C" void kernel_launch(void* const* d_in, const int* in_sizes, int n_in, void* d_out, int out_size, void* d_ws, size_t ws_size, hipStream_t stream) {
    static int grid = 0;
    if (grid == 0) {
        if (n_in != 22 || in_sizes[0] != M * D || out_size != M * D || ws_size < WS_END) { fprintf(stderr, "kernel_launch: unexpected shapes (n_in %d, in0 %d, out %d, ws %zu); nothing launched\n", n_in, n_in > 0 ? in_sizes[0] : -1, out_size, ws_size); grid = -1; return; }
        int dev = 0, cus = 0, per_cu = 0;
        if (hipGetDevice(&dev) != hipSuccess || hipDeviceGetAttribute(&cus, hipDeviceAttributeMultiprocessorCount, dev) != hipSuccess) { grid = -1; return; }
        if (hipFuncSetAttribute((const void*)mk_fwd, hipFuncAttributeMaxDynamicSharedMemorySize, LDS_BYTES) != hipSuccess) { fprintf(stderr, "kernel_launch: hipFuncSetAttribute failed\n"); grid = -1; return; }
        if (hipOccupancyMaxActiveBlocksPerMultiprocessor(&per_cu, (const void*)mk_fwd, NWAVES * 64, LDS_BYTES) != hipSuccess || per_cu < 1) { fprintf(stderr, "kernel_launch: occupancy query says %d blocks per CU\n", per_cu); per_cu = 1; }
        (void)hipGetLastError();
        grid = cus * 1;
    }
    if (grid < 0) return;
    if (hipMemsetAsync((char*)d_ws + WS_CTL, 0, CTL_ZERO_BYTES, stream) != hipSuccess) { fprintf(stderr, "kernel_launch: hipMemsetAsync failed\n"); return; }
    Args a{};
    for (int i = 0; i < 22; ++i) a.in[i] = (const float*)d_in[i];
    a.out = (float*)d_out; a.ws = (unsigned char*)d_ws;
#if MK_PER_PHASE
    for (int ph = 0; ph < N_PHASES; ++ph) { a.ph_lo = ph; a.ph_hi = ph + 1; a.li = ph;
        hipLaunchKernelGGL(mk_fwd, dim3(grid), dim3(NWAVES * 64), LDS_BYTES, stream, a); }
#else
    a.ph_lo = 0; a.ph_hi = N_PHASES; a.li = 0;
#ifdef PROBE_PHASE
#ifndef PROBE_MODE
#define PROBE_MODE 1
#endif
    { void* kargs0[] = {&a};
      hipError_t e0 = hipLaunchCooperativeKernel((const void*)mk_fwd, dim3(grid), dim3(NWAVES * 64), kargs0, LDS_BYTES, stream);
      if (e0 != hipSuccess) fprintf(stderr, "kernel_launch: cooperative launch failed: %s (grid %d)\n", hipGetErrorString(e0), grid);
      Args a2 = a; a2.ph_lo = PROBE_PHASE; a2.ph_hi = PROBE_PHASE + 1; a2.pad = PROBE_MODE;
      hipLaunchKernelGGL(mk_fwd, dim3(grid), dim3(NWAVES * 64), LDS_BYTES, stream, a2); }
#elif defined(MK_PLAIN_LAUNCH)
    hipLaunchKernelGGL(mk_fwd, dim3(grid), dim3(NWAVES * 64), LDS_BYTES, stream, a);
#else
    void* kargs[] = {&a};
    hipError_t e = hipLaunchCooperativeKernel((const void*)mk_fwd, dim3(grid), dim3(NWAVES * 64), kargs, LDS_BYTES, stream);
    if (e != hipSuccess) fprintf(stderr, "kernel_launch: cooperative launch failed: %s (grid %d)\n", hipGetErrorString(e), grid);
#endif
#endif
}
```

```cpp
#include <hip/hip_runtime.h>
#include <cstdio>
#include <cstdint>
namespace pg8 {
#define PG8_LAS __attribute__((address_space(3)))
typedef unsigned short bf16_t;
typedef short bf16x8 __attribute__((ext_vector_type(8)));
typedef float f32x4 __attribute__((ext_vector_type(4)));
typedef unsigned u32x4 __attribute__((ext_vector_type(4)));
constexpr int BM = 256, BK = 64, HALF = 128, HTB = HALF * BK * 2  , STAGE_BYTES = 8 * HTB, NXCD = 8, WGM = 8;

__host__ __device__ __forceinline__ int lds_byte(int r, int c) { const int st = (r >> 4) * 2 + (c >> 5), rr = r & 15, cc = c & 31, ob = rr * 64 + cc * 2; return st * 1024 + (ob ^ (((ob >> 9) & 1) << 5)); }
__host__ __device__ __forceinline__ void stage_rc(int b, int& R, int& C) { const int st = b / 1024, sb = b % 1024, swz = sb ^ (((sb >> 9) & 1) << 5); R = (st >> 1) * 16 + swz / 64; C = (st & 1) * 32 + (swz % 64) / 2; }
__host__ __device__ __forceinline__ int perm32(int rho) { const int n = rho >> 4, i = rho & 15; return 8 * (i >> 2) + 4 * n + (i & 3); }

struct Unit { int pm, pn; };
struct Gemm { const bf16_t* A; const bf16_t* Bt; int M, N, K; };

struct StaticOrder {
    int nM, nN, nwg, G, c;
    __host__ __device__ void init(int M, int N, int G_, int c_) { nM = M / BM; nN = N / BM; nwg = nM * nN; G = G_; c = c_; }
    __host__ __device__ bool next(int i, Unit& u) const {
        const long L = (long)i * G + c; if (L >= nwg) return false;
        int wgid = (int)L; { const int q = nwg / NXCD, r = nwg % NXCD, xcd = wgid % NXCD, off = wgid / NXCD; wgid = (xcd < r ? xcd * (q + 1) : r * (q + 1) + (xcd - r) * q) + off; }
        const int nig = WGM * nN, gid = wgid / nig, fm = gid * WGM, gsz = (nM - fm) < WGM ? (nM - fm) : WGM;
        u.pm = fm + ((wgid % nig) % gsz); u.pn = (wgid % nig) / gsz; return true;
    }
    __device__ __forceinline__ void a_ready(const Unit&) const {}
    __device__ __forceinline__ void done(const Unit&) const {}
};

__device__ __forceinline__ unsigned cvt_pk_bf16(float lo, float hi) { unsigned r; asm volatile("v_cvt_pk_bf16_f32 %0, %1, %2" : "=v"(r) : "v"(lo), "v"(hi)); return r; }
typedef float f32x2 __attribute__((ext_vector_type(2)));
__device__ __forceinline__ f32x2 gelu_pk(f32x2 v) {
    const f32x2 av = __builtin_elementwise_abs(v), d = av * 0.2316418882f + 1.0f;
    f32x2 t; t.x = __builtin_amdgcn_rcpf(d.x); t.y = __builtin_amdgcn_rcpf(d.y);
    f32x2 q = t * 0.5307027145f + (-0.7265760135f); q = q * t + 0.7107068705f; q = q * t + (-0.142248368f); q = q * t + 0.127414796f; q = q * t;
    const f32x2 s = (v * v) * (-0.72134752044f);
    f32x2 e; e.x = __builtin_amdgcn_exp2f(s.x); e.y = __builtin_amdgcn_exp2f(s.y);
    const f32x2 m = v * (q * e), r = v - m;
    f32x2 o; o.x = v.x < 0.f ? m.x : r.x; o.y = v.y < 0.f ? m.y : r.y; return o;
}


constexpr float RMS_EPS = 1e-6f;
__device__ __forceinline__ float sigm(float x) { return __builtin_amdgcn_rcpf(1.0f + __expf(-x)); }
__device__ __forceinline__ u32x4 pack8(const f32x4 v0, const f32x4 v1) { u32x4 w; w.x = cvt_pk_bf16(v0[0], v0[1]); w.y = cvt_pk_bf16(v0[2], v0[3]); w.z = cvt_pk_bf16(v1[0], v1[1]); w.w = cvt_pk_bf16(v1[2], v1[3]); return w; }
typedef unsigned long long u64_t;
__device__ __forceinline__ float ssq_f(u64_t v) { return fmaf((float)(unsigned)(v >> 32), 4294967296.0f, (float)(unsigned)v); }
__device__ __forceinline__ float rstd_of(u64_t ssq) { return __builtin_amdgcn_rsqf(fmaf(ssq_f(ssq), 1.0f / (1024.0f * 1048576.0f), RMS_EPS)); }
__device__ __forceinline__ u64_t ssq_fix(float s) { return (u64_t)(s * 1048576.0f); }

struct EpiInL0 {
    static constexpr bool PERM = true, AFTER_DRAIN = false;
    bf16_t* UB; bf16_t* PB; const u64_t* ssq;
    __device__ __forceinline__ void operator()(const f32x4 (&acc)[2][2][4][2], const Unit& u, int wr, int wc, int fr, int fq) const {
        const int row0 = u.pm * BM + wr * 64 + fr, cw = wc * 32 + 8 * fq;
        u64_t q[2][4];
#pragma unroll
        for (int ai = 0; ai < 2; ++ai)
#pragma unroll
            for (int m = 0; m < 4; ++m) q[ai][m] = ssq[row0 + ai * HALF + m * 16];
#pragma unroll
        for (int ai = 0; ai < 2; ++ai)
#pragma unroll
            for (int m = 0; m < 4; ++m) {
                const int row = row0 + ai * HALF + m * 16;
                const float rs = rstd_of(q[ai][m]), c1 = rs * -1.4426950408889634f;
                if (u.pn < 4) {
                    f32x4 o[2];
#pragma unroll
                    for (int n = 0; n < 2; ++n)
#pragma unroll
                        for (int j = 0; j < 4; j += 2) {
                            const f32x2 a = {acc[ai][0][m][n][j], acc[ai][0][m][n][j + 1]}, g = {acc[ai][1][m][n][j], acc[ai][1][m][n][j + 1]};
                            const f32x2 t = g * c1; f32x2 e; e.x = __builtin_amdgcn_exp2f(t.x); e.y = __builtin_amdgcn_exp2f(t.y);
                            const f32x2 d = e + 1.0f; f32x2 r; r.x = __builtin_amdgcn_rcpf(d.x); r.y = __builtin_amdgcn_rcpf(d.y);
                            const f32x2 h = a * (r * rs); o[n][j] = h.x; o[n][j + 1] = h.y; }
                    *(u32x4*)(UB + (size_t)row * 512 + u.pn * 128 + cw) = pack8(o[0], o[1]);
                } else {
#pragma unroll
                    for (int bj = 0; bj < 2; ++bj) *(u32x4*)(PB + (size_t)row * 512 + (u.pn - 4) * 256 + bj * HALF + cw) = pack8(acc[ai][bj][m][0] * rs, acc[ai][bj][m][1] * rs);
                }
            }
    }
};
struct EpiResid {
    static constexpr bool PERM = true, AFTER_DRAIN = false;
    bf16_t* XB; u64_t* ssq; bf16_t* XBw;
    __device__ __forceinline__ void operator()(const f32x4 (&acc)[2][2][4][2], const Unit& u, int wr, int wc, int fr, int fq) const {
        const int row0 = u.pm * BM + wr * 64 + fr, cw = u.pn * BM + wc * 32 + 8 * fq;
        u32x4 r[2][4][2];
#pragma unroll
        for (int ai = 0; ai < 2; ++ai)
#pragma unroll
            for (int m = 0; m < 4; ++m)
#pragma unroll
                for (int bj = 0; bj < 2; ++bj) r[ai][m][bj] = *(const u32x4*)(XB + (size_t)(row0 + ai * HALF + m * 16) * 1024 + bj * HALF + cw);
#pragma unroll
        for (int ai = 0; ai < 2; ++ai)
#pragma unroll
            for (int m = 0; m < 4; ++m) {
                const int row = row0 + ai * HALF + m * 16;
                float s = 0.f;
#pragma unroll
                for (int bj = 0; bj < 2; ++bj) {
                    const u32x4 rr = r[ai][m][bj];
                    f32x4 v0, v1;
                    v0[0] = __builtin_bit_cast(float, rr.x << 16) + acc[ai][bj][m][0][0]; v0[1] = __builtin_bit_cast(float, rr.x & 0xffff0000u) + acc[ai][bj][m][0][1];
                    v0[2] = __builtin_bit_cast(float, rr.y << 16) + acc[ai][bj][m][0][2]; v0[3] = __builtin_bit_cast(float, rr.y & 0xffff0000u) + acc[ai][bj][m][0][3];
                    v1[0] = __builtin_bit_cast(float, rr.z << 16) + acc[ai][bj][m][1][0]; v1[1] = __builtin_bit_cast(float, rr.z & 0xffff0000u) + acc[ai][bj][m][1][1];
                    v1[2] = __builtin_bit_cast(float, rr.w << 16) + acc[ai][bj][m][1][2]; v1[3] = __builtin_bit_cast(float, rr.w & 0xffff0000u) + acc[ai][bj][m][1][3];
                    const u32x4 w = pack8(v0, v1);
                    *(u32x4*)(XBw + ((size_t)row * 1024 + bj * HALF + cw)) = w;
                    const float q0 = __builtin_bit_cast(float, w.x << 16), q1 = __builtin_bit_cast(float, w.x & 0xffff0000u), q2 = __builtin_bit_cast(float, w.y << 16), q3 = __builtin_bit_cast(float, w.y & 0xffff0000u);
                    const float q4 = __builtin_bit_cast(float, w.z << 16), q5 = __builtin_bit_cast(float, w.z & 0xffff0000u), q6 = __builtin_bit_cast(float, w.w << 16), q7 = __builtin_bit_cast(float, w.w & 0xffff0000u);
                    s += (q0 * q0 + q1 * q1) + (q2 * q2 + q3 * q3) + (q4 * q4 + q5 * q5) + (q6 * q6 + q7 * q7);
                }
                s += __shfl_xor(s, 16); s += __shfl_xor(s, 32);
                if (fq == 0) atomicAdd(ssq + row, ssq_fix(s));
            }
    }
};
struct EpiSwiGLU {
    static constexpr bool PERM = true, AFTER_DRAIN = false;
    bf16_t* H; const u64_t* ssq; int probe_mode;
    __device__ __forceinline__ void operator()(const f32x4 (&acc)[2][2][4][2], const Unit& u, int wr, int wc, int fr, int fq) const {
        const int row0 = u.pm * BM + wr * 64 + fr, cw = wc * 32 + 8 * fq;
        if (probe_mode == 2) { if (acc[0][0][0][0][0] == 123.456f) H[0] = 1; return; }
        u64_t q[2][4];
#pragma unroll
        for (int ai = 0; ai < 2; ++ai)
#pragma unroll
            for (int m = 0; m < 4; ++m) q[ai][m] = ssq[row0 + ai * HALF + m * 16];
#pragma unroll
        for (int ai = 0; ai < 2; ++ai)
#pragma unroll
            for (int m = 0; m < 4; ++m) {
                const int row = row0 + ai * HALF + m * 16;
                const float rs = rstd_of(q[ai][m]), c1 = rs * -1.4426950408889634f, rs2 = rs * rs;
                f32x4 o[2];
#pragma unroll
                for (int n = 0; n < 2; ++n)
#pragma unroll
                    for (int j = 0; j < 4; j += 2) {
                        const f32x2 g = {acc[ai][0][m][n][j], acc[ai][0][m][n][j + 1]}, up = {acc[ai][1][m][n][j], acc[ai][1][m][n][j + 1]};
                        const f32x2 t = g * c1; f32x2 e; e.x = __builtin_amdgcn_exp2f(t.x); e.y = __builtin_amdgcn_exp2f(t.y);
                        const f32x2 d = e + 1.0f; f32x2 r; r.x = __builtin_amdgcn_rcpf(d.x); r.y = __builtin_amdgcn_rcpf(d.y);
                        const f32x2 h = (g * up) * (r * rs2); o[n][j] = h.x; o[n][j + 1] = h.y; }
                *(u32x4*)(H + (size_t)row * 2816 + u.pn * 128 + cw) = pack8(o[0], o[1]);
            }
    }
};
struct EpiPQT {
    static constexpr bool PERM = true, AFTER_DRAIN = false;
    bf16_t* PQT; const u64_t* ssq;
    __device__ __forceinline__ void operator()(const f32x4 (&acc)[2][2][4][2], const Unit& u, int wr, int wc, int fr, int fq) const {
        const int tok0 = u.pn * BM + wc * 32 + 8 * fq, b = (u.pn * BM) >> 12;
        f32x4 rs[2][2];
#pragma unroll
        for (int bj = 0; bj < 2; ++bj)
#pragma unroll
            for (int n = 0; n < 2; ++n)
#pragma unroll
                for (int j = 0; j < 4; ++j) rs[bj][n][j] = rstd_of(ssq[tok0 + bj * HALF + 4 * n + j]);
#pragma unroll
        for (int ai = 0; ai < 2; ++ai)
#pragma unroll
            for (int m = 0; m < 4; ++m) {
                const int r = u.pm * BM + ai * HALF + wr * 64 + m * 16 + fr, pq = r >> 9, ch = r & 511;
                bf16_t* base = PQT + ((size_t)(b * 512 + ch) * 2 + pq) * 4096;
#pragma unroll
                for (int bj = 0; bj < 2; ++bj) *(u32x4*)(base + ((tok0 + bj * HALF) & 4095)) = pack8(acc[ai][bj][m][0] * rs[bj][0], acc[ai][bj][m][1] * rs[bj][1]);
            }
    }
};
struct EpiGeluUV {
    static constexpr bool PERM = true, AFTER_DRAIN = false;
    bf16_t* U; bf16_t* V; const u64_t* ssq;
    __device__ __forceinline__ void operator()(const f32x4 (&acc)[2][2][4][2], const Unit& u, int wr, int wc, int fr, int fq) const {
        const int row0 = u.pm * BM + wr * 64 + fr, cw = wc * 32 + 8 * fq;
        bf16_t* dst = (u.pn < 2) ? U : V; const int colb = (u.pn & 1) * BM;
        u64_t q[2][4];
#pragma unroll
        for (int ai = 0; ai < 2; ++ai)
#pragma unroll
            for (int m = 0; m < 4; ++m) q[ai][m] = ssq[row0 + ai * HALF + m * 16];
#pragma unroll
        for (int ai = 0; ai < 2; ++ai)
#pragma unroll
            for (int m = 0; m < 4; ++m) {
                const int row = row0 + ai * HALF + m * 16;
                const float rs = rstd_of(q[ai][m]);
#pragma unroll
                for (int bj = 0; bj < 2; ++bj) {
                    const f32x4 v0 = acc[ai][bj][m][0] * rs, v1 = acc[ai][bj][m][1] * rs;
                    const f32x2 a = gelu_pk((f32x2){v0[0], v0[1]}), bq = gelu_pk((f32x2){v0[2], v0[3]}), c = gelu_pk((f32x2){v1[0], v1[1]}), d = gelu_pk((f32x2){v1[2], v1[3]});
                    *(u32x4*)(dst + (size_t)row * 512 + colb + bj * HALF + cw) = pack8((f32x4){a.x, a.y, bq.x, bq.y}, (f32x4){c.x, c.y, d.x, d.y});
                }
            }
    }
};
struct EpiDFT {
    static constexpr bool PERM = true, AFTER_DRAIN = false;
    bf16_t* AM;
    __device__ __forceinline__ void operator()(const f32x4 (&acc)[2][2][4][2], const Unit& u, int wr, int wc, int fr, int fq) const {
        const int row0 = (u.pn >> 1) * 4096 + u.pm * BM + wr * 64 + fr, cw = (u.pn & 1) * BM + wc * 32 + 8 * fq;
#pragma unroll
        for (int ai = 0; ai < 2; ++ai)
#pragma unroll
            for (int m = 0; m < 4; ++m) {
                const int row = row0 + ai * HALF + m * 16;
#pragma unroll
                for (int bj = 0; bj < 2; ++bj) *(u32x4*)(AM + (size_t)row * 1024 + bj * HALF + cw) = pack8(acc[ai][bj][m][0], acc[ai][bj][m][1]);
            }
    }
};

template <class Epi, class Sched, bool ALIGN_EPI = false, bool SP2 = false>
__device__ __forceinline__ void gemm_phase(PG8_LAS unsigned char* lds, const Gemm g, const Sched& S, const Epi& E) {
    const int tid = threadIdx.x, wid = __builtin_amdgcn_readfirstlane(tid >> 6), lane = tid & 63, wr = wid >> 2, wc = wid & 3, fr = lane & 15, fq = lane >> 4;
    const int K = g.K, nt = K / BK;
    unsigned voffA[2], voffB[2];
#pragma unroll
    for (int i = 0; i < 2; ++i) { int R, C; stage_rc(tid * 16 + i * 8192, R, C); const int Rb = Epi::PERM ? ((R & ~31) + perm32(R & 31)) : R;
        voffA[i] = (unsigned)(R * K + C) * 2u; voffB[i] = (unsigned)(Rb * K + C) * 2u; }
    const size_t kstep = (size_t)(BK * 2);
    const size_t hstep = (size_t)HALF * K * 2;
    const size_t tstep = 2 * hstep;
    const unsigned ldsw = (unsigned)wid * 1024u;
    const int aoff = lds_byte(wr * 64 + fr, fq * 8), boff = lds_byte(wc * 32 + fr, fq * 8);
#define PG8_SA(b, h) (((b) * 2 + (h)) * HTB)
#define PG8_SB(b, h) ((4 + (b) * 2 + (h)) * HTB)
#define PG8_STAGE(bufoff, gbase, voff) do { _Pragma("unroll") for (int _i = 0; _i < 2; ++_i) \
        __builtin_amdgcn_global_load_lds((const unsigned*)((const char*)(gbase) + (voff)[_i]), (PG8_LAS unsigned*)(lds + (bufoff) + ldsw + _i * 8192), 16, 0, 0); } while (0)
#define PG8_LDA(dst, b, h) do { _Pragma("unroll") for (int m = 0; m < 4; ++m) _Pragma("unroll") for (int k = 0; k < 2; ++k) dst[m][k] = *(const PG8_LAS bf16x8*)(lds + PG8_SA(b, h) + aoff + m * 2048 + k * 1024); } while (0)
#define PG8_LDB(dst, b, h) do { _Pragma("unroll") for (int n = 0; n < 2; ++n) _Pragma("unroll") for (int k = 0; k < 2; ++k) dst[n][k] = *(const PG8_LAS bf16x8*)(lds + PG8_SB(b, h) + boff + n * 2048 + k * 1024); } while (0)
#define PG8_MMA(ai, bj, At, Bt) do { __builtin_amdgcn_s_setprio(1); _Pragma("unroll") for (int m = 0; m < 4; ++m) _Pragma("unroll") for (int n = 0; n < 2; ++n) _Pragma("unroll") for (int k = 0; k < 2; ++k) \
        acc[ai][bj][m][n] = __builtin_amdgcn_mfma_f32_16x16x32_bf16(Bt[n][k], At[m][k], acc[ai][bj][m][n], 0, 0, 0); __builtin_amdgcn_s_setprio(0); } while (0)
#define PG8_WAIT_V(n) asm volatile("s_waitcnt vmcnt(" #n ")" ::: "memory")
#define PG8_WAIT_L(n) asm volatile("s_waitcnt lgkmcnt(" #n ")" ::: "memory")
#define PG8_BAR __builtin_amdgcn_s_barrier()
#define PG8_SCHED __builtin_amdgcn_sched_barrier(0)
    Unit cur, nxt; int ui = 0;
    if (!S.next(0, cur)) return;
    f32x4 acc[2][2][4][2];
#pragma unroll
    for (int a = 0; a < 2; ++a)
#pragma unroll
        for (int b = 0; b < 2; ++b)
#pragma unroll
            for (int m = 0; m < 4; ++m)
#pragma unroll
                for (int n = 0; n < 2; ++n) acc[a][b][m][n] = (f32x4){0.f, 0.f, 0.f, 0.f};
    bf16x8 At[4][2], B0[2][2], B1[2][2];
    const char* cA = (const char*)g.A + (size_t)cur.pm * tstep; const char* cB = (const char*)g.Bt + (size_t)cur.pn * tstep;
    S.a_ready(cur);
    if constexpr (SP2) {
        PG8_STAGE(PG8_SB(0, 0), cB, voffB); PG8_STAGE(PG8_SB(0, 1), cB + hstep, voffB); PG8_STAGE(PG8_SA(0, 0), cA, voffA); PG8_STAGE(PG8_SA(0, 1), cA + hstep, voffA);
        if (wr == 1) PG8_BAR;
        PG8_WAIT_V(2); PG8_BAR;
        PG8_STAGE(PG8_SB(1, 0), cB + kstep, voffB); PG8_STAGE(PG8_SA(1, 0), cA + kstep, voffA); PG8_STAGE(PG8_SB(1, 1), cB + hstep + kstep, voffB);
        PG8_WAIT_V(6); PG8_BAR;
    } else {
        PG8_STAGE(PG8_SB(0, 0), cB, voffB); PG8_STAGE(PG8_SA(0, 0), cA, voffA); PG8_STAGE(PG8_SB(0, 1), cB + hstep, voffB); PG8_STAGE(PG8_SA(0, 1), cA + hstep, voffA);
        if (wr == 1) PG8_BAR;
        PG8_WAIT_V(4); PG8_BAR;
        PG8_STAGE(PG8_SB(1, 0), cB + kstep, voffB); PG8_STAGE(PG8_SA(1, 0), cA + kstep, voffA); PG8_STAGE(PG8_SB(1, 1), cB + hstep + kstep, voffB);
        PG8_WAIT_V(6); PG8_BAR;
    }
    for (;;) {
        const bool has_next = S.next(ui + 1, nxt);
        const char* nA = has_next ? (const char*)g.A + (size_t)nxt.pm * tstep : cA; const char* nB = has_next ? (const char*)g.Bt + (size_t)nxt.pn * tstep : cB;
        for (int t = 0; t < nt; t += 2) {
            const bool last = (t == nt - 2);
            const char* a1 = cA + (size_t)(t + 1) * kstep;
            const char* a2 = last ? nA : cA + (size_t)(t + 2) * kstep; const char* b2 = last ? nB : cB + (size_t)(t + 2) * kstep;
            const char* a3 = a2 + kstep; const char* b3 = b2 + kstep;
            if (last && has_next) S.a_ready(nxt);
            if constexpr (SP2) {
            PG8_LDB(B0, 0, 0); PG8_LDB(B1, 0, 1); PG8_SCHED; PG8_LDA(At, 0, 0); PG8_STAGE(PG8_SA(1, 1), a1 + hstep, voffA);
            PG8_WAIT_V(8); PG8_WAIT_L(0); PG8_BAR; PG8_MMA(0, 0, At, B0); PG8_MMA(0, 1, At, B1); PG8_BAR; PG8_SCHED;
            PG8_LDA(At, 0, 1); PG8_STAGE(PG8_SB(0, 0), b2, voffB); PG8_STAGE(PG8_SB(0, 1), b2 + hstep, voffB); PG8_STAGE(PG8_SA(0, 0), a2, voffA);
            PG8_WAIT_V(8); PG8_WAIT_L(0); PG8_BAR; PG8_MMA(1, 0, At, B0); PG8_MMA(1, 1, At, B1); PG8_BAR; PG8_SCHED;
            PG8_LDB(B0, 1, 0); PG8_LDB(B1, 1, 1); PG8_SCHED; PG8_LDA(At, 1, 0); PG8_STAGE(PG8_SA(0, 1), a2 + hstep, voffA);
            PG8_WAIT_V(8); PG8_WAIT_L(0); PG8_BAR; PG8_MMA(0, 0, At, B0); PG8_MMA(0, 1, At, B1); PG8_BAR; PG8_SCHED;
            PG8_LDA(At, 1, 1); PG8_STAGE(PG8_SB(1, 0), b3, voffB); PG8_STAGE(PG8_SB(1, 1), b3 + hstep, voffB); PG8_STAGE(PG8_SA(1, 0), a3, voffA);
            PG8_WAIT_V(8); PG8_WAIT_L(0); PG8_BAR; PG8_MMA(1, 0, At, B0); PG8_MMA(1, 1, At, B1); PG8_BAR; PG8_SCHED;
            } else {
            PG8_LDB(B0, 0, 0); PG8_SCHED; PG8_LDA(At, 0, 0); PG8_STAGE(PG8_SA(1, 1), a1 + hstep, voffA);
            PG8_WAIT_L(8); PG8_BAR; PG8_WAIT_L(0); PG8_MMA(0, 0, At, B0); PG8_BAR; PG8_SCHED;
            PG8_LDB(B1, 0, 1); PG8_STAGE(PG8_SB(0, 0), b2, voffB);
            PG8_BAR; PG8_WAIT_L(0); PG8_MMA(0, 1, At, B1); PG8_BAR;
            PG8_LDA(At, 0, 1); PG8_STAGE(PG8_SA(0, 0), a2, voffA);
            PG8_BAR; PG8_WAIT_L(0); PG8_MMA(1, 0, At, B0); PG8_BAR; PG8_SCHED;
            PG8_STAGE(PG8_SB(0, 1), b2 + hstep, voffB);
            PG8_WAIT_V(6); PG8_BAR; PG8_MMA(1, 1, At, B1); PG8_BAR;
            PG8_LDB(B0, 1, 0); PG8_SCHED; PG8_LDA(At, 1, 0); PG8_STAGE(PG8_SA(0, 1), a2 + hstep, voffA);
            PG8_WAIT_L(8); PG8_BAR; PG8_WAIT_L(0); PG8_MMA(0, 0, At, B0); PG8_BAR; PG8_SCHED;
            PG8_LDB(B1, 1, 1); PG8_STAGE(PG8_SB(1, 0), b3, voffB);
            PG8_BAR; PG8_WAIT_L(0); PG8_MMA(0, 1, At, B1); PG8_BAR;
            PG8_LDA(At, 1, 1); PG8_STAGE(PG8_SA(1, 0), a3, voffA);
            PG8_BAR; PG8_WAIT_L(0); PG8_MMA(1, 0, At, B0); PG8_BAR; PG8_SCHED;
            PG8_STAGE(PG8_SB(1, 1), b3 + hstep, voffB);
            PG8_WAIT_V(6); PG8_BAR; PG8_MMA(1, 1, At, B1); PG8_BAR;
            }
        }
        if constexpr (ALIGN_EPI) { if (wr == 0) PG8_BAR; }
        if constexpr (!Epi::AFTER_DRAIN) { E(acc, cur, wr, wc, fr, fq); S.done(cur); }
        if (!has_next) break;
#pragma unroll
        for (int a = 0; a < 2; ++a)
#pragma unroll
            for (int b = 0; b < 2; ++b)
#pragma unroll
                for (int m = 0; m < 4; ++m)
#pragma unroll
                    for (int n = 0; n < 2; ++n) acc[a][b][m][n] = (f32x4){0.f, 0.f, 0.f, 0.f};
        cur = nxt; cA = nA; cB = nB; ++ui;
        if constexpr (ALIGN_EPI) { if (wr == 1) PG8_BAR; }
    }
    PG8_WAIT_V(0);
    if constexpr (!ALIGN_EPI) { if (wr == 0) PG8_BAR; }
    PG8_BAR;
    if constexpr (Epi::AFTER_DRAIN) { E.fused(acc, cur, wr, wc, fr, fq, lds, wid, lane); S.done(cur); }
#undef PG8_SA
#undef PG8_SB
#undef PG8_STAGE
#undef PG8_LDA
#undef PG8_LDB
#undef PG8_MMA
#undef PG8_WAIT_V
#undef PG8_WAIT_L
#undef PG8_BAR
#undef PG8_SCHED
}
}
#define GAS __attribute__((address_space(1)))
#define LAS __attribute__((address_space(3)))
typedef unsigned short bf16;
typedef unsigned v4u __attribute__((ext_vector_type(4)));
typedef float f32x4 __attribute__((ext_vector_type(4)));
typedef short bf16x8 __attribute__((ext_vector_type(8)));
typedef GAS unsigned gu32;
typedef GAS unsigned long long gu64;
#define RLX_AGENT __ATOMIC_RELAXED, __HIP_MEMORY_SCOPE_AGENT
#define LDS_WAIT() asm volatile("s_waitcnt lgkmcnt(0)" ::: "memory")
#define VM_WAIT() asm volatile("s_waitcnt vmcnt(0)" ::: "memory")
__device__ __forceinline__ unsigned long long rt() { return __builtin_amdgcn_s_memrealtime(); }
__device__ __forceinline__ unsigned f2bf(float f) { unsigned u = __builtin_bit_cast(unsigned, f); return (u + 0x7fffu + ((u >> 16) & 1u)) >> 16; }
__device__ __forceinline__ unsigned pk2(float lo, float hi) { return f2bf(lo) | (f2bf(hi) << 16); }

#define XB_TMO      128
#define XB_XCNT(j)  (256  + 64 * (j))
#define XB_XSUB(j)  (1280 + 64 * (j))
#define XB_XGEN(j)  (2304 + 64 * (j))
#define XB_TOP      3328
#define XB_TOPGEN   3392
#define XCD_BAR_WORDS 3456
#define XB_SPIN_CAP (1u << 18)

__device__ __forceinline__ unsigned xb_ld(unsigned* p)              { return __hip_atomic_load(p, __ATOMIC_RELAXED, __HIP_MEMORY_SCOPE_AGENT); }
__device__ __forceinline__ unsigned xb_add(unsigned* p, unsigned v) { return __hip_atomic_fetch_add(p, v, __ATOMIC_RELAXED, __HIP_MEMORY_SCOPE_AGENT); }
__device__ __forceinline__ unsigned xb_xcc_id() { return (unsigned)__builtin_amdgcn_s_getreg((3 << 11) | 20) & 0xFu; }
#define XB_SPIN(cond, bar) do { unsigned _sp = 0; while (cond) { __builtin_amdgcn_s_sleep(1); \
    if ((++_sp & 255u) == 0u) { if (xb_ld(&(bar)[XB_TMO])) break; if (_sp > XB_SPIN_CAP) { atomicAdd(&(bar)[XB_TMO], 1u); break; } } } } while (0)

struct XcdBarrier {
    unsigned* bar; unsigned x;
    volatile LAS unsigned* st;
};

__device__ __forceinline__ XcdBarrier xcd_barrier_post(unsigned* bar, volatile LAS unsigned* st) {
    XcdBarrier b; b.bar = bar; b.x = xb_xcc_id(); b.st = st;
    if (threadIdx.x == 0) (void)xb_add(&bar[XB_XCNT(b.x)], 1u);
    return b;
}
__device__ __forceinline__ void xcd_barrier_complete(unsigned* bar, unsigned x, unsigned& nloc, unsigned& nx) {
    const unsigned G = gridDim.x * gridDim.y * gridDim.z;
    unsigned sum, cnt, mine, sp = 0u;
    for (;;) {
        sum = 0u; cnt = 0u; mine = 0u;
#pragma unroll
        for (unsigned j = 0; j < 16; ++j) { const unsigned c = xb_ld(&bar[XB_XCNT(j)]); sum += c; cnt += (c > 0u) ? 1u : 0u; mine = (j == x) ? c : mine; }
        if (sum == G) break;
        __builtin_amdgcn_s_sleep(1);
        if ((++sp & 255u) == 0u) { if (xb_ld(&bar[XB_TMO])) break; if (sp > XB_SPIN_CAP) { atomicAdd(&bar[XB_TMO], 1u); break; } }
    }
    nloc = mine > 0u ? mine : 1u; nx = cnt > 0u ? cnt : 1u;
}

__device__ __forceinline__ void xcd_barrier(const XcdBarrier& b) {
    asm volatile("s_waitcnt vmcnt(0)" ::: "memory");
    __syncthreads();
    if (threadIdx.x == 0) {
        unsigned* bar = b.bar;
        __builtin_amdgcn_s_waitcnt(0);
        unsigned nloc = b.st[0], nx = b.st[1];
        if (nloc == 0u) { xcd_barrier_complete(bar, b.x, nloc, nx); b.st[0] = nloc; b.st[1] = nx; }
        const unsigned old = xb_add(&bar[XB_XSUB(b.x)], 1u);
        const unsigned gen = old / nloc;
        if (old + 1u == (gen + 1u) * nloc) {
            __builtin_amdgcn_fence(__ATOMIC_RELEASE, "agent");
            asm volatile("s_waitcnt vmcnt(0)" ::: "memory");
            const unsigned og = xb_add(&bar[XB_TOP], 1u);
            const unsigned tg = og / nx;
            if (og + 1u == (tg + 1u) * nx) xb_add(&bar[XB_TOPGEN], 1u);
            else XB_SPIN(xb_ld(&bar[XB_TOPGEN]) == tg, bar);
            __builtin_amdgcn_fence(__ATOMIC_ACQUIRE, "agent");
            xb_add(&bar[XB_XGEN(b.x)], 1u);
            asm volatile("s_waitcnt vmcnt(0)" ::: "memory");
        } else {
            XB_SPIN(xb_ld(&bar[XB_XGEN(b.x)]) == gen, bar);
            __builtin_amdgcn_fence(__ATOMIC_ACQUIRE, "agent");
            asm volatile("s_waitcnt vmcnt(0)" ::: "memory");
        }
    }
    __syncthreads();
}

constexpr int NWAVES = 8;
#ifndef MK_PER_PHASE
#define MK_PER_PHASE 0
#endif
constexpr int N_PHASES = 13;

constexpr int NB = 8, S = 4096, D = 1024, FF = 2816, M = NB * S;
typedef float f32x2g __attribute__((ext_vector_type(2)));
typedef unsigned u32x2g __attribute__((ext_vector_type(2)));

constexpr size_t MiB = 1u << 20;
constexpr size_t WS_CTL = 0, CTL_ZERO_BYTES = 1 * MiB;
constexpr size_t WS_SSQ = 46 * MiB + 512 * 1024;
constexpr size_t WS_WIN0 = 2 * MiB;
constexpr size_t WS_WOUT0 = 5 * MiB;
constexpr size_t WS_WGU0 = 7 * MiB;
constexpr size_t WS_WDN0 = 18 * MiB;
constexpr size_t WS_WPQ1 = 24 * MiB;
constexpr size_t WS_WUV1 = 26 * MiB;
constexpr size_t WS_WOUT1 = 28 * MiB;
constexpr size_t WS_WGU1 = 30 * MiB;
constexpr size_t WS_WDN1 = 41 * MiB;
constexpr size_t WS_DFT = 48 * MiB;
constexpr size_t WS_XB = 112 * MiB;
constexpr size_t WS_AM = 176 * MiB;
constexpr size_t WS_H = 240 * MiB;
constexpr size_t WS_UB = WS_H, WS_PB = WS_H + 32 * MiB;
constexpr size_t WS_PQT = WS_H, WS_U1 = WS_H + 64 * MiB, WS_V1 = WS_H + 96 * MiB, WS_PQF = WS_H + 128 * MiB;
constexpr size_t WS_END = 416 * MiB;
static_assert(WS_H + (size_t)M * FF * 2 <= WS_END && WS_V1 + (size_t)M * 512 * 2 <= WS_END, "d_ws map");
constexpr int CW_BAR = 4096;

constexpr int RING_OFF = 0, RING_BYTES = 131072;
constexpr int LDSCTL_OFF = RING_BYTES, MISC_OFF = LDSCTL_OFF + 320;
constexpr int LDS_BYTES = 147456;

struct Frame {
    LAS unsigned char* lds;
    volatile LAS unsigned* MISC;
    gu32* ctl;
    int tid, lane, wave;
    int vcu, G;
};
__device__ __forceinline__ float wave_sum(float v) {
#pragma unroll
    for (int o = 1; o < 64; o <<= 1) v += __shfl_xor(v, o);
    return v;
}
__device__ __forceinline__ float bf_lo(unsigned x) { return __builtin_bit_cast(float, x << 16); }
__device__ __forceinline__ float bf_hi(unsigned x) { return __builtin_bit_cast(float, x & 0xffff0000u); }
#define WG_BAR() do { asm volatile("s_waitcnt vmcnt(0) lgkmcnt(0)" ::: "memory"); __builtin_amdgcn_s_barrier(); asm volatile("" ::: "memory"); } while (0)

__device__ __forceinline__ void p0_transpose_item(const float* W, int ldw, const float* gk, bf16* WT, int ldt, int k0, int n0, int dk0, int drow0, LAS float* scr, int lane) {
    float v[32];
    const float* wp = W + (size_t)(k0 + (lane >> 5)) * ldw + n0 + (lane & 31);
#pragma unroll
    for (int i = 0; i < 32; ++i) v[i] = wp[(size_t)(2 * i) * ldw];
    const int c = lane & 7;
    f32x4 g0 = {1.f, 1.f, 1.f, 1.f}, g1 = {1.f, 1.f, 1.f, 1.f};
    if (gk) { g0 = *(const GAS f32x4*)(gk + k0 + 8 * c); g1 = *(const GAS f32x4*)(gk + k0 + 8 * c + 4); }
#pragma unroll
    for (int i = 0; i < 32; ++i) scr[(2 * i + (lane >> 5)) * 33 + (lane & 31)] = v[i];
    LDS_WAIT(); asm volatile("" ::: "memory");
#pragma unroll
    for (int j = 0; j < 4; ++j) { const int n = (lane >> 3) + 8 * j; const LAS float* s = scr + (8 * c) * 33 + n;
        v4u o; o.x = pk2(s[0 * 33] * g0.x, s[1 * 33] * g0.y); o.y = pk2(s[2 * 33] * g0.z, s[3 * 33] * g0.w); o.z = pk2(s[4 * 33] * g1.x, s[5 * 33] * g1.y); o.w = pk2(s[6 * 33] * g1.z, s[7 * 33] * g1.w);
        *(GAS v4u*)(WT + (size_t)(drow0 + n) * ldt + dk0 + 8 * c) = o; }
    LDS_WAIT(); asm volatile("" ::: "memory");
}
__device__ __forceinline__ void p0_job(const float* W, int ldw, const float* gk, int kbeg, int kext, int ncol0, int next, bf16* WT, int ldt, int dkbase, int mode, int half_or_off,
                                       LAS float* scr, int lane, int gw, int NGW, int& cursor) {
    const int nkb = kext / 64, nnb = next / 32, nitems = nkb * nnb;
    int first = (gw - (cursor % NGW) + NGW) % NGW;
    for (int it = first; it < nitems; it += NGW) {
        const int kb = it / nnb, nb = it % nnb, nrel = 32 * nb;
        const int drow0 = (mode == 0) ? (half_or_off + nrel) : (256 * (nrel >> 7) + 128 * half_or_off + (nrel & 127));
        p0_transpose_item(W, ldw, gk, WT, ldt, kbeg + 64 * kb, ncol0 + nrel, dkbase + 64 * kb, drow0, scr, lane);
    }
    cursor += nitems;
}
__device__ __forceinline__ void p0_fold_item(const float* L, int lrow0, const float* sc, const float* Rm, bf16* out, int dk0, float scale, int dw, int lane) {
    const int d = 64 * dw + lane;
    float l0[8], l1[8];
    { const float s0 = sc ? sc[lane] : 1.f, s1 = sc ? sc[64 + lane] : 1.f;
#pragma unroll
      for (int j = 0; j < 8; ++j) { l0[j] = L[(size_t)(lrow0 + j) * 128 + lane] * s0; l1[j] = L[(size_t)(lrow0 + j) * 128 + 64 + lane] * s1; } }
    float acc[8];
#pragma unroll
    for (int j = 0; j < 8; ++j) acc[j] = 0.f;
#pragma unroll
    for (int cb = 0; cb < 4; ++cb) {
        float r[32];
#pragma unroll
        for (int i = 0; i < 32; ++i) r[i] = Rm[(size_t)(cb * 32 + i) * 1024 + d];
#pragma unroll
        for (int i = 0; i < 32; ++i) { const int cp = cb * 32 + i;
#pragma unroll
            for (int j = 0; j < 8; ++j) { const float lv = __builtin_bit_cast(float, __builtin_amdgcn_readlane(__builtin_bit_cast(int, cp < 64 ? l0[j] : l1[j]), cp & 63)); acc[j] = fmaf(lv, r[i], acc[j]); } }
    }
    v4u o; o.x = pk2(acc[0] * scale, acc[1] * scale); o.y = pk2(acc[2] * scale, acc[3] * scale); o.z = pk2(acc[4] * scale, acc[5] * scale); o.w = pk2(acc[6] * scale, acc[7] * scale);
    *(GAS v4u*)(out + (size_t)d * 1024 + dk0) = o;
}
__device__ __forceinline__ void p0_pq_item(const float* Win1, const float* g1, bf16* WPQ, int h, int half, int k0, const LAS float* tab, int lane) {
    const int cp = 64 * half + lane;
    float ap[8], aq[8], w0[8], w1[8];
#pragma unroll
    for (int j = 0; j < 8; ++j) { const float g = g1[k0 + j]; ap[j] = 0.f; aq[j] = 0.f; w0[j] = Win1[(size_t)(k0 + j) * 1536 + h * 128 + lane] * g; w1[j] = Win1[(size_t)(k0 + j) * 1536 + h * 128 + 64 + lane] * g; }
#pragma unroll 8
    for (int c = 0; c < 128; ++c) {
        const int ph = c * cp;
        const float cs = tab[ph & 127], sn = tab[(ph - 32) & 127];
#pragma unroll
        for (int j = 0; j < 8; ++j) { const float w = __builtin_bit_cast(float, __builtin_amdgcn_readlane(__builtin_bit_cast(int, c < 64 ? w0[j] : w1[j]), c & 63)); ap[j] = fmaf(w, cs, ap[j]); aq[j] = fmaf(w, sn, aq[j]); }
    }
    v4u o; o.x = pk2(ap[0], ap[1]); o.y = pk2(ap[2], ap[3]); o.z = pk2(ap[4], ap[5]); o.w = pk2(ap[6], ap[7]);
    *(GAS v4u*)(WPQ + (size_t)(h * 128 + cp) * 1024 + k0) = o;
    o.x = pk2(aq[0], aq[1]); o.y = pk2(aq[2], aq[3]); o.z = pk2(aq[4], aq[5]); o.w = pk2(aq[6], aq[7]);
    *(GAS v4u*)(WPQ + (size_t)(512 + h * 128 + cp) * 1024 + k0) = o;
}

struct Ptrs {
    const float* in[22]; float* out; unsigned char* ws;
};

__device__ __forceinline__ void p0_prologue(Frame& F, const Ptrs& P) {
    const float* x = P.in[0]; const float* mix_g = P.in[1]; const float* ffn_g = P.in[2];
    const float* ev_w_in = P.in[3]; const float* ev_pool_w = P.in[8]; const float* ev_pool_scale = P.in[9]; const float* ev_w_out = P.in[10];
    const float* od_w_in = P.in[11]; const float* od_fourier_w = P.in[12]; const float* od_w_out = P.in[17];
    const float* w_gate = P.in[18]; const float* w_up = P.in[19]; const float* w_down = P.in[20];
    unsigned char* ws = P.ws;
    LAS float* scr = (LAS float*)(F.lds + RING_OFF + F.wave * 8448);
    LAS float* CT = (LAS float*)(F.lds + RING_OFF + 69632);
    LAS float* tab = (LAS float*)(F.lds + RING_OFF + 69632 + 16384);
    for (int i = F.tid; i < 4096; i += NWAVES * 64) CT[i] = cospif((float)i * (1.0f / 2048.0f));
    if (F.tid < 128) tab[F.tid] = cospif((float)F.tid * (1.0f / 64.0f));
    WG_BAR();
    const int gw = F.vcu * NWAVES + F.wave, NGW = F.G * NWAVES, lane = F.lane;
    { unsigned long long* z = (unsigned long long*)(ws + WS_SSQ) + M; const int gt = F.vcu * NWAVES * 64 + F.tid, NT = F.G * NWAVES * 64;
      for (int i = gt; i < 4 * M; i += NT) z[i] = 0ull; }
    int cur = 0;
    p0_job(ev_w_in, 1536, mix_g, 0, 1024, 0, 512, (bf16*)(ws + WS_WIN0), 1024, 0, 1, 0, scr, lane, gw, NGW, cur);
    p0_job(ev_w_in, 1536, mix_g, 0, 1024, 512, 512, (bf16*)(ws + WS_WIN0), 1024, 0, 1, 1, scr, lane, gw, NGW, cur);
    p0_job(ev_w_in, 1536, mix_g, 0, 1024, 1024, 512, (bf16*)(ws + WS_WIN0), 1024, 0, 0, 1024, scr, lane, gw, NGW, cur);
    p0_job(ev_w_out, 1024, nullptr, 0, 512, 0, 1024, (bf16*)(ws + WS_WOUT0), 1024, 0, 0, 0, scr, lane, gw, NGW, cur);
    p0_job(w_gate, FF, ffn_g, 0, 1024, 0, FF, (bf16*)(ws + WS_WGU0), 1024, 0, 1, 0, scr, lane, gw, NGW, cur);
    p0_job(w_up, FF, ffn_g, 0, 1024, 0, FF, (bf16*)(ws + WS_WGU0), 1024, 0, 1, 1, scr, lane, gw, NGW, cur);
    p0_job(w_down, 1024, nullptr, 0, FF, 0, 1024, (bf16*)(ws + WS_WDN0), FF, 0, 0, 0, scr, lane, gw, NGW, cur);
    p0_job(od_w_in, 1536, mix_g + D, 0, 1024, 512, 1024, (bf16*)(ws + WS_WUV1), 1024, 0, 0, 0, scr, lane, gw, NGW, cur);
    p0_job(od_w_out, 1024, nullptr, 512, 512, 0, 1024, (bf16*)(ws + WS_WOUT1), 1024, 512, 0, 0, scr, lane, gw, NGW, cur);
    p0_job(w_gate + (size_t)D * FF, FF, ffn_g + D, 0, 1024, 0, FF, (bf16*)(ws + WS_WGU1), 1024, 0, 1, 0, scr, lane, gw, NGW, cur);
    p0_job(w_up + (size_t)D * FF, FF, ffn_g + D, 0, 1024, 0, FF, (bf16*)(ws + WS_WGU1), 1024, 0, 1, 1, scr, lane, gw, NGW, cur);
    p0_job(w_down + (size_t)FF * D, 1024, nullptr, 0, FF, 0, 1024, (bf16*)(ws + WS_WDN1), FF, 0, 0, 0, scr, lane, gw, NGW, cur);
    {
        int first = (gw - (cur % NGW) + NGW) % NGW;
        for (int it = first; it < 1024; it += NGW) { const int g = it >> 8, cc = (it >> 4) & 15, dw = it & 15;
            p0_fold_item(ev_pool_w, g * 128 + cc * 8, ev_pool_scale + g * 128, ev_w_out + (size_t)(512 + g * 128) * 1024, (bf16*)(ws + WS_WOUT0), 512 + g * 128 + cc * 8, 1.0f, dw, lane); }
        cur += 1024;
        first = (gw - (cur % NGW) + NGW) % NGW;
        for (int it = first; it < 1024; it += NGW) { const int h = it >> 8, cc = (it >> 4) & 15, dw = it & 15;
            p0_fold_item(od_fourier_w, h * 128 + cc * 8, nullptr, od_w_out + (size_t)(h * 128) * 1024, (bf16*)(ws + WS_WOUT1), h * 128 + cc * 8, 1.0f / 724.0773439350247f, dw, lane); }
        cur += 1024;
        first = (gw - (cur % NGW) + NGW) % NGW;
        for (int it = first; it < 1024; it += NGW) { const int h = it >> 8, half = (it >> 7) & 1, kc = it & 127;
            p0_pq_item(od_w_in, mix_g + D, (bf16*)(ws + WS_WPQ1), h, half, kc * 8, tab, lane); }
        cur += 1024;
    }
    {
        bf16* Dm = (bf16*)(ws + WS_DFT);
        int first = (gw - (cur % NGW) + NGW) % NGW;
        for (int t = first; t < S; t += NGW) {
#pragma unroll 2
            for (int q = 0; q < 8; ++q) {
                const int k0 = (q * 64 + lane) * 8, s0 = k0 & (S / 2 - 1), sinpart = k0 >> 11;
                float v[8];
#pragma unroll
                for (int e = 0; e < 8; ++e) { int idx = (s0 + e) * t + (sinpart ? 1024 : 0); if (sinpart && s0 + e == 0) idx = 2048 * t; v[e] = CT[idx & (S - 1)]; }
                v4u o; o.x = pk2(v[0], v[1]); o.y = pk2(v[2], v[3]); o.z = pk2(v[4], v[5]); o.w = pk2(v[6], v[7]);
                *(GAS v4u*)(Dm + (size_t)t * S + k0) = o;
            }
        }
        cur += S;
    }
    {
        bf16* XB = (bf16*)(ws + WS_XB); unsigned long long* ssq0 = (unsigned long long*)(ws + WS_SSQ);
        for (int m0 = 4 * gw; m0 < M; m0 += 4 * NGW) {
            f32x4 v[4][4];
#pragma unroll
            for (int r = 0; r < 4; ++r) { const GAS f32x4* xr = (const GAS f32x4*)(x + (size_t)(m0 + r) * D) + lane;
#pragma unroll
                for (int j = 0; j < 4; ++j) v[r][j] = xr[64 * j]; }
#pragma unroll
            for (int r = 0; r < 4; ++r) { float s = 0.f;
#pragma unroll
                for (int j = 0; j < 4; ++j) s += (v[r][j].x * v[r][j].x + v[r][j].y * v[r][j].y) + (v[r][j].z * v[r][j].z + v[r][j].w * v[r][j].w);
                s = wave_sum(s);
                if (lane == 0) ssq0[m0 + r] = pg8::ssq_fix(s);
                GAS unsigned long long* o8 = (GAS unsigned long long*)(XB + (size_t)(m0 + r) * D) + lane;
#pragma unroll
                for (int j = 0; j < 4; ++j) o8[64 * j] = (unsigned long long)pk2(v[r][j].x, v[r][j].y) | ((unsigned long long)pk2(v[r][j].z, v[r][j].w) << 32); }
        }
    }
}

__device__ __forceinline__ float reduce_scatter16(float (&v)[16], int lane) {
#pragma unroll
    for (int o = 8; o >= 1; o >>= 1) {
        const bool up = (lane & o) != 0;
#pragma unroll
        for (int i = 0; i < o; ++i) { const float send = up ? v[i] : v[i + o]; const float keep = up ? v[i + o] : v[i]; v[i] = keep + __shfl_xor(send, o); }
    }
    float t = v[0] + __shfl_xor(v[0], 16);
    return t + __shfl_xor(t, 32);
}
__device__ __forceinline__ void mix0_conv_item(Frame& F, const Ptrs& P, int item) {
    const bf16* UB = (const bf16*)(P.ws + WS_UB); bf16* AM = (bf16*)(P.ws + WS_AM);
    const float* cw = P.in[4]; const float* cb = P.in[5]; const float* lg = P.in[6]; const float* lb = P.in[7];
    const int b = item >> 6, t0 = (item & 63) * 64, rowbase = b * S;
    LAS unsigned* tile = (LAS unsigned*)(F.lds + RING_OFF);
    LAS float* red = (LAS float*)(F.lds + RING_OFF + 98304);
    LAS float* stats = (LAS float*)(F.lds + RING_OFF + 98304 + 1024);
    { v4u tv[12];
#pragma unroll
      for (int i = 0; i < 12; ++i) { const int t = t0 - 15 + F.wave + NWAVES * i, tc = t < 0 ? 0 : (t > S - 1 ? S - 1 : t);
          tv[i] = *(const GAS v4u*)(UB + (size_t)(rowbase + tc) * 512 + F.lane * 8); }
#pragma unroll
      for (int i = 0; i < 12; ++i) { const int r = F.wave + NWAVES * i, t = t0 - 15 + r; const bool ok = (t >= 0 && t < S);
          v4u w = tv[i]; w.x = ok ? w.x : 0u; w.y = ok ? w.y : 0u; w.z = ok ? w.z : 0u; w.w = ok ? w.w : 0u;
          *(LAS v4u*)(tile + r * 256 + F.lane * 4) = w; } }
    WG_BAR();
    int tidl = F.tid; asm volatile("" : "+v"(tidl));
    const int rg = tidl >> 8, cp = tidl & 255, lanel = tidl & 63;
    const f32x2g bb = *(const GAS f32x2g*)(cb + 2 * cp);
    const f32x2g g2 = *(const GAS f32x2g*)(lg + 2 * cp), b2 = *(const GAS f32x2g*)(lb + 2 * cp);
    float w0[31], w1[31];
#pragma unroll
    for (int j = 0; j < 31; ++j) { const f32x2g w = *(const GAS f32x2g*)(cw + j * 512 + 2 * cp); w0[j] = w.x; w1[j] = w.y; }
#pragma unroll 1
    for (int p = 0; p < 4; ++p) {
        float a0[8], a1[8];
#pragma unroll
        for (int o = 0; o < 8; ++o) { a0[o] = bb.x; a1[o] = bb.y; }
        const LAS unsigned* tp = tile + (32 * rg + 8 * p) * 256 + cp;
#pragma unroll
        for (int ii = 0; ii < 38; ++ii) {
            const unsigned xx = tp[ii * 256];
            const float x0 = bf_lo(xx), x1 = bf_hi(xx);
#pragma unroll
            for (int o = 0; o < 8; ++o) { const int j = ii - o; if (j >= 0 && j <= 30) { a0[o] = fmaf(w0[j], x0, a0[o]); a1[o] = fmaf(w1[j], x1, a1[o]); } }
        }
        float v[16];
#pragma unroll
        for (int o = 0; o < 8; ++o) { v[2 * o] = a0[o] + a1[o]; v[2 * o + 1] = a0[o] * a0[o] + a1[o] * a1[o]; }
        const float tot = reduce_scatter16(v, lanel);
        if (lanel < 16) red[F.wave * 16 + lanel] = tot;
        WG_BAR();
        if (cp < 8) { const int wb = rg * 4; float s = 0.f, q = 0.f;
#pragma unroll
            for (int w = 0; w < 4; ++w) { s += red[(wb + w) * 16 + 2 * cp]; q += red[(wb + w) * 16 + 2 * cp + 1]; }
            const float mean = s * (1.0f / 512.0f), var = q * (1.0f / 512.0f) - mean * mean;
            stats[(rg * 8 + cp) * 2] = mean; stats[(rg * 8 + cp) * 2 + 1] = rsqrtf(var + 1e-6f); }
        WG_BAR();
#pragma unroll
        for (int o = 0; o < 8; ++o) {
            const float mean = stats[(rg * 8 + o) * 2], rstd = stats[(rg * 8 + o) * 2 + 1];
            float y0 = (a0[o] - mean) * rstd * g2.x + b2.x, y1 = (a1[o] - mean) * rstd * g2.y + b2.y;
            y0 = y0 * __builtin_amdgcn_rcpf(1.0f + __expf(-y0)); y1 = y1 * __builtin_amdgcn_rcpf(1.0f + __expf(-y1));
            *(GAS unsigned*)(AM + (size_t)(rowbase + t0 + 32 * rg + 8 * p + o) * 1024 + 2 * cp) = pk2(y0, y1);
        }
    }
    WG_BAR();
}
template <int H> __device__ __forceinline__ void pool_rows(const LAS unsigned* tp  , bf16* orow  , int tfirst) {
    unsigned x[32 + 2 * H];
#pragma unroll
    for (int i = 0; i < 32 + 2 * H; ++i) x[i] = tp[i * 256];
    float s0 = 0.f, s1 = 0.f;
#pragma unroll
    for (int i = 0; i < 2 * H; ++i) { s0 += bf_lo(x[i]); s1 += bf_hi(x[i]); }
#pragma unroll
    for (int o = 0; o < 32; ++o) {
        const int t = tfirst + o;
        const int lo = (t - H) < 0 ? 0 : (t - H), hi = (t + H - 1) > (S - 1) ? (S - 1) : (t + H - 1);
        const float inv = 1.0f / (float)(hi - lo + 1);
        *(GAS unsigned*)(orow + (size_t)o * 1024) = pk2(s0 * inv - bf_lo(x[o + H]), s1 * inv - bf_hi(x[o + H]));
        if (o < 31) { s0 += bf_lo(x[o + 2 * H]) - bf_lo(x[o]); s1 += bf_hi(x[o + 2 * H]) - bf_hi(x[o]); }
    }
}
__device__ __forceinline__ void mix0_pool_item(Frame& F, const Ptrs& P, int item) {
    const bf16* PB = (const bf16*)(P.ws + WS_PB); bf16* AM = (bf16*)(P.ws + WS_AM);
    const int b = item >> 6, t0 = (item & 63) * 64, rowbase = b * S;
    LAS unsigned* tile = (LAS unsigned*)(F.lds + RING_OFF);
    { v4u tv[10];
#pragma unroll
      for (int i = 0; i < 10; ++i) { const int t = t0 - 8 + F.wave + NWAVES * i, tc = t < 0 ? 0 : (t > S - 1 ? S - 1 : t);
          tv[i] = *(const GAS v4u*)(PB + (size_t)(rowbase + tc) * 512 + F.lane * 8); }
#pragma unroll
      for (int i = 0; i < 10; ++i) { const int r = F.wave + NWAVES * i, t = t0 - 8 + r; const bool ok = (t >= 0 && t < S);
          v4u w = tv[i]; w.x = ok ? w.x : 0u; w.y = ok ? w.y : 0u; w.z = ok ? w.z : 0u; w.w = ok ? w.w : 0u;
          *(LAS v4u*)(tile + r * 256 + F.lane * 4) = w; } }
    WG_BAR();
    const int rg = F.tid >> 8, cp = F.tid & 255, g = __builtin_amdgcn_readfirstlane(cp >> 6);
    bf16* orow = AM + (size_t)(rowbase + t0 + 32 * rg) * 1024 + 512 + 2 * cp;
    const int tfirst = t0 + 32 * rg;
    if (g == 0) pool_rows<1>(tile + (32 * rg + 8 - 1) * 256 + cp, orow, tfirst);
    else if (g == 1) pool_rows<2>(tile + (32 * rg + 8 - 2) * 256 + cp, orow, tfirst);
    else if (g == 2) pool_rows<4>(tile + (32 * rg + 8 - 4) * 256 + cp, orow, tfirst);
    else pool_rows<8>(tile + (32 * rg + 8 - 8) * 256 + cp, orow, tfirst);
    WG_BAR();
}

__device__ __forceinline__ void sgu_item(Frame& F, const Ptrs& P, int item) {
    const bf16* U = (const bf16*)(P.ws + WS_U1); const bf16* V = (const bf16*)(P.ws + WS_V1); bf16* AM = (bf16*)(P.ws + WS_AM);
    const float* lng = P.in[13]; const float* lnb = P.in[14]; const float* sw = P.in[15]; const float* sb = P.in[16];
    const int h = item & 3, rowbase = (item >> 2) * 128;
    LAS bf16* vnT = (LAS bf16*)(F.lds + RING_OFF);
    const int lane = F.lane;
    {
        const f32x2g g2 = *(const GAS f32x2g*)(lng + h * 128 + 2 * lane), b2 = *(const GAS f32x2g*)(lnb + h * 128 + 2 * lane);
        unsigned xv[16];
#pragma unroll
        for (int i = 0; i < 16; ++i) xv[i] = *(const GAS unsigned*)(V + (size_t)(rowbase + F.wave + 8 * i) * 512 + h * 128 + 2 * lane);
#pragma unroll
        for (int i = 0; i < 16; ++i) { const int k = F.wave + 8 * i;
            const float v0 = bf_lo(xv[i]), v1 = bf_hi(xv[i]);
            const float mean = wave_sum(v0 + v1) * (1.0f / 128.0f), d0 = v0 - mean, d1 = v1 - mean;
            const float rstd = rsqrtf(wave_sum(d0 * d0 + d1 * d1) * (1.0f / 128.0f) + 1e-6f);
            vnT[(2 * lane) * 136 + k] = (bf16)f2bf(d0 * rstd * g2.x + b2.x); vnT[(2 * lane + 1) * 136 + k] = (bf16)f2bf(d1 * rstd * g2.y + b2.y); }
    }
    WG_BAR();
    {
        const int fr = lane & 15, fq = lane >> 4, q = 16 * F.wave + fr;
        pg8::f32x4 acc[8];
#pragma unroll
        for (int nt = 0; nt < 8; ++nt) acc[nt] = (pg8::f32x4){0.f, 0.f, 0.f, 0.f};
#pragma unroll
        for (int ks = 0; ks < 4; ++ks) {
            const GAS pg8::f32x4* wp = (const GAS pg8::f32x4*)(sw + (size_t)(h * 128 + q) * 128 + ks * 32 + 8 * fq);
            const pg8::f32x4 wa = wp[0], wb = wp[1];
            pg8::u32x4 wq; wq.x = pk2(wa[0], wa[1]); wq.y = pk2(wa[2], wa[3]); wq.z = pk2(wb[0], wb[1]); wq.w = pk2(wb[2], wb[3]);
            const pg8::bf16x8 wf = __builtin_bit_cast(pg8::bf16x8, wq);
#pragma unroll
            for (int nt = 0; nt < 8; ++nt) {
                const pg8::bf16x8 vf = *(const LAS pg8::bf16x8*)(vnT + (16 * nt + fr) * 136 + ks * 32 + 8 * fq);
                acc[nt] = __builtin_amdgcn_mfma_f32_16x16x32_bf16(vf, wf, acc[nt], 0, 0, 0);
            }
        }
        const float bias = sb[h * 128 + q]; const size_t t = (size_t)(rowbase + q);
#pragma unroll
        for (int nt = 0; nt < 8; ++nt) { const int c0 = h * 128 + 16 * nt + 4 * fq;
            const u32x2g uu = *(const GAS u32x2g*)(U + t * 512 + c0);
            u32x2g o; o.x = pk2(bf_lo(uu.x) * (acc[nt][0] + bias), bf_hi(uu.x) * (acc[nt][1] + bias)); o.y = pk2(bf_lo(uu.y) * (acc[nt][2] + bias), bf_hi(uu.y) * (acc[nt][3] + bias));
            *(GAS u32x2g*)(AM + t * 1024 + 512 + c0) = o; }
    }
    WG_BAR();
}

__device__ __forceinline__ void fold_rows(Frame& F, const Ptrs& P) {
    const bf16* PQT = (const bf16*)(P.ws + WS_PQT); bf16* PQF = (bf16*)(P.ws + WS_PQF);
    LAS unsigned short* buf = (LAS unsigned short*)(F.lds + RING_OFF + F.wave * 16384);
    const int gw = F.vcu * NWAVES + F.wave, NGW = F.G * NWAVES, lane = F.lane;
    for (int row = gw; row < NB * 512; row += NGW) {
        const GAS v4u* src = (const GAS v4u*)(PQT + (size_t)row * 2 * S) + lane;
        v4u t[16];
#pragma unroll
        for (int i = 0; i < 16; ++i) t[i] = src[64 * i];
#pragma unroll
        for (int i = 0; i < 16; ++i) *(LAS v4u*)(buf + (size_t)(64 * i + lane) * 8) = t[i];
        LDS_WAIT(); asm volatile("" ::: "memory");
        GAS v4u* dst = (GAS v4u*)(PQF + (size_t)row * S) + lane;
#pragma unroll
        for (int q = 0; q < 8; ++q) {
            const int k0 = (q * 64 + lane) * 8, sinpart = k0 >> 11, s0 = k0 & (S / 2 - 1);
            const LAS unsigned short* pr = buf + (sinpart ? S : 0);
            float v[8];
#pragma unroll
            for (int e = 0; e < 8; ++e) { const int sidx = s0 + e;
                const float a = __builtin_bit_cast(float, (unsigned)pr[sidx] << 16), bm = __builtin_bit_cast(float, (unsigned)pr[(S - sidx) & (S - 1)] << 16);
                v[e] = sinpart ? (a - bm) : (a + bm);
                if (sidx == 0) v[e] = sinpart ? __builtin_bit_cast(float, (unsigned)buf[S / 2] << 16) : a; }
            v4u o; o.x = pk2(v[0], v[1]); o.y = pk2(v[2], v[3]); o.z = pk2(v[4], v[5]); o.w = pk2(v[6], v[7]);
            dst[64 * q] = o;
        }
        LDS_WAIT(); asm volatile("" ::: "memory");
    }
}

struct Args { const float* in[22]; float* out; unsigned char* ws; int ph_lo, ph_hi, li, pad; };
__global__ void __launch_bounds__(NWAVES * 64, 2) mk_fwd(Args args) {
    extern __shared__ __attribute__((aligned(16))) unsigned char lds[];
    Frame F;
    F.lds = (LAS unsigned char*)lds;
    F.MISC = (volatile LAS unsigned*)(F.lds + MISC_OFF);
    F.tid = threadIdx.x; F.lane = F.tid & 63; F.wave = __builtin_amdgcn_readfirstlane(F.tid >> 6);
    F.G = gridDim.x; { const int bx = blockIdx.x; F.vcu = (F.G % 8 == 0) ? (bx % 8) * (F.G / 8) + bx / 8 : bx; }
    Ptrs P;
#pragma unroll
    for (int i = 0; i < 22; ++i) P.in[i] = args.in[i];
    P.out = args.out; P.ws = args.ws;
    unsigned char* ws = args.ws;
    F.ctl = (gu32*)(ws + WS_CTL);
    for (int u = F.tid; u < (LDS_BYTES - LDSCTL_OFF) / 4; u += NWAVES * 64) ((LAS unsigned*)(F.lds + LDSCTL_OFF))[u] = 0u;
    __syncthreads();
    XcdBarrier bar; bar.bar = (unsigned*)(F.ctl + CW_BAR); bar.x = 0; bar.st = nullptr;
    if (!MK_PER_PHASE) bar = xcd_barrier_post((unsigned*)(F.ctl + CW_BAR), F.MISC + 8);
    const int lo = args.ph_lo, hi = args.ph_hi;
#ifndef PH_MASK
#define PH_MASK 0x1FFF
#endif
#define IN(k) ((((PH_MASK) >> (k)) & 1) && lo <= (k) && (k) < hi)
#ifndef PROBE_BARX
#define PROBE_BARX 1
#endif
#define SEAM(k) do { if (IN(k) && IN((k) + 1)) { for (int bx_ = 0; bx_ < PROBE_BARX; ++bx_) xcd_barrier(bar); } } while (0)
    unsigned long long* ssq = (unsigned long long*)(ws + WS_SSQ);
    bf16* XB = (bf16*)(ws + WS_XB); bf16* AM = (bf16*)(ws + WS_AM); bf16* HB = (bf16*)(ws + WS_H);
    const int bid = (int)blockIdx.x;
    const bool dup = args.pad != 0;
    bf16* TRX = (bf16*)(ws + WS_END); unsigned long long* TRS = (unsigned long long*)(ws + WS_END + 64 * MiB);

    if (IN(0)) { p0_prologue(F, P); } SEAM(0);
    if (IN(1)) { pg8::Gemm g{XB, (const bf16*)(ws + WS_WIN0), M, 1536, D}; pg8::StaticOrder So; So.init(M, 1536, F.G, bid);
        pg8::EpiInL0 E{(bf16*)(ws + WS_UB), (bf16*)(ws + WS_PB), ssq};
        pg8::gemm_phase<pg8::EpiInL0, pg8::StaticOrder, true, true>(F.lds + RING_OFF, g, So, E); } SEAM(1);
    if (IN(2)) { for (int it = F.vcu; it < 1024; it += F.G) {
#ifndef NO_CONV
            if (it < 512) mix0_conv_item(F, P, it);
#endif
#ifndef NO_POOL
            if (it >= 512) mix0_pool_item(F, P, it - 512);
#endif
 } } SEAM(2);
    if (IN(3)) { pg8::Gemm g{AM, (const bf16*)(ws + WS_WOUT0), M, D, D}; pg8::StaticOrder So; So.init(M, D, F.G, bid);
        pg8::EpiResid E{XB, dup ? TRS : ssq + M, dup ? TRX : XB};
        pg8::gemm_phase<pg8::EpiResid, pg8::StaticOrder, true, true>(F.lds + RING_OFF, g, So, E); } SEAM(3);
    if (IN(4)) { pg8::Gemm g{XB, (const bf16*)(ws + WS_WGU0), M, 2 * FF, D}; pg8::StaticOrder So; So.init(M, 2 * FF, F.G, bid);
        pg8::EpiSwiGLU E{HB, ssq + M, args.pad};
        pg8::gemm_phase<pg8::EpiSwiGLU, pg8::StaticOrder, true, true>(F.lds + RING_OFF, g, So, E); } SEAM(4);
    if (IN(5)) { pg8::Gemm g{HB, (const bf16*)(ws + WS_WDN0), M, D, FF}; pg8::StaticOrder So; So.init(M, D, F.G, bid);
        pg8::EpiResid E{XB, dup ? TRS : ssq + 2 * M, dup ? TRX : XB};
        pg8::gemm_phase<pg8::EpiResid, pg8::StaticOrder, true, true>(F.lds + RING_OFF, g, So, E); } SEAM(5);
    if (IN(6)) {
        { pg8::Gemm g{(const bf16*)(ws + WS_WPQ1), XB, 1024, M, D}; pg8::StaticOrder So; So.init(1024, M, F.G, bid);
          pg8::EpiPQT E{(bf16*)(ws + WS_PQT), ssq + 2 * M};
          pg8::gemm_phase<pg8::EpiPQT, pg8::StaticOrder, true, true>(F.lds + RING_OFF, g, So, E); }
        { pg8::Gemm g{XB, (const bf16*)(ws + WS_WUV1), M, 1024, D}; pg8::StaticOrder So; So.init(M, 1024, F.G, bid);
          pg8::EpiGeluUV E{(bf16*)(ws + WS_U1), (bf16*)(ws + WS_V1), ssq + 2 * M};
          pg8::gemm_phase<pg8::EpiGeluUV, pg8::StaticOrder, true, true>(F.lds + RING_OFF, g, So, E); }
    } SEAM(6);
    if (IN(7)) {
        { fold_rows(F, P); }
        { for (int it = F.vcu; it < 1024; it += F.G) sgu_item(F, P, it); }
    } SEAM(7);
    if (IN(8)) { pg8::Gemm g{(const bf16*)(ws + WS_DFT), (const bf16*)(ws + WS_PQF), S, NB * 512, S}; pg8::StaticOrder So; So.init(S, NB * 512, F.G, bid);
        pg8::EpiDFT E{AM};
        pg8::gemm_phase<pg8::EpiDFT, pg8::StaticOrder, true, true>(F.lds + RING_OFF, g, So, E); } SEAM(8);
    if (IN(9)) { pg8::Gemm g{AM, (const bf16*)(ws + WS_WOUT1), M, D, D}; pg8::StaticOrder So; So.init(M, D, F.G, bid);
        pg8::EpiResid E{XB, dup ? TRS : ssq + 3 * M, dup ? TRX : XB};
        pg8::gemm_phase<pg8::EpiResid, pg8::StaticOrder, true, true>(F.lds + RING_OFF, g, So, E); } SEAM(9);
    if (IN(10)) { pg8::Gemm g{XB, (const bf16*)(ws + WS_WGU1), M, 2 * FF, D}; pg8::StaticOrder So; So.init(M, 2 * FF, F.G, bid);
        pg8::EpiSwiGLU E{HB, ssq + 3 * M, args.pad};
        pg8::gemm_phase<pg8::EpiSwiGLU, pg8::StaticOrder, true, true>(F.lds + RING_OFF, g, So, E); } SEAM(10);
    if (IN(11)) { pg8::Gemm g{HB, (const bf16*)(ws + WS_WDN1), M, D, FF}; pg8::StaticOrder So; So.init(M, D, F.G, bid);
        pg8::EpiResid E{XB, dup ? TRS : ssq + 4 * M, dup ? TRX : XB};
        pg8::gemm_phase<pg8::EpiResid, pg8::StaticOrder, true, true>(F.lds + RING_OFF, g, So, E); } SEAM(11);
    if (IN(12)) {
        const float* gf = P.in[21]; const unsigned long long* ssq4 = ssq + 4 * M;
        const int gw = F.vcu * NWAVES + F.wave, NGW = F.G * NWAVES;
        for (int m = gw; m < M; m += NGW) {
            const GAS u32x2g* xr = (const GAS u32x2g*)(XB + (size_t)m * D) + F.lane; GAS f32x4* orow = (GAS f32x4*)(P.out + (size_t)m * D) + F.lane; const GAS f32x4* gr = (const GAS f32x4*)gf + F.lane;
            const float rs = pg8::rstd_of(ssq4[m]);
#pragma unroll
            for (int j = 0; j < 4; ++j) { const u32x2g xx = xr[64 * j]; const f32x4 gg = gr[64 * j];
                f32x4 v; v.x = bf_lo(xx.x); v.y = bf_hi(xx.x); v.z = bf_lo(xx.y); v.w = bf_hi(xx.y); orow[64 * j] = v * rs * gg; }
        }
    }
#undef IN
#undef SEAM
}

extern "C" void kernel_launch(void* const* d_in, const int* in_sizes, int n_in, void* d_out, int out_size, void* d_ws, size_t ws_size, hipStream_t stream) {
    static int grid = 0;
    if (grid == 0) {
        if (n_in != 22 || in_sizes[0] != M * D || out_size != M * D || ws_size < WS_END) { fprintf(stderr, "kernel_launch: unexpected shapes (n_in %d, in0 %d, out %d, ws %zu); nothing launched\n", n_in, n_in > 0 ? in_sizes[0] : -1, out_size, ws_size); grid = -1; return; }
        int dev = 0, cus = 0, per_cu = 0;
        if (hipGetDevice(&dev) != hipSuccess || hipDeviceGetAttribute(&cus, hipDeviceAttributeMultiprocessorCount, dev) != hipSuccess) { grid = -1; return; }
        if (hipFuncSetAttribute((const void*)mk_fwd, hipFuncAttributeMaxDynamicSharedMemorySize, LDS_BYTES) != hipSuccess) { fprintf(stderr, "kernel_launch: hipFuncSetAttribute failed\n"); grid = -1; return; }
        if (hipOccupancyMaxActiveBlocksPerMultiprocessor(&per_cu, (const void*)mk_fwd, NWAVES * 64, LDS_BYTES) != hipSuccess || per_cu < 1) { fprintf(stderr, "kernel_launch: occupancy query says %d blocks per CU\n", per_cu); per_cu = 1; }
        (void)hipGetLastError();
        grid = cus * 1;
    }
    if (grid < 0) return;
    if (hipMemsetAsync((char*)d_ws + WS_CTL, 0, CTL_ZERO_BYTES, stream) != hipSuccess) { fprintf(stderr, "kernel_launch: hipMemsetAsync failed\n"); return; }
    Args a{};
    for (int i = 0; i < 22; ++i) a.in[i] = (const float*)d_in[i];
    a.out = (float*)d_out; a.ws = (unsigned char*)d_ws;
#if MK_PER_PHASE
    for (int ph = 0; ph < N_PHASES; ++ph) { a.ph_lo = ph; a.ph_hi = ph + 1; a.li = ph;
        hipLaunchKernelGGL(mk_fwd, dim3(grid), dim3(NWAVES * 64), LDS_BYTES, stream, a); }
#else
    a.ph_lo = 0; a.ph_hi = N_PHASES; a.li = 0;
#ifdef PROBE_PHASE
#ifndef PROBE_MODE
#define PROBE_MODE 1
#endif
    { void* kargs0[] = {&a};
      hipError_t e0 = hipLaunchCooperativeKernel((const void*)mk_fwd, dim3(grid), dim3(NWAVES * 64), kargs0, LDS_BYTES, stream);
      if (e0 != hipSuccess) fprintf(stderr, "kernel_launch: cooperative launch failed: %s (grid %d)\n", hipGetErrorString(e0), grid);
      Args a2 = a; a2.ph_lo = PROBE_PHASE; a2.ph_hi = PROBE_PHASE + 1; a2.pad = PROBE_MODE;
      hipLaunchKernelGGL(mk_fwd, dim3(grid), dim3(NWAVES * 64), LDS_BYTES, stream, a2); }
#elif defined(MK_PLAIN_LAUNCH)
    hipLaunchKernelGGL(mk_fwd, dim3(grid), dim3(NWAVES * 64), LDS_BYTES, stream, a);
#else
    void* kargs[] = {&a};
    hipError_t e = hipLaunchCooperativeKernel((const void*)mk_fwd, dim3(grid), dim3(NWAVES * 64), kargs, LDS_BYTES, stream);
    if (e != hipSuccess) fprintf(stderr, "kernel_launch: cooperative launch failed: %s (grid %d)\n", hipGetErrorString(e), grid);
#endif
#endif
}
```

```cpp
#include <hip/hip_runtime.h>
#include <cstdio>
#include <cstdint>
namespace pg8 {
#define PG8_LAS __attribute__((address_space(3)))
typedef unsigned short bf16_t;
typedef short bf16x8 __attribute__((ext_vector_type(8)));
typedef float f32x4 __attribute__((ext_vector_type(4)));
typedef unsigned u32x4 __attribute__((ext_vector_type(4)));
constexpr int BM = 256, BK = 64, HALF = 128, HTB = HALF * BK * 2  , STAGE_BYTES = 8 * HTB, NXCD = 8, WGM = 8;

__host__ __device__ __forceinline__ int lds_byte(int r, int c) { const int st = (r >> 4) * 2 + (c >> 5), rr = r & 15, cc = c & 31, ob = rr * 64 + cc * 2; return st * 1024 + (ob ^ (((ob >> 9) & 1) << 5)); }
__host__ __device__ __forceinline__ void stage_rc(int b, int& R, int& C) { const int st = b / 1024, sb = b % 1024, swz = sb ^ (((sb >> 9) & 1) << 5); R = (st >> 1) * 16 + swz / 64; C = (st & 1) * 32 + (swz % 64) / 2; }
__host__ __device__ __forceinline__ int perm32(int rho) { const int n = rho >> 4, i = rho & 15; return 8 * (i >> 2) + 4 * n + (i & 3); }

struct Unit { int pm, pn; };
struct Gemm { const bf16_t* A; const bf16_t* Bt; int M, N, K; };

struct StaticOrder {
    int nM, nN, nwg, G, c;
    __host__ __device__ void init(int M, int N, int G_, int c_) { nM = M / BM; nN = N / BM; nwg = nM * nN; G = G_; c = c_; }
    __host__ __device__ bool next(int i, Unit& u) const {
        const long L = (long)i * G + c; if (L >= nwg) return false;
        int wgid = (int)L; { const int q = nwg / NXCD, r = nwg % NXCD, xcd = wgid % NXCD, off = wgid / NXCD; wgid = (xcd < r ? xcd * (q + 1) : r * (q + 1) + (xcd - r) * q) + off; }
        const int nig = WGM * nN, gid = wgid / nig, fm = gid * WGM, gsz = (nM - fm) < WGM ? (nM - fm) : WGM;
        u.pm = fm + ((wgid % nig) % gsz); u.pn = (wgid % nig) / gsz; return true;
    }
    __device__ __forceinline__ void a_ready(const Unit&) const {}
    __device__ __forceinline__ void done(const Unit&) const {}
};

__device__ __forceinline__ unsigned cvt_pk_bf16(float lo, float hi) { unsigned r; asm volatile("v_cvt_pk_bf16_f32 %0, %1, %2" : "=v"(r) : "v"(lo), "v"(hi)); return r; }
typedef float f32x2 __attribute__((ext_vector_type(2)));
__device__ __forceinline__ f32x2 gelu_pk(f32x2 v) {
    const f32x2 av = __builtin_elementwise_abs(v), d = av * 0.2316418882f + 1.0f;
    f32x2 t; t.x = __builtin_amdgcn_rcpf(d.x); t.y = __builtin_amdgcn_rcpf(d.y);
    f32x2 q = t * 0.5307027145f + (-0.7265760135f); q = q * t + 0.7107068705f; q = q * t + (-0.142248368f); q = q * t + 0.127414796f; q = q * t;
    const f32x2 s = (v * v) * (-0.72134752044f);
    f32x2 e; e.x = __builtin_amdgcn_exp2f(s.x); e.y = __builtin_amdgcn_exp2f(s.y);
    const f32x2 m = v * (q * e), r = v - m;
    f32x2 o; o.x = v.x < 0.f ? m.x : r.x; o.y = v.y < 0.f ? m.y : r.y; return o;
}


constexpr float RMS_EPS = 1e-6f;
__device__ __forceinline__ float sigm(float x) { return __builtin_amdgcn_rcpf(1.0f + __expf(-x)); }
__device__ __forceinline__ u32x4 pack8(const f32x4 v0, const f32x4 v1) { u32x4 w; w.x = cvt_pk_bf16(v0[0], v0[1]); w.y = cvt_pk_bf16(v0[2], v0[3]); w.z = cvt_pk_bf16(v1[0], v1[1]); w.w = cvt_pk_bf16(v1[2], v1[3]); return w; }
typedef unsigned long long u64_t;
__device__ __forceinline__ float ssq_f(u64_t v) { return fmaf((float)(unsigned)(v >> 32), 4294967296.0f, (float)(unsigned)v); }
__device__ __forceinline__ float rstd_of(u64_t ssq) { return __builtin_amdgcn_rsqf(fmaf(ssq_f(ssq), 1.0f / (1024.0f * 1048576.0f), RMS_EPS)); }
__device__ __forceinline__ u64_t ssq_fix(float s) { return (u64_t)(s * 1048576.0f); }

struct EpiInL0 {
    static constexpr bool PERM = true, AFTER_DRAIN = false;
    bf16_t* UB; bf16_t* PB; const u64_t* ssq;
    __device__ __forceinline__ void operator()(const f32x4 (&acc)[2][2][4][2], const Unit& u, int wr, int wc, int fr, int fq) const {
        const int row0 = u.pm * BM + wr * 64 + fr, cw = wc * 32 + 8 * fq;
        u64_t q[2][4];
#pragma unroll
        for (int ai = 0; ai < 2; ++ai)
#pragma unroll
            for (int m = 0; m < 4; ++m) q[ai][m] = ssq[row0 + ai * HALF + m * 16];
#pragma unroll
        for (int ai = 0; ai < 2; ++ai)
#pragma unroll
            for (int m = 0; m < 4; ++m) {
                const int row = row0 + ai * HALF + m * 16;
                const float rs = rstd_of(q[ai][m]), c1 = rs * -1.4426950408889634f;
                if (u.pn < 4) {
                    f32x4 o[2];
#pragma unroll
                    for (int n = 0; n < 2; ++n)
#pragma unroll
                        for (int j = 0; j < 4; j += 2) {
                            const f32x2 a = {acc[ai][0][m][n][j], acc[ai][0][m][n][j + 1]}, g = {acc[ai][1][m][n][j], acc[ai][1][m][n][j + 1]};
                            const f32x2 t = g * c1; f32x2 e; e.x = __builtin_amdgcn_exp2f(t.x); e.y = __builtin_amdgcn_exp2f(t.y);
                            const f32x2 d = e + 1.0f; f32x2 r; r.x = __builtin_amdgcn_rcpf(d.x); r.y = __builtin_amdgcn_rcpf(d.y);
                            const f32x2 h = a * (r * rs); o[n][j] = h.x; o[n][j + 1] = h.y; }
                    *(u32x4*)(UB + (size_t)row * 512 + u.pn * 128 + cw) = pack8(o[0], o[1]);
                } else {
#pragma unroll
                    for (int bj = 0; bj < 2; ++bj) *(u32x4*)(PB + (size_t)row * 512 + (u.pn - 4) * 256 + bj * HALF + cw) = pack8(acc[ai][bj][m][0] * rs, acc[ai][bj][m][1] * rs);
                }
            }
    }
};
struct EpiResid {
    static constexpr bool PERM = true, AFTER_DRAIN = false;
    bf16_t* XB; u64_t* ssq; bf16_t* XBw; int probe_mode;
    __device__ __forceinline__ void operator()(const f32x4 (&acc)[2][2][4][2], const Unit& u, int wr, int wc, int fr, int fq) const {
        const int row0 = u.pm * BM + wr * 64 + fr, cw = u.pn * BM + wc * 32 + 8 * fq;
        if (probe_mode == 2) { if (acc[0][0][0][0][0] == 123.456f) XBw[0] = 1; return; }
        u32x4 r[2][4][2];
#pragma unroll
        for (int ai = 0; ai < 2; ++ai)
#pragma unroll
            for (int m = 0; m < 4; ++m)
#pragma unroll
                for (int bj = 0; bj < 2; ++bj) r[ai][m][bj] = *(const u32x4*)(XB + (size_t)(row0 + ai * HALF + m * 16) * 1024 + bj * HALF + cw);
#pragma unroll
        for (int ai = 0; ai < 2; ++ai)
#pragma unroll
            for (int m = 0; m < 4; ++m) {
                const int row = row0 + ai * HALF + m * 16;
                f32x2 s2 = {0.f, 0.f};
#pragma unroll
                for (int bj = 0; bj < 2; ++bj) {
                    const u32x4 rr = r[ai][m][bj];
                    const f32x2 a0 = {acc[ai][bj][m][0][0], acc[ai][bj][m][0][1]}, a1 = {acc[ai][bj][m][0][2], acc[ai][bj][m][0][3]}, a2 = {acc[ai][bj][m][1][0], acc[ai][bj][m][1][1]}, a3 = {acc[ai][bj][m][1][2], acc[ai][bj][m][1][3]};
                    const f32x2 v0 = a0 + (f32x2){__builtin_bit_cast(float, rr.x << 16), __builtin_bit_cast(float, rr.x & 0xffff0000u)};
                    const f32x2 v1 = a1 + (f32x2){__builtin_bit_cast(float, rr.y << 16), __builtin_bit_cast(float, rr.y & 0xffff0000u)};
                    const f32x2 v2 = a2 + (f32x2){__builtin_bit_cast(float, rr.z << 16), __builtin_bit_cast(float, rr.z & 0xffff0000u)};
                    const f32x2 v3 = a3 + (f32x2){__builtin_bit_cast(float, rr.w << 16), __builtin_bit_cast(float, rr.w & 0xffff0000u)};
                    u32x4 w; w.x = cvt_pk_bf16(v0.x, v0.y); w.y = cvt_pk_bf16(v1.x, v1.y); w.z = cvt_pk_bf16(v2.x, v2.y); w.w = cvt_pk_bf16(v3.x, v3.y);
                    *(u32x4*)(XBw + ((size_t)row * 1024 + bj * HALF + cw)) = w;
                    s2 = v0 * v0 + s2; s2 = v1 * v1 + s2; s2 = v2 * v2 + s2; s2 = v3 * v3 + s2;
                }
                float s = s2.x + s2.y;
                s += __shfl_xor(s, 16); s += __shfl_xor(s, 32);
                if (fq == 0) atomicAdd(ssq + row, ssq_fix(s));
            }
    }
};
struct EpiSwiGLU {
    static constexpr bool PERM = true, AFTER_DRAIN = false;
    bf16_t* H; const u64_t* ssq; int probe_mode;
    __device__ __forceinline__ void operator()(const f32x4 (&acc)[2][2][4][2], const Unit& u, int wr, int wc, int fr, int fq) const {
        const int row0 = u.pm * BM + wr * 64 + fr, cw = wc * 32 + 8 * fq;
        if (probe_mode == 2) { if (acc[0][0][0][0][0] == 123.456f) H[0] = 1; return; }
        u64_t q[2][4];
#pragma unroll
        for (int ai = 0; ai < 2; ++ai)
#pragma unroll
            for (int m = 0; m < 4; ++m) q[ai][m] = ssq[row0 + ai * HALF + m * 16];
#pragma unroll
        for (int ai = 0; ai < 2; ++ai)
#pragma unroll
            for (int m = 0; m < 4; ++m) {
                const int row = row0 + ai * HALF + m * 16;
                const float rs = rstd_of(q[ai][m]), c1 = rs * -1.4426950408889634f, rs2 = rs * rs;
                f32x4 o[2];
#pragma unroll
                for (int n = 0; n < 2; ++n)
#pragma unroll
                    for (int j = 0; j < 4; j += 2) {
                        const f32x2 g = {acc[ai][0][m][n][j], acc[ai][0][m][n][j + 1]}, up = {acc[ai][1][m][n][j], acc[ai][1][m][n][j + 1]};
                        const f32x2 t = g * c1; f32x2 e; e.x = __builtin_amdgcn_exp2f(t.x); e.y = __builtin_amdgcn_exp2f(t.y);
                        const f32x2 d = e + 1.0f; f32x2 r; r.x = __builtin_amdgcn_rcpf(d.x); r.y = __builtin_amdgcn_rcpf(d.y);
                        const f32x2 h = (g * up) * (r * rs2); o[n][j] = h.x; o[n][j + 1] = h.y; }
                *(u32x4*)(H + (size_t)row * 2816 + u.pn * 128 + cw) = pack8(o[0], o[1]);
            }
    }
};
struct EpiPQT {
    static constexpr bool PERM = true, AFTER_DRAIN = false;
    bf16_t* PQT; const u64_t* ssq;
    __device__ __forceinline__ void operator()(const f32x4 (&acc)[2][2][4][2], const Unit& u, int wr, int wc, int fr, int fq) const {
        const int tok0 = u.pn * BM + wc * 32 + 8 * fq, b = (u.pn * BM) >> 12;
#pragma unroll
        for (int bj = 0; bj < 2; ++bj) {
            u64_t q[8];
#pragma unroll
            for (int j = 0; j < 8; ++j) q[j] = ssq[tok0 + bj * HALF + j];
            f32x4 rs0, rs1;
#pragma unroll
            for (int j = 0; j < 4; ++j) { rs0[j] = rstd_of(q[j]); rs1[j] = rstd_of(q[4 + j]); }
#pragma unroll
            for (int ai = 0; ai < 2; ++ai)
#pragma unroll
                for (int m = 0; m < 4; ++m) {
                    const int r = u.pm * BM + ai * HALF + wr * 64 + m * 16 + fr, pq = r >> 9, ch = r & 511;
                    bf16_t* base = PQT + ((size_t)(b * 512 + ch) * 2 + pq) * 4096;
                    *(u32x4*)(base + ((tok0 + bj * HALF) & 4095)) = pack8(acc[ai][bj][m][0] * rs0, acc[ai][bj][m][1] * rs1);
                }
        }
    }
};
struct EpiGeluUV {
    static constexpr bool PERM = true, AFTER_DRAIN = false;
    bf16_t* U; bf16_t* V; const u64_t* ssq;
    __device__ __forceinline__ void operator()(const f32x4 (&acc)[2][2][4][2], const Unit& u, int wr, int wc, int fr, int fq) const {
        const int row0 = u.pm * BM + wr * 64 + fr, cw = wc * 32 + 8 * fq;
        bf16_t* dst = (u.pn < 2) ? U : V; const int colb = (u.pn & 1) * BM;
        u64_t q[2][4];
#pragma unroll
        for (int ai = 0; ai < 2; ++ai)
#pragma unroll
            for (int m = 0; m < 4; ++m) q[ai][m] = ssq[row0 + ai * HALF + m * 16];
#pragma unroll
        for (int ai = 0; ai < 2; ++ai)
#pragma unroll
            for (int m = 0; m < 4; ++m) {
                const int row = row0 + ai * HALF + m * 16;
                const float rs = rstd_of(q[ai][m]);
#pragma unroll
                for (int bj = 0; bj < 2; ++bj) {
                    const f32x4 v0 = acc[ai][bj][m][0] * rs, v1 = acc[ai][bj][m][1] * rs;
                    const f32x2 a = gelu_pk((f32x2){v0[0], v0[1]}), bq = gelu_pk((f32x2){v0[2], v0[3]}), c = gelu_pk((f32x2){v1[0], v1[1]}), d = gelu_pk((f32x2){v1[2], v1[3]});
                    *(u32x4*)(dst + (size_t)row * 512 + colb + bj * HALF + cw) = pack8((f32x4){a.x, a.y, bq.x, bq.y}, (f32x4){c.x, c.y, d.x, d.y});
                }
            }
    }
};
struct EpiDFT {
    static constexpr bool PERM = true, AFTER_DRAIN = false;
    bf16_t* AM;
    __device__ __forceinline__ void operator()(const f32x4 (&acc)[2][2][4][2], const Unit& u, int wr, int wc, int fr, int fq) const {
        const int row0 = (u.pn >> 1) * 4096 + u.pm * BM + wr * 64 + fr, cw = (u.pn & 1) * BM + wc * 32 + 8 * fq;
#pragma unroll
        for (int ai = 0; ai < 2; ++ai)
#pragma unroll
            for (int m = 0; m < 4; ++m) {
                const int row = row0 + ai * HALF + m * 16;
#pragma unroll
                for (int bj = 0; bj < 2; ++bj) *(u32x4*)(AM + (size_t)row * 1024 + bj * HALF + cw) = pack8(acc[ai][bj][m][0], acc[ai][bj][m][1]);
            }
    }
};

template <class Epi, class Sched, bool ALIGN_EPI = false, bool SP2 = false>
__device__ __forceinline__ void gemm_phase(PG8_LAS unsigned char* lds, const Gemm g, const Sched& S, const Epi& E) {
    const int tid = threadIdx.x, wid = __builtin_amdgcn_readfirstlane(tid >> 6), lane = tid & 63, wr = wid >> 2, wc = wid & 3, fr = lane & 15, fq = lane >> 4;
    const int K = g.K, nt = K / BK;
    unsigned voffA[2], voffB[2];
#pragma unroll
    for (int i = 0; i < 2; ++i) { int R, C; stage_rc(tid * 16 + i * 8192, R, C); const int Rb = Epi::PERM ? ((R & ~31) + perm32(R & 31)) : R;
        voffA[i] = (unsigned)(R * K + C) * 2u; voffB[i] = (unsigned)(Rb * K + C) * 2u; }
    const size_t kstep = (size_t)(BK * 2);
    const size_t hstep = (size_t)HALF * K * 2;
    const size_t tstep = 2 * hstep;
    const unsigned ldsw = (unsigned)wid * 1024u;
    const int aoff = lds_byte(wr * 64 + fr, fq * 8), boff = lds_byte(wc * 32 + fr, fq * 8);
#define PG8_SA(b, h) (((b) * 2 + (h)) * HTB)
#define PG8_SB(b, h) ((4 + (b) * 2 + (h)) * HTB)
#define PG8_STAGE(bufoff, gbase, voff) do { _Pragma("unroll") for (int _i = 0; _i < 2; ++_i) \
        __builtin_amdgcn_global_load_lds((const unsigned*)((const char*)(gbase) + (voff)[_i]), (PG8_LAS unsigned*)(lds + (bufoff) + ldsw + _i * 8192), 16, 0, 0); } while (0)
#define PG8_LDA(dst, b, h) do { _Pragma("unroll") for (int m = 0; m < 4; ++m) _Pragma("unroll") for (int k = 0; k < 2; ++k) dst[m][k] = *(const PG8_LAS bf16x8*)(lds + PG8_SA(b, h) + aoff + m * 2048 + k * 1024); } while (0)
#define PG8_LDB(dst, b, h) do { _Pragma("unroll") for (int n = 0; n < 2; ++n) _Pragma("unroll") for (int k = 0; k < 2; ++k) dst[n][k] = *(const PG8_LAS bf16x8*)(lds + PG8_SB(b, h) + boff + n * 2048 + k * 1024); } while (0)
#define PG8_MMA(ai, bj, At, Bt) do { __builtin_amdgcn_s_setprio(1); _Pragma("unroll") for (int m = 0; m < 4; ++m) _Pragma("unroll") for (int n = 0; n < 2; ++n) _Pragma("unroll") for (int k = 0; k < 2; ++k) \
        acc[ai][bj][m][n] = __builtin_amdgcn_mfma_f32_16x16x32_bf16(Bt[n][k], At[m][k], acc[ai][bj][m][n], 0, 0, 0); __builtin_amdgcn_s_setprio(0); } while (0)
#define PG8_WAIT_V(n) asm volatile("s_waitcnt vmcnt(" #n ")" ::: "memory")
#define PG8_WAIT_L(n) asm volatile("s_waitcnt lgkmcnt(" #n ")" ::: "memory")
#define PG8_BAR __builtin_amdgcn_s_barrier()
#define PG8_SCHED __builtin_amdgcn_sched_barrier(0)
    Unit cur, nxt; int ui = 0;
    if (!S.next(0, cur)) return;
    f32x4 acc[2][2][4][2];
#pragma unroll
    for (int a = 0; a < 2; ++a)
#pragma unroll
        for (int b = 0; b < 2; ++b)
#pragma unroll
            for (int m = 0; m < 4; ++m)
#pragma unroll
                for (int n = 0; n < 2; ++n) acc[a][b][m][n] = (f32x4){0.f, 0.f, 0.f, 0.f};
    bf16x8 At[4][2], B0[2][2], B1[2][2];
    const char* cA = (const char*)g.A + (size_t)cur.pm * tstep; const char* cB = (const char*)g.Bt + (size_t)cur.pn * tstep;
    S.a_ready(cur);
    if constexpr (SP2) {
        PG8_STAGE(PG8_SB(0, 0), cB, voffB); PG8_STAGE(PG8_SB(0, 1), cB + hstep, voffB); PG8_STAGE(PG8_SA(0, 0), cA, voffA); PG8_STAGE(PG8_SA(0, 1), cA + hstep, voffA);
        if (wr == 1) PG8_BAR;
        PG8_WAIT_V(2); PG8_BAR;
        PG8_STAGE(PG8_SB(1, 0), cB + kstep, voffB); PG8_STAGE(PG8_SA(1, 0), cA + kstep, voffA); PG8_STAGE(PG8_SB(1, 1), cB + hstep + kstep, voffB);
        PG8_WAIT_V(6); PG8_BAR;
    } else {
        PG8_STAGE(PG8_SB(0, 0), cB, voffB); PG8_STAGE(PG8_SA(0, 0), cA, voffA); PG8_STAGE(PG8_SB(0, 1), cB + hstep, voffB); PG8_STAGE(PG8_SA(0, 1), cA + hstep, voffA);
        if (wr == 1) PG8_BAR;
        PG8_WAIT_V(4); PG8_BAR;
        PG8_STAGE(PG8_SB(1, 0), cB + kstep, voffB); PG8_STAGE(PG8_SA(1, 0), cA + kstep, voffA); PG8_STAGE(PG8_SB(1, 1), cB + hstep + kstep, voffB);
        PG8_WAIT_V(6); PG8_BAR;
    }
    for (;;) {
        const bool has_next = S.next(ui + 1, nxt);
        const char* nA = has_next ? (const char*)g.A + (size_t)nxt.pm * tstep : cA; const char* nB = has_next ? (const char*)g.Bt + (size_t)nxt.pn * tstep : cB;
        for (int t = 0; t < nt; t += 2) {
            const bool last = (t == nt - 2);
            const char* a1 = cA + (size_t)(t + 1) * kstep;
            const char* a2 = last ? nA : cA + (size_t)(t + 2) * kstep; const char* b2 = last ? nB : cB + (size_t)(t + 2) * kstep;
            const char* a3 = a2 + kstep; const char* b3 = b2 + kstep;
            if (last && has_next) S.a_ready(nxt);
            if constexpr (SP2) {
            PG8_LDB(B0, 0, 0); PG8_LDB(B1, 0, 1); PG8_SCHED; PG8_LDA(At, 0, 0); PG8_STAGE(PG8_SA(1, 1), a1 + hstep, voffA);
            PG8_WAIT_V(8); PG8_WAIT_L(0); PG8_BAR; PG8_MMA(0, 0, At, B0); PG8_MMA(0, 1, At, B1); PG8_BAR; PG8_SCHED;
            PG8_LDA(At, 0, 1); PG8_STAGE(PG8_SB(0, 0), b2, voffB); PG8_STAGE(PG8_SB(0, 1), b2 + hstep, voffB); PG8_STAGE(PG8_SA(0, 0), a2, voffA);
            PG8_WAIT_V(8); PG8_WAIT_L(0); PG8_BAR; PG8_MMA(1, 0, At, B0); PG8_MMA(1, 1, At, B1); PG8_BAR; PG8_SCHED;
            PG8_LDB(B0, 1, 0); PG8_LDB(B1, 1, 1); PG8_SCHED; PG8_LDA(At, 1, 0); PG8_STAGE(PG8_SA(0, 1), a2 + hstep, voffA);
            PG8_WAIT_V(8); PG8_WAIT_L(0); PG8_BAR; PG8_MMA(0, 0, At, B0); PG8_MMA(0, 1, At, B1); PG8_BAR; PG8_SCHED;
            PG8_LDA(At, 1, 1); PG8_STAGE(PG8_SB(1, 0), b3, voffB); PG8_STAGE(PG8_SB(1, 1), b3 + hstep, voffB); PG8_STAGE(PG8_SA(1, 0), a3, voffA);
            PG8_WAIT_V(8); PG8_WAIT_L(0); PG8_BAR; PG8_MMA(1, 0, At, B0); PG8_MMA(1, 1, At, B1); PG8_BAR; PG8_SCHED;
            } else {
            PG8_LDB(B0, 0, 0); PG8_SCHED; PG8_LDA(At, 0, 0); PG8_STAGE(PG8_SA(1, 1), a1 + hstep, voffA);
            PG8_WAIT_L(8); PG8_BAR; PG8_WAIT_L(0); PG8_MMA(0, 0, At, B0); PG8_BAR; PG8_SCHED;
            PG8_LDB(B1, 0, 1); PG8_STAGE(PG8_SB(0, 0), b2, voffB);
            PG8_BAR; PG8_WAIT_L(0); PG8_MMA(0, 1, At, B1); PG8_BAR;
            PG8_LDA(At, 0, 1); PG8_STAGE(PG8_SA(0, 0), a2, voffA);
            PG8_BAR; PG8_WAIT_L(0); PG8_MMA(1, 0, At, B0); PG8_BAR; PG8_SCHED;
            PG8_STAGE(PG8_SB(0, 1), b2 + hstep, voffB);
            PG8_WAIT_V(6); PG8_BAR; PG8_MMA(1, 1, At, B1); PG8_BAR;
            PG8_LDB(B0, 1, 0); PG8_SCHED; PG8_LDA(At, 1, 0); PG8_STAGE(PG8_SA(0, 1), a2 + hstep, voffA);
            PG8_WAIT_L(8); PG8_BAR; PG8_WAIT_L(0); PG8_MMA(0, 0, At, B0); PG8_BAR; PG8_SCHED;
            PG8_LDB(B1, 1, 1); PG8_STAGE(PG8_SB(1, 0), b3, voffB);
            PG8_BAR; PG8_WAIT_L(0); PG8_MMA(0, 1, At, B1); PG8_BAR;
            PG8_LDA(At, 1, 1); PG8_STAGE(PG8_SA(1, 0), a3, voffA);
            PG8_BAR; PG8_WAIT_L(0); PG8_MMA(1, 0, At, B0); PG8_BAR; PG8_SCHED;
            PG8_STAGE(PG8_SB(1, 1), b3 + hstep, voffB);
            PG8_WAIT_V(6); PG8_BAR; PG8_MMA(1, 1, At, B1); PG8_BAR;
            }
        }
        if constexpr (ALIGN_EPI) { if (wr == 0) PG8_BAR; }
        if constexpr (!Epi::AFTER_DRAIN) { E(acc, cur, wr, wc, fr, fq); S.done(cur); }
        if (!has_next) break;
#pragma unroll
        for (int a = 0; a < 2; ++a)
#pragma unroll
            for (int b = 0; b < 2; ++b)
#pragma unroll
                for (int m = 0; m < 4; ++m)
#pragma unroll
                    for (int n = 0; n < 2; ++n) acc[a][b][m][n] = (f32x4){0.f, 0.f, 0.f, 0.f};
        cur = nxt; cA = nA; cB = nB; ++ui;
        if constexpr (ALIGN_EPI) { if (wr == 1) PG8_BAR; }
    }
    PG8_WAIT_V(0);
    if constexpr (!ALIGN_EPI) { if (wr == 0) PG8_BAR; }
    PG8_BAR;
    if constexpr (Epi::AFTER_DRAIN) { E.fused(acc, cur, wr, wc, fr, fq, lds, wid, lane); S.done(cur); }
#undef PG8_SA
#undef PG8_SB
#undef PG8_STAGE
#undef PG8_LDA
#undef PG8_LDB
#undef PG8_MMA
#undef PG8_WAIT_V
#undef PG8_WAIT_L
#undef PG8_BAR
#undef PG8_SCHED
}
}
#define GAS __attribute__((address_space(1)))
#define LAS __attribute__((address_space(3)))
typedef unsigned short bf16;
typedef unsigned v4u __attribute__((ext_vector_type(4)));
typedef float f32x4 __attribute__((ext_vector_type(4)));
typedef short bf16x8 __attribute__((ext_vector_type(8)));
typedef GAS unsigned gu32;
typedef GAS unsigned long long gu64;
#define RLX_AGENT __ATOMIC_RELAXED, __HIP_MEMORY_SCOPE_AGENT
#define LDS_WAIT() asm volatile("s_waitcnt lgkmcnt(0)" ::: "memory")
#define VM_WAIT() asm volatile("s_waitcnt vmcnt(0)" ::: "memory")
__device__ __forceinline__ unsigned long long rt() { return __builtin_amdgcn_s_memrealtime(); }
__device__ __forceinline__ unsigned f2bf(float f) { unsigned u = __builtin_bit_cast(unsigned, f); return (u + 0x7fffu + ((u >> 16) & 1u)) >> 16; }
__device__ __forceinline__ unsigned pk2(float lo, float hi) { return f2bf(lo) | (f2bf(hi) << 16); }

#define XB_TMO      128
#define XB_XCNT(j)  (256  + 64 * (j))
#define XB_XSUB(j)  (1280 + 64 * (j))
#define XB_XGEN(j)  (2304 + 64 * (j))
#define XB_TOP      3328
#define XB_TOPGEN   3392
#define XCD_BAR_WORDS 3456
#define XB_SPIN_CAP (1u << 18)

__device__ __forceinline__ unsigned xb_ld(unsigned* p)              { return __hip_atomic_load(p, __ATOMIC_RELAXED, __HIP_MEMORY_SCOPE_AGENT); }
__device__ __forceinline__ unsigned xb_add(unsigned* p, unsigned v) { return __hip_atomic_fetch_add(p, v, __ATOMIC_RELAXED, __HIP_MEMORY_SCOPE_AGENT); }
__device__ __forceinline__ unsigned xb_xcc_id() { return (unsigned)__builtin_amdgcn_s_getreg((3 << 11) | 20) & 0xFu; }
#define XB_SPIN(cond, bar) do { unsigned _sp = 0; while (cond) { __builtin_amdgcn_s_sleep(1); \
    if ((++_sp & 255u) == 0u) { if (xb_ld(&(bar)[XB_TMO])) break; if (_sp > XB_SPIN_CAP) { atomicAdd(&(bar)[XB_TMO], 1u); break; } } } } while (0)

struct XcdBarrier {
    unsigned* bar; unsigned x;
    volatile LAS unsigned* st;
};

__device__ __forceinline__ XcdBarrier xcd_barrier_post(unsigned* bar, volatile LAS unsigned* st) {
    XcdBarrier b; b.bar = bar; b.x = xb_xcc_id(); b.st = st;
    if (threadIdx.x == 0) (void)xb_add(&bar[XB_XCNT(b.x)], 1u);
    return b;
}
__device__ __forceinline__ void xcd_barrier_complete(unsigned* bar, unsigned x, unsigned& nloc, unsigned& nx) {
    const unsigned G = gridDim.x * gridDim.y * gridDim.z;
    unsigned sum, cnt, mine, sp = 0u;
    for (;;) {
        sum = 0u; cnt = 0u; mine = 0u;
#pragma unroll
        for (unsigned j = 0; j < 16; ++j) { const unsigned c = xb_ld(&bar[XB_XCNT(j)]); sum += c; cnt += (c > 0u) ? 1u : 0u; mine = (j == x) ? c : mine; }
        if (sum == G) break;
        __builtin_amdgcn_s_sleep(1);
        if ((++sp & 255u) == 0u) { if (xb_ld(&bar[XB_TMO])) break; if (sp > XB_SPIN_CAP) { atomicAdd(&bar[XB_TMO], 1u); break; } }
    }
    nloc = mine > 0u ? mine : 1u; nx = cnt > 0u ? cnt : 1u;
}

__device__ __forceinline__ void xcd_barrier(const XcdBarrier& b) {
    asm volatile("s_waitcnt vmcnt(0)" ::: "memory");
    __syncthreads();
    if (threadIdx.x == 0) {
        unsigned* bar = b.bar;
        __builtin_amdgcn_s_waitcnt(0);
        unsigned nloc = b.st[0], nx = b.st[1];
        if (nloc == 0u) { xcd_barrier_complete(bar, b.x, nloc, nx); b.st[0] = nloc; b.st[1] = nx; }
        const unsigned old = xb_add(&bar[XB_XSUB(b.x)], 1u);
        const unsigned gen = old / nloc;
        if (old + 1u == (gen + 1u) * nloc) {
            __builtin_amdgcn_fence(__ATOMIC_RELEASE, "agent");
            asm volatile("s_waitcnt vmcnt(0)" ::: "memory");
            const unsigned og = xb_add(&bar[XB_TOP], 1u);
            const unsigned tg = og / nx;
            if (og + 1u == (tg + 1u) * nx) xb_add(&bar[XB_TOPGEN], 1u);
            else XB_SPIN(xb_ld(&bar[XB_TOPGEN]) == tg, bar);
            __builtin_amdgcn_fence(__ATOMIC_ACQUIRE, "agent");
            xb_add(&bar[XB_XGEN(b.x)], 1u);
            asm volatile("s_waitcnt vmcnt(0)" ::: "memory");
        } else {
            XB_SPIN(xb_ld(&bar[XB_XGEN(b.x)]) == gen, bar);
            __builtin_amdgcn_fence(__ATOMIC_ACQUIRE, "agent");
            asm volatile("s_waitcnt vmcnt(0)" ::: "memory");
        }
    }
    __syncthreads();
}

constexpr int NWAVES = 8;
#ifndef MK_PER_PHASE
#define MK_PER_PHASE 0
#endif
constexpr int N_PHASES = 13;

constexpr int NB = 8, S = 4096, D = 1024, FF = 2816, M = NB * S;
typedef float f32x2g __attribute__((ext_vector_type(2)));
typedef unsigned u32x2g __attribute__((ext_vector_type(2)));

constexpr size_t MiB = 1u << 20;
constexpr size_t WS_CTL = 0, CTL_ZERO_BYTES = 1 * MiB;
constexpr size_t WS_SSQ = 46 * MiB + 512 * 1024;
constexpr size_t WS_WIN0 = 2 * MiB;
constexpr size_t WS_WOUT0 = 5 * MiB;
constexpr size_t WS_WGU0 = 7 * MiB;
constexpr size_t WS_WDN0 = 18 * MiB;
constexpr size_t WS_WPQ1 = 24 * MiB;
constexpr size_t WS_WUV1 = 26 * MiB;
constexpr size_t WS_WOUT1 = 28 * MiB;
constexpr size_t WS_WGU1 = 30 * MiB;
constexpr size_t WS_WDN1 = 41 * MiB;
constexpr size_t WS_DFT = 48 * MiB;
constexpr size_t WS_XB = 112 * MiB;
constexpr size_t WS_AM = 176 * MiB;
constexpr size_t WS_H = 240 * MiB;
constexpr size_t WS_UB = WS_H, WS_PB = WS_H + 32 * MiB;
constexpr size_t WS_PQT = WS_H, WS_U1 = WS_H + 64 * MiB, WS_V1 = WS_H + 96 * MiB, WS_PQF = WS_H + 128 * MiB;
constexpr size_t WS_END = 416 * MiB;
static_assert(WS_H + (size_t)M * FF * 2 <= WS_END && WS_V1 + (size_t)M * 512 * 2 <= WS_END, "d_ws map");
constexpr int CW_BAR = 4096;

constexpr int RING_OFF = 0, RING_BYTES = 131072;
constexpr int LDSCTL_OFF = RING_BYTES, MISC_OFF = LDSCTL_OFF + 320;
constexpr int LDS_BYTES = 147456;

struct Frame {
    LAS unsigned char* lds;
    volatile LAS unsigned* MISC;
    gu32* ctl;
    int tid, lane, wave;
    int vcu, G;
};
__device__ __forceinline__ float wave_sum(float v) {
#pragma unroll
    for (int o = 1; o < 64; o <<= 1) v += __shfl_xor(v, o);
    return v;
}
__device__ __forceinline__ float bf_lo(unsigned x) { return __builtin_bit_cast(float, x << 16); }
__device__ __forceinline__ float bf_hi(unsigned x) { return __builtin_bit_cast(float, x & 0xffff0000u); }
#define WG_BAR() do { asm volatile("s_waitcnt vmcnt(0) lgkmcnt(0)" ::: "memory"); __builtin_amdgcn_s_barrier(); asm volatile("" ::: "memory"); } while (0)
#define LDS_BAR() do { asm volatile("s_waitcnt lgkmcnt(0)" ::: "memory"); __builtin_amdgcn_s_barrier(); asm volatile("" ::: "memory"); } while (0)

__device__ __forceinline__ void p0_transpose_item(const float* W, int ldw, const float* gk, bf16* WT, int ldt, int k0, int n0, int dk0, int drow0, LAS float* scr, int lane) {
    float v[32];
    const float* wp = W + (size_t)(k0 + (lane >> 5)) * ldw + n0 + (lane & 31);
#pragma unroll
    for (int i = 0; i < 32; ++i) v[i] = wp[(size_t)(2 * i) * ldw];
    const int c = lane & 7;
    f32x4 g0 = {1.f, 1.f, 1.f, 1.f}, g1 = {1.f, 1.f, 1.f, 1.f};
    if (gk) { g0 = *(const GAS f32x4*)(gk + k0 + 8 * c); g1 = *(const GAS f32x4*)(gk + k0 + 8 * c + 4); }
#pragma unroll
    for (int i = 0; i < 32; ++i) scr[(2 * i + (lane >> 5)) * 33 + (lane & 31)] = v[i];
    LDS_WAIT(); asm volatile("" ::: "memory");
#pragma unroll
    for (int j = 0; j < 4; ++j) { const int n = (lane >> 3) + 8 * j; const LAS float* s = scr + (8 * c) * 33 + n;
        v4u o; o.x = pk2(s[0 * 33] * g0.x, s[1 * 33] * g0.y); o.y = pk2(s[2 * 33] * g0.z, s[3 * 33] * g0.w); o.z = pk2(s[4 * 33] * g1.x, s[5 * 33] * g1.y); o.w = pk2(s[6 * 33] * g1.z, s[7 * 33] * g1.w);
        *(GAS v4u*)(WT + (size_t)(drow0 + n) * ldt + dk0 + 8 * c) = o; }
    LDS_WAIT(); asm volatile("" ::: "memory");
}
__device__ __forceinline__ void p0_job(const float* W, int ldw, const float* gk, int kbeg, int kext, int ncol0, int next, bf16* WT, int ldt, int dkbase, int mode, int half_or_off,
                                       LAS float* scr, int lane, int gw, int NGW, int& cursor) {
    const int nkb = kext / 64, nnb = next / 32, nitems = nkb * nnb;
    int first = (gw - (cursor % NGW) + NGW) % NGW;
    for (int it = first; it < nitems; it += NGW) {
        const int kb = it / nnb, nb = it % nnb, nrel = 32 * nb;
        const int drow0 = (mode == 0) ? (half_or_off + nrel) : (256 * (nrel >> 7) + 128 * half_or_off + (nrel & 127));
        p0_transpose_item(W, ldw, gk, WT, ldt, kbeg + 64 * kb, ncol0 + nrel, dkbase + 64 * kb, drow0, scr, lane);
    }
    cursor += nitems;
}
__device__ __forceinline__ void p0_fold_item(const float* L, int lrow0, const float* sc, const float* Rm, bf16* out, int dk0, float scale, int dw, int lane) {
    const int d = 64 * dw + lane;
    float l0[8], l1[8];
    { const float s0 = sc ? sc[lane] : 1.f, s1 = sc ? sc[64 + lane] : 1.f;
#pragma unroll
      for (int j = 0; j < 8; ++j) { l0[j] = L[(size_t)(lrow0 + j) * 128 + lane] * s0; l1[j] = L[(size_t)(lrow0 + j) * 128 + 64 + lane] * s1; } }
    float acc[8];
#pragma unroll
    for (int j = 0; j < 8; ++j) acc[j] = 0.f;
#pragma unroll
    for (int cb = 0; cb < 4; ++cb) {
        float r[32];
#pragma unroll
        for (int i = 0; i < 32; ++i) r[i] = Rm[(size_t)(cb * 32 + i) * 1024 + d];
#pragma unroll
        for (int i = 0; i < 32; ++i) { const int cp = cb * 32 + i;
#pragma unroll
            for (int j = 0; j < 8; ++j) { const float lv = __builtin_bit_cast(float, __builtin_amdgcn_readlane(__builtin_bit_cast(int, cp < 64 ? l0[j] : l1[j]), cp & 63)); acc[j] = fmaf(lv, r[i], acc[j]); } }
    }
    v4u o; o.x = pk2(acc[0] * scale, acc[1] * scale); o.y = pk2(acc[2] * scale, acc[3] * scale); o.z = pk2(acc[4] * scale, acc[5] * scale); o.w = pk2(acc[6] * scale, acc[7] * scale);
    *(GAS v4u*)(out + (size_t)d * 1024 + dk0) = o;
}
__device__ __forceinline__ void p0_pq_item(const float* Win1, const float* g1, bf16* WPQ, int h, int half, int k0, const LAS float* tab, int lane) {
    const int cp = 64 * half + lane;
    float ap[8], aq[8], w0[8], w1[8];
#pragma unroll
    for (int j = 0; j < 8; ++j) { const float g = g1[k0 + j]; ap[j] = 0.f; aq[j] = 0.f; w0[j] = Win1[(size_t)(k0 + j) * 1536 + h * 128 + lane] * g; w1[j] = Win1[(size_t)(k0 + j) * 1536 + h * 128 + 64 + lane] * g; }
#pragma unroll 8
    for (int c = 0; c < 128; ++c) {
        const int ph = c * cp;
        const float cs = tab[ph & 127], sn = tab[(ph - 32) & 127];
#pragma unroll
        for (int j = 0; j < 8; ++j) { const float w = __builtin_bit_cast(float, __builtin_amdgcn_readlane(__builtin_bit_cast(int, c < 64 ? w0[j] : w1[j]), c & 63)); ap[j] = fmaf(w, cs, ap[j]); aq[j] = fmaf(w, sn, aq[j]); }
    }
    v4u o; o.x = pk2(ap[0], ap[1]); o.y = pk2(ap[2], ap[3]); o.z = pk2(ap[4], ap[5]); o.w = pk2(ap[6], ap[7]);
    *(GAS v4u*)(WPQ + (size_t)(h * 128 + cp) * 1024 + k0) = o;
    o.x = pk2(aq[0], aq[1]); o.y = pk2(aq[2], aq[3]); o.z = pk2(aq[4], aq[5]); o.w = pk2(aq[6], aq[7]);
    *(GAS v4u*)(WPQ + (size_t)(512 + h * 128 + cp) * 1024 + k0) = o;
}

struct Ptrs {
    const float* in[22]; float* out; unsigned char* ws;
};

__device__ __forceinline__ void p0_prologue(Frame& F, const Ptrs& P) {
    const float* x = P.in[0]; const float* mix_g = P.in[1]; const float* ffn_g = P.in[2];
    const float* ev_w_in = P.in[3]; const float* ev_pool_w = P.in[8]; const float* ev_pool_scale = P.in[9]; const float* ev_w_out = P.in[10];
    const float* od_w_in = P.in[11]; const float* od_fourier_w = P.in[12]; const float* od_w_out = P.in[17];
    const float* w_gate = P.in[18]; const float* w_up = P.in[19]; const float* w_down = P.in[20];
    unsigned char* ws = P.ws;
    LAS float* scr = (LAS float*)(F.lds + RING_OFF + F.wave * 8448);
    LAS float* CT = (LAS float*)(F.lds + RING_OFF + 69632);
    LAS float* tab = (LAS float*)(F.lds + RING_OFF + 69632 + 16384);
    for (int i = F.tid; i < 4096; i += NWAVES * 64) CT[i] = cospif((float)i * (1.0f / 2048.0f));
    if (F.tid < 128) tab[F.tid] = cospif((float)F.tid * (1.0f / 64.0f));
    WG_BAR();
    const int gw = F.vcu * NWAVES + F.wave, NGW = F.G * NWAVES, lane = F.lane;
    { unsigned long long* z = (unsigned long long*)(ws + WS_SSQ) + M; const int gt = F.vcu * NWAVES * 64 + F.tid, NT = F.G * NWAVES * 64;
      for (int i = gt; i < 4 * M; i += NT) z[i] = 0ull; }
    int cur = 0;
    p0_job(ev_w_in, 1536, mix_g, 0, 1024, 0, 512, (bf16*)(ws + WS_WIN0), 1024, 0, 1, 0, scr, lane, gw, NGW, cur);
    p0_job(ev_w_in, 1536, mix_g, 0, 1024, 512, 512, (bf16*)(ws + WS_WIN0), 1024, 0, 1, 1, scr, lane, gw, NGW, cur);
    p0_job(ev_w_in, 1536, mix_g, 0, 1024, 1024, 512, (bf16*)(ws + WS_WIN0), 1024, 0, 0, 1024, scr, lane, gw, NGW, cur);
    p0_job(ev_w_out, 1024, nullptr, 0, 512, 0, 1024, (bf16*)(ws + WS_WOUT0), 1024, 0, 0, 0, scr, lane, gw, NGW, cur);
    p0_job(w_gate, FF, ffn_g, 0, 1024, 0, FF, (bf16*)(ws + WS_WGU0), 1024, 0, 1, 0, scr, lane, gw, NGW, cur);
    p0_job(w_up, FF, ffn_g, 0, 1024, 0, FF, (bf16*)(ws + WS_WGU0), 1024, 0, 1, 1, scr, lane, gw, NGW, cur);
    p0_job(w_down, 1024, nullptr, 0, FF, 0, 1024, (bf16*)(ws + WS_WDN0), FF, 0, 0, 0, scr, lane, gw, NGW, cur);
    p0_job(od_w_in, 1536, mix_g + D, 0, 1024, 512, 1024, (bf16*)(ws + WS_WUV1), 1024, 0, 0, 0, scr, lane, gw, NGW, cur);
    p0_job(od_w_out, 1024, nullptr, 512, 512, 0, 1024, (bf16*)(ws + WS_WOUT1), 1024, 512, 0, 0, scr, lane, gw, NGW, cur);
    p0_job(w_gate + (size_t)D * FF, FF, ffn_g + D, 0, 1024, 0, FF, (bf16*)(ws + WS_WGU1), 1024, 0, 1, 0, scr, lane, gw, NGW, cur);
    p0_job(w_up + (size_t)D * FF, FF, ffn_g + D, 0, 1024, 0, FF, (bf16*)(ws + WS_WGU1), 1024, 0, 1, 1, scr, lane, gw, NGW, cur);
    p0_job(w_down + (size_t)FF * D, 1024, nullptr, 0, FF, 0, 1024, (bf16*)(ws + WS_WDN1), FF, 0, 0, 0, scr, lane, gw, NGW, cur);
    {
        int first = (gw - (cur % NGW) + NGW) % NGW;
        for (int it = first; it < 1024; it += NGW) { const int g = it >> 8, cc = (it >> 4) & 15, dw = it & 15;
            p0_fold_item(ev_pool_w, g * 128 + cc * 8, ev_pool_scale + g * 128, ev_w_out + (size_t)(512 + g * 128) * 1024, (bf16*)(ws + WS_WOUT0), 512 + g * 128 + cc * 8, 1.0f, dw, lane); }
        cur += 1024;
        first = (gw - (cur % NGW) + NGW) % NGW;
        for (int it = first; it < 1024; it += NGW) { const int h = it >> 8, cc = (it >> 4) & 15, dw = it & 15;
            p0_fold_item(od_fourier_w, h * 128 + cc * 8, nullptr, od_w_out + (size_t)(h * 128) * 1024, (bf16*)(ws + WS_WOUT1), h * 128 + cc * 8, 1.0f / 724.0773439350247f, dw, lane); }
        cur += 1024;
        first = (gw - (cur % NGW) + NGW) % NGW;
        for (int it = first; it < 1024; it += NGW) { const int h = it >> 8, half = (it >> 7) & 1, kc = it & 127;
            p0_pq_item(od_w_in, mix_g + D, (bf16*)(ws + WS_WPQ1), h, half, kc * 8, tab, lane); }
        cur += 1024;
    }
    {
        bf16* Dm = (bf16*)(ws + WS_DFT);
        int first = (gw - (cur % NGW) + NGW) % NGW;
        for (int t = first; t < S; t += NGW) {
#pragma unroll 2
            for (int q = 0; q < 8; ++q) {
                const int k0 = (q * 64 + lane) * 8, s0 = k0 & (S / 2 - 1), sinpart = k0 >> 11;
                float v[8];
#pragma unroll
                for (int e = 0; e < 8; ++e) { int idx = (s0 + e) * t + (sinpart ? 1024 : 0); if (sinpart && s0 + e == 0) idx = 2048 * t; v[e] = CT[idx & (S - 1)]; }
                v4u o; o.x = pk2(v[0], v[1]); o.y = pk2(v[2], v[3]); o.z = pk2(v[4], v[5]); o.w = pk2(v[6], v[7]);
                *(GAS v4u*)(Dm + (size_t)t * S + k0) = o;
            }
        }
        cur += S;
    }
    {
        bf16* XB = (bf16*)(ws + WS_XB); unsigned long long* ssq0 = (unsigned long long*)(ws + WS_SSQ);
        for (int m0 = 4 * gw; m0 < M; m0 += 4 * NGW) {
            f32x4 v[4][4];
#pragma unroll
            for (int r = 0; r < 4; ++r) { const GAS f32x4* xr = (const GAS f32x4*)(x + (size_t)(m0 + r) * D) + lane;
#pragma unroll
                for (int j = 0; j < 4; ++j) v[r][j] = xr[64 * j]; }
#pragma unroll
            for (int r = 0; r < 4; ++r) { float s = 0.f;
#pragma unroll
                for (int j = 0; j < 4; ++j) s += (v[r][j].x * v[r][j].x + v[r][j].y * v[r][j].y) + (v[r][j].z * v[r][j].z + v[r][j].w * v[r][j].w);
                s = wave_sum(s);
                if (lane == 0) ssq0[m0 + r] = pg8::ssq_fix(s);
                GAS unsigned long long* o8 = (GAS unsigned long long*)(XB + (size_t)(m0 + r) * D) + lane;
#pragma unroll
                for (int j = 0; j < 4; ++j) o8[64 * j] = (unsigned long long)pk2(v[r][j].x, v[r][j].y) | ((unsigned long long)pk2(v[r][j].z, v[r][j].w) << 32); }
        }
    }
}

__device__ __forceinline__ float fsel(bool c, float a, float b) { return c ? a : b; }
__device__ __forceinline__ float reduce_scatter32(float (&v)[32], int lane) {
#pragma unroll
    for (int o = 16; o >= 1; o >>= 1) {
        const bool up = (lane & o) != 0;
#pragma unroll
        for (int i = 0; i < o; ++i) { const float lo_ = v[i], hi_ = v[i + o]; const float send = fsel(up, lo_, hi_), keep = fsel(up, hi_, lo_); v[i] = keep + __shfl_xor(send, o); }
#pragma unroll
        for (int i = 0; i < o; ++i) asm volatile("" : "+v"(v[i]));
    }
    return v[0] + __shfl_xor(v[0], 32);
}
__device__ __forceinline__ float reduce_scatter16(float (&v)[16], int lane) {
#pragma unroll
    for (int o = 8; o >= 1; o >>= 1) {
        const bool up = (lane & o) != 0;
#pragma unroll
        for (int i = 0; i < o; ++i) { const float lo_ = v[i], hi_ = v[i + o]; const float send = fsel(up, lo_, hi_), keep = fsel(up, hi_, lo_); v[i] = keep + __shfl_xor(send, o); }
#pragma unroll
        for (int i = 0; i < o; ++i) asm volatile("" : "+v"(v[i]));
    }
    float t = v[0] + __shfl_xor(v[0], 16);
    return t + __shfl_xor(t, 32);
}
template <int pmode> __device__ __forceinline__ void mix0_conv_item(Frame& F, const Ptrs& P, int item) {
    const bf16* UB = (const bf16*)(P.ws + WS_UB); bf16* AM = (bf16*)(P.ws + WS_AM);
    const float* cw = P.in[4]; const float* cb = P.in[5]; const float* lg = P.in[6]; const float* lb = P.in[7];
    const int b = item >> 6, t0 = (item & 63) * 64, rowbase = b * S;
    LAS unsigned* tile = (LAS unsigned*)(F.lds + RING_OFF);
    LAS float* red = (LAS float*)(F.lds + RING_OFF + 98304);
    if (pmode != 7) { v4u tv[12];
#pragma unroll
      for (int i = 0; i < 12; ++i) { const int t = t0 - 15 + F.wave + NWAVES * i, tc = t < 0 ? 0 : (t > S - 1 ? S - 1 : t);
          tv[i] = *(const GAS v4u*)(UB + (size_t)(rowbase + tc) * 512 + F.lane * 8); }
#pragma unroll
      for (int i = 0; i < 12; ++i) { const int r = F.wave + NWAVES * i, t = t0 - 15 + r; const bool ok = (t >= 0 && t < S);
          v4u w = tv[i]; w.x = ok ? w.x : 0u; w.y = ok ? w.y : 0u; w.z = ok ? w.z : 0u; w.w = ok ? w.w : 0u;
          *(LAS v4u*)(tile + r * 256 + F.lane * 4) = w; } }
    LDS_BAR();
    int tidl = F.tid; asm volatile("" : "+v"(tidl));
    const int rg = tidl >> 8, cp = tidl & 255, lanel = tidl & 63;
    const f32x2g bb = *(const GAS f32x2g*)(cb + 2 * cp);
    const f32x2g g2 = *(const GAS f32x2g*)(lg + 2 * cp), b2 = *(const GAS f32x2g*)(lb + 2 * cp);
    float w0[31], w1[31];
#pragma unroll
    for (int j = 0; j < 31; ++j) { const f32x2g w = *(const GAS f32x2g*)(cw + j * 512 + 2 * cp); w0[j] = w.x; w1[j] = w.y; }
#pragma unroll 1
    for (int p = 0; p < (pmode == 10 ? 1 : 4); ++p) {
        float a0[8], a1[8];
#pragma unroll
        for (int o = 0; o < 8; ++o) { a0[o] = bb.x; a1[o] = bb.y; }
        const LAS unsigned* tp = tile + (32 * rg + 8 * p) * 256 + cp;
        if (pmode != 5)
#pragma unroll
        for (int ii = 0; ii < 38; ++ii) {
            const unsigned xx = tp[ii * 256];
            const float x0 = bf_lo(xx), x1 = bf_hi(xx);
#pragma unroll
            for (int o = 0; o < 8; ++o) { const int j = ii - o; if (j >= 0 && j <= 30) { a0[o] = fmaf(w0[j], x0, a0[o]); a1[o] = fmaf(w1[j], x1, a1[o]); } }
        }
        float v[16];
#pragma unroll
        for (int o = 0; o < 8; ++o) { v[2 * o] = a0[o] + a1[o]; v[2 * o + 1] = a0[o] * a0[o] + a1[o] * a1[o]; }
        LAS float* redp = red + (p & 1) * 128;
        if (pmode != 6) {
        const float tot = reduce_scatter16(v, lanel);
        if (lanel < 16) redp[(F.wave & 3) * 16 + lanel + rg * 64] = tot;
        LDS_BAR(); }
        float mean8[8], rstd8[8];
        {
            const LAS f32x4* rp = (const LAS f32x4*)(redp + rg * 64);
            f32x4 acc4[4];
#pragma unroll
            for (int k = 0; k < 4; ++k) acc4[k] = rp[k];
#pragma unroll
            for (int w = 1; w < 4; ++w)
#pragma unroll
                for (int k = 0; k < 4; ++k) acc4[k] = acc4[k] + rp[w * 4 + k];
#pragma unroll
            for (int o = 0; o < 8; ++o) { const float sm = acc4[o >> 1][(o & 1) * 2], sq = acc4[o >> 1][(o & 1) * 2 + 1];
                const float mean = sm * (1.0f / 512.0f), var = sq * (1.0f / 512.0f) - mean * mean; mean8[o] = mean; rstd8[o] = __builtin_amdgcn_rsqf(var + 1e-6f); }
        }
        if (pmode != 8)
#pragma unroll
        for (int o = 0; o < 8; ++o) {
            const float mean = mean8[o], rstd = rstd8[o];
            float y0 = (a0[o] - mean) * rstd * g2.x + b2.x, y1 = (a1[o] - mean) * rstd * g2.y + b2.y;
            y0 = y0 * __builtin_amdgcn_rcpf(1.0f + __expf(-y0)); y1 = y1 * __builtin_amdgcn_rcpf(1.0f + __expf(-y1));
            *(GAS unsigned*)(AM + (size_t)(rowbase + t0 + 32 * rg + 8 * p + o) * 1024 + 2 * cp) = pk2(y0, y1);
        }
    }
    LDS_BAR();
}
template <int H> __device__ __forceinline__ void pool_rows(const LAS unsigned* tp  , bf16* orow  , int tfirst) {
    unsigned x[32 + 2 * H];
#pragma unroll
    for (int i = 0; i < 32 + 2 * H; ++i) x[i] = tp[i * 256];
    float s0 = 0.f, s1 = 0.f;
#pragma unroll
    for (int i = 0; i < 2 * H; ++i) { s0 += bf_lo(x[i]); s1 += bf_hi(x[i]); }
#pragma unroll
    for (int o = 0; o < 32; ++o) {
        const int t = tfirst + o;
        const int lo = (t - H) < 0 ? 0 : (t - H), hi = (t + H - 1) > (S - 1) ? (S - 1) : (t + H - 1);
        const float inv = 1.0f / (float)(hi - lo + 1);
        *(GAS unsigned*)(orow + (size_t)o * 1024) = pk2(s0 * inv - bf_lo(x[o + H]), s1 * inv - bf_hi(x[o + H]));
        if (o < 31) { s0 += bf_lo(x[o + 2 * H]) - bf_lo(x[o]); s1 += bf_hi(x[o + 2 * H]) - bf_hi(x[o]); }
    }
}
__device__ __forceinline__ void mix0_pool_item(Frame& F, const Ptrs& P, int item) {
    const bf16* PB = (const bf16*)(P.ws + WS_PB); bf16* AM = (bf16*)(P.ws + WS_AM);
    const int b = item >> 6, t0 = (item & 63) * 64, rowbase = b * S;
    LAS unsigned* tile = (LAS unsigned*)(F.lds + RING_OFF);
    { v4u tv[10];
#pragma unroll
      for (int i = 0; i < 10; ++i) { const int t = t0 - 8 + F.wave + NWAVES * i, tc = t < 0 ? 0 : (t > S - 1 ? S - 1 : t);
          tv[i] = *(const GAS v4u*)(PB + (size_t)(rowbase + tc) * 512 + F.lane * 8); }
#pragma unroll
      for (int i = 0; i < 10; ++i) { const int r = F.wave + NWAVES * i, t = t0 - 8 + r; const bool ok = (t >= 0 && t < S);
          v4u w = tv[i]; w.x = ok ? w.x : 0u; w.y = ok ? w.y : 0u; w.z = ok ? w.z : 0u; w.w = ok ? w.w : 0u;
          *(LAS v4u*)(tile + r * 256 + F.lane * 4) = w; } }
    LDS_BAR();
    const int rg = F.tid >> 8, cp = F.tid & 255, g = __builtin_amdgcn_readfirstlane(cp >> 6);
    bf16* orow = AM + (size_t)(rowbase + t0 + 32 * rg) * 1024 + 512 + 2 * cp;
    const int tfirst = t0 + 32 * rg;
    if (g == 0) pool_rows<1>(tile + (32 * rg + 8 - 1) * 256 + cp, orow, tfirst);
    else if (g == 1) pool_rows<2>(tile + (32 * rg + 8 - 2) * 256 + cp, orow, tfirst);
    else if (g == 2) pool_rows<4>(tile + (32 * rg + 8 - 4) * 256 + cp, orow, tfirst);
    else pool_rows<8>(tile + (32 * rg + 8 - 8) * 256 + cp, orow, tfirst);
    LDS_BAR();
}

__device__ __forceinline__ void sgu_item(Frame& F, const Ptrs& P, int item) {
    const bf16* U = (const bf16*)(P.ws + WS_U1); const bf16* V = (const bf16*)(P.ws + WS_V1); bf16* AM = (bf16*)(P.ws + WS_AM);
    const float* lng = P.in[13]; const float* lnb = P.in[14]; const float* sw = P.in[15]; const float* sb = P.in[16];
    const int h = item & 3, rowbase = (item >> 2) * 128;
    LAS bf16* vnT = (LAS bf16*)(F.lds + RING_OFF);
    int lane = F.lane; asm volatile("" : "+v"(lane));
    {
        const f32x2g g2 = *(const GAS f32x2g*)(lng + h * 128 + 2 * lane), b2 = *(const GAS f32x2g*)(lnb + h * 128 + 2 * lane);
        unsigned xv[16];
#pragma unroll
        for (int i = 0; i < 16; ++i) xv[i] = *(const GAS unsigned*)(V + (size_t)(rowbase + F.wave + 8 * i) * 512 + h * 128 + 2 * lane);
        float st[32];
#pragma unroll
        for (int i = 0; i < 16; ++i) { const float v0 = bf_lo(xv[i]), v1 = bf_hi(xv[i]); st[2 * i] = v0 + v1; st[2 * i + 1] = v0 * v0 + v1 * v1; }
        const float tot = reduce_scatter32(st, lane);
#pragma unroll
        for (int i = 0; i < 16; ++i) { const int k = F.wave + 8 * i;
            const float sm = __shfl(tot, 2 * i), sq = __shfl(tot, 2 * i + 1);
            const float mean = sm * (1.0f / 128.0f), rstd = __builtin_amdgcn_rsqf(sq * (1.0f / 128.0f) - mean * mean + 1e-6f);
            const float v0 = bf_lo(xv[i]), v1 = bf_hi(xv[i]);
            vnT[(2 * lane) * 136 + k] = (bf16)f2bf((v0 - mean) * rstd * g2.x + b2.x); vnT[(2 * lane + 1) * 136 + k] = (bf16)f2bf((v1 - mean) * rstd * g2.y + b2.y); }
    }
    LDS_BAR();
    {
        const int fr = lane & 15, fq = lane >> 4, q = 16 * F.wave + fr;
        pg8::f32x4 acc[8];
#pragma unroll
        for (int nt = 0; nt < 8; ++nt) acc[nt] = (pg8::f32x4){0.f, 0.f, 0.f, 0.f};
#pragma unroll
        for (int ks = 0; ks < 4; ++ks) {
            const GAS pg8::f32x4* wp = (const GAS pg8::f32x4*)(sw + (size_t)(h * 128 + q) * 128 + ks * 32 + 8 * fq);
            const pg8::f32x4 wa = wp[0], wb = wp[1];
            pg8::u32x4 wq; wq.x = pk2(wa[0], wa[1]); wq.y = pk2(wa[2], wa[3]); wq.z = pk2(wb[0], wb[1]); wq.w = pk2(wb[2], wb[3]);
            const pg8::bf16x8 wf = __builtin_bit_cast(pg8::bf16x8, wq);
#pragma unroll
            for (int nt = 0; nt < 8; ++nt) {
                const pg8::bf16x8 vf = *(const LAS pg8::bf16x8*)(vnT + (16 * nt + fr) * 136 + ks * 32 + 8 * fq);
                acc[nt] = __builtin_amdgcn_mfma_f32_16x16x32_bf16(vf, wf, acc[nt], 0, 0, 0);
            }
        }
        const float bias = sb[h * 128 + q]; const size_t t = (size_t)(rowbase + q);
#pragma unroll
        for (int nt = 0; nt < 8; ++nt) { const int c0 = h * 128 + 16 * nt + 4 * fq;
            const u32x2g uu = *(const GAS u32x2g*)(U + t * 512 + c0);
            u32x2g o; o.x = pk2(bf_lo(uu.x) * (acc[nt][0] + bias), bf_hi(uu.x) * (acc[nt][1] + bias)); o.y = pk2(bf_lo(uu.y) * (acc[nt][2] + bias), bf_hi(uu.y) * (acc[nt][3] + bias));
            *(GAS u32x2g*)(AM + t * 1024 + 512 + c0) = o; }
    }
    LDS_BAR();
}

__device__ __forceinline__ void fold_rows(Frame& F, const Ptrs& P) {
    const bf16* PQT = (const bf16*)(P.ws + WS_PQT); bf16* PQF = (bf16*)(P.ws + WS_PQF);
    LAS unsigned short* buf = (LAS unsigned short*)(F.lds + RING_OFF + F.wave * 16384);
    const int gw = F.vcu * NWAVES + F.wave, NGW = F.G * NWAVES;
    for (int row = gw; row < NB * 512; row += NGW) {
        int lane = F.lane; asm volatile("" : "+v"(lane));
        const GAS v4u* src = (const GAS v4u*)(PQT + (size_t)row * 2 * S) + lane;
        v4u t[16];
#pragma unroll
        for (int i = 0; i < 16; ++i) t[i] = src[64 * i];
#pragma unroll
        for (int i = 0; i < 16; ++i) *(LAS v4u*)(buf + (size_t)(64 * i + lane) * 8) = t[i];
        LDS_WAIT(); asm volatile("" ::: "memory");
        GAS v4u* dst = (GAS v4u*)(PQF + (size_t)row * S) + lane;
#pragma unroll
        for (int q = 0; q < 8; ++q) {
            const int k0 = (q * 64 + lane) * 8, sinpart = k0 >> 11, s0 = k0 & (S / 2 - 1);
            const LAS unsigned short* pr = buf + (sinpart ? S : 0);
            float v[8];
#pragma unroll
            for (int e = 0; e < 8; ++e) { const int sidx = s0 + e;
                const float a = __builtin_bit_cast(float, (unsigned)pr[sidx] << 16), bm = __builtin_bit_cast(float, (unsigned)pr[(S - sidx) & (S - 1)] << 16);
                v[e] = sinpart ? (a - bm) : (a + bm);
                if (sidx == 0) v[e] = sinpart ? __builtin_bit_cast(float, (unsigned)buf[S / 2] << 16) : a; }
            v4u o; o.x = pk2(v[0], v[1]); o.y = pk2(v[2], v[3]); o.z = pk2(v[4], v[5]); o.w = pk2(v[6], v[7]);
            dst[64 * q] = o;
        }
        LDS_WAIT(); asm volatile("" ::: "memory");
    }
}

struct Args { const float* in[22]; float* out; unsigned char* ws; int ph_lo, ph_hi, li, pad; };
template <int PM> __device__ __forceinline__ void mk_body(const Args& args) {
    extern __shared__ __attribute__((aligned(16))) unsigned char lds[];
    Frame F;
    F.lds = (LAS unsigned char*)lds;
    F.MISC = (volatile LAS unsigned*)(F.lds + MISC_OFF);
    F.tid = threadIdx.x; F.lane = F.tid & 63; F.wave = __builtin_amdgcn_readfirstlane(F.tid >> 6);
    F.G = gridDim.x; { const int bx = blockIdx.x; F.vcu = (F.G % 8 == 0) ? (bx % 8) * (F.G / 8) + bx / 8 : bx; }
    Ptrs P;
#pragma unroll
    for (int i = 0; i < 22; ++i) P.in[i] = args.in[i];
    P.out = args.out; P.ws = args.ws;
    unsigned char* ws = args.ws;
    F.ctl = (gu32*)(ws + WS_CTL);
    for (int u = F.tid; u < (LDS_BYTES - LDSCTL_OFF) / 4; u += NWAVES * 64) ((LAS unsigned*)(F.lds + LDSCTL_OFF))[u] = 0u;
    __syncthreads();
    XcdBarrier bar; bar.bar = (unsigned*)(F.ctl + CW_BAR); bar.x = 0; bar.st = nullptr;
    if (!MK_PER_PHASE) bar = xcd_barrier_post((unsigned*)(F.ctl + CW_BAR), F.MISC + 8);
    const int lo = args.ph_lo, hi = args.ph_hi;
#ifndef PH_MASK
#define PH_MASK 0x1FFF
#endif
#define IN(k) ((((PH_MASK) >> (k)) & 1) && lo <= (k) && (k) < hi)
#ifndef PROBE_BARX
#define PROBE_BARX 1
#endif
#define SEAM(k) do { if (IN(k) && IN((k) + 1)) { for (int bx_ = 0; bx_ < PROBE_BARX; ++bx_) xcd_barrier(bar); } } while (0)
    unsigned long long* ssq = (unsigned long long*)(ws + WS_SSQ);
    bf16* XB = (bf16*)(ws + WS_XB); bf16* AM = (bf16*)(ws + WS_AM); bf16* HB = (bf16*)(ws + WS_H);
    const int bid = (int)blockIdx.x;
    constexpr bool dup = PM != 0;
    bf16* TRX = (bf16*)(ws + WS_END); unsigned long long* TRS = (unsigned long long*)(ws + WS_END + 64 * MiB);

    if (IN(0)) { p0_prologue(F, P); } SEAM(0);
    if (IN(1)) { pg8::Gemm g{XB, (const bf16*)(ws + WS_WIN0), M, 1536, D}; pg8::StaticOrder So; So.init(M, 1536, F.G, bid);
        pg8::EpiInL0 E{(bf16*)(ws + WS_UB), (bf16*)(ws + WS_PB), ssq};
        pg8::gemm_phase<pg8::EpiInL0, pg8::StaticOrder, true, true>(F.lds + RING_OFF, g, So, E); } SEAM(1);
    if (IN(2)) { for (int it = F.vcu; it < 1024; it += F.G) {
#ifndef NO_CONV
            if (it < 512 && PM != 4 && PM != 9) mix0_conv_item<PM>(F, P, it);
#endif
#ifndef NO_POOL
            if (it >= 512 && PM != 3 && PM != 9) mix0_pool_item(F, P, it - 512);
#endif
 } } SEAM(2);
    if (IN(3)) { pg8::Gemm g{AM, (const bf16*)(ws + WS_WOUT0), M, D, D}; pg8::StaticOrder So; So.init(M, D, F.G, bid);
        pg8::EpiResid E{XB, dup ? TRS : ssq + M, dup ? TRX : XB, PM};
        pg8::gemm_phase<pg8::EpiResid, pg8::StaticOrder, true, true>(F.lds + RING_OFF, g, So, E); } SEAM(3);
    if (IN(4)) { pg8::Gemm g{XB, (const bf16*)(ws + WS_WGU0), M, 2 * FF, D}; pg8::StaticOrder So; So.init(M, 2 * FF, F.G, bid);
        pg8::EpiSwiGLU E{HB, ssq + M, PM};
        pg8::gemm_phase<pg8::EpiSwiGLU, pg8::StaticOrder, true, true>(F.lds + RING_OFF, g, So, E); } SEAM(4);
    if (IN(5)) { pg8::Gemm g{HB, (const bf16*)(ws + WS_WDN0), M, D, FF}; pg8::StaticOrder So; So.init(M, D, F.G, bid);
        pg8::EpiResid E{XB, dup ? TRS : ssq + 2 * M, dup ? TRX : XB, PM};
        pg8::gemm_phase<pg8::EpiResid, pg8::StaticOrder, true, true>(F.lds + RING_OFF, g, So, E); } SEAM(5);
    if (IN(6)) {
        { pg8::Gemm g{(const bf16*)(ws + WS_WPQ1), XB, 1024, M, D}; pg8::StaticOrder So; So.init(1024, M, F.G, bid);
          pg8::EpiPQT E{(bf16*)(ws + WS_PQT), ssq + 2 * M};
          pg8::gemm_phase<pg8::EpiPQT, pg8::StaticOrder, true, true>(F.lds + RING_OFF, g, So, E); }
        { pg8::Gemm g{XB, (const bf16*)(ws + WS_WUV1), M, 1024, D}; pg8::StaticOrder So; So.init(M, 1024, F.G, bid);
          pg8::EpiGeluUV E{(bf16*)(ws + WS_U1), (bf16*)(ws + WS_V1), ssq + 2 * M};
          pg8::gemm_phase<pg8::EpiGeluUV, pg8::StaticOrder, true, true>(F.lds + RING_OFF, g, So, E); }
    } SEAM(6);
    if (IN(7)) {
        { fold_rows(F, P); }
        { for (int it = F.vcu; it < 1024; it += F.G) sgu_item(F, P, it); }
    } SEAM(7);
    if (IN(8)) { pg8::Gemm g{(const bf16*)(ws + WS_DFT), (const bf16*)(ws + WS_PQF), S, NB * 512, S}; pg8::StaticOrder So; So.init(S, NB * 512, F.G, bid);
        pg8::EpiDFT E{AM};
        pg8::gemm_phase<pg8::EpiDFT, pg8::StaticOrder, true, true>(F.lds + RING_OFF, g, So, E); } SEAM(8);
    if (IN(9)) { pg8::Gemm g{AM, (const bf16*)(ws + WS_WOUT1), M, D, D}; pg8::StaticOrder So; So.init(M, D, F.G, bid);
        pg8::EpiResid E{XB, dup ? TRS : ssq + 3 * M, dup ? TRX : XB, PM};
        pg8::gemm_phase<pg8::EpiResid, pg8::StaticOrder, true, true>(F.lds + RING_OFF, g, So, E); } SEAM(9);
    if (IN(10)) { pg8::Gemm g{XB, (const bf16*)(ws + WS_WGU1), M, 2 * FF, D}; pg8::StaticOrder So; So.init(M, 2 * FF, F.G, bid);
        pg8::EpiSwiGLU E{HB, ssq + 3 * M, PM};
        pg8::gemm_phase<pg8::EpiSwiGLU, pg8::StaticOrder, true, true>(F.lds + RING_OFF, g, So, E); } SEAM(10);
    if (IN(11)) { pg8::Gemm g{HB, (const bf16*)(ws + WS_WDN1), M, D, FF}; pg8::StaticOrder So; So.init(M, D, F.G, bid);
        pg8::EpiResid E{XB, dup ? TRS : ssq + 4 * M, dup ? TRX : XB, PM};
        pg8::gemm_phase<pg8::EpiResid, pg8::StaticOrder, true, true>(F.lds + RING_OFF, g, So, E); } SEAM(11);
    if (IN(12)) {
        const float* gf = P.in[21]; const unsigned long long* ssq4 = ssq + 4 * M;
        const int gw = F.vcu * NWAVES + F.wave, NGW = F.G * NWAVES;
        for (int m = gw; m < M; m += NGW) {
            const GAS u32x2g* xr = (const GAS u32x2g*)(XB + (size_t)m * D) + F.lane; GAS f32x4* orow = (GAS f32x4*)(P.out + (size_t)m * D) + F.lane; const GAS f32x4* gr = (const GAS f32x4*)gf + F.lane;
            const float rs = pg8::rstd_of(ssq4[m]);
#pragma unroll
            for (int j = 0; j < 4; ++j) { const u32x2g xx = xr[64 * j]; const f32x4 gg = gr[64 * j];
                f32x4 v; v.x = bf_lo(xx.x); v.y = bf_hi(xx.x); v.z = bf_lo(xx.y); v.w = bf_hi(xx.y); orow[64 * j] = v * rs * gg; }
        }
    }
#undef IN
#undef SEAM
}
__global__ void __launch_bounds__(NWAVES * 64, 2) mk_fwd(Args args) { mk_body<0>(args); }
#ifdef PROBE_PHASE
#ifndef PROBE_MODE
#define PROBE_MODE 1
#endif
__global__ void __launch_bounds__(NWAVES * 64, 2) mk_probe(Args args) { mk_body<PROBE_MODE>(args); }
#endif

extern "C" void kernel_launch(void* const* d_in, const int* in_sizes, int n_in, void* d_out, int out_size, void* d_ws, size_t ws_size, hipStream_t stream) {
    static int grid = 0;
    if (grid == 0) {
        if (n_in != 22 || in_sizes[0] != M * D || out_size != M * D || ws_size < WS_END) { fprintf(stderr, "kernel_launch: unexpected shapes (n_in %d, in0 %d, out %d, ws %zu); nothing launched\n", n_in, n_in > 0 ? in_sizes[0] : -1, out_size, ws_size); grid = -1; return; }
        int dev = 0, cus = 0, per_cu = 0;
        if (hipGetDevice(&dev) != hipSuccess || hipDeviceGetAttribute(&cus, hipDeviceAttributeMultiprocessorCount, dev) != hipSuccess) { grid = -1; return; }
#ifdef PROBE_PHASE
        (void)hipFuncSetAttribute((const void*)mk_probe, hipFuncAttributeMaxDynamicSharedMemorySize, LDS_BYTES);
#endif
        if (hipFuncSetAttribute((const void*)mk_fwd, hipFuncAttributeMaxDynamicSharedMemorySize, LDS_BYTES) != hipSuccess) { fprintf(stderr, "kernel_launch: hipFuncSetAttribute failed\n"); grid = -1; return; }
        if (hipOccupancyMaxActiveBlocksPerMultiprocessor(&per_cu, (const void*)mk_fwd, NWAVES * 64, LDS_BYTES) != hipSuccess || per_cu < 1) { fprintf(stderr, "kernel_launch: occupancy query says %d blocks per CU\n", per_cu); per_cu = 1; }
        (void)hipGetLastError();
        grid = cus * 1;
    }
    if (grid < 0) return;
    if (hipMemsetAsync((char*)d_ws + WS_CTL, 0, CTL_ZERO_BYTES, stream) != hipSuccess) { fprintf(stderr, "kernel_launch: hipMemsetAsync failed\n"); return; }
    Args a{};
    for (int i = 0; i < 22; ++i) a.in[i] = (const float*)d_in[i];
    a.out = (float*)d_out; a.ws = (unsigned char*)d_ws;
#if MK_PER_PHASE
    for (int ph = 0; ph < N_PHASES; ++ph) { a.ph_lo = ph; a.ph_hi = ph + 1; a.li = ph;
        hipLaunchKernelGGL(mk_fwd, dim3(grid), dim3(NWAVES * 64), LDS_BYTES, stream, a); }
#else
    a.ph_lo = 0; a.ph_hi = N_PHASES; a.li = 0;
#ifdef PROBE_PHASE
#ifndef PROBE_MODE
#define PROBE_MODE 1
#endif
    { void* kargs0[] = {&a};
      hipError_t e0 = hipLaunchCooperativeKernel((const void*)mk_fwd, dim3(grid), dim3(NWAVES * 64), kargs0, LDS_BYTES, stream);
      if (e0 != hipSuccess) fprintf(stderr, "kernel_launch: cooperative launch failed: %s (grid %d)\n", hipGetErrorString(e0), grid);
      Args a2 = a; a2.ph_lo = PROBE_PHASE; a2.ph_hi = PROBE_PHASE + 1; a2.pad = PROBE_MODE;
      hipLaunchKernelGGL(mk_probe, dim3(grid), dim3(NWAVES * 64), LDS_BYTES, stream, a2); }
#elif defined(MK_PLAIN_LAUNCH)
    hipLaunchKernelGGL(mk_fwd, dim3(grid), dim3(NWAVES * 64), LDS_BYTES, stream, a);
#else
    void* kargs[] = {&a};
    hipError_t e = hipLaunchCooperativeKernel((const void*)mk_fwd, dim3(grid), dim3(NWAVES * 64), kargs, LDS_BYTES, stream);
    if (e != hipSuccess) fprintf(stderr, "kernel_launch: cooperative launch failed: %s (grid %d)\n", hipGetErrorString(e), grid);
#endif
#endif
}
```

```cpp
#include <hip/hip_runtime.h>
#include <cstdio>
#include <cstdint>
namespace pg8 {
#define PG8_LAS __attribute__((address_space(3)))
typedef unsigned short bf16_t;
typedef short bf16x8 __attribute__((ext_vector_type(8)));
typedef float f32x4 __attribute__((ext_vector_type(4)));
typedef unsigned u32x4 __attribute__((ext_vector_type(4)));
constexpr int BM = 256, BK = 64, HALF = 128, HTB = HALF * BK * 2  , STAGE_BYTES = 8 * HTB, NXCD = 8, WGM = 8;

__host__ __device__ __forceinline__ int lds_byte(int r, int c) { const int st = (r >> 4) * 2 + (c >> 5), rr = r & 15, cc = c & 31, ob = rr * 64 + cc * 2; return st * 1024 + (ob ^ (((ob >> 9) & 1) << 5)); }
__host__ __device__ __forceinline__ void stage_rc(int b, int& R, int& C) { const int st = b / 1024, sb = b % 1024, swz = sb ^ (((sb >> 9) & 1) << 5); R = (st >> 1) * 16 + swz / 64; C = (st & 1) * 32 + (swz % 64) / 2; }
__host__ __device__ __forceinline__ int perm32(int rho) { const int n = rho >> 4, i = rho & 15; return 8 * (i >> 2) + 4 * n + (i & 3); }

struct Unit { int pm, pn; };
struct Gemm { const bf16_t* A; const bf16_t* Bt; int M, N, K; };

struct StaticOrder {
    int nM, nN, nwg, G, c;
    __host__ __device__ void init(int M, int N, int G_, int c_) { nM = M / BM; nN = N / BM; nwg = nM * nN; G = G_; c = c_; }
    __host__ __device__ bool next(int i, Unit& u) const {
        const long L = (long)i * G + c; if (L >= nwg) return false;
        int wgid = (int)L; { const int q = nwg / NXCD, r = nwg % NXCD, xcd = wgid % NXCD, off = wgid / NXCD; wgid = (xcd < r ? xcd * (q + 1) : r * (q + 1) + (xcd - r) * q) + off; }
        const int nig = WGM * nN, gid = wgid / nig, fm = gid * WGM, gsz = (nM - fm) < WGM ? (nM - fm) : WGM;
        u.pm = fm + ((wgid % nig) % gsz); u.pn = (wgid % nig) / gsz; return true;
    }
    __device__ __forceinline__ void a_ready(const Unit&) const {}
    __device__ __forceinline__ void done(const Unit&) const {}
};

__device__ __forceinline__ unsigned cvt_pk_bf16(float lo, float hi) { unsigned r; asm volatile("v_cvt_pk_bf16_f32 %0, %1, %2" : "=v"(r) : "v"(lo), "v"(hi)); return r; }
typedef float f32x2 __attribute__((ext_vector_type(2)));
__device__ __forceinline__ f32x2 gelu_pk(f32x2 v) {
    const f32x2 av = __builtin_elementwise_abs(v), d = av * 0.2316418882f + 1.0f;
    f32x2 t; t.x = __builtin_amdgcn_rcpf(d.x); t.y = __builtin_amdgcn_rcpf(d.y);
    f32x2 q = t * 0.5307027145f + (-0.7265760135f); q = q * t + 0.7107068705f; q = q * t + (-0.142248368f); q = q * t + 0.127414796f; q = q * t;
    const f32x2 s = (v * v) * (-0.72134752044f);
    f32x2 e; e.x = __builtin_amdgcn_exp2f(s.x); e.y = __builtin_amdgcn_exp2f(s.y);
    const f32x2 m = v * (q * e), r = v - m;
    f32x2 o; o.x = v.x < 0.f ? m.x : r.x; o.y = v.y < 0.f ? m.y : r.y; return o;
}


constexpr float RMS_EPS = 1e-6f;
__device__ __forceinline__ float sigm(float x) { return __builtin_amdgcn_rcpf(1.0f + __expf(-x)); }
__device__ __forceinline__ u32x4 pack8(const f32x4 v0, const f32x4 v1) { u32x4 w; w.x = cvt_pk_bf16(v0[0], v0[1]); w.y = cvt_pk_bf16(v0[2], v0[3]); w.z = cvt_pk_bf16(v1[0], v1[1]); w.w = cvt_pk_bf16(v1[2], v1[3]); return w; }
typedef unsigned long long u64_t;
__device__ __forceinline__ float ssq_f(u64_t v) { return fmaf((float)(unsigned)(v >> 32), 4294967296.0f, (float)(unsigned)v); }
__device__ __forceinline__ float rstd_of(u64_t ssq) { return __builtin_amdgcn_rsqf(fmaf(ssq_f(ssq), 1.0f / (1024.0f * 1048576.0f), RMS_EPS)); }
__device__ __forceinline__ u64_t ssq_fix(float s) { return (u64_t)(s * 1048576.0f); }

struct EpiInL0 {
    static constexpr bool PERM = true, AFTER_DRAIN = false;
    bf16_t* UB; bf16_t* PB; const u64_t* ssq;
    __device__ __forceinline__ void operator()(const f32x4 (&acc)[2][2][4][2], const Unit& u, int wr, int wc, int fr, int fq) const {
        const int row0 = u.pm * BM + wr * 64 + fr, cw = wc * 32 + 8 * fq;
        u64_t q[2][4];
#pragma unroll
        for (int ai = 0; ai < 2; ++ai)
#pragma unroll
            for (int m = 0; m < 4; ++m) q[ai][m] = ssq[row0 + ai * HALF + m * 16];
#pragma unroll
        for (int ai = 0; ai < 2; ++ai)
#pragma unroll
            for (int m = 0; m < 4; ++m) {
                const int row = row0 + ai * HALF + m * 16;
                const float rs = rstd_of(q[ai][m]), c1 = rs * -1.4426950408889634f;
                if (u.pn < 4) {
                    f32x4 o[2];
#pragma unroll
                    for (int n = 0; n < 2; ++n)
#pragma unroll
                        for (int j = 0; j < 4; j += 2) {
                            const f32x2 a = {acc[ai][0][m][n][j], acc[ai][0][m][n][j + 1]}, g = {acc[ai][1][m][n][j], acc[ai][1][m][n][j + 1]};
                            const f32x2 t = g * c1; f32x2 e; e.x = __builtin_amdgcn_exp2f(t.x); e.y = __builtin_amdgcn_exp2f(t.y);
                            const f32x2 d = e + 1.0f; f32x2 r; r.x = __builtin_amdgcn_rcpf(d.x); r.y = __builtin_amdgcn_rcpf(d.y);
                            const f32x2 h = a * (r * rs); o[n][j] = h.x; o[n][j + 1] = h.y; }
                    *(u32x4*)(UB + (size_t)row * 512 + u.pn * 128 + cw) = pack8(o[0], o[1]);
                } else {
#pragma unroll
                    for (int bj = 0; bj < 2; ++bj) *(u32x4*)(PB + (size_t)row * 512 + (u.pn - 4) * 256 + bj * HALF + cw) = pack8(acc[ai][bj][m][0] * rs, acc[ai][bj][m][1] * rs);
                }
            }
    }
};
struct EpiResid {
    static constexpr bool PERM = true, AFTER_DRAIN = false;
    bf16_t* XB; u64_t* ssq; bf16_t* XBw; int probe_mode;
    __device__ __forceinline__ void operator()(const f32x4 (&acc)[2][2][4][2], const Unit& u, int wr, int wc, int fr, int fq) const {
        const int row0 = u.pm * BM + wr * 64 + fr, cw = u.pn * BM + wc * 32 + 8 * fq;
        if (probe_mode == 2) { if (acc[0][0][0][0][0] == 123.456f) XBw[0] = 1; return; }
        u32x4 r[2][4][2];
#pragma unroll
        for (int ai = 0; ai < 2; ++ai)
#pragma unroll
            for (int m = 0; m < 4; ++m)
#pragma unroll
                for (int bj = 0; bj < 2; ++bj) r[ai][m][bj] = *(const u32x4*)(XB + (size_t)(row0 + ai * HALF + m * 16) * 1024 + bj * HALF + cw);
#pragma unroll
        for (int ai = 0; ai < 2; ++ai)
#pragma unroll
            for (int m = 0; m < 4; ++m) {
                const int row = row0 + ai * HALF + m * 16;
                f32x2 s2 = {0.f, 0.f};
#pragma unroll
                for (int bj = 0; bj < 2; ++bj) {
                    const u32x4 rr = r[ai][m][bj];
                    const f32x2 a0 = {acc[ai][bj][m][0][0], acc[ai][bj][m][0][1]}, a1 = {acc[ai][bj][m][0][2], acc[ai][bj][m][0][3]}, a2 = {acc[ai][bj][m][1][0], acc[ai][bj][m][1][1]}, a3 = {acc[ai][bj][m][1][2], acc[ai][bj][m][1][3]};
                    const f32x2 v0 = a0 + (f32x2){__builtin_bit_cast(float, rr.x << 16), __builtin_bit_cast(float, rr.x & 0xffff0000u)};
                    const f32x2 v1 = a1 + (f32x2){__builtin_bit_cast(float, rr.y << 16), __builtin_bit_cast(float, rr.y & 0xffff0000u)};
                    const f32x2 v2 = a2 + (f32x2){__builtin_bit_cast(float, rr.z << 16), __builtin_bit_cast(float, rr.z & 0xffff0000u)};
                    const f32x2 v3 = a3 + (f32x2){__builtin_bit_cast(float, rr.w << 16), __builtin_bit_cast(float, rr.w & 0xffff0000u)};
                    u32x4 w; w.x = cvt_pk_bf16(v0.x, v0.y); w.y = cvt_pk_bf16(v1.x, v1.y); w.z = cvt_pk_bf16(v2.x, v2.y); w.w = cvt_pk_bf16(v3.x, v3.y);
                    *(u32x4*)(XBw + ((size_t)row * 1024 + bj * HALF + cw)) = w;
                    s2 = v0 * v0 + s2; s2 = v1 * v1 + s2; s2 = v2 * v2 + s2; s2 = v3 * v3 + s2;
                }
                float s = s2.x + s2.y;
                s += __shfl_xor(s, 16); s += __shfl_xor(s, 32);
                if (fq == 0) atomicAdd(ssq + row, ssq_fix(s));
            }
    }
};
struct EpiSwiGLU {
    static constexpr bool PERM = true, AFTER_DRAIN = false;
    bf16_t* H; const u64_t* ssq; int probe_mode;
    __device__ __forceinline__ void operator()(const f32x4 (&acc)[2][2][4][2], const Unit& u, int wr, int wc, int fr, int fq) const {
        const int row0 = u.pm * BM + wr * 64 + fr, cw = wc * 32 + 8 * fq;
        if (probe_mode == 2) { if (acc[0][0][0][0][0] == 123.456f) H[0] = 1; return; }
        u64_t q[2][4];
#pragma unroll
        for (int ai = 0; ai < 2; ++ai)
#pragma unroll
            for (int m = 0; m < 4; ++m) q[ai][m] = ssq[row0 + ai * HALF + m * 16];
#pragma unroll
        for (int ai = 0; ai < 2; ++ai)
#pragma unroll
            for (int m = 0; m < 4; ++m) {
                const int row = row0 + ai * HALF + m * 16;
                const float rs = rstd_of(q[ai][m]), c1 = rs * -1.4426950408889634f, rs2 = rs * rs;
                f32x4 o[2];
#pragma unroll
                for (int n = 0; n < 2; ++n)
#pragma unroll
                    for (int j = 0; j < 4; j += 2) {
                        const f32x2 g = {acc[ai][0][m][n][j], acc[ai][0][m][n][j + 1]}, up = {acc[ai][1][m][n][j], acc[ai][1][m][n][j + 1]};
                        const f32x2 t = g * c1; f32x2 e; e.x = __builtin_amdgcn_exp2f(t.x); e.y = __builtin_amdgcn_exp2f(t.y);
                        const f32x2 d = e + 1.0f; f32x2 r; r.x = __builtin_amdgcn_rcpf(d.x); r.y = __builtin_amdgcn_rcpf(d.y);
                        const f32x2 h = (g * up) * (r * rs2); o[n][j] = h.x; o[n][j + 1] = h.y; }
                *(u32x4*)(H + (size_t)row * 2816 + u.pn * 128 + cw) = pack8(o[0], o[1]);
            }
    }
};
struct EpiPQT {
    static constexpr bool PERM = true, AFTER_DRAIN = false;
    bf16_t* PQT; const u64_t* ssq;
    __device__ __forceinline__ void operator()(const f32x4 (&acc)[2][2][4][2], const Unit& u, int wr, int wc, int fr, int fq) const {
        const int tok0 = u.pn * BM + wc * 32 + 8 * fq, b = (u.pn * BM) >> 12;
#pragma unroll
        for (int bj = 0; bj < 2; ++bj) {
            u64_t q[8];
#pragma unroll
            for (int j = 0; j < 8; ++j) q[j] = ssq[tok0 + bj * HALF + j];
            f32x4 rs0, rs1;
#pragma unroll
            for (int j = 0; j < 4; ++j) { rs0[j] = rstd_of(q[j]); rs1[j] = rstd_of(q[4 + j]); }
#pragma unroll
            for (int ai = 0; ai < 2; ++ai)
#pragma unroll
                for (int m = 0; m < 4; ++m) {
                    const int r = u.pm * BM + ai * HALF + wr * 64 + m * 16 + fr, pq = r >> 9, ch = r & 511;
                    bf16_t* base = PQT + ((size_t)(b * 512 + ch) * 2 + pq) * 4096;
                    *(u32x4*)(base + ((tok0 + bj * HALF) & 4095)) = pack8(acc[ai][bj][m][0] * rs0, acc[ai][bj][m][1] * rs1);
                }
        }
    }
};
struct EpiGeluUV {
    static constexpr bool PERM = true, AFTER_DRAIN = false;
    bf16_t* U; bf16_t* V; const u64_t* ssq;
    __device__ __forceinline__ void operator()(const f32x4 (&acc)[2][2][4][2], const Unit& u, int wr, int wc, int fr, int fq) const {
        const int row0 = u.pm * BM + wr * 64 + fr, cw = wc * 32 + 8 * fq;
        bf16_t* dst = (u.pn < 2) ? U : V; const int colb = (u.pn & 1) * BM;
        u64_t q[2][4];
#pragma unroll
        for (int ai = 0; ai < 2; ++ai)
#pragma unroll
            for (int m = 0; m < 4; ++m) q[ai][m] = ssq[row0 + ai * HALF + m * 16];
#pragma unroll
        for (int ai = 0; ai < 2; ++ai)
#pragma unroll
            for (int m = 0; m < 4; ++m) {
                const int row = row0 + ai * HALF + m * 16;
                const float rs = rstd_of(q[ai][m]);
#pragma unroll
                for (int bj = 0; bj < 2; ++bj) {
                    const f32x4 v0 = acc[ai][bj][m][0] * rs, v1 = acc[ai][bj][m][1] * rs;
                    const f32x2 a = gelu_pk((f32x2){v0[0], v0[1]}), bq = gelu_pk((f32x2){v0[2], v0[3]}), c = gelu_pk((f32x2){v1[0], v1[1]}), d = gelu_pk((f32x2){v1[2], v1[3]});
                    *(u32x4*)(dst + (size_t)row * 512 + colb + bj * HALF + cw) = pack8((f32x4){a.x, a.y, bq.x, bq.y}, (f32x4){c.x, c.y, d.x, d.y});
                }
            }
    }
};
struct EpiDFT2 {
    static constexpr bool PERM = true, AFTER_DRAIN = false;
    bf16_t* AM;
    __device__ __forceinline__ void operator()(const f32x4 (&acc)[2][2][4][2], const Unit& u, int wr, int wc, int fr, int fq) const {
#pragma unroll
        for (int bj = 0; bj < 2; ++bj) {
            const int n = u.pn * BM + bj * HALF + wc * 32 + 8 * fq, b = n >> 13, t1 = (n >> 9) & 15, ch = n & 511;
            bf16_t* base = AM + (size_t)(b * 4096 + t1) * 1024 + ch;
#pragma unroll
            for (int ai = 0; ai < 2; ++ai)
#pragma unroll
                for (int m = 0; m < 4; ++m) { const int t2 = ai * HALF + wr * 64 + m * 16 + fr;
                    *(u32x4*)(base + (size_t)(16 * t2) * 1024) = pack8(acc[ai][bj][m][0], acc[ai][bj][m][1]); }
        }
    }
};

template <class Epi, class Sched, bool ALIGN_EPI = false, bool SP2 = false>
__device__ __forceinline__ void gemm_phase(PG8_LAS unsigned char* lds, const Gemm g, const Sched& S, const Epi& E) {
    const int tid = threadIdx.x, wid = __builtin_amdgcn_readfirstlane(tid >> 6), lane = tid & 63, wr = wid >> 2, wc = wid & 3, fr = lane & 15, fq = lane >> 4;
    const int K = g.K, nt = K / BK;
    unsigned voffA[2], voffB[2];
#pragma unroll
    for (int i = 0; i < 2; ++i) { int R, C; stage_rc(tid * 16 + i * 8192, R, C); const int Rb = Epi::PERM ? ((R & ~31) + perm32(R & 31)) : R;
        voffA[i] = (unsigned)(R * K + C) * 2u; voffB[i] = (unsigned)(Rb * K + C) * 2u; }
    const size_t kstep = (size_t)(BK * 2);
    const size_t hstep = (size_t)HALF * K * 2;
    const size_t tstep = 2 * hstep;
    const unsigned ldsw = (unsigned)wid * 1024u;
    const int aoff = lds_byte(wr * 64 + fr, fq * 8), boff = lds_byte(wc * 32 + fr, fq * 8);
#define PG8_SA(b, h) (((b) * 2 + (h)) * HTB)
#define PG8_SB(b, h) ((4 + (b) * 2 + (h)) * HTB)
#define PG8_STAGE(bufoff, gbase, voff) do { _Pragma("unroll") for (int _i = 0; _i < 2; ++_i) \
        __builtin_amdgcn_global_load_lds((const unsigned*)((const char*)(gbase) + (voff)[_i]), (PG8_LAS unsigned*)(lds + (bufoff) + ldsw + _i * 8192), 16, 0, 0); } while (0)
#define PG8_LDA(dst, b, h) do { _Pragma("unroll") for (int m = 0; m < 4; ++m) _Pragma("unroll") for (int k = 0; k < 2; ++k) dst[m][k] = *(const PG8_LAS bf16x8*)(lds + PG8_SA(b, h) + aoff + m * 2048 + k * 1024); } while (0)
#define PG8_LDB(dst, b, h) do { _Pragma("unroll") for (int n = 0; n < 2; ++n) _Pragma("unroll") for (int k = 0; k < 2; ++k) dst[n][k] = *(const PG8_LAS bf16x8*)(lds + PG8_SB(b, h) + boff + n * 2048 + k * 1024); } while (0)
#define PG8_MMA(ai, bj, At, Bt) do { __builtin_amdgcn_s_setprio(1); _Pragma("unroll") for (int m = 0; m < 4; ++m) _Pragma("unroll") for (int n = 0; n < 2; ++n) _Pragma("unroll") for (int k = 0; k < 2; ++k) \
        acc[ai][bj][m][n] = __builtin_amdgcn_mfma_f32_16x16x32_bf16(Bt[n][k], At[m][k], acc[ai][bj][m][n], 0, 0, 0); __builtin_amdgcn_s_setprio(0); } while (0)
#define PG8_WAIT_V(n) asm volatile("s_waitcnt vmcnt(" #n ")" ::: "memory")
#define PG8_WAIT_L(n) asm volatile("s_waitcnt lgkmcnt(" #n ")" ::: "memory")
#define PG8_BAR __builtin_amdgcn_s_barrier()
#define PG8_SCHED __builtin_amdgcn_sched_barrier(0)
    Unit cur, nxt; int ui = 0;
    if (!S.next(0, cur)) return;
    f32x4 acc[2][2][4][2];
#pragma unroll
    for (int a = 0; a < 2; ++a)
#pragma unroll
        for (int b = 0; b < 2; ++b)
#pragma unroll
            for (int m = 0; m < 4; ++m)
#pragma unroll
                for (int n = 0; n < 2; ++n) acc[a][b][m][n] = (f32x4){0.f, 0.f, 0.f, 0.f};
    bf16x8 At[4][2], B0[2][2], B1[2][2];
    const char* cA = (const char*)g.A + (size_t)cur.pm * tstep; const char* cB = (const char*)g.Bt + (size_t)cur.pn * tstep;
    S.a_ready(cur);
    if constexpr (SP2) {
        PG8_STAGE(PG8_SB(0, 0), cB, voffB); PG8_STAGE(PG8_SB(0, 1), cB + hstep, voffB); PG8_STAGE(PG8_SA(0, 0), cA, voffA); PG8_STAGE(PG8_SA(0, 1), cA + hstep, voffA);
        if (wr == 1) PG8_BAR;
        PG8_WAIT_V(2); PG8_BAR;
        PG8_STAGE(PG8_SB(1, 0), cB + kstep, voffB); PG8_STAGE(PG8_SA(1, 0), cA + kstep, voffA); PG8_STAGE(PG8_SB(1, 1), cB + hstep + kstep, voffB);
        PG8_WAIT_V(6); PG8_BAR;
    } else {
        PG8_STAGE(PG8_SB(0, 0), cB, voffB); PG8_STAGE(PG8_SA(0, 0), cA, voffA); PG8_STAGE(PG8_SB(0, 1), cB + hstep, voffB); PG8_STAGE(PG8_SA(0, 1), cA + hstep, voffA);
        if (wr == 1) PG8_BAR;
        PG8_WAIT_V(4); PG8_BAR;
        PG8_STAGE(PG8_SB(1, 0), cB + kstep, voffB); PG8_STAGE(PG8_SA(1, 0), cA + kstep, voffA); PG8_STAGE(PG8_SB(1, 1), cB + hstep + kstep, voffB);
        PG8_WAIT_V(6); PG8_BAR;
    }
    for (;;) {
        const bool has_next = S.next(ui + 1, nxt);
        const char* nA = has_next ? (const char*)g.A + (size_t)nxt.pm * tstep : cA; const char* nB = has_next ? (const char*)g.Bt + (size_t)nxt.pn * tstep : cB;
        for (int t = 0; t < nt; t += 2) {
            const bool last = (t == nt - 2);
            const char* a1 = cA + (size_t)(t + 1) * kstep;
            const char* a2 = last ? nA : cA + (size_t)(t + 2) * kstep; const char* b2 = last ? nB : cB + (size_t)(t + 2) * kstep;
            const char* a3 = a2 + kstep; const char* b3 = b2 + kstep;
            if (last && has_next) S.a_ready(nxt);
            if constexpr (SP2) {
            PG8_LDB(B0, 0, 0); PG8_LDB(B1, 0, 1); PG8_SCHED; PG8_LDA(At, 0, 0); PG8_STAGE(PG8_SA(1, 1), a1 + hstep, voffA);
            PG8_WAIT_V(8); PG8_WAIT_L(0); PG8_BAR; PG8_MMA(0, 0, At, B0); PG8_MMA(0, 1, At, B1); PG8_BAR; PG8_SCHED;
            PG8_LDA(At, 0, 1); PG8_STAGE(PG8_SB(0, 0), b2, voffB); PG8_STAGE(PG8_SB(0, 1), b2 + hstep, voffB); PG8_STAGE(PG8_SA(0, 0), a2, voffA);
            PG8_WAIT_V(8); PG8_WAIT_L(0); PG8_BAR; PG8_MMA(1, 0, At, B0); PG8_MMA(1, 1, At, B1); PG8_BAR; PG8_SCHED;
            PG8_LDB(B0, 1, 0); PG8_LDB(B1, 1, 1); PG8_SCHED; PG8_LDA(At, 1, 0); PG8_STAGE(PG8_SA(0, 1), a2 + hstep, voffA);
            PG8_WAIT_V(8); PG8_WAIT_L(0); PG8_BAR; PG8_MMA(0, 0, At, B0); PG8_MMA(0, 1, At, B1); PG8_BAR; PG8_SCHED;
            PG8_LDA(At, 1, 1); PG8_STAGE(PG8_SB(1, 0), b3, voffB); PG8_STAGE(PG8_SB(1, 1), b3 + hstep, voffB); PG8_STAGE(PG8_SA(1, 0), a3, voffA);
            PG8_WAIT_V(8); PG8_WAIT_L(0); PG8_BAR; PG8_MMA(1, 0, At, B0); PG8_MMA(1, 1, At, B1); PG8_BAR; PG8_SCHED;
            } else {
            PG8_LDB(B0, 0, 0); PG8_SCHED; PG8_LDA(At, 0, 0); PG8_STAGE(PG8_SA(1, 1), a1 + hstep, voffA);
            PG8_WAIT_L(8); PG8_BAR; PG8_WAIT_L(0); PG8_MMA(0, 0, At, B0); PG8_BAR; PG8_SCHED;
            PG8_LDB(B1, 0, 1); PG8_STAGE(PG8_SB(0, 0), b2, voffB);
            PG8_BAR; PG8_WAIT_L(0); PG8_MMA(0, 1, At, B1); PG8_BAR;
            PG8_LDA(At, 0, 1); PG8_STAGE(PG8_SA(0, 0), a2, voffA);
            PG8_BAR; PG8_WAIT_L(0); PG8_MMA(1, 0, At, B0); PG8_BAR; PG8_SCHED;
            PG8_STAGE(PG8_SB(0, 1), b2 + hstep, voffB);
            PG8_WAIT_V(6); PG8_BAR; PG8_MMA(1, 1, At, B1); PG8_BAR;
            PG8_LDB(B0, 1, 0); PG8_SCHED; PG8_LDA(At, 1, 0); PG8_STAGE(PG8_SA(0, 1), a2 + hstep, voffA);
            PG8_WAIT_L(8); PG8_BAR; PG8_WAIT_L(0); PG8_MMA(0, 0, At, B0); PG8_BAR; PG8_SCHED;
            PG8_LDB(B1, 1, 1); PG8_STAGE(PG8_SB(1, 0), b3, voffB);
            PG8_BAR; PG8_WAIT_L(0); PG8_MMA(0, 1, At, B1); PG8_BAR;
            PG8_LDA(At, 1, 1); PG8_STAGE(PG8_SA(1, 0), a3, voffA);
            PG8_BAR; PG8_WAIT_L(0); PG8_MMA(1, 0, At, B0); PG8_BAR; PG8_SCHED;
            PG8_STAGE(PG8_SB(1, 1), b3 + hstep, voffB);
            PG8_WAIT_V(6); PG8_BAR; PG8_MMA(1, 1, At, B1); PG8_BAR;
            }
        }
        if constexpr (ALIGN_EPI) { if (wr == 0) PG8_BAR; }
        if constexpr (!Epi::AFTER_DRAIN) { E(acc, cur, wr, wc, fr, fq); S.done(cur); }
        if (!has_next) break;
#pragma unroll
        for (int a = 0; a < 2; ++a)
#pragma unroll
            for (int b = 0; b < 2; ++b)
#pragma unroll
                for (int m = 0; m < 4; ++m)
#pragma unroll
                    for (int n = 0; n < 2; ++n) acc[a][b][m][n] = (f32x4){0.f, 0.f, 0.f, 0.f};
        cur = nxt; cA = nA; cB = nB; ++ui;
        if constexpr (ALIGN_EPI) { if (wr == 1) PG8_BAR; }
    }
    PG8_WAIT_V(0);
    if constexpr (!ALIGN_EPI) { if (wr == 0) PG8_BAR; }
    PG8_BAR;
    if constexpr (Epi::AFTER_DRAIN) { E.fused(acc, cur, wr, wc, fr, fq, lds, wid, lane); S.done(cur); }
#undef PG8_SA
#undef PG8_SB
#undef PG8_STAGE
#undef PG8_LDA
#undef PG8_LDB
#undef PG8_MMA
#undef PG8_WAIT_V
#undef PG8_WAIT_L
#undef PG8_BAR
#undef PG8_SCHED
}
}
#define GAS __attribute__((address_space(1)))
#define LAS __attribute__((address_space(3)))
typedef unsigned short bf16;
typedef unsigned v4u __attribute__((ext_vector_type(4)));
typedef float f32x4 __attribute__((ext_vector_type(4)));
typedef short bf16x8 __attribute__((ext_vector_type(8)));
typedef GAS unsigned gu32;
typedef GAS unsigned long long gu64;
#define RLX_AGENT __ATOMIC_RELAXED, __HIP_MEMORY_SCOPE_AGENT
#define LDS_WAIT() asm volatile("s_waitcnt lgkmcnt(0)" ::: "memory")
#define VM_WAIT() asm volatile("s_waitcnt vmcnt(0)" ::: "memory")
__device__ __forceinline__ unsigned long long rt() { return __builtin_amdgcn_s_memrealtime(); }
__device__ __forceinline__ unsigned f2bf(float f) { unsigned u = __builtin_bit_cast(unsigned, f); return (u + 0x7fffu + ((u >> 16) & 1u)) >> 16; }
__device__ __forceinline__ unsigned pk2(float lo, float hi) { return f2bf(lo) | (f2bf(hi) << 16); }

#define XB_TMO      128
#define XB_XCNT(j)  (256  + 64 * (j))
#define XB_XSUB(j)  (1280 + 64 * (j))
#define XB_XGEN(j)  (2304 + 64 * (j))
#define XB_TOP      3328
#define XB_TOPGEN   3392
#define XCD_BAR_WORDS 3456
#define XB_SPIN_CAP (1u << 18)

__device__ __forceinline__ unsigned xb_ld(unsigned* p)              { return __hip_atomic_load(p, __ATOMIC_RELAXED, __HIP_MEMORY_SCOPE_AGENT); }
__device__ __forceinline__ unsigned xb_add(unsigned* p, unsigned v) { return __hip_atomic_fetch_add(p, v, __ATOMIC_RELAXED, __HIP_MEMORY_SCOPE_AGENT); }
__device__ __forceinline__ unsigned xb_xcc_id() { return (unsigned)__builtin_amdgcn_s_getreg((3 << 11) | 20) & 0xFu; }
#define XB_SPIN(cond, bar) do { unsigned _sp = 0; while (cond) { __builtin_amdgcn_s_sleep(1); \
    if ((++_sp & 255u) == 0u) { if (xb_ld(&(bar)[XB_TMO])) break; if (_sp > XB_SPIN_CAP) { atomicAdd(&(bar)[XB_TMO], 1u); break; } } } } while (0)

struct XcdBarrier {
    unsigned* bar; unsigned x;
    volatile LAS unsigned* st;
};

__device__ __forceinline__ XcdBarrier xcd_barrier_post(unsigned* bar, volatile LAS unsigned* st) {
    XcdBarrier b; b.bar = bar; b.x = xb_xcc_id(); b.st = st;
    if (threadIdx.x == 0) (void)xb_add(&bar[XB_XCNT(b.x)], 1u);
    return b;
}
__device__ __forceinline__ void xcd_barrier_complete(unsigned* bar, unsigned x, unsigned& nloc, unsigned& nx) {
    const unsigned G = gridDim.x * gridDim.y * gridDim.z;
    unsigned sum, cnt, mine, sp = 0u;
    for (;;) {
        sum = 0u; cnt = 0u; mine = 0u;
#pragma unroll
        for (unsigned j = 0; j < 16; ++j) { const unsigned c = xb_ld(&bar[XB_XCNT(j)]); sum += c; cnt += (c > 0u) ? 1u : 0u; mine = (j == x) ? c : mine; }
        if (sum == G) break;
        __builtin_amdgcn_s_sleep(1);
        if ((++sp & 255u) == 0u) { if (xb_ld(&bar[XB_TMO])) break; if (sp > XB_SPIN_CAP) { atomicAdd(&bar[XB_TMO], 1u); break; } }
    }
    nloc = mine > 0u ? mine : 1u; nx = cnt > 0u ? cnt : 1u;
}

__device__ __forceinline__ void xcd_barrier(const XcdBarrier& b) {
    asm volatile("s_waitcnt vmcnt(0)" ::: "memory");
    __syncthreads();
    if (threadIdx.x == 0) {
        unsigned* bar = b.bar;
        __builtin_amdgcn_s_waitcnt(0);
        unsigned nloc = b.st[0], nx = b.st[1];
        if (nloc == 0u) { xcd_barrier_complete(bar, b.x, nloc, nx); b.st[0] = nloc; b.st[1] = nx; }
        const unsigned old = xb_add(&bar[XB_XSUB(b.x)], 1u);
        const unsigned gen = old / nloc;
        if (old + 1u == (gen + 1u) * nloc) {
            __builtin_amdgcn_fence(__ATOMIC_RELEASE, "agent");
            asm volatile("s_waitcnt vmcnt(0)" ::: "memory");
            const unsigned og = xb_add(&bar[XB_TOP], 1u);
            const unsigned tg = og / nx;
            if (og + 1u == (tg + 1u) * nx) xb_add(&bar[XB_TOPGEN], 1u);
            else XB_SPIN(xb_ld(&bar[XB_TOPGEN]) == tg, bar);
            __builtin_amdgcn_fence(__ATOMIC_ACQUIRE, "agent");
            xb_add(&bar[XB_XGEN(b.x)], 1u);
            asm volatile("s_waitcnt vmcnt(0)" ::: "memory");
        } else {
            XB_SPIN(xb_ld(&bar[XB_XGEN(b.x)]) == gen, bar);
            __builtin_amdgcn_fence(__ATOMIC_ACQUIRE, "agent");
            asm volatile("s_waitcnt vmcnt(0)" ::: "memory");
        }
    }
    __syncthreads();
}

constexpr int NWAVES = 8;
#ifndef MK_PER_PHASE
#define MK_PER_PHASE 0
#endif
constexpr int N_PHASES = 13;

constexpr int NB = 8, S = 4096, D = 1024, FF = 2816, M = NB * S;
typedef float f32x2g __attribute__((ext_vector_type(2)));
typedef unsigned u32x2g __attribute__((ext_vector_type(2)));

constexpr size_t MiB = 1u << 20;
constexpr size_t WS_CTL = 0, CTL_ZERO_BYTES = 1 * MiB;
constexpr size_t WS_SSQ = 46 * MiB + 512 * 1024;
constexpr size_t WS_WIN0 = 2 * MiB;
constexpr size_t WS_WOUT0 = 5 * MiB;
constexpr size_t WS_WGU0 = 7 * MiB;
constexpr size_t WS_WDN0 = 18 * MiB;
constexpr size_t WS_WPQ1 = 24 * MiB;
constexpr size_t WS_WUV1 = 26 * MiB;
constexpr size_t WS_WOUT1 = 28 * MiB;
constexpr size_t WS_WGU1 = 30 * MiB;
constexpr size_t WS_WDN1 = 41 * MiB;
constexpr size_t WS_DFT = 48 * MiB;
constexpr size_t WS_XB = 112 * MiB;
constexpr size_t WS_AM = 176 * MiB;
constexpr size_t WS_H = 240 * MiB;
constexpr size_t WS_UB = WS_H, WS_PB = WS_H + 32 * MiB;
constexpr size_t WS_PQT = WS_H, WS_U1 = WS_H + 64 * MiB, WS_V1 = WS_H + 96 * MiB, WS_ZP = WS_H + 128 * MiB;
constexpr size_t WS_END = 432 * MiB;
static_assert(WS_H + (size_t)M * FF * 2 <= WS_END && WS_V1 + (size_t)M * 512 * 2 <= WS_ZP && WS_ZP + 64 * MiB <= WS_END, "d_ws map");
constexpr int CW_BAR = 4096;

constexpr int RING_OFF = 0, RING_BYTES = 131072;
constexpr int LDSCTL_OFF = RING_BYTES, MISC_OFF = LDSCTL_OFF + 320;
constexpr int LDS_BYTES = 147456;

struct Frame {
    LAS unsigned char* lds;
    volatile LAS unsigned* MISC;
    gu32* ctl;
    int tid, lane, wave;
    int vcu, G;
};
__device__ __forceinline__ float wave_sum(float v) {
#pragma unroll
    for (int o = 1; o < 64; o <<= 1) v += __shfl_xor(v, o);
    return v;
}
__device__ __forceinline__ float bf_lo(unsigned x) { return __builtin_bit_cast(float, x << 16); }
__device__ __forceinline__ float bf_hi(unsigned x) { return __builtin_bit_cast(float, x & 0xffff0000u); }
#define WG_BAR() do { asm volatile("s_waitcnt vmcnt(0) lgkmcnt(0)" ::: "memory"); __builtin_amdgcn_s_barrier(); asm volatile("" ::: "memory"); } while (0)
#define LDS_BAR() do { asm volatile("s_waitcnt lgkmcnt(0)" ::: "memory"); __builtin_amdgcn_s_barrier(); asm volatile("" ::: "memory"); } while (0)

__device__ __forceinline__ void p0_transpose_item(const float* W, int ldw, const float* gk, bf16* WT, int ldt, int k0, int n0, int dk0, int drow0, LAS float* scr, int lane) {
    float v[32];
    const float* wp = W + (size_t)(k0 + (lane >> 5)) * ldw + n0 + (lane & 31);
#pragma unroll
    for (int i = 0; i < 32; ++i) v[i] = wp[(size_t)(2 * i) * ldw];
    const int c = lane & 7;
    f32x4 g0 = {1.f, 1.f, 1.f, 1.f}, g1 = {1.f, 1.f, 1.f, 1.f};
    if (gk) { g0 = *(const GAS f32x4*)(gk + k0 + 8 * c); g1 = *(const GAS f32x4*)(gk + k0 + 8 * c + 4); }
#pragma unroll
    for (int i = 0; i < 32; ++i) scr[(2 * i + (lane >> 5)) * 33 + (lane & 31)] = v[i];
    LDS_WAIT(); asm volatile("" ::: "memory");
#pragma unroll
    for (int j = 0; j < 4; ++j) { const int n = (lane >> 3) + 8 * j; const LAS float* s = scr + (8 * c) * 33 + n;
        v4u o; o.x = pk2(s[0 * 33] * g0.x, s[1 * 33] * g0.y); o.y = pk2(s[2 * 33] * g0.z, s[3 * 33] * g0.w); o.z = pk2(s[4 * 33] * g1.x, s[5 * 33] * g1.y); o.w = pk2(s[6 * 33] * g1.z, s[7 * 33] * g1.w);
        *(GAS v4u*)(WT + (size_t)(drow0 + n) * ldt + dk0 + 8 * c) = o; }
    LDS_WAIT(); asm volatile("" ::: "memory");
}
__device__ __forceinline__ void p0_job(const float* W, int ldw, const float* gk, int kbeg, int kext, int ncol0, int next, bf16* WT, int ldt, int dkbase, int mode, int half_or_off,
                                       LAS float* scr, int lane, int gw, int NGW, int& cursor) {
    const int nkb = kext / 64, nnb = next / 32, nitems = nkb * nnb;
    int first = (gw - (cursor % NGW) + NGW) % NGW;
    for (int it = first; it < nitems; it += NGW) {
        const int kb = it / nnb, nb = it % nnb, nrel = 32 * nb;
        const int drow0 = (mode == 0) ? (half_or_off + nrel) : (256 * (nrel >> 7) + 128 * half_or_off + (nrel & 127));
        p0_transpose_item(W, ldw, gk, WT, ldt, kbeg + 64 * kb, ncol0 + nrel, dkbase + 64 * kb, drow0, scr, lane);
    }
    cursor += nitems;
}
__device__ __forceinline__ void p0_fold_item(const float* L, int lrow0, const float* sc, const float* Rm, bf16* out, int dk0, float scale, int dw, int lane) {
    const int d = 64 * dw + lane;
    float l0[8], l1[8];
    { const float s0 = sc ? sc[lane] : 1.f, s1 = sc ? sc[64 + lane] : 1.f;
#pragma unroll
      for (int j = 0; j < 8; ++j) { l0[j] = L[(size_t)(lrow0 + j) * 128 + lane] * s0; l1[j] = L[(size_t)(lrow0 + j) * 128 + 64 + lane] * s1; } }
    float acc[8];
#pragma unroll
    for (int j = 0; j < 8; ++j) acc[j] = 0.f;
#pragma unroll
    for (int cb = 0; cb < 4; ++cb) {
        float r[32];
#pragma unroll
        for (int i = 0; i < 32; ++i) r[i] = Rm[(size_t)(cb * 32 + i) * 1024 + d];
#pragma unroll
        for (int i = 0; i < 32; ++i) { const int cp = cb * 32 + i;
#pragma unroll
            for (int j = 0; j < 8; ++j) { const float lv = __builtin_bit_cast(float, __builtin_amdgcn_readlane(__builtin_bit_cast(int, cp < 64 ? l0[j] : l1[j]), cp & 63)); acc[j] = fmaf(lv, r[i], acc[j]); } }
    }
    v4u o; o.x = pk2(acc[0] * scale, acc[1] * scale); o.y = pk2(acc[2] * scale, acc[3] * scale); o.z = pk2(acc[4] * scale, acc[5] * scale); o.w = pk2(acc[6] * scale, acc[7] * scale);
    *(GAS v4u*)(out + (size_t)d * 1024 + dk0) = o;
}
__device__ __forceinline__ void p0_pq_item(const float* Win1, const float* g1, bf16* WPQ, int h, int half, int k0, const LAS float* tab, int lane) {
    const int cp = 64 * half + lane;
    float ap[8], aq[8], w0[8], w1[8];
#pragma unroll
    for (int j = 0; j < 8; ++j) { const float g = g1[k0 + j]; ap[j] = 0.f; aq[j] = 0.f; w0[j] = Win1[(size_t)(k0 + j) * 1536 + h * 128 + lane] * g; w1[j] = Win1[(size_t)(k0 + j) * 1536 + h * 128 + 64 + lane] * g; }
#pragma unroll 8
    for (int c = 0; c < 128; ++c) {
        const int ph = c * cp;
        const float cs = tab[ph & 127], sn = tab[(ph - 32) & 127];
#pragma unroll
        for (int j = 0; j < 8; ++j) { const float w = __builtin_bit_cast(float, __builtin_amdgcn_readlane(__builtin_bit_cast(int, c < 64 ? w0[j] : w1[j]), c & 63)); ap[j] = fmaf(w, cs, ap[j]); aq[j] = fmaf(w, sn, aq[j]); }
    }
    v4u o; o.x = pk2(ap[0], ap[1]); o.y = pk2(ap[2], ap[3]); o.z = pk2(ap[4], ap[5]); o.w = pk2(ap[6], ap[7]);
    *(GAS v4u*)(WPQ + (size_t)(h * 128 + cp) * 1024 + k0) = o;
    o.x = pk2(aq[0], aq[1]); o.y = pk2(aq[2], aq[3]); o.z = pk2(aq[4], aq[5]); o.w = pk2(aq[6], aq[7]);
    *(GAS v4u*)(WPQ + (size_t)(512 + h * 128 + cp) * 1024 + k0) = o;
}

struct Ptrs {
    const float* in[22]; float* out; unsigned char* ws;
};

__device__ __forceinline__ void p0_prologue(Frame& F, const Ptrs& P) {
    const float* x = P.in[0]; const float* mix_g = P.in[1]; const float* ffn_g = P.in[2];
    const float* ev_w_in = P.in[3]; const float* ev_pool_w = P.in[8]; const float* ev_pool_scale = P.in[9]; const float* ev_w_out = P.in[10];
    const float* od_w_in = P.in[11]; const float* od_fourier_w = P.in[12]; const float* od_w_out = P.in[17];
    const float* w_gate = P.in[18]; const float* w_up = P.in[19]; const float* w_down = P.in[20];
    unsigned char* ws = P.ws;
    LAS float* scr = (LAS float*)(F.lds + RING_OFF + F.wave * 8448);
    LAS float* CT = (LAS float*)(F.lds + RING_OFF + 69632);
    LAS float* tab = (LAS float*)(F.lds + RING_OFF + 69632 + 16384);
    for (int i = F.tid; i < 4096; i += NWAVES * 64) CT[i] = cospif((float)i * (1.0f / 2048.0f));
    if (F.tid < 128) tab[F.tid] = cospif((float)F.tid * (1.0f / 64.0f));
    WG_BAR();
    const int gw = F.vcu * NWAVES + F.wave, NGW = F.G * NWAVES, lane = F.lane;
    { unsigned long long* z = (unsigned long long*)(ws + WS_SSQ) + M; const int gt = F.vcu * NWAVES * 64 + F.tid, NT = F.G * NWAVES * 64;
      for (int i = gt; i < 4 * M; i += NT) z[i] = 0ull; }
    int cur = 0;
    p0_job(ev_w_in, 1536, mix_g, 0, 1024, 0, 512, (bf16*)(ws + WS_WIN0), 1024, 0, 1, 0, scr, lane, gw, NGW, cur);
    p0_job(ev_w_in, 1536, mix_g, 0, 1024, 512, 512, (bf16*)(ws + WS_WIN0), 1024, 0, 1, 1, scr, lane, gw, NGW, cur);
    p0_job(ev_w_in, 1536, mix_g, 0, 1024, 1024, 512, (bf16*)(ws + WS_WIN0), 1024, 0, 0, 1024, scr, lane, gw, NGW, cur);
    p0_job(ev_w_out, 1024, nullptr, 0, 512, 0, 1024, (bf16*)(ws + WS_WOUT0), 1024, 0, 0, 0, scr, lane, gw, NGW, cur);
    p0_job(w_gate, FF, ffn_g, 0, 1024, 0, FF, (bf16*)(ws + WS_WGU0), 1024, 0, 1, 0, scr, lane, gw, NGW, cur);
    p0_job(w_up, FF, ffn_g, 0, 1024, 0, FF, (bf16*)(ws + WS_WGU0), 1024, 0, 1, 1, scr, lane, gw, NGW, cur);
    p0_job(w_down, 1024, nullptr, 0, FF, 0, 1024, (bf16*)(ws + WS_WDN0), FF, 0, 0, 0, scr, lane, gw, NGW, cur);
    p0_job(od_w_in, 1536, mix_g + D, 0, 1024, 512, 1024, (bf16*)(ws + WS_WUV1), 1024, 0, 0, 0, scr, lane, gw, NGW, cur);
    p0_job(od_w_out, 1024, nullptr, 512, 512, 0, 1024, (bf16*)(ws + WS_WOUT1), 1024, 512, 0, 0, scr, lane, gw, NGW, cur);
    p0_job(w_gate + (size_t)D * FF, FF, ffn_g + D, 0, 1024, 0, FF, (bf16*)(ws + WS_WGU1), 1024, 0, 1, 0, scr, lane, gw, NGW, cur);
    p0_job(w_up + (size_t)D * FF, FF, ffn_g + D, 0, 1024, 0, FF, (bf16*)(ws + WS_WGU1), 1024, 0, 1, 1, scr, lane, gw, NGW, cur);
    p0_job(w_down + (size_t)FF * D, 1024, nullptr, 0, FF, 0, 1024, (bf16*)(ws + WS_WDN1), FF, 0, 0, 0, scr, lane, gw, NGW, cur);
    {
        int first = (gw - (cur % NGW) + NGW) % NGW;
        for (int it = first; it < 1024; it += NGW) { const int g = it >> 8, cc = (it >> 4) & 15, dw = it & 15;
            p0_fold_item(ev_pool_w, g * 128 + cc * 8, ev_pool_scale + g * 128, ev_w_out + (size_t)(512 + g * 128) * 1024, (bf16*)(ws + WS_WOUT0), 512 + g * 128 + cc * 8, 1.0f, dw, lane); }
        cur += 1024;
        first = (gw - (cur % NGW) + NGW) % NGW;
        for (int it = first; it < 1024; it += NGW) { const int h = it >> 8, cc = (it >> 4) & 15, dw = it & 15;
            p0_fold_item(od_fourier_w, h * 128 + cc * 8, nullptr, od_w_out + (size_t)(h * 128) * 1024, (bf16*)(ws + WS_WOUT1), h * 128 + cc * 8, 1.0f / 724.0773439350247f, dw, lane); }
        cur += 1024;
        first = (gw - (cur % NGW) + NGW) % NGW;
        for (int it = first; it < 1024; it += NGW) { const int h = it >> 8, half = (it >> 7) & 1, kc = it & 127;
            p0_pq_item(od_w_in, mix_g + D, (bf16*)(ws + WS_WPQ1), h, half, kc * 8, tab, lane); }
        cur += 1024;
    }
    {
        bf16* A2 = (bf16*)(ws + WS_DFT);
        int first = (gw - (cur % NGW) + NGW) % NGW;
        for (int t2 = first; t2 < 256; t2 += NGW) {
            const int k0 = lane * 8, sinpart = k0 >> 8, s0 = k0 & 255;
            float v[8];
#pragma unroll
            for (int e = 0; e < 8; ++e) v[e] = CT[((((s0 + e) * t2) & 255) * 16 - (sinpart ? 1024 : 0)) & (S - 1)];
            v4u o; o.x = pk2(v[0], v[1]); o.y = pk2(v[2], v[3]); o.z = pk2(v[4], v[5]); o.w = pk2(v[6], v[7]);
            *(GAS v4u*)(A2 + (size_t)t2 * 512 + k0) = o;
        }
        cur += 256;
    }
    {
        bf16* XB = (bf16*)(ws + WS_XB); unsigned long long* ssq0 = (unsigned long long*)(ws + WS_SSQ);
        for (int m0 = 4 * gw; m0 < M; m0 += 4 * NGW) {
            f32x4 v[4][4];
#pragma unroll
            for (int r = 0; r < 4; ++r) { const GAS f32x4* xr = (const GAS f32x4*)(x + (size_t)(m0 + r) * D) + lane;
#pragma unroll
                for (int j = 0; j < 4; ++j) v[r][j] = xr[64 * j]; }
#pragma unroll
            for (int r = 0; r < 4; ++r) { float s = 0.f;
#pragma unroll
                for (int j = 0; j < 4; ++j) s += (v[r][j].x * v[r][j].x + v[r][j].y * v[r][j].y) + (v[r][j].z * v[r][j].z + v[r][j].w * v[r][j].w);
                s = wave_sum(s);
                if (lane == 0) ssq0[m0 + r] = pg8::ssq_fix(s);
                GAS unsigned long long* o8 = (GAS unsigned long long*)(XB + (size_t)(m0 + r) * D) + lane;
#pragma unroll
                for (int j = 0; j < 4; ++j) o8[64 * j] = (unsigned long long)pk2(v[r][j].x, v[r][j].y) | ((unsigned long long)pk2(v[r][j].z, v[r][j].w) << 32); }
        }
    }
}

__device__ __forceinline__ float fsel(bool c, float a, float b) { return c ? a : b; }
__device__ __forceinline__ float reduce_scatter32(float (&v)[32], int lane) {
#pragma unroll
    for (int o = 16; o >= 1; o >>= 1) {
        const bool up = (lane & o) != 0;
#pragma unroll
        for (int i = 0; i < o; ++i) { const float lo_ = v[i], hi_ = v[i + o]; const float send = fsel(up, lo_, hi_), keep = fsel(up, hi_, lo_); v[i] = keep + __shfl_xor(send, o); }
#pragma unroll
        for (int i = 0; i < o; ++i) asm volatile("" : "+v"(v[i]));
    }
    return v[0] + __shfl_xor(v[0], 32);
}
__device__ __forceinline__ float reduce_scatter16(float (&v)[16], int lane) {
#pragma unroll
    for (int o = 8; o >= 1; o >>= 1) {
        const bool up = (lane & o) != 0;
#pragma unroll
        for (int i = 0; i < o; ++i) { const float lo_ = v[i], hi_ = v[i + o]; const float send = fsel(up, lo_, hi_), keep = fsel(up, hi_, lo_); v[i] = keep + __shfl_xor(send, o); }
#pragma unroll
        for (int i = 0; i < o; ++i) asm volatile("" : "+v"(v[i]));
    }
    float t = v[0] + __shfl_xor(v[0], 16);
    return t + __shfl_xor(t, 32);
}
template <int pmode> __device__ __forceinline__ void mix0_conv_item(Frame& F, const Ptrs& P, int item) {
    const bf16* UB = (const bf16*)(P.ws + WS_UB); bf16* AM = (bf16*)(P.ws + WS_AM);
    const float* cw = P.in[4]; const float* cb = P.in[5]; const float* lg = P.in[6]; const float* lb = P.in[7];
    const int b = item >> 6, t0 = (item & 63) * 64, rowbase = b * S;
    LAS unsigned* tile = (LAS unsigned*)(F.lds + RING_OFF);
    LAS float* red = (LAS float*)(F.lds + RING_OFF + 98304);
    int tidl = F.tid; asm volatile("" : "+v"(tidl));
    const int rg = tidl >> 8, cp = tidl & 255, lanel = tidl & 63;
    const f32x2g bb = *(const GAS f32x2g*)(cb + 2 * cp);
    const f32x2g g2 = *(const GAS f32x2g*)(lg + 2 * cp), b2 = *(const GAS f32x2g*)(lb + 2 * cp);
    float w0[31], w1[31];
#pragma unroll
    for (int j = 0; j < 31; ++j) { const f32x2g w = *(const GAS f32x2g*)(cw + j * 512 + 2 * cp); w0[j] = w.x; w1[j] = w.y; }
    if (pmode != 7) { v4u tv[12];
#pragma unroll
      for (int i = 0; i < 12; ++i) { const int t = t0 - 15 + F.wave + NWAVES * i, tc = t < 0 ? 0 : (t > S - 1 ? S - 1 : t);
          tv[i] = *(const GAS v4u*)(UB + (size_t)(rowbase + tc) * 512 + F.lane * 8); }
#pragma unroll
      for (int i = 0; i < 12; ++i) { const int r = F.wave + NWAVES * i, t = t0 - 15 + r; const bool ok = (t >= 0 && t < S);
          v4u w = tv[i]; w.x = ok ? w.x : 0u; w.y = ok ? w.y : 0u; w.z = ok ? w.z : 0u; w.w = ok ? w.w : 0u;
          *(LAS v4u*)(tile + r * 256 + F.lane * 4) = w; } }
    LDS_BAR();
#pragma unroll 1
    for (int p = 0; p < (pmode == 10 ? 1 : 4); ++p) {
        float a0[8], a1[8];
#pragma unroll
        for (int o = 0; o < 8; ++o) { a0[o] = bb.x; a1[o] = bb.y; }
        const LAS unsigned* tp = tile + (32 * rg + 8 * p) * 256 + cp;
        if (pmode != 5)
#pragma unroll
        for (int ii = 0; ii < 38; ++ii) {
            const unsigned xx = tp[ii * 256];
            const float x0 = bf_lo(xx), x1 = bf_hi(xx);
#pragma unroll
            for (int o = 0; o < 8; ++o) { const int j = ii - o; if (j >= 0 && j <= 30) { a0[o] = fmaf(w0[j], x0, a0[o]); a1[o] = fmaf(w1[j], x1, a1[o]); } }
        }
        float v[16];
#pragma unroll
        for (int o = 0; o < 8; ++o) { v[2 * o] = a0[o] + a1[o]; v[2 * o + 1] = a0[o] * a0[o] + a1[o] * a1[o]; }
        LAS float* redp = red + (p & 1) * 128;
        if (pmode != 6) {
        const float tot = reduce_scatter16(v, lanel);
        if (lanel < 16) redp[(F.wave & 3) * 16 + lanel + rg * 64] = tot;
        LDS_BAR(); }
        float mean8[8], rstd8[8];
        {
            const LAS f32x4* rp = (const LAS f32x4*)(redp + rg * 64);
            f32x4 acc4[4];
#pragma unroll
            for (int k = 0; k < 4; ++k) acc4[k] = rp[k];
#pragma unroll
            for (int w = 1; w < 4; ++w)
#pragma unroll
                for (int k = 0; k < 4; ++k) acc4[k] = acc4[k] + rp[w * 4 + k];
#pragma unroll
            for (int o = 0; o < 8; ++o) { const float sm = acc4[o >> 1][(o & 1) * 2], sq = acc4[o >> 1][(o & 1) * 2 + 1];
                const float mean = sm * (1.0f / 512.0f), var = sq * (1.0f / 512.0f) - mean * mean; mean8[o] = mean; rstd8[o] = __builtin_amdgcn_rsqf(var + 1e-6f); }
        }
        if (pmode != 8)
#pragma unroll
        for (int o = 0; o < 8; ++o) {
            const float mean = mean8[o], rstd = rstd8[o];
            float y0 = (a0[o] - mean) * rstd * g2.x + b2.x, y1 = (a1[o] - mean) * rstd * g2.y + b2.y;
            y0 = y0 * __builtin_amdgcn_rcpf(1.0f + __expf(-y0)); y1 = y1 * __builtin_amdgcn_rcpf(1.0f + __expf(-y1));
            *(GAS unsigned*)(AM + (size_t)(rowbase + t0 + 32 * rg + 8 * p + o) * 1024 + 2 * cp) = pk2(y0, y1);
        }
    }
    LDS_BAR();
}
template <int H> __device__ __forceinline__ void pool_rows(const LAS unsigned* tp  , bf16* orow  , int tfirst) {
    unsigned x[32 + 2 * H];
#pragma unroll
    for (int i = 0; i < 32 + 2 * H; ++i) x[i] = tp[i * 256];
    float s0 = 0.f, s1 = 0.f;
#pragma unroll
    for (int i = 0; i < 2 * H; ++i) { s0 += bf_lo(x[i]); s1 += bf_hi(x[i]); }
#pragma unroll
    for (int o = 0; o < 32; ++o) {
        const int t = tfirst + o;
        const int lo = (t - H) < 0 ? 0 : (t - H), hi = (t + H - 1) > (S - 1) ? (S - 1) : (t + H - 1);
        const float inv = 1.0f / (float)(hi - lo + 1);
        *(GAS unsigned*)(orow + (size_t)o * 1024) = pk2(s0 * inv - bf_lo(x[o + H]), s1 * inv - bf_hi(x[o + H]));
        if (o < 31) { s0 += bf_lo(x[o + 2 * H]) - bf_lo(x[o]); s1 += bf_hi(x[o + 2 * H]) - bf_hi(x[o]); }
    }
}
__device__ __forceinline__ void mix0_pool_item(Frame& F, const Ptrs& P, int item) {
    const bf16* PB = (const bf16*)(P.ws + WS_PB); bf16* AM = (bf16*)(P.ws + WS_AM);
    const int b = item >> 6, t0 = (item & 63) * 64, rowbase = b * S;
    LAS unsigned* tile = (LAS unsigned*)(F.lds + RING_OFF);
    { v4u tv[10];
#pragma unroll
      for (int i = 0; i < 10; ++i) { const int t = t0 - 8 + F.wave + NWAVES * i, tc = t < 0 ? 0 : (t > S - 1 ? S - 1 : t);
          tv[i] = *(const GAS v4u*)(PB + (size_t)(rowbase + tc) * 512 + F.lane * 8); }
#pragma unroll
      for (int i = 0; i < 10; ++i) { const int r = F.wave + NWAVES * i, t = t0 - 8 + r; const bool ok = (t >= 0 && t < S);
          v4u w = tv[i]; w.x = ok ? w.x : 0u; w.y = ok ? w.y : 0u; w.z = ok ? w.z : 0u; w.w = ok ? w.w : 0u;
          *(LAS v4u*)(tile + r * 256 + F.lane * 4) = w; } }
    LDS_BAR();
    const int rg = F.tid >> 8, cp = F.tid & 255, g = __builtin_amdgcn_readfirstlane(cp >> 6);
    bf16* orow = AM + (size_t)(rowbase + t0 + 32 * rg) * 1024 + 512 + 2 * cp;
    const int tfirst = t0 + 32 * rg;
    if (g == 0) pool_rows<1>(tile + (32 * rg + 8 - 1) * 256 + cp, orow, tfirst);
    else if (g == 1) pool_rows<2>(tile + (32 * rg + 8 - 2) * 256 + cp, orow, tfirst);
    else if (g == 2) pool_rows<4>(tile + (32 * rg + 8 - 4) * 256 + cp, orow, tfirst);
    else pool_rows<8>(tile + (32 * rg + 8 - 8) * 256 + cp, orow, tfirst);
    LDS_BAR();
}

__device__ __forceinline__ void sgu_item(Frame& F, const Ptrs& P, int item) {
    const bf16* U = (const bf16*)(P.ws + WS_U1); const bf16* V = (const bf16*)(P.ws + WS_V1); bf16* AM = (bf16*)(P.ws + WS_AM);
    const float* lng = P.in[13]; const float* lnb = P.in[14]; const float* sw = P.in[15]; const float* sb = P.in[16];
    const int h = item & 3, rowbase = (item >> 2) * 128;
    LAS bf16* vnT = (LAS bf16*)(F.lds + RING_OFF);
    int lane = F.lane; asm volatile("" : "+v"(lane));
    const int fr = lane & 15, fq = lane >> 4, q = 16 * F.wave + fr;
    pg8::f32x4 wa[4], wb[4];
#pragma unroll
    for (int ks = 0; ks < 4; ++ks) { const GAS pg8::f32x4* wp = (const GAS pg8::f32x4*)(sw + (size_t)(h * 128 + q) * 128 + ks * 32 + 8 * fq); wa[ks] = wp[0]; wb[ks] = wp[1]; }
    u32x2g uu[8];
#pragma unroll
    for (int nt = 0; nt < 8; ++nt) uu[nt] = *(const GAS u32x2g*)(U + (size_t)(rowbase + q) * 512 + h * 128 + 16 * nt + 4 * fq);
    const float bias = sb[h * 128 + q];
    {
        const f32x2g g2 = *(const GAS f32x2g*)(lng + h * 128 + 2 * lane), b2 = *(const GAS f32x2g*)(lnb + h * 128 + 2 * lane);
        unsigned xv[16];
#pragma unroll
        for (int i = 0; i < 16; ++i) xv[i] = *(const GAS unsigned*)(V + (size_t)(rowbase + F.wave + 8 * i) * 512 + h * 128 + 2 * lane);
        float st[32];
#pragma unroll
        for (int i = 0; i < 16; ++i) { const float v0 = bf_lo(xv[i]), v1 = bf_hi(xv[i]); st[2 * i] = v0 + v1; st[2 * i + 1] = v0 * v0 + v1 * v1; }
        const float tot = reduce_scatter32(st, lane);
#pragma unroll
        for (int i = 0; i < 16; ++i) { const int k = F.wave + 8 * i;
            const float sm = __shfl(tot, 2 * i), sq = __shfl(tot, 2 * i + 1);
            const float mean = sm * (1.0f / 128.0f), rstd = __builtin_amdgcn_rsqf(sq * (1.0f / 128.0f) - mean * mean + 1e-6f);
            const float v0 = bf_lo(xv[i]), v1 = bf_hi(xv[i]);
            vnT[(2 * lane) * 136 + k] = (bf16)f2bf((v0 - mean) * rstd * g2.x + b2.x); vnT[(2 * lane + 1) * 136 + k] = (bf16)f2bf((v1 - mean) * rstd * g2.y + b2.y); }
    }
    LDS_BAR();
    {
        pg8::f32x4 acc[8];
#pragma unroll
        for (int nt = 0; nt < 8; ++nt) acc[nt] = (pg8::f32x4){0.f, 0.f, 0.f, 0.f};
#pragma unroll
        for (int ks = 0; ks < 4; ++ks) {
            pg8::u32x4 wq; wq.x = pk2(wa[ks][0], wa[ks][1]); wq.y = pk2(wa[ks][2], wa[ks][3]); wq.z = pk2(wb[ks][0], wb[ks][1]); wq.w = pk2(wb[ks][2], wb[ks][3]);
            const pg8::bf16x8 wf = __builtin_bit_cast(pg8::bf16x8, wq);
#pragma unroll
            for (int nt = 0; nt < 8; ++nt) {
                const pg8::bf16x8 vf = *(const LAS pg8::bf16x8*)(vnT + (16 * nt + fr) * 136 + ks * 32 + 8 * fq);
                acc[nt] = __builtin_amdgcn_mfma_f32_16x16x32_bf16(vf, wf, acc[nt], 0, 0, 0);
            }
        }
        const size_t t = (size_t)(rowbase + q);
#pragma unroll
        for (int nt = 0; nt < 8; ++nt) { const int c0 = h * 128 + 16 * nt + 4 * fq;
            u32x2g o; o.x = pk2(bf_lo(uu[nt].x) * (acc[nt][0] + bias), bf_hi(uu[nt].x) * (acc[nt][1] + bias)); o.y = pk2(bf_lo(uu[nt].y) * (acc[nt][2] + bias), bf_hi(uu[nt].y) * (acc[nt][3] + bias));
            *(GAS u32x2g*)(AM + t * 1024 + 512 + c0) = o; }
    }
    LDS_BAR();
}

struct cpx { float r, i; };
__device__ __forceinline__ cpx cadd(cpx a, cpx b) { return {a.r + b.r, a.i + b.i}; }
__device__ __forceinline__ cpx csub(cpx a, cpx b) { return {a.r - b.r, a.i - b.i}; }
__device__ __forceinline__ cpx cmulc(cpx a, float c, float s) { return {a.r * c + a.i * s, a.i * c - a.r * s}; }
__device__ __forceinline__ cpx cmni(cpx a) { return {a.i, -a.r}; }
__device__ __forceinline__ void dft4(cpx& x0, cpx& x1, cpx& x2, cpx& x3) {
    const cpx s02 = cadd(x0, x2), d02 = csub(x0, x2), s13 = cadd(x1, x3), d13 = cmni(csub(x1, x3));
    x0 = cadd(s02, s13); x1 = cadd(d02, d13); x2 = csub(s02, s13); x3 = csub(d02, d13);
}
__device__ __forceinline__ void fft16(cpx (&x)[16], cpx (&z)[16]) {
    constexpr float C1 = 0.92387953251128674f, S1 = 0.38268343236508977f, R2 = 0.70710678118654752f;
#pragma unroll
    for (int b = 0; b < 4; ++b) dft4(x[b], x[4 + b], x[8 + b], x[12 + b]);
    x[4 + 1] = cmulc(x[4 + 1], C1, S1);  x[8 + 1] = cmulc(x[8 + 1], R2, R2);   x[12 + 1] = cmulc(x[12 + 1], S1, C1);
    x[4 + 2] = cmulc(x[4 + 2], R2, R2);  x[8 + 2] = cmni(x[8 + 2]);            x[12 + 2] = cmulc(x[12 + 2], -R2, R2);
    x[4 + 3] = cmulc(x[4 + 3], S1, C1);  x[8 + 3] = cmulc(x[8 + 3], -R2, R2);  x[12 + 3] = cmulc(x[12 + 3], -C1, -S1);
#pragma unroll
    for (int c = 0; c < 4; ++c) { dft4(x[4 * c], x[4 * c + 1], x[4 * c + 2], x[4 * c + 3]);
        z[c] = x[4 * c]; z[c + 4] = x[4 * c + 1]; z[c + 8] = x[4 * c + 2]; z[c + 12] = x[4 * c + 3]; }
}
__device__ __forceinline__ void fft_stage1(Frame& F, const Ptrs& P) {
    const bf16* PQT = (const bf16*)(P.ws + WS_PQT); bf16* ZP = (bf16*)(P.ws + WS_ZP);
    LAS float* CT = (LAS float*)(F.lds + RING_OFF + 65536);
    { int tl = F.tid; asm volatile("" : "+v"(tl)); for (int i = tl; i < 4096; i += NWAVES * 64) CT[i] = cospif((float)i * (1.0f / 2048.0f)); }
    LDS_BAR();
    int gw = F.vcu * NWAVES + F.wave; asm volatile("" : "+s"(gw)); const int NGW = F.G * NWAVES;
    for (int item = gw; item < NB * 512 * 2; item += NGW) {
        int lane = F.lane; asm volatile("" : "+v"(lane));
        const int row = item >> 1, s20 = 128 * (item & 1) + 2 * lane, b = row >> 9, ch = row & 511;
        const bf16* src = PQT + (size_t)row * 2 * S + s20;
        unsigned xp[16], xq[16];
#pragma unroll
        for (int s1 = 0; s1 < 16; ++s1) { xp[s1] = *(const GAS unsigned*)(src + 256 * s1); xq[s1] = *(const GAS unsigned*)(src + S + 256 * s1); }
        unsigned zr[16], zi[16];
#pragma unroll
        for (int e = 0; e < 2; ++e) {
            cpx x[16], z[16];
#pragma unroll
            for (int s1 = 0; s1 < 16; ++s1) { x[s1].r = e ? bf_hi(xp[s1]) : bf_lo(xp[s1]); x[s1].i = -(e ? bf_hi(xq[s1]) : bf_lo(xq[s1])); }
            fft16(x, z);
            const int s2 = s20 + e;
#pragma unroll
            for (int t1 = 0; t1 < 16; ++t1) {
                const int idx = s2 * t1;
                const cpx w = cmulc(z[t1], CT[idx], CT[(idx - 1024) & (S - 1)]);
                const unsigned hr = f2bf(w.r), hi = f2bf(w.i);
                if (e == 0) { zr[t1] = hr; zi[t1] = hi; } else { zr[t1] |= hr << 16; zi[t1] |= hi << 16; }
            }
        }
#pragma unroll
        for (int t1 = 0; t1 < 16; ++t1) { bf16* dst = ZP + ((size_t)((b * 16 + t1) * 512 + ch)) * 512 + s20;
            *(GAS unsigned*)dst = zr[t1]; *(GAS unsigned*)(dst + 256) = zi[t1]; }
    }
}

struct Args { const float* in[22]; float* out; unsigned char* ws; int ph_lo, ph_hi, li, pad; };
template <int PM> __device__ __forceinline__ void mk_body(const Args& args) {
    extern __shared__ __attribute__((aligned(16))) unsigned char lds[];
    Frame F;
    F.lds = (LAS unsigned char*)lds;
    F.MISC = (volatile LAS unsigned*)(F.lds + MISC_OFF);
    F.tid = threadIdx.x; F.lane = F.tid & 63; F.wave = __builtin_amdgcn_readfirstlane(F.tid >> 6);
    F.G = gridDim.x; { const int bx = blockIdx.x; F.vcu = (F.G % 8 == 0) ? (bx % 8) * (F.G / 8) + bx / 8 : bx; }
    Ptrs P;
#pragma unroll
    for (int i = 0; i < 22; ++i) P.in[i] = args.in[i];
    P.out = args.out; P.ws = args.ws;
    unsigned char* ws = args.ws;
    F.ctl = (gu32*)(ws + WS_CTL);
    for (int u = F.tid; u < (LDS_BYTES - LDSCTL_OFF) / 4; u += NWAVES * 64) ((LAS unsigned*)(F.lds + LDSCTL_OFF))[u] = 0u;
    __syncthreads();
    XcdBarrier bar; bar.bar = (unsigned*)(F.ctl + CW_BAR); bar.x = 0; bar.st = nullptr;
    if (!MK_PER_PHASE) bar = xcd_barrier_post((unsigned*)(F.ctl + CW_BAR), F.MISC + 8);
    const int lo = args.ph_lo, hi = args.ph_hi;
#ifndef PH_MASK
#define PH_MASK 0x1FFF
#endif
#define IN(k) ((((PH_MASK) >> (k)) & 1) && lo <= (k) && (k) < hi)
#ifndef PROBE_BARX
#define PROBE_BARX 1
#endif
#define SEAM(k) do { if (IN(k) && IN((k) + 1)) { for (int bx_ = 0; bx_ < PROBE_BARX; ++bx_) xcd_barrier(bar); } } while (0)
    unsigned long long* ssq = (unsigned long long*)(ws + WS_SSQ);
    bf16* XB = (bf16*)(ws + WS_XB); bf16* AM = (bf16*)(ws + WS_AM); bf16* HB = (bf16*)(ws + WS_H);
    const int bid = (int)blockIdx.x;
    constexpr bool dup = PM != 0;
    bf16* TRX = (bf16*)(ws + WS_END); unsigned long long* TRS = (unsigned long long*)(ws + WS_END + 64 * MiB);

    if (IN(0)) { p0_prologue(F, P); } SEAM(0);
    if (IN(1)) { pg8::Gemm g{XB, (const bf16*)(ws + WS_WIN0), M, 1536, D}; pg8::StaticOrder So; So.init(M, 1536, F.G, bid);
        pg8::EpiInL0 E{(bf16*)(ws + WS_UB), (bf16*)(ws + WS_PB), ssq};
        pg8::gemm_phase<pg8::EpiInL0, pg8::StaticOrder, true, true>(F.lds + RING_OFF, g, So, E); } SEAM(1);
    if (IN(2)) { for (int it = F.vcu; it < 1024; it += F.G) {
#ifndef NO_CONV
            if (it < 512 && PM != 4 && PM != 9) mix0_conv_item<PM>(F, P, it);
#endif
#ifndef NO_POOL
            if (it >= 512 && PM != 3 && PM != 9) mix0_pool_item(F, P, it - 512);
#endif
 } } SEAM(2);
    if (IN(3)) { pg8::Gemm g{AM, (const bf16*)(ws + WS_WOUT0), M, D, D}; pg8::StaticOrder So; So.init(M, D, F.G, bid);
        pg8::EpiResid E{XB, dup ? TRS : ssq + M, dup ? TRX : XB, PM};
        pg8::gemm_phase<pg8::EpiResid, pg8::StaticOrder, true, true>(F.lds + RING_OFF, g, So, E); } SEAM(3);
    if (IN(4)) { pg8::Gemm g{XB, (const bf16*)(ws + WS_WGU0), M, 2 * FF, D}; pg8::StaticOrder So; So.init(M, 2 * FF, F.G, bid);
        pg8::EpiSwiGLU E{HB, ssq + M, PM};
        pg8::gemm_phase<pg8::EpiSwiGLU, pg8::StaticOrder, true, true>(F.lds + RING_OFF, g, So, E); } SEAM(4);
    if (IN(5)) { pg8::Gemm g{HB, (const bf16*)(ws + WS_WDN0), M, D, FF}; pg8::StaticOrder So; So.init(M, D, F.G, bid);
        pg8::EpiResid E{XB, dup ? TRS : ssq + 2 * M, dup ? TRX : XB, PM};
        pg8::gemm_phase<pg8::EpiResid, pg8::StaticOrder, true, true>(F.lds + RING_OFF, g, So, E); } SEAM(5);
    if (IN(6)) {
        { pg8::Gemm g{(const bf16*)(ws + WS_WPQ1), XB, 1024, M, D}; pg8::StaticOrder So; So.init(1024, M, F.G, bid);
          pg8::EpiPQT E{(bf16*)(ws + WS_PQT), ssq + 2 * M};
          pg8::gemm_phase<pg8::EpiPQT, pg8::StaticOrder, true, true>(F.lds + RING_OFF, g, So, E); }
        { pg8::Gemm g{XB, (const bf16*)(ws + WS_WUV1), M, 1024, D}; pg8::StaticOrder So; So.init(M, 1024, F.G, bid);
          pg8::EpiGeluUV E{(bf16*)(ws + WS_U1), (bf16*)(ws + WS_V1), ssq + 2 * M};
          pg8::gemm_phase<pg8::EpiGeluUV, pg8::StaticOrder, true, true>(F.lds + RING_OFF, g, So, E); }
    } SEAM(6);
    if (IN(7)) {
        { fft_stage1(F, P); }
        { for (int it = F.vcu; it < 1024; it += F.G) sgu_item(F, P, it); }
    } SEAM(7);
    if (IN(8)) { pg8::Gemm g{(const bf16*)(ws + WS_DFT), (const bf16*)(ws + WS_ZP), 256, NB * 16 * 512, 512}; pg8::StaticOrder So; So.init(256, NB * 16 * 512, F.G, bid);
        pg8::EpiDFT2 E{AM};
        pg8::gemm_phase<pg8::EpiDFT2, pg8::StaticOrder, true, true>(F.lds + RING_OFF, g, So, E); } SEAM(8);
    if (IN(9)) { pg8::Gemm g{AM, (const bf16*)(ws + WS_WOUT1), M, D, D}; pg8::StaticOrder So; So.init(M, D, F.G, bid);
        pg8::EpiResid E{XB, dup ? TRS : ssq + 3 * M, dup ? TRX : XB, PM};
        pg8::gemm_phase<pg8::EpiResid, pg8::StaticOrder, true, true>(F.lds + RING_OFF, g, So, E); } SEAM(9);
    if (IN(10)) { pg8::Gemm g{XB, (const bf16*)(ws + WS_WGU1), M, 2 * FF, D}; pg8::StaticOrder So; So.init(M, 2 * FF, F.G, bid);
        pg8::EpiSwiGLU E{HB, ssq + 3 * M, PM};
        pg8::gemm_phase<pg8::EpiSwiGLU, pg8::StaticOrder, true, true>(F.lds + RING_OFF, g, So, E); } SEAM(10);
    if (IN(11)) { pg8::Gemm g{HB, (const bf16*)(ws + WS_WDN1), M, D, FF}; pg8::StaticOrder So; So.init(M, D, F.G, bid);
        pg8::EpiResid E{XB, dup ? TRS : ssq + 4 * M, dup ? TRX : XB, PM};
        pg8::gemm_phase<pg8::EpiResid, pg8::StaticOrder, true, true>(F.lds + RING_OFF, g, So, E); } SEAM(11);
    if (IN(12)) {
        const float* gf = P.in[21]; const unsigned long long* ssq4 = ssq + 4 * M;
        const int gw = F.vcu * NWAVES + F.wave, NGW = F.G * NWAVES;
        for (int m = gw; m < M; m += NGW) {
            const GAS u32x2g* xr = (const GAS u32x2g*)(XB + (size_t)m * D) + F.lane; GAS f32x4* orow = (GAS f32x4*)(P.out + (size_t)m * D) + F.lane; const GAS f32x4* gr = (const GAS f32x4*)gf + F.lane;
            const float rs = pg8::rstd_of(ssq4[m]);
#pragma unroll
            for (int j = 0; j < 4; ++j) { const u32x2g xx = xr[64 * j]; const f32x4 gg = gr[64 * j];
                f32x4 v; v.x = bf_lo(xx.x); v.y = bf_hi(xx.x); v.z = bf_lo(xx.y); v.w = bf_hi(xx.y); orow[64 * j] = v * rs * gg; }
        }
    }
#undef IN
#undef SEAM
}
__global__ void __launch_bounds__(NWAVES * 64, 2) mk_fwd(Args args) { mk_body<0>(args); }
#ifdef PROBE_PHASE
#ifndef PROBE_MODE
#define PROBE_MODE 1
#endif
__global__ void __launch_bounds__(NWAVES * 64, 2) mk_probe(Args args) { mk_body<PROBE_MODE>(args); }
#endif

extern "C" void kernel_launch(void* const* d_in, const int* in_sizes, int n_in, void* d_out, int out_size, void* d_ws, size_t ws_size, hipStream_t stream) {
    static int grid = 0;
    if (grid == 0) {
        if (n_in != 22 || in_sizes[0] != M * D || out_size != M * D || ws_size < WS_END) { fprintf(stderr, "kernel_launch: unexpected shapes (n_in %d, in0 %d, out %d, ws %zu); nothing launched\n", n_in, n_in > 0 ? in_sizes[0] : -1, out_size, ws_size); grid = -1; return; }
        int dev = 0, cus = 0, per_cu = 0;
        if (hipGetDevice(&dev) != hipSuccess || hipDeviceGetAttribute(&cus, hipDeviceAttributeMultiprocessorCount, dev) != hipSuccess) { grid = -1; return; }
#ifdef PROBE_PHASE
        (void)hipFuncSetAttribute((const void*)mk_probe, hipFuncAttributeMaxDynamicSharedMemorySize, LDS_BYTES);
#endif
        if (hipFuncSetAttribute((const void*)mk_fwd, hipFuncAttributeMaxDynamicSharedMemorySize, LDS_BYTES) != hipSuccess) { fprintf(stderr, "kernel_launch: hipFuncSetAttribute failed\n"); grid = -1; return; }
        if (hipOccupancyMaxActiveBlocksPerMultiprocessor(&per_cu, (const void*)mk_fwd, NWAVES * 64, LDS_BYTES) != hipSuccess || per_cu < 1) { fprintf(stderr, "kernel_launch: occupancy query says %d blocks per CU\n", per_cu); per_cu = 1; }
        (void)hipGetLastError();
        grid = cus * 1;
    }
    if (grid < 0) return;
    if (hipMemsetAsync((char*)d_ws + WS_CTL, 0, CTL_ZERO_BYTES, stream) != hipSuccess) { fprintf(stderr, "kernel_launch: hipMemsetAsync failed\n"); return; }
    Args a{};
    for (int i = 0; i < 22; ++i) a.in[i] = (const float*)d_in[i];
    a.out = (float*)d_out; a.ws = (unsigned char*)d_ws;
#if MK_PER_PHASE
    for (int ph = 0; ph < N_PHASES; ++ph) { a.ph_lo = ph; a.ph_hi = ph + 1; a.li = ph;
        hipLaunchKernelGGL(mk_fwd, dim3(grid), dim3(NWAVES * 64), LDS_BYTES, stream, a); }
#else
    a.ph_lo = 0; a.ph_hi = N_PHASES; a.li = 0;
#ifdef PROBE_PHASE
#ifndef PROBE_MODE
#define PROBE_MODE 1
#endif
    { void* kargs0[] = {&a};
      hipError_t e0 = hipLaunchCooperativeKernel((const void*)mk_fwd, dim3(grid), dim3(NWAVES * 64), kargs0, LDS_BYTES, stream);
      if (e0 != hipSuccess) fprintf(stderr, "kernel_launch: cooperative launch failed: %s (grid %d)\n", hipGetErrorString(e0), grid);
      Args a2 = a; a2.ph_lo = PROBE_PHASE; a2.ph_hi = PROBE_PHASE + 1; a2.pad = PROBE_MODE;
      hipLaunchKernelGGL(mk_probe, dim3(grid), dim3(NWAVES * 64), LDS_BYTES, stream, a2); }
#elif defined(MK_PLAIN_LAUNCH)
    hipLaunchKernelGGL(mk_fwd, dim3(grid), dim3(NWAVES * 64), LDS_BYTES, stream, a);
#else
    void* kargs[] = {&a};
    hipError_t e = hipLaunchCooperativeKernel((const void*)mk_fwd, dim3(grid), dim3(NWAVES * 64), kargs, LDS_BYTES, stream);
    if (e != hipSuccess) fprintf(stderr, "kernel_launch: cooperative launch failed: %s (grid %d)\n", hipGetErrorString(e), grid);
#endif
#endif
}
```

```cpp
#include <hip/hip_runtime.h>
#include <cstdio>
#include <cstdint>
namespace pg8 {
#define PG8_LAS __attribute__((address_space(3)))
typedef unsigned short bf16_t;
typedef short bf16x8 __attribute__((ext_vector_type(8)));
typedef float f32x4 __attribute__((ext_vector_type(4)));
typedef unsigned u32x4 __attribute__((ext_vector_type(4)));
constexpr int BM = 256, BK = 64, HALF = 128, HTB = HALF * BK * 2  , STAGE_BYTES = 8 * HTB, NXCD = 8, WGM = 8;

__host__ __device__ __forceinline__ int lds_byte(int r, int c) { const int st = (r >> 4) * 2 + (c >> 5), rr = r & 15, cc = c & 31, ob = rr * 64 + cc * 2; return st * 1024 + (ob ^ (((ob >> 9) & 1) << 5)); }
__host__ __device__ __forceinline__ void stage_rc(int b, int& R, int& C) { const int st = b / 1024, sb = b % 1024, swz = sb ^ (((sb >> 9) & 1) << 5); R = (st >> 1) * 16 + swz / 64; C = (st & 1) * 32 + (swz % 64) / 2; }
__host__ __device__ __forceinline__ int perm32(int rho) { const int n = rho >> 4, i = rho & 15; return 8 * (i >> 2) + 4 * n + (i & 3); }

struct Unit { int pm, pn; };
struct Gemm { const bf16_t* A; const bf16_t* Bt; int M, N, K; };

struct StaticOrder {
    int nM, nN, nwg, G, c;
    __host__ __device__ void init(int M, int N, int G_, int c_) { nM = M / BM; nN = N / BM; nwg = nM * nN; G = G_; c = c_; }
    __host__ __device__ bool next(int i, Unit& u) const {
        const long L = (long)i * G + c; if (L >= nwg) return false;
        int wgid = (int)L; { const int q = nwg / NXCD, r = nwg % NXCD, xcd = wgid % NXCD, off = wgid / NXCD; wgid = (xcd < r ? xcd * (q + 1) : r * (q + 1) + (xcd - r) * q) + off; }
        const int nig = WGM * nN, gid = wgid / nig, fm = gid * WGM, gsz = (nM - fm) < WGM ? (nM - fm) : WGM;
        u.pm = fm + ((wgid % nig) % gsz); u.pn = (wgid % nig) / gsz; return true;
    }
    __device__ __forceinline__ void a_ready(const Unit&) const {}
    __device__ __forceinline__ void done(const Unit&) const {}
};

__device__ __forceinline__ unsigned cvt_pk_bf16(float lo, float hi) { unsigned r; asm volatile("v_cvt_pk_bf16_f32 %0, %1, %2" : "=v"(r) : "v"(lo), "v"(hi)); return r; }
typedef float f32x2 __attribute__((ext_vector_type(2)));
__device__ __forceinline__ f32x2 gelu_pk(f32x2 v) {
    const f32x2 av = __builtin_elementwise_abs(v), d = av * 0.2316418882f + 1.0f;
    f32x2 t; t.x = __builtin_amdgcn_rcpf(d.x); t.y = __builtin_amdgcn_rcpf(d.y);
    f32x2 q = t * 0.5307027145f + (-0.7265760135f); q = q * t + 0.7107068705f; q = q * t + (-0.142248368f); q = q * t + 0.127414796f; q = q * t;
    const f32x2 s = (v * v) * (-0.72134752044f);
    f32x2 e; e.x = __builtin_amdgcn_exp2f(s.x); e.y = __builtin_amdgcn_exp2f(s.y);
    const f32x2 m = v * (q * e), r = v - m;
    f32x2 o; o.x = v.x < 0.f ? m.x : r.x; o.y = v.y < 0.f ? m.y : r.y; return o;
}


constexpr float RMS_EPS = 1e-6f;
__device__ __forceinline__ float sigm(float x) { return __builtin_amdgcn_rcpf(1.0f + __expf(-x)); }
__device__ __forceinline__ u32x4 pack8(const f32x4 v0, const f32x4 v1) { u32x4 w; w.x = cvt_pk_bf16(v0[0], v0[1]); w.y = cvt_pk_bf16(v0[2], v0[3]); w.z = cvt_pk_bf16(v1[0], v1[1]); w.w = cvt_pk_bf16(v1[2], v1[3]); return w; }
__device__ __forceinline__ void store16_wt(void* p, u32x4 v) { asm volatile("global_store_dwordx4 %0, %1, off sc1\n\ts_nop 1" :: "v"(p), "v"(v) : "memory"); }
typedef unsigned long long u64_t;
__device__ __forceinline__ float ssq_f(u64_t v) { return fmaf((float)(unsigned)(v >> 32), 4294967296.0f, (float)(unsigned)v); }
__device__ __forceinline__ float rstd_of(u64_t ssq) { return __builtin_amdgcn_rsqf(fmaf(ssq_f(ssq), 1.0f / (1024.0f * 1048576.0f), RMS_EPS)); }
__device__ __forceinline__ u64_t ssq_fix(float s) { return (u64_t)(s * 1048576.0f); }

struct EpiInL0 {
    static constexpr bool PERM = true, AFTER_DRAIN = false;
    bf16_t* UB; bf16_t* PB; const u64_t* ssq;
    __device__ __forceinline__ void operator()(const f32x4 (&acc)[2][2][4][2], const Unit& u, int wr, int wc, int fr, int fq) const {
        const int row0 = u.pm * BM + wr * 64 + fr, cw = wc * 32 + 8 * fq;
        u64_t q[2][4];
#pragma unroll
        for (int ai = 0; ai < 2; ++ai)
#pragma unroll
            for (int m = 0; m < 4; ++m) q[ai][m] = ssq[row0 + ai * HALF + m * 16];
#pragma unroll
        for (int ai = 0; ai < 2; ++ai)
#pragma unroll
            for (int m = 0; m < 4; ++m) {
                const int row = row0 + ai * HALF + m * 16;
                const float rs = rstd_of(q[ai][m]), c1 = rs * -1.4426950408889634f;
                if (u.pn < 4) {
                    f32x4 o[2];
#pragma unroll
                    for (int n = 0; n < 2; ++n)
#pragma unroll
                        for (int j = 0; j < 4; j += 2) {
                            const f32x2 a = {acc[ai][0][m][n][j], acc[ai][0][m][n][j + 1]}, g = {acc[ai][1][m][n][j], acc[ai][1][m][n][j + 1]};
                            const f32x2 t = g * c1; f32x2 e; e.x = __builtin_amdgcn_exp2f(t.x); e.y = __builtin_amdgcn_exp2f(t.y);
                            const f32x2 d = e + 1.0f; f32x2 r; r.x = __builtin_amdgcn_rcpf(d.x); r.y = __builtin_amdgcn_rcpf(d.y);
                            const f32x2 h = a * (r * rs); o[n][j] = h.x; o[n][j + 1] = h.y; }
                    store16_wt(UB + (size_t)row * 512 + u.pn * 128 + cw, pack8(o[0], o[1]));
                } else {
#pragma unroll
                    for (int bj = 0; bj < 2; ++bj) store16_wt(PB + (size_t)row * 512 + (u.pn - 4) * 256 + bj * HALF + cw, pack8(acc[ai][bj][m][0] * rs, acc[ai][bj][m][1] * rs));
                }
            }
    }
};
struct EpiResid {
    static constexpr bool PERM = true, AFTER_DRAIN = false;
    bf16_t* XB; u64_t* ssq; bf16_t* XBw; int probe_mode;
    __device__ __forceinline__ void operator()(const f32x4 (&acc)[2][2][4][2], const Unit& u, int wr, int wc, int fr, int fq) const {
        const int row0 = u.pm * BM + wr * 64 + fr, cw = u.pn * BM + wc * 32 + 8 * fq;
        if (probe_mode == 2) { if (acc[0][0][0][0][0] == 123.456f) XBw[0] = 1; return; }
        u32x4 r[2][4][2];
#pragma unroll
        for (int ai = 0; ai < 2; ++ai)
#pragma unroll
            for (int m = 0; m < 4; ++m)
#pragma unroll
                for (int bj = 0; bj < 2; ++bj) r[ai][m][bj] = *(const u32x4*)(XB + (size_t)(row0 + ai * HALF + m * 16) * 1024 + bj * HALF + cw);
#pragma unroll
        for (int ai = 0; ai < 2; ++ai)
#pragma unroll
            for (int m = 0; m < 4; ++m) {
                const int row = row0 + ai * HALF + m * 16;
                f32x2 s2 = {0.f, 0.f};
#pragma unroll
                for (int bj = 0; bj < 2; ++bj) {
                    const u32x4 rr = r[ai][m][bj];
                    const f32x2 a0 = {acc[ai][bj][m][0][0], acc[ai][bj][m][0][1]}, a1 = {acc[ai][bj][m][0][2], acc[ai][bj][m][0][3]}, a2 = {acc[ai][bj][m][1][0], acc[ai][bj][m][1][1]}, a3 = {acc[ai][bj][m][1][2], acc[ai][bj][m][1][3]};
                    const f32x2 v0 = a0 + (f32x2){__builtin_bit_cast(float, rr.x << 16), __builtin_bit_cast(float, rr.x & 0xffff0000u)};
                    const f32x2 v1 = a1 + (f32x2){__builtin_bit_cast(float, rr.y << 16), __builtin_bit_cast(float, rr.y & 0xffff0000u)};
                    const f32x2 v2 = a2 + (f32x2){__builtin_bit_cast(float, rr.z << 16), __builtin_bit_cast(float, rr.z & 0xffff0000u)};
                    const f32x2 v3 = a3 + (f32x2){__builtin_bit_cast(float, rr.w << 16), __builtin_bit_cast(float, rr.w & 0xffff0000u)};
                    u32x4 w; w.x = cvt_pk_bf16(v0.x, v0.y); w.y = cvt_pk_bf16(v1.x, v1.y); w.z = cvt_pk_bf16(v2.x, v2.y); w.w = cvt_pk_bf16(v3.x, v3.y);
                    *(u32x4*)(XBw + ((size_t)row * 1024 + bj * HALF + cw)) = w;
                    s2 = v0 * v0 + s2; s2 = v1 * v1 + s2; s2 = v2 * v2 + s2; s2 = v3 * v3 + s2;
                }
                float s = s2.x + s2.y;
                s += __shfl_xor(s, 16); s += __shfl_xor(s, 32);
                if (fq == 0) atomicAdd(ssq + row, ssq_fix(s));
            }
    }
};
struct EpiSwiGLU {
    static constexpr bool PERM = true, AFTER_DRAIN = false;
    bf16_t* H; const u64_t* ssq; int probe_mode;
    __device__ __forceinline__ void operator()(const f32x4 (&acc)[2][2][4][2], const Unit& u, int wr, int wc, int fr, int fq) const {
        const int row0 = u.pm * BM + wr * 64 + fr, cw = wc * 32 + 8 * fq;
        if (probe_mode == 2) { if (acc[0][0][0][0][0] == 123.456f) H[0] = 1; return; }
        u64_t q[2][4];
#pragma unroll
        for (int ai = 0; ai < 2; ++ai)
#pragma unroll
            for (int m = 0; m < 4; ++m) q[ai][m] = ssq[row0 + ai * HALF + m * 16];
#pragma unroll
        for (int ai = 0; ai < 2; ++ai)
#pragma unroll
            for (int m = 0; m < 4; ++m) {
                const int row = row0 + ai * HALF + m * 16;
                const float rs = rstd_of(q[ai][m]), c1 = rs * -1.4426950408889634f, rs2 = rs * rs;
                f32x4 o[2];
#pragma unroll
                for (int n = 0; n < 2; ++n)
#pragma unroll
                    for (int j = 0; j < 4; j += 2) {
                        const f32x2 g = {acc[ai][0][m][n][j], acc[ai][0][m][n][j + 1]}, up = {acc[ai][1][m][n][j], acc[ai][1][m][n][j + 1]};
                        const f32x2 t = g * c1; f32x2 e; e.x = __builtin_amdgcn_exp2f(t.x); e.y = __builtin_amdgcn_exp2f(t.y);
                        const f32x2 d = e + 1.0f; f32x2 r; r.x = __builtin_amdgcn_rcpf(d.x); r.y = __builtin_amdgcn_rcpf(d.y);
                        const f32x2 h = (g * up) * (r * rs2); o[n][j] = h.x; o[n][j + 1] = h.y; }
                store16_wt(H + (size_t)row * 2816 + u.pn * 128 + cw, pack8(o[0], o[1]));
            }
    }
};
struct EpiPQT {
    static constexpr bool PERM = true, AFTER_DRAIN = false;
    bf16_t* PQT; const u64_t* ssq;
    __device__ __forceinline__ void operator()(const f32x4 (&acc)[2][2][4][2], const Unit& u, int wr, int wc, int fr, int fq) const {
        const int tok0 = u.pn * BM + wc * 32 + 8 * fq, b = (u.pn * BM) >> 12;
#pragma unroll
        for (int bj = 0; bj < 2; ++bj) {
            u64_t q[8];
#pragma unroll
            for (int j = 0; j < 8; ++j) q[j] = ssq[tok0 + bj * HALF + j];
            f32x4 rs0, rs1;
#pragma unroll
            for (int j = 0; j < 4; ++j) { rs0[j] = rstd_of(q[j]); rs1[j] = rstd_of(q[4 + j]); }
#pragma unroll
            for (int ai = 0; ai < 2; ++ai)
#pragma unroll
                for (int m = 0; m < 4; ++m) {
                    const int r = u.pm * BM + ai * HALF + wr * 64 + m * 16 + fr, pq = r >> 9, ch = r & 511;
                    bf16_t* base = PQT + ((size_t)(b * 512 + ch) * 2 + pq) * 4096;
                    store16_wt(base + ((tok0 + bj * HALF) & 4095), pack8(acc[ai][bj][m][0] * rs0, acc[ai][bj][m][1] * rs1));
                }
        }
    }
};
struct EpiGeluUV {
    static constexpr bool PERM = true, AFTER_DRAIN = false;
    bf16_t* U; bf16_t* V; const u64_t* ssq;
    __device__ __forceinline__ void operator()(const f32x4 (&acc)[2][2][4][2], const Unit& u, int wr, int wc, int fr, int fq) const {
        const int row0 = u.pm * BM + wr * 64 + fr, cw = wc * 32 + 8 * fq;
        bf16_t* dst = (u.pn < 2) ? U : V; const int colb = (u.pn & 1) * BM;
        u64_t q[2][4];
#pragma unroll
        for (int ai = 0; ai < 2; ++ai)
#pragma unroll
            for (int m = 0; m < 4; ++m) q[ai][m] = ssq[row0 + ai * HALF + m * 16];
#pragma unroll
        for (int ai = 0; ai < 2; ++ai)
#pragma unroll
            for (int m = 0; m < 4; ++m) {
                const int row = row0 + ai * HALF + m * 16;
                const float rs = rstd_of(q[ai][m]);
#pragma unroll
                for (int bj = 0; bj < 2; ++bj) {
                    const f32x4 v0 = acc[ai][bj][m][0] * rs, v1 = acc[ai][bj][m][1] * rs;
                    const f32x2 a = gelu_pk((f32x2){v0[0], v0[1]}), bq = gelu_pk((f32x2){v0[2], v0[3]}), c = gelu_pk((f32x2){v1[0], v1[1]}), d = gelu_pk((f32x2){v1[2], v1[3]});
                    store16_wt(dst + (size_t)row * 512 + colb + bj * HALF + cw, pack8((f32x4){a.x, a.y, bq.x, bq.y}, (f32x4){c.x, c.y, d.x, d.y}));
                }
            }
    }
};
struct EpiDFT2 {
    static constexpr bool PERM = true, AFTER_DRAIN = false;
    bf16_t* AM;
    __device__ __forceinline__ void operator()(const f32x4 (&acc)[2][2][4][2], const Unit& u, int wr, int wc, int fr, int fq) const {
#pragma unroll
        for (int bj = 0; bj < 2; ++bj) {
            const int n = u.pn * BM + bj * HALF + wc * 32 + 8 * fq, b = n >> 13, t1 = (n >> 9) & 15, ch = n & 511;
            bf16_t* base = AM + (size_t)(b * 4096 + t1) * 1024 + ch;
#pragma unroll
            for (int ai = 0; ai < 2; ++ai)
#pragma unroll
                for (int m = 0; m < 4; ++m) { const int t2 = ai * HALF + wr * 64 + m * 16 + fr;
                    store16_wt(base + (size_t)(16 * t2) * 1024, pack8(acc[ai][bj][m][0], acc[ai][bj][m][1])); }
        }
    }
};

template <class Epi, class Sched, bool ALIGN_EPI = false, bool SP2 = false>
__device__ __forceinline__ void gemm_phase(PG8_LAS unsigned char* lds, const Gemm g, const Sched& S, const Epi& E) {
    const int tid = threadIdx.x, wid = __builtin_amdgcn_readfirstlane(tid >> 6), lane = tid & 63, wr = wid >> 2, wc = wid & 3, fr = lane & 15, fq = lane >> 4;
    const int K = g.K, nt = K / BK;
    unsigned voffA[2], voffB[2];
#pragma unroll
    for (int i = 0; i < 2; ++i) { int R, C; stage_rc(tid * 16 + i * 8192, R, C); const int Rb = Epi::PERM ? ((R & ~31) + perm32(R & 31)) : R;
        voffA[i] = (unsigned)(R * K + C) * 2u; voffB[i] = (unsigned)(Rb * K + C) * 2u; }
    const size_t kstep = (size_t)(BK * 2);
    const size_t hstep = (size_t)HALF * K * 2;
    const size_t tstep = 2 * hstep;
    const unsigned ldsw = (unsigned)wid * 1024u;
    const int aoff = lds_byte(wr * 64 + fr, fq * 8), boff = lds_byte(wc * 32 + fr, fq * 8);
#define PG8_SA(b, h) (((b) * 2 + (h)) * HTB)
#define PG8_SB(b, h) ((4 + (b) * 2 + (h)) * HTB)
#define PG8_STAGE(bufoff, gbase, voff) do { _Pragma("unroll") for (int _i = 0; _i < 2; ++_i) \
        __builtin_amdgcn_global_load_lds((const unsigned*)((const char*)(gbase) + (voff)[_i]), (PG8_LAS unsigned*)(lds + (bufoff) + ldsw + _i * 8192), 16, 0, 0); } while (0)
#define PG8_LDA(dst, b, h) do { _Pragma("unroll") for (int m = 0; m < 4; ++m) _Pragma("unroll") for (int k = 0; k < 2; ++k) dst[m][k] = *(const PG8_LAS bf16x8*)(lds + PG8_SA(b, h) + aoff + m * 2048 + k * 1024); } while (0)
#define PG8_LDB(dst, b, h) do { _Pragma("unroll") for (int n = 0; n < 2; ++n) _Pragma("unroll") for (int k = 0; k < 2; ++k) dst[n][k] = *(const PG8_LAS bf16x8*)(lds + PG8_SB(b, h) + boff + n * 2048 + k * 1024); } while (0)
#define PG8_MMA(ai, bj, At, Bt) do { __builtin_amdgcn_s_setprio(1); _Pragma("unroll") for (int m = 0; m < 4; ++m) _Pragma("unroll") for (int n = 0; n < 2; ++n) _Pragma("unroll") for (int k = 0; k < 2; ++k) \
        acc[ai][bj][m][n] = __builtin_amdgcn_mfma_f32_16x16x32_bf16(Bt[n][k], At[m][k], acc[ai][bj][m][n], 0, 0, 0); __builtin_amdgcn_s_setprio(0); } while (0)
#define PG8_WAIT_V(n) asm volatile("s_waitcnt vmcnt(" #n ")" ::: "memory")
#define PG8_WAIT_L(n) asm volatile("s_waitcnt lgkmcnt(" #n ")" ::: "memory")
#define PG8_BAR __builtin_amdgcn_s_barrier()
#define PG8_SCHED __builtin_amdgcn_sched_barrier(0)
    Unit cur, nxt; int ui = 0;
    if (!S.next(0, cur)) return;
    f32x4 acc[2][2][4][2];
#pragma unroll
    for (int a = 0; a < 2; ++a)
#pragma unroll
        for (int b = 0; b < 2; ++b)
#pragma unroll
            for (int m = 0; m < 4; ++m)
#pragma unroll
                for (int n = 0; n < 2; ++n) acc[a][b][m][n] = (f32x4){0.f, 0.f, 0.f, 0.f};
    bf16x8 At[4][2], B0[2][2], B1[2][2];
    const char* cA = (const char*)g.A + (size_t)cur.pm * tstep; const char* cB = (const char*)g.Bt + (size_t)cur.pn * tstep;
    S.a_ready(cur);
    if constexpr (SP2) {
        PG8_STAGE(PG8_SB(0, 0), cB, voffB); PG8_STAGE(PG8_SB(0, 1), cB + hstep, voffB); PG8_STAGE(PG8_SA(0, 0), cA, voffA); PG8_STAGE(PG8_SA(0, 1), cA + hstep, voffA);
        if (wr == 1) PG8_BAR;
        PG8_WAIT_V(2); PG8_BAR;
        PG8_STAGE(PG8_SB(1, 0), cB + kstep, voffB); PG8_STAGE(PG8_SA(1, 0), cA + kstep, voffA); PG8_STAGE(PG8_SB(1, 1), cB + hstep + kstep, voffB);
        PG8_WAIT_V(6); PG8_BAR;
    } else {
        PG8_STAGE(PG8_SB(0, 0), cB, voffB); PG8_STAGE(PG8_SA(0, 0), cA, voffA); PG8_STAGE(PG8_SB(0, 1), cB + hstep, voffB); PG8_STAGE(PG8_SA(0, 1), cA + hstep, voffA);
        if (wr == 1) PG8_BAR;
        PG8_WAIT_V(4); PG8_BAR;
        PG8_STAGE(PG8_SB(1, 0), cB + kstep, voffB); PG8_STAGE(PG8_SA(1, 0), cA + kstep, voffA); PG8_STAGE(PG8_SB(1, 1), cB + hstep + kstep, voffB);
        PG8_WAIT_V(6); PG8_BAR;
    }
    for (;;) {
        const bool has_next = S.next(ui + 1, nxt);
        const char* nA = has_next ? (const char*)g.A + (size_t)nxt.pm * tstep : cA; const char* nB = has_next ? (const char*)g.Bt + (size_t)nxt.pn * tstep : cB;
        for (int t = 0; t < nt; t += 2) {
            const bool last = (t == nt - 2);
            const char* a1 = cA + (size_t)(t + 1) * kstep;
            const char* a2 = last ? nA : cA + (size_t)(t + 2) * kstep; const char* b2 = last ? nB : cB + (size_t)(t + 2) * kstep;
            const char* a3 = a2 + kstep; const char* b3 = b2 + kstep;
            if (last && has_next) S.a_ready(nxt);
            if constexpr (SP2) {
            PG8_LDB(B0, 0, 0); PG8_LDB(B1, 0, 1); PG8_SCHED; PG8_LDA(At, 0, 0); PG8_STAGE(PG8_SA(1, 1), a1 + hstep, voffA);
            PG8_WAIT_V(8); PG8_WAIT_L(0); PG8_BAR; PG8_MMA(0, 0, At, B0); PG8_MMA(0, 1, At, B1); PG8_BAR; PG8_SCHED;
            PG8_LDA(At, 0, 1); PG8_STAGE(PG8_SB(0, 0), b2, voffB); PG8_STAGE(PG8_SB(0, 1), b2 + hstep, voffB); PG8_STAGE(PG8_SA(0, 0), a2, voffA);
            PG8_WAIT_V(8); PG8_WAIT_L(0); PG8_BAR; PG8_MMA(1, 0, At, B0); PG8_MMA(1, 1, At, B1); PG8_BAR; PG8_SCHED;
            PG8_LDB(B0, 1, 0); PG8_LDB(B1, 1, 1); PG8_SCHED; PG8_LDA(At, 1, 0); PG8_STAGE(PG8_SA(0, 1), a2 + hstep, voffA);
            PG8_WAIT_V(8); PG8_WAIT_L(0); PG8_BAR; PG8_MMA(0, 0, At, B0); PG8_MMA(0, 1, At, B1); PG8_BAR; PG8_SCHED;
            PG8_LDA(At, 1, 1); PG8_STAGE(PG8_SB(1, 0), b3, voffB); PG8_STAGE(PG8_SB(1, 1), b3 + hstep, voffB); PG8_STAGE(PG8_SA(1, 0), a3, voffA);
            PG8_WAIT_V(8); PG8_WAIT_L(0); PG8_BAR; PG8_MMA(1, 0, At, B0); PG8_MMA(1, 1, At, B1); PG8_BAR; PG8_SCHED;
            } else {
            PG8_LDB(B0, 0, 0); PG8_SCHED; PG8_LDA(At, 0, 0); PG8_STAGE(PG8_SA(1, 1), a1 + hstep, voffA);
            PG8_WAIT_L(8); PG8_BAR; PG8_WAIT_L(0); PG8_MMA(0, 0, At, B0); PG8_BAR; PG8_SCHED;
            PG8_LDB(B1, 0, 1); PG8_STAGE(PG8_SB(0, 0), b2, voffB);
            PG8_BAR; PG8_WAIT_L(0); PG8_MMA(0, 1, At, B1); PG8_BAR;
            PG8_LDA(At, 0, 1); PG8_STAGE(PG8_SA(0, 0), a2, voffA);
            PG8_BAR; PG8_WAIT_L(0); PG8_MMA(1, 0, At, B0); PG8_BAR; PG8_SCHED;
            PG8_STAGE(PG8_SB(0, 1), b2 + hstep, voffB);
            PG8_WAIT_V(6); PG8_BAR; PG8_MMA(1, 1, At, B1); PG8_BAR;
            PG8_LDB(B0, 1, 0); PG8_SCHED; PG8_LDA(At, 1, 0); PG8_STAGE(PG8_SA(0, 1), a2 + hstep, voffA);
            PG8_WAIT_L(8); PG8_BAR; PG8_WAIT_L(0); PG8_MMA(0, 0, At, B0); PG8_BAR; PG8_SCHED;
            PG8_LDB(B1, 1, 1); PG8_STAGE(PG8_SB(1, 0), b3, voffB);
            PG8_BAR; PG8_WAIT_L(0); PG8_MMA(0, 1, At, B1); PG8_BAR;
            PG8_LDA(At, 1, 1); PG8_STAGE(PG8_SA(1, 0), a3, voffA);
            PG8_BAR; PG8_WAIT_L(0); PG8_MMA(1, 0, At, B0); PG8_BAR; PG8_SCHED;
            PG8_STAGE(PG8_SB(1, 1), b3 + hstep, voffB);
            PG8_WAIT_V(6); PG8_BAR; PG8_MMA(1, 1, At, B1); PG8_BAR;
            }
        }
        if constexpr (ALIGN_EPI) { if (wr == 0) PG8_BAR; }
        if constexpr (!Epi::AFTER_DRAIN) { E(acc, cur, wr, wc, fr, fq); S.done(cur); }
        if (!has_next) break;
#pragma unroll
        for (int a = 0; a < 2; ++a)
#pragma unroll
            for (int b = 0; b < 2; ++b)
#pragma unroll
                for (int m = 0; m < 4; ++m)
#pragma unroll
                    for (int n = 0; n < 2; ++n) acc[a][b][m][n] = (f32x4){0.f, 0.f, 0.f, 0.f};
        cur = nxt; cA = nA; cB = nB; ++ui;
        if constexpr (ALIGN_EPI) { if (wr == 1) PG8_BAR; }
    }
    PG8_WAIT_V(0);
    if constexpr (!ALIGN_EPI) { if (wr == 0) PG8_BAR; }
    PG8_BAR;
    if constexpr (Epi::AFTER_DRAIN) { E.fused(acc, cur, wr, wc, fr, fq, lds, wid, lane); S.done(cur); }
#undef PG8_SA
#undef PG8_SB
#undef PG8_STAGE
#undef PG8_LDA
#undef PG8_LDB
#undef PG8_MMA
#undef PG8_WAIT_V
#undef PG8_WAIT_L
#undef PG8_BAR
#undef PG8_SCHED
}
}
#define GAS __attribute__((address_space(1)))
#define LAS __attribute__((address_space(3)))
typedef unsigned short bf16;
typedef unsigned v4u __attribute__((ext_vector_type(4)));
typedef float f32x4 __attribute__((ext_vector_type(4)));
typedef short bf16x8 __attribute__((ext_vector_type(8)));
typedef GAS unsigned gu32;
typedef GAS unsigned long long gu64;
#define RLX_AGENT __ATOMIC_RELAXED, __HIP_MEMORY_SCOPE_AGENT
#define LDS_WAIT() asm volatile("s_waitcnt lgkmcnt(0)" ::: "memory")
#define VM_WAIT() asm volatile("s_waitcnt vmcnt(0)" ::: "memory")
__device__ __forceinline__ unsigned long long rt() { return __builtin_amdgcn_s_memrealtime(); }
__device__ __forceinline__ unsigned f2bf(float f) { unsigned u = __builtin_bit_cast(unsigned, f); return (u + 0x7fffu + ((u >> 16) & 1u)) >> 16; }
__device__ __forceinline__ unsigned pk2(float lo, float hi) { return f2bf(lo) | (f2bf(hi) << 16); }

#define XB_TMO      128
#define XB_XCNT(j)  (256  + 64 * (j))
#define XB_XSUB(j)  (1280 + 64 * (j))
#define XB_XGEN(j)  (2304 + 64 * (j))
#define XB_TOP      3328
#define XB_TOPGEN   3392
#define XCD_BAR_WORDS 3456
#define XB_SPIN_CAP (1u << 18)

__device__ __forceinline__ unsigned xb_ld(unsigned* p)              { return __hip_atomic_load(p, __ATOMIC_RELAXED, __HIP_MEMORY_SCOPE_AGENT); }
__device__ __forceinline__ unsigned xb_add(unsigned* p, unsigned v) { return __hip_atomic_fetch_add(p, v, __ATOMIC_RELAXED, __HIP_MEMORY_SCOPE_AGENT); }
__device__ __forceinline__ unsigned xb_xcc_id() { return (unsigned)__builtin_amdgcn_s_getreg((3 << 11) | 20) & 0xFu; }
#define XB_SPIN(cond, bar) do { unsigned _sp = 0; while (cond) { __builtin_amdgcn_s_sleep(1); \
    if ((++_sp & 255u) == 0u) { if (xb_ld(&(bar)[XB_TMO])) break; if (_sp > XB_SPIN_CAP) { atomicAdd(&(bar)[XB_TMO], 1u); break; } } } } while (0)

struct XcdBarrier {
    unsigned* bar; unsigned x;
    volatile LAS unsigned* st;
};

__device__ __forceinline__ XcdBarrier xcd_barrier_post(unsigned* bar, volatile LAS unsigned* st) {
    XcdBarrier b; b.bar = bar; b.x = xb_xcc_id(); b.st = st;
    if (threadIdx.x == 0) (void)xb_add(&bar[XB_XCNT(b.x)], 1u);
    return b;
}
__device__ __forceinline__ void xcd_barrier_complete(unsigned* bar, unsigned x, unsigned& nloc, unsigned& nx) {
    const unsigned G = gridDim.x * gridDim.y * gridDim.z;
    unsigned sum, cnt, mine, sp = 0u;
    for (;;) {
        sum = 0u; cnt = 0u; mine = 0u;
#pragma unroll
        for (unsigned j = 0; j < 16; ++j) { const unsigned c = xb_ld(&bar[XB_XCNT(j)]); sum += c; cnt += (c > 0u) ? 1u : 0u; mine = (j == x) ? c : mine; }
        if (sum == G) break;
        __builtin_amdgcn_s_sleep(1);
        if ((++sp & 255u) == 0u) { if (xb_ld(&bar[XB_TMO])) break; if (sp > XB_SPIN_CAP) { atomicAdd(&bar[XB_TMO], 1u); break; } }
    }
    nloc = mine > 0u ? mine : 1u; nx = cnt > 0u ? cnt : 1u;
}

__device__ __forceinline__ void xcd_barrier(const XcdBarrier& b) {
    asm volatile("s_waitcnt vmcnt(0)" ::: "memory");
    __syncthreads();
    if (threadIdx.x == 0) {
        unsigned* bar = b.bar;
        __builtin_amdgcn_s_waitcnt(0);
        unsigned nloc = b.st[0], nx = b.st[1];
        if (nloc == 0u) { xcd_barrier_complete(bar, b.x, nloc, nx); b.st[0] = nloc; b.st[1] = nx; }
        const unsigned old = xb_add(&bar[XB_XSUB(b.x)], 1u);
        const unsigned gen = old / nloc;
        if (old + 1u == (gen + 1u) * nloc) {
            __builtin_amdgcn_fence(__ATOMIC_RELEASE, "agent");
            asm volatile("s_waitcnt vmcnt(0)" ::: "memory");
            const unsigned og = xb_add(&bar[XB_TOP], 1u);
            const unsigned tg = og / nx;
            if (og + 1u == (tg + 1u) * nx) xb_add(&bar[XB_TOPGEN], 1u);
            else XB_SPIN(xb_ld(&bar[XB_TOPGEN]) == tg, bar);
            __builtin_amdgcn_fence(__ATOMIC_ACQUIRE, "agent");
            xb_add(&bar[XB_XGEN(b.x)], 1u);
            asm volatile("s_waitcnt vmcnt(0)" ::: "memory");
        } else {
            XB_SPIN(xb_ld(&bar[XB_XGEN(b.x)]) == gen, bar);
            __builtin_amdgcn_fence(__ATOMIC_ACQUIRE, "agent");
            asm volatile("s_waitcnt vmcnt(0)" ::: "memory");
        }
    }
    __syncthreads();
}

constexpr int NWAVES = 8;
#ifndef MK_PER_PHASE
#define MK_PER_PHASE 0
#endif
constexpr int N_PHASES = 13;

constexpr int NB = 8, S = 4096, D = 1024, FF = 2816, M = NB * S;
typedef float f32x2g __attribute__((ext_vector_type(2)));
typedef unsigned u32x2g __attribute__((ext_vector_type(2)));

constexpr size_t MiB = 1u << 20;
constexpr size_t WS_CTL = 0, CTL_ZERO_BYTES = 1 * MiB;
constexpr size_t WS_SSQ = 46 * MiB + 512 * 1024;
constexpr size_t WS_WIN0 = 2 * MiB;
constexpr size_t WS_WOUT0 = 5 * MiB;
constexpr size_t WS_WGU0 = 7 * MiB;
constexpr size_t WS_WDN0 = 18 * MiB;
constexpr size_t WS_WPQ1 = 24 * MiB;
constexpr size_t WS_WUV1 = 26 * MiB;
constexpr size_t WS_WOUT1 = 28 * MiB;
constexpr size_t WS_WGU1 = 30 * MiB;
constexpr size_t WS_WDN1 = 41 * MiB;
constexpr size_t WS_DFT = 48 * MiB;
constexpr size_t WS_XB = 112 * MiB;
constexpr size_t WS_AM = 176 * MiB;
constexpr size_t WS_H = 240 * MiB;
constexpr size_t WS_UB = WS_H, WS_PB = WS_H + 32 * MiB;
constexpr size_t WS_PQT = WS_H, WS_U1 = WS_H + 64 * MiB, WS_V1 = WS_H + 96 * MiB, WS_ZP = WS_H + 128 * MiB;
constexpr size_t WS_END = 432 * MiB;
static_assert(WS_H + (size_t)M * FF * 2 <= WS_END && WS_V1 + (size_t)M * 512 * 2 <= WS_ZP && WS_ZP + 64 * MiB <= WS_END, "d_ws map");
constexpr int CW_BAR = 4096;

constexpr int RING_OFF = 0, RING_BYTES = 131072;
constexpr int LDSCTL_OFF = RING_BYTES, MISC_OFF = LDSCTL_OFF + 320;
constexpr int LDS_BYTES = 147456;

struct Frame {
    LAS unsigned char* lds;
    volatile LAS unsigned* MISC;
    gu32* ctl;
    int tid, lane, wave;
    int vcu, G;
};
__device__ __forceinline__ float wave_sum(float v) {
#pragma unroll
    for (int o = 1; o < 64; o <<= 1) v += __shfl_xor(v, o);
    return v;
}
__device__ __forceinline__ float bf_lo(unsigned x) { return __builtin_bit_cast(float, x << 16); }
__device__ __forceinline__ float bf_hi(unsigned x) { return __builtin_bit_cast(float, x & 0xffff0000u); }
#define WG_BAR() do { asm volatile("s_waitcnt vmcnt(0) lgkmcnt(0)" ::: "memory"); __builtin_amdgcn_s_barrier(); asm volatile("" ::: "memory"); } while (0)
#define LDS_BAR() do { asm volatile("s_waitcnt lgkmcnt(0)" ::: "memory"); __builtin_amdgcn_s_barrier(); asm volatile("" ::: "memory"); } while (0)

__device__ __forceinline__ void p0_transpose_item(const float* W, int ldw, const float* gk, bf16* WT, int ldt, int k0, int n0, int dk0, int drow0, LAS float* scr, int lane) {
    float v[32];
    const float* wp = W + (size_t)(k0 + (lane >> 5)) * ldw + n0 + (lane & 31);
#pragma unroll
    for (int i = 0; i < 32; ++i) v[i] = wp[(size_t)(2 * i) * ldw];
    const int c = lane & 7;
    f32x4 g0 = {1.f, 1.f, 1.f, 1.f}, g1 = {1.f, 1.f, 1.f, 1.f};
    if (gk) { g0 = *(const GAS f32x4*)(gk + k0 + 8 * c); g1 = *(const GAS f32x4*)(gk + k0 + 8 * c + 4); }
#pragma unroll
    for (int i = 0; i < 32; ++i) scr[(2 * i + (lane >> 5)) * 33 + (lane & 31)] = v[i];
    LDS_WAIT(); asm volatile("" ::: "memory");
#pragma unroll
    for (int j = 0; j < 4; ++j) { const int n = (lane >> 3) + 8 * j; const LAS float* s = scr + (8 * c) * 33 + n;
        v4u o; o.x = pk2(s[0 * 33] * g0.x, s[1 * 33] * g0.y); o.y = pk2(s[2 * 33] * g0.z, s[3 * 33] * g0.w); o.z = pk2(s[4 * 33] * g1.x, s[5 * 33] * g1.y); o.w = pk2(s[6 * 33] * g1.z, s[7 * 33] * g1.w);
        *(GAS v4u*)(WT + (size_t)(drow0 + n) * ldt + dk0 + 8 * c) = o; }
    LDS_WAIT(); asm volatile("" ::: "memory");
}
__device__ __forceinline__ void p0_job(const float* W, int ldw, const float* gk, int kbeg, int kext, int ncol0, int next, bf16* WT, int ldt, int dkbase, int mode, int half_or_off,
                                       LAS float* scr, int lane, int gw, int NGW, int& cursor) {
    const int nkb = kext / 64, nnb = next / 32, nitems = nkb * nnb;
    int first = (gw - (cursor % NGW) + NGW) % NGW;
    for (int it = first; it < nitems; it += NGW) {
        const int kb = it / nnb, nb = it % nnb, nrel = 32 * nb;
        const int drow0 = (mode == 0) ? (half_or_off + nrel) : (256 * (nrel >> 7) + 128 * half_or_off + (nrel & 127));
        p0_transpose_item(W, ldw, gk, WT, ldt, kbeg + 64 * kb, ncol0 + nrel, dkbase + 64 * kb, drow0, scr, lane);
    }
    cursor += nitems;
}
__device__ __forceinline__ void p0_fold_item(const float* L, int lrow0, const float* sc, const float* Rm, bf16* out, int dk0, float scale, int dw, int lane) {
    const int d = 64 * dw + lane;
    float l0[8], l1[8];
    { const float s0 = sc ? sc[lane] : 1.f, s1 = sc ? sc[64 + lane] : 1.f;
#pragma unroll
      for (int j = 0; j < 8; ++j) { l0[j] = L[(size_t)(lrow0 + j) * 128 + lane] * s0; l1[j] = L[(size_t)(lrow0 + j) * 128 + 64 + lane] * s1; } }
    float acc[8];
#pragma unroll
    for (int j = 0; j < 8; ++j) acc[j] = 0.f;
#pragma unroll
    for (int cb = 0; cb < 4; ++cb) {
        float r[32];
#pragma unroll
        for (int i = 0; i < 32; ++i) r[i] = Rm[(size_t)(cb * 32 + i) * 1024 + d];
#pragma unroll
        for (int i = 0; i < 32; ++i) { const int cp = cb * 32 + i;
#pragma unroll
            for (int j = 0; j < 8; ++j) { const float lv = __builtin_bit_cast(float, __builtin_amdgcn_readlane(__builtin_bit_cast(int, cp < 64 ? l0[j] : l1[j]), cp & 63)); acc[j] = fmaf(lv, r[i], acc[j]); } }
    }
    v4u o; o.x = pk2(acc[0] * scale, acc[1] * scale); o.y = pk2(acc[2] * scale, acc[3] * scale); o.z = pk2(acc[4] * scale, acc[5] * scale); o.w = pk2(acc[6] * scale, acc[7] * scale);
    *(GAS v4u*)(out + (size_t)d * 1024 + dk0) = o;
}
__device__ __forceinline__ void p0_pq_item(const float* Win1, const float* g1, bf16* WPQ, int h, int half, int k0, const LAS float* tab, int lane) {
    const int cp = 64 * half + lane;
    float ap[8], aq[8], w0[8], w1[8];
#pragma unroll
    for (int j = 0; j < 8; ++j) { const float g = g1[k0 + j]; ap[j] = 0.f; aq[j] = 0.f; w0[j] = Win1[(size_t)(k0 + j) * 1536 + h * 128 + lane] * g; w1[j] = Win1[(size_t)(k0 + j) * 1536 + h * 128 + 64 + lane] * g; }
#pragma unroll 8
    for (int c = 0; c < 128; ++c) {
        const int ph = c * cp;
        const float cs = tab[ph & 127], sn = tab[(ph - 32) & 127];
#pragma unroll
        for (int j = 0; j < 8; ++j) { const float w = __builtin_bit_cast(float, __builtin_amdgcn_readlane(__builtin_bit_cast(int, c < 64 ? w0[j] : w1[j]), c & 63)); ap[j] = fmaf(w, cs, ap[j]); aq[j] = fmaf(w, sn, aq[j]); }
    }
    v4u o; o.x = pk2(ap[0], ap[1]); o.y = pk2(ap[2], ap[3]); o.z = pk2(ap[4], ap[5]); o.w = pk2(ap[6], ap[7]);
    *(GAS v4u*)(WPQ + (size_t)(h * 128 + cp) * 1024 + k0) = o;
    o.x = pk2(aq[0], aq[1]); o.y = pk2(aq[2], aq[3]); o.z = pk2(aq[4], aq[5]); o.w = pk2(aq[6], aq[7]);
    *(GAS v4u*)(WPQ + (size_t)(512 + h * 128 + cp) * 1024 + k0) = o;
}

struct Ptrs {
    const float* in[22]; float* out; unsigned char* ws;
};

__device__ __forceinline__ void p0_prologue(Frame& F, const Ptrs& P) {
    const float* x = P.in[0]; const float* mix_g = P.in[1]; const float* ffn_g = P.in[2];
    const float* ev_w_in = P.in[3]; const float* ev_pool_w = P.in[8]; const float* ev_pool_scale = P.in[9]; const float* ev_w_out = P.in[10];
    const float* od_w_in = P.in[11]; const float* od_fourier_w = P.in[12]; const float* od_w_out = P.in[17];
    const float* w_gate = P.in[18]; const float* w_up = P.in[19]; const float* w_down = P.in[20];
    unsigned char* ws = P.ws;
    LAS float* scr = (LAS float*)(F.lds + RING_OFF + F.wave * 8448);
    LAS float* CT = (LAS float*)(F.lds + RING_OFF + 69632);
    LAS float* tab = (LAS float*)(F.lds + RING_OFF + 69632 + 16384);
    for (int i = F.tid; i < 4096; i += NWAVES * 64) CT[i] = cospif((float)i * (1.0f / 2048.0f));
    if (F.tid < 128) tab[F.tid] = cospif((float)F.tid * (1.0f / 64.0f));
    WG_BAR();
    const int gw = F.vcu * NWAVES + F.wave, NGW = F.G * NWAVES, lane = F.lane;
    { unsigned long long* z = (unsigned long long*)(ws + WS_SSQ) + M; const int gt = F.vcu * NWAVES * 64 + F.tid, NT = F.G * NWAVES * 64;
      for (int i = gt; i < 4 * M; i += NT) z[i] = 0ull; }
    int cur = 0;
    p0_job(ev_w_in, 1536, mix_g, 0, 1024, 0, 512, (bf16*)(ws + WS_WIN0), 1024, 0, 1, 0, scr, lane, gw, NGW, cur);
    p0_job(ev_w_in, 1536, mix_g, 0, 1024, 512, 512, (bf16*)(ws + WS_WIN0), 1024, 0, 1, 1, scr, lane, gw, NGW, cur);
    p0_job(ev_w_in, 1536, mix_g, 0, 1024, 1024, 512, (bf16*)(ws + WS_WIN0), 1024, 0, 0, 1024, scr, lane, gw, NGW, cur);
    p0_job(ev_w_out, 1024, nullptr, 0, 512, 0, 1024, (bf16*)(ws + WS_WOUT0), 1024, 0, 0, 0, scr, lane, gw, NGW, cur);
    p0_job(w_gate, FF, ffn_g, 0, 1024, 0, FF, (bf16*)(ws + WS_WGU0), 1024, 0, 1, 0, scr, lane, gw, NGW, cur);
    p0_job(w_up, FF, ffn_g, 0, 1024, 0, FF, (bf16*)(ws + WS_WGU0), 1024, 0, 1, 1, scr, lane, gw, NGW, cur);
    p0_job(w_down, 1024, nullptr, 0, FF, 0, 1024, (bf16*)(ws + WS_WDN0), FF, 0, 0, 0, scr, lane, gw, NGW, cur);
    p0_job(od_w_in, 1536, mix_g + D, 0, 1024, 512, 1024, (bf16*)(ws + WS_WUV1), 1024, 0, 0, 0, scr, lane, gw, NGW, cur);
    p0_job(od_w_out, 1024, nullptr, 512, 512, 0, 1024, (bf16*)(ws + WS_WOUT1), 1024, 512, 0, 0, scr, lane, gw, NGW, cur);
    p0_job(w_gate + (size_t)D * FF, FF, ffn_g + D, 0, 1024, 0, FF, (bf16*)(ws + WS_WGU1), 1024, 0, 1, 0, scr, lane, gw, NGW, cur);
    p0_job(w_up + (size_t)D * FF, FF, ffn_g + D, 0, 1024, 0, FF, (bf16*)(ws + WS_WGU1), 1024, 0, 1, 1, scr, lane, gw, NGW, cur);
    p0_job(w_down + (size_t)FF * D, 1024, nullptr, 0, FF, 0, 1024, (bf16*)(ws + WS_WDN1), FF, 0, 0, 0, scr, lane, gw, NGW, cur);
    {
        int first = (gw - (cur % NGW) + NGW) % NGW;
        for (int it = first; it < 1024; it += NGW) { const int g = it >> 8, cc = (it >> 4) & 15, dw = it & 15;
            p0_fold_item(ev_pool_w, g * 128 + cc * 8, ev_pool_scale + g * 128, ev_w_out + (size_t)(512 + g * 128) * 1024, (bf16*)(ws + WS_WOUT0), 512 + g * 128 + cc * 8, 1.0f, dw, lane); }
        cur += 1024;
        first = (gw - (cur % NGW) + NGW) % NGW;
        for (int it = first; it < 1024; it += NGW) { const int h = it >> 8, cc = (it >> 4) & 15, dw = it & 15;
            p0_fold_item(od_fourier_w, h * 128 + cc * 8, nullptr, od_w_out + (size_t)(h * 128) * 1024, (bf16*)(ws + WS_WOUT1), h * 128 + cc * 8, 1.0f / 724.0773439350247f, dw, lane); }
        cur += 1024;
        first = (gw - (cur % NGW) + NGW) % NGW;
        for (int it = first; it < 1024; it += NGW) { const int h = it >> 8, half = (it >> 7) & 1, kc = it & 127;
            p0_pq_item(od_w_in, mix_g + D, (bf16*)(ws + WS_WPQ1), h, half, kc * 8, tab, lane); }
        cur += 1024;
    }
    {
        bf16* A2 = (bf16*)(ws + WS_DFT);
        int first = (gw - (cur % NGW) + NGW) % NGW;
        for (int t2 = first; t2 < 256; t2 += NGW) {
            const int k0 = lane * 8, sinpart = k0 >> 8, s0 = k0 & 255;
            float v[8];
#pragma unroll
            for (int e = 0; e < 8; ++e) v[e] = CT[((((s0 + e) * t2) & 255) * 16 - (sinpart ? 1024 : 0)) & (S - 1)];
            v4u o; o.x = pk2(v[0], v[1]); o.y = pk2(v[2], v[3]); o.z = pk2(v[4], v[5]); o.w = pk2(v[6], v[7]);
            *(GAS v4u*)(A2 + (size_t)t2 * 512 + k0) = o;
        }
        cur += 256;
    }
    {
        bf16* XB = (bf16*)(ws + WS_XB); unsigned long long* ssq0 = (unsigned long long*)(ws + WS_SSQ);
        for (int m0 = 4 * gw; m0 < M; m0 += 4 * NGW) {
            f32x4 v[4][4];
#pragma unroll
            for (int r = 0; r < 4; ++r) { const GAS f32x4* xr = (const GAS f32x4*)(x + (size_t)(m0 + r) * D) + lane;
#pragma unroll
                for (int j = 0; j < 4; ++j) v[r][j] = xr[64 * j]; }
#pragma unroll
            for (int r = 0; r < 4; ++r) { float s = 0.f;
#pragma unroll
                for (int j = 0; j < 4; ++j) s += (v[r][j].x * v[r][j].x + v[r][j].y * v[r][j].y) + (v[r][j].z * v[r][j].z + v[r][j].w * v[r][j].w);
                s = wave_sum(s);
                if (lane == 0) ssq0[m0 + r] = pg8::ssq_fix(s);
                GAS unsigned long long* o8 = (GAS unsigned long long*)(XB + (size_t)(m0 + r) * D) + lane;
#pragma unroll
                for (int j = 0; j < 4; ++j) o8[64 * j] = (unsigned long long)pk2(v[r][j].x, v[r][j].y) | ((unsigned long long)pk2(v[r][j].z, v[r][j].w) << 32); }
        }
    }
}

__device__ __forceinline__ float fsel(bool c, float a, float b) { return c ? a : b; }
__device__ __forceinline__ float reduce_scatter32(float (&v)[32], int lane) {
#pragma unroll
    for (int o = 16; o >= 1; o >>= 1) {
        const bool up = (lane & o) != 0;
#pragma unroll
        for (int i = 0; i < o; ++i) { const float lo_ = v[i], hi_ = v[i + o]; const float send = fsel(up, lo_, hi_), keep = fsel(up, hi_, lo_); v[i] = keep + __shfl_xor(send, o); }
#pragma unroll
        for (int i = 0; i < o; ++i) asm volatile("" : "+v"(v[i]));
    }
    return v[0] + __shfl_xor(v[0], 32);
}
__device__ __forceinline__ float reduce_scatter16(float (&v)[16], int lane) {
#pragma unroll
    for (int o = 8; o >= 1; o >>= 1) {
        const bool up = (lane & o) != 0;
#pragma unroll
        for (int i = 0; i < o; ++i) { const float lo_ = v[i], hi_ = v[i + o]; const float send = fsel(up, lo_, hi_), keep = fsel(up, hi_, lo_); v[i] = keep + __shfl_xor(send, o); }
#pragma unroll
        for (int i = 0; i < o; ++i) asm volatile("" : "+v"(v[i]));
    }
    float t = v[0] + __shfl_xor(v[0], 16);
    return t + __shfl_xor(t, 32);
}
template <int pmode> __device__ __forceinline__ void mix0_conv_item(Frame& F, const Ptrs& P, int item) {
    const bf16* UB = (const bf16*)(P.ws + WS_UB); bf16* AM = (bf16*)(P.ws + WS_AM);
    const float* cw = P.in[4]; const float* cb = P.in[5]; const float* lg = P.in[6]; const float* lb = P.in[7];
    const int b = item >> 6, t0 = (item & 63) * 64, rowbase = b * S;
    LAS unsigned* tile = (LAS unsigned*)(F.lds + RING_OFF);
    LAS float* red = (LAS float*)(F.lds + RING_OFF + 98304);
    int tidl = F.tid; asm volatile("" : "+v"(tidl));
    const int rg = tidl >> 8, cp = tidl & 255, lanel = tidl & 63;
    const f32x2g bb = *(const GAS f32x2g*)(cb + 2 * cp);
    const f32x2g g2 = *(const GAS f32x2g*)(lg + 2 * cp), b2 = *(const GAS f32x2g*)(lb + 2 * cp);
    float w0[31], w1[31];
#pragma unroll
    for (int j = 0; j < 31; ++j) { const f32x2g w = *(const GAS f32x2g*)(cw + j * 512 + 2 * cp); w0[j] = w.x; w1[j] = w.y; }
    if (pmode != 7) { v4u tv[12];
#pragma unroll
      for (int i = 0; i < 12; ++i) { const int t = t0 - 15 + F.wave + NWAVES * i, tc = t < 0 ? 0 : (t > S - 1 ? S - 1 : t);
          tv[i] = *(const GAS v4u*)(UB + (size_t)(rowbase + tc) * 512 + F.lane * 8); }
#pragma unroll
      for (int i = 0; i < 12; ++i) { const int r = F.wave + NWAVES * i, t = t0 - 15 + r; const bool ok = (t >= 0 && t < S);
          v4u w = tv[i]; w.x = ok ? w.x : 0u; w.y = ok ? w.y : 0u; w.z = ok ? w.z : 0u; w.w = ok ? w.w : 0u;
          *(LAS v4u*)(tile + r * 256 + F.lane * 4) = w; } }
    LDS_BAR();
#pragma unroll 1
    for (int p = 0; p < (pmode == 10 ? 1 : 4); ++p) {
        float a0[8], a1[8];
#pragma unroll
        for (int o = 0; o < 8; ++o) { a0[o] = bb.x; a1[o] = bb.y; }
        const LAS unsigned* tp = tile + (32 * rg + 8 * p) * 256 + cp;
        if (pmode != 5)
#pragma unroll
        for (int ii = 0; ii < 38; ++ii) {
            const unsigned xx = tp[ii * 256];
            const float x0 = bf_lo(xx), x1 = bf_hi(xx);
#pragma unroll
            for (int o = 0; o < 8; ++o) { const int j = ii - o; if (j >= 0 && j <= 30) { a0[o] = fmaf(w0[j], x0, a0[o]); a1[o] = fmaf(w1[j], x1, a1[o]); } }
        }
        float v[16];
#pragma unroll
        for (int o = 0; o < 8; ++o) { v[2 * o] = a0[o] + a1[o]; v[2 * o + 1] = a0[o] * a0[o] + a1[o] * a1[o]; }
        LAS float* redp = red + (p & 1) * 128;
        if (pmode != 6) {
        const float tot = reduce_scatter16(v, lanel);
        if (lanel < 16) redp[(F.wave & 3) * 16 + lanel + rg * 64] = tot;
        LDS_BAR(); }
        float mean8[8], rstd8[8];
        {
            const LAS f32x4* rp = (const LAS f32x4*)(redp + rg * 64);
            f32x4 acc4[4];
#pragma unroll
            for (int k = 0; k < 4; ++k) acc4[k] = rp[k];
#pragma unroll
            for (int w = 1; w < 4; ++w)
#pragma unroll
                for (int k = 0; k < 4; ++k) acc4[k] = acc4[k] + rp[w * 4 + k];
#pragma unroll
            for (int o = 0; o < 8; ++o) { const float sm = acc4[o >> 1][(o & 1) * 2], sq = acc4[o >> 1][(o & 1) * 2 + 1];
                const float mean = sm * (1.0f / 512.0f), var = sq * (1.0f / 512.0f) - mean * mean; mean8[o] = mean; rstd8[o] = __builtin_amdgcn_rsqf(var + 1e-6f); }
        }
        if (pmode != 8)
#pragma unroll
        for (int o = 0; o < 8; ++o) {
            const float mean = mean8[o], rstd = rstd8[o];
            float y0 = (a0[o] - mean) * rstd * g2.x + b2.x, y1 = (a1[o] - mean) * rstd * g2.y + b2.y;
            y0 = y0 * __builtin_amdgcn_rcpf(1.0f + __expf(-y0)); y1 = y1 * __builtin_amdgcn_rcpf(1.0f + __expf(-y1));
            *(GAS unsigned*)(AM + (size_t)(rowbase + t0 + 32 * rg + 8 * p + o) * 1024 + 2 * cp) = pk2(y0, y1);
        }
    }
    LDS_BAR();
}
template <int H> __device__ __forceinline__ void pool_rows(const LAS unsigned* tp  , bf16* orow  , int tfirst) {
    unsigned x[32 + 2 * H];
#pragma unroll
    for (int i = 0; i < 32 + 2 * H; ++i) x[i] = tp[i * 256];
    float s0 = 0.f, s1 = 0.f;
#pragma unroll
    for (int i = 0; i < 2 * H; ++i) { s0 += bf_lo(x[i]); s1 += bf_hi(x[i]); }
#pragma unroll
    for (int o = 0; o < 32; ++o) {
        const int t = tfirst + o;
        const int lo = (t - H) < 0 ? 0 : (t - H), hi = (t + H - 1) > (S - 1) ? (S - 1) : (t + H - 1);
        const float inv = 1.0f / (float)(hi - lo + 1);
        *(GAS unsigned*)(orow + (size_t)o * 1024) = pk2(s0 * inv - bf_lo(x[o + H]), s1 * inv - bf_hi(x[o + H]));
        if (o < 31) { s0 += bf_lo(x[o + 2 * H]) - bf_lo(x[o]); s1 += bf_hi(x[o + 2 * H]) - bf_hi(x[o]); }
    }
}
__device__ __forceinline__ void mix0_pool_item(Frame& F, const Ptrs& P, int item) {
    const bf16* PB = (const bf16*)(P.ws + WS_PB); bf16* AM = (bf16*)(P.ws + WS_AM);
    const int b = item >> 6, t0 = (item & 63) * 64, rowbase = b * S;
    LAS unsigned* tile = (LAS unsigned*)(F.lds + RING_OFF);
    { v4u tv[10];
#pragma unroll
      for (int i = 0; i < 10; ++i) { const int t = t0 - 8 + F.wave + NWAVES * i, tc = t < 0 ? 0 : (t > S - 1 ? S - 1 : t);
          tv[i] = *(const GAS v4u*)(PB + (size_t)(rowbase + tc) * 512 + F.lane * 8); }
#pragma unroll
      for (int i = 0; i < 10; ++i) { const int r = F.wave + NWAVES * i, t = t0 - 8 + r; const bool ok = (t >= 0 && t < S);
          v4u w = tv[i]; w.x = ok ? w.x : 0u; w.y = ok ? w.y : 0u; w.z = ok ? w.z : 0u; w.w = ok ? w.w : 0u;
          *(LAS v4u*)(tile + r * 256 + F.lane * 4) = w; } }
    LDS_BAR();
    const int rg = F.tid >> 8, cp = F.tid & 255, g = __builtin_amdgcn_readfirstlane(cp >> 6);
    bf16* orow = AM + (size_t)(rowbase + t0 + 32 * rg) * 1024 + 512 + 2 * cp;
    const int tfirst = t0 + 32 * rg;
    if (g == 0) pool_rows<1>(tile + (32 * rg + 8 - 1) * 256 + cp, orow, tfirst);
    else if (g == 1) pool_rows<2>(tile + (32 * rg + 8 - 2) * 256 + cp, orow, tfirst);
    else if (g == 2) pool_rows<4>(tile + (32 * rg + 8 - 4) * 256 + cp, orow, tfirst);
    else pool_rows<8>(tile + (32 * rg + 8 - 8) * 256 + cp, orow, tfirst);
    LDS_BAR();
}

__device__ __forceinline__ void sgu_item(Frame& F, const Ptrs& P, int item) {
    const bf16* U = (const bf16*)(P.ws + WS_U1); const bf16* V = (const bf16*)(P.ws + WS_V1); bf16* AM = (bf16*)(P.ws + WS_AM);
    const float* lng = P.in[13]; const float* lnb = P.in[14]; const float* sw = P.in[15]; const float* sb = P.in[16];
    const int h = item & 3, rowbase = (item >> 2) * 128;
    LAS bf16* vnT = (LAS bf16*)(F.lds + RING_OFF);
    int lane = F.lane; asm volatile("" : "+v"(lane));
    const int fr = lane & 15, fq = lane >> 4, q = 16 * F.wave + fr;
    pg8::f32x4 wa[4], wb[4];
#pragma unroll
    for (int ks = 0; ks < 4; ++ks) { const GAS pg8::f32x4* wp = (const GAS pg8::f32x4*)(sw + (size_t)(h * 128 + q) * 128 + ks * 32 + 8 * fq); wa[ks] = wp[0]; wb[ks] = wp[1]; }
    u32x2g uu[8];
#pragma unroll
    for (int nt = 0; nt < 8; ++nt) uu[nt] = *(const GAS u32x2g*)(U + (size_t)(rowbase + q) * 512 + h * 128 + 16 * nt + 4 * fq);
    const float bias = sb[h * 128 + q];
    {
        const f32x2g g2 = *(const GAS f32x2g*)(lng + h * 128 + 2 * lane), b2 = *(const GAS f32x2g*)(lnb + h * 128 + 2 * lane);
        unsigned xv[16];
#pragma unroll
        for (int i = 0; i < 16; ++i) xv[i] = *(const GAS unsigned*)(V + (size_t)(rowbase + 16 * F.wave + i) * 512 + h * 128 + 2 * lane);
        float st[32];
#pragma unroll
        for (int i = 0; i < 16; ++i) { const float v0 = bf_lo(xv[i]), v1 = bf_hi(xv[i]); st[2 * i] = v0 + v1; st[2 * i + 1] = v0 * v0 + v1 * v1; }
        const float tot = reduce_scatter32(st, lane);
        unsigned y0[8], y1[8];
#pragma unroll
        for (int i = 0; i < 16; ++i) {
            const float sm = __builtin_bit_cast(float, __builtin_amdgcn_readlane(__builtin_bit_cast(int, tot), 2 * i)), sq = __builtin_bit_cast(float, __builtin_amdgcn_readlane(__builtin_bit_cast(int, tot), 2 * i + 1));
            const float mean = sm * (1.0f / 128.0f), rstd = __builtin_amdgcn_rsqf(sq * (1.0f / 128.0f) - mean * mean + 1e-6f);
            const unsigned a0 = f2bf((bf_lo(xv[i]) - mean) * rstd * g2.x + b2.x), a1 = f2bf((bf_hi(xv[i]) - mean) * rstd * g2.y + b2.y);
            if (i & 1) { y0[i >> 1] |= a0 << 16; y1[i >> 1] |= a1 << 16; } else { y0[i >> 1] = a0; y1[i >> 1] = a1; }
        }
        LAS bf16* d0 = vnT + (2 * lane) * 136 + 16 * F.wave;
        *(LAS v4u*)d0 = (v4u){y0[0], y0[1], y0[2], y0[3]}; *(LAS v4u*)(d0 + 8) = (v4u){y0[4], y0[5], y0[6], y0[7]};
        *(LAS v4u*)(d0 + 136) = (v4u){y1[0], y1[1], y1[2], y1[3]}; *(LAS v4u*)(d0 + 136 + 8) = (v4u){y1[4], y1[5], y1[6], y1[7]};
    }
    LDS_BAR();
    {
        pg8::f32x4 acc[8];
#pragma unroll
        for (int nt = 0; nt < 8; ++nt) acc[nt] = (pg8::f32x4){0.f, 0.f, 0.f, 0.f};
#pragma unroll
        for (int ks = 0; ks < 4; ++ks) {
            pg8::u32x4 wq; wq.x = pk2(wa[ks][0], wa[ks][1]); wq.y = pk2(wa[ks][2], wa[ks][3]); wq.z = pk2(wb[ks][0], wb[ks][1]); wq.w = pk2(wb[ks][2], wb[ks][3]);
            const pg8::bf16x8 wf = __builtin_bit_cast(pg8::bf16x8, wq);
#pragma unroll
            for (int nt = 0; nt < 8; ++nt) {
                const pg8::bf16x8 vf = *(const LAS pg8::bf16x8*)(vnT + (16 * nt + fr) * 136 + ks * 32 + 8 * fq);
                acc[nt] = __builtin_amdgcn_mfma_f32_16x16x32_bf16(vf, wf, acc[nt], 0, 0, 0);
            }
        }
        const size_t t = (size_t)(rowbase + q);
#pragma unroll
        for (int nt = 0; nt < 8; ++nt) { const int c0 = h * 128 + 16 * nt + 4 * fq;
            u32x2g o; o.x = pk2(bf_lo(uu[nt].x) * (acc[nt][0] + bias), bf_hi(uu[nt].x) * (acc[nt][1] + bias)); o.y = pk2(bf_lo(uu[nt].y) * (acc[nt][2] + bias), bf_hi(uu[nt].y) * (acc[nt][3] + bias));
            *(GAS u32x2g*)(AM + t * 1024 + 512 + c0) = o; }
    }
    LDS_BAR();
}

struct cpx { float r, i; };
__device__ __forceinline__ cpx cadd(cpx a, cpx b) { return {a.r + b.r, a.i + b.i}; }
__device__ __forceinline__ cpx csub(cpx a, cpx b) { return {a.r - b.r, a.i - b.i}; }
__device__ __forceinline__ cpx cmulc(cpx a, float c, float s) { return {a.r * c + a.i * s, a.i * c - a.r * s}; }
__device__ __forceinline__ cpx cmni(cpx a) { return {a.i, -a.r}; }
__device__ __forceinline__ void dft4(cpx& x0, cpx& x1, cpx& x2, cpx& x3) {
    const cpx s02 = cadd(x0, x2), d02 = csub(x0, x2), s13 = cadd(x1, x3), d13 = cmni(csub(x1, x3));
    x0 = cadd(s02, s13); x1 = cadd(d02, d13); x2 = csub(s02, s13); x3 = csub(d02, d13);
}
__device__ __forceinline__ void fft16(cpx (&x)[16], cpx (&z)[16]) {
    constexpr float C1 = 0.92387953251128674f, S1 = 0.38268343236508977f, R2 = 0.70710678118654752f;
#pragma unroll
    for (int b = 0; b < 4; ++b) dft4(x[b], x[4 + b], x[8 + b], x[12 + b]);
    x[4 + 1] = cmulc(x[4 + 1], C1, S1);  x[8 + 1] = cmulc(x[8 + 1], R2, R2);   x[12 + 1] = cmulc(x[12 + 1], S1, C1);
    x[4 + 2] = cmulc(x[4 + 2], R2, R2);  x[8 + 2] = cmni(x[8 + 2]);            x[12 + 2] = cmulc(x[12 + 2], -R2, R2);
    x[4 + 3] = cmulc(x[4 + 3], S1, C1);  x[8 + 3] = cmulc(x[8 + 3], -R2, R2);  x[12 + 3] = cmulc(x[12 + 3], -C1, -S1);
#pragma unroll
    for (int c = 0; c < 4; ++c) { dft4(x[4 * c], x[4 * c + 1], x[4 * c + 2], x[4 * c + 3]);
        z[c] = x[4 * c]; z[c + 4] = x[4 * c + 1]; z[c + 8] = x[4 * c + 2]; z[c + 12] = x[4 * c + 3]; }
}
__device__ __forceinline__ void fft_stage1(Frame& F, const Ptrs& P) {
    const bf16* PQT = (const bf16*)(P.ws + WS_PQT); bf16* ZP = (bf16*)(P.ws + WS_ZP);
    LAS float* CT = (LAS float*)(F.lds + RING_OFF + 65536);
    { int tl = F.tid; asm volatile("" : "+v"(tl)); for (int i = tl; i < 4096; i += NWAVES * 64) CT[i] = cospif((float)i * (1.0f / 2048.0f)); }
    LDS_BAR();
    int gw = F.vcu * NWAVES + F.wave; asm volatile("" : "+s"(gw)); const int NGW = F.G * NWAVES;
    for (int item = gw; item < NB * 512 * 2; item += NGW) {
        int lane = F.lane; asm volatile("" : "+v"(lane));
        const int row = item >> 1, s20 = 128 * (item & 1) + 2 * lane, b = row >> 9, ch = row & 511;
        const bf16* src = PQT + (size_t)row * 2 * S + s20;
        unsigned xp[16], xq[16];
#pragma unroll
        for (int s1 = 0; s1 < 16; ++s1) { xp[s1] = *(const GAS unsigned*)(src + 256 * s1); xq[s1] = *(const GAS unsigned*)(src + S + 256 * s1); }
        unsigned zr[16], zi[16];
#pragma unroll
        for (int e = 0; e < 2; ++e) {
            cpx x[16], z[16];
#pragma unroll
            for (int s1 = 0; s1 < 16; ++s1) { x[s1].r = e ? bf_hi(xp[s1]) : bf_lo(xp[s1]); x[s1].i = -(e ? bf_hi(xq[s1]) : bf_lo(xq[s1])); }
            fft16(x, z);
            const int s2 = s20 + e;
#pragma unroll
            for (int t1 = 0; t1 < 16; ++t1) {
                const int idx = s2 * t1;
                const cpx w = cmulc(z[t1], CT[idx], CT[(idx - 1024) & (S - 1)]);
                const unsigned hr = f2bf(w.r), hi = f2bf(w.i);
                if (e == 0) { zr[t1] = hr; zi[t1] = hi; } else { zr[t1] |= hr << 16; zi[t1] |= hi << 16; }
            }
        }
#pragma unroll
        for (int t1 = 0; t1 < 16; ++t1) { bf16* dst = ZP + ((size_t)((b * 16 + t1) * 512 + ch)) * 512 + s20;
            *(GAS unsigned*)dst = zr[t1]; *(GAS unsigned*)(dst + 256) = zi[t1]; }
    }
}

struct Args { const float* in[22]; float* out; unsigned char* ws; int ph_lo, ph_hi, li, pad; };
template <int PM> __device__ __forceinline__ void mk_body(const Args& args) {
    extern __shared__ __attribute__((aligned(16))) unsigned char lds[];
    Frame F;
    F.lds = (LAS unsigned char*)lds;
    F.MISC = (volatile LAS unsigned*)(F.lds + MISC_OFF);
    F.tid = threadIdx.x; F.lane = F.tid & 63; F.wave = __builtin_amdgcn_readfirstlane(F.tid >> 6);
    F.G = gridDim.x; { const int bx = blockIdx.x; F.vcu = (F.G % 8 == 0) ? (bx % 8) * (F.G / 8) + bx / 8 : bx; }
    Ptrs P;
#pragma unroll
    for (int i = 0; i < 22; ++i) P.in[i] = args.in[i];
    P.out = args.out; P.ws = args.ws;
    unsigned char* ws = args.ws;
    F.ctl = (gu32*)(ws + WS_CTL);
    for (int u = F.tid; u < (LDS_BYTES - LDSCTL_OFF) / 4; u += NWAVES * 64) ((LAS unsigned*)(F.lds + LDSCTL_OFF))[u] = 0u;
    __syncthreads();
    XcdBarrier bar; bar.bar = (unsigned*)(F.ctl + CW_BAR); bar.x = 0; bar.st = nullptr;
    if (!MK_PER_PHASE) bar = xcd_barrier_post((unsigned*)(F.ctl + CW_BAR), F.MISC + 8);
    const int lo = args.ph_lo, hi = args.ph_hi;
#ifndef PH_MASK
#define PH_MASK 0x1FFF
#endif
#define IN(k) ((((PH_MASK) >> (k)) & 1) && lo <= (k) && (k) < hi)
#ifndef PROBE_BARX
#define PROBE_BARX 1
#endif
#define SEAM(k) do { if (IN(k) && IN((k) + 1)) { for (int bx_ = 0; bx_ < PROBE_BARX; ++bx_) xcd_barrier(bar); } } while (0)
    unsigned long long* ssq = (unsigned long long*)(ws + WS_SSQ);
    bf16* XB = (bf16*)(ws + WS_XB); bf16* AM = (bf16*)(ws + WS_AM); bf16* HB = (bf16*)(ws + WS_H);
    const int bid = (int)blockIdx.x;
    constexpr bool dup = PM != 0;
    bf16* TRX = (bf16*)(ws + WS_END); unsigned long long* TRS = (unsigned long long*)(ws + WS_END + 64 * MiB);

    if (IN(0)) { p0_prologue(F, P); } SEAM(0);
    if (IN(1)) { pg8::Gemm g{XB, (const bf16*)(ws + WS_WIN0), M, 1536, D}; pg8::StaticOrder So; So.init(M, 1536, F.G, bid);
        pg8::EpiInL0 E{(bf16*)(ws + WS_UB), (bf16*)(ws + WS_PB), ssq};
        pg8::gemm_phase<pg8::EpiInL0, pg8::StaticOrder, true, true>(F.lds + RING_OFF, g, So, E); } SEAM(1);
    if (IN(2)) { for (int it = F.vcu; it < 1024; it += F.G) {
#ifndef NO_CONV
            if (it < 512 && PM != 4 && PM != 9) mix0_conv_item<PM>(F, P, it);
#endif
#ifndef NO_POOL
            if (it >= 512 && PM != 3 && PM != 9) mix0_pool_item(F, P, it - 512);
#endif
 } } SEAM(2);
    if (IN(3)) { pg8::Gemm g{AM, (const bf16*)(ws + WS_WOUT0), M, D, D}; pg8::StaticOrder So; So.init(M, D, F.G, bid);
        pg8::EpiResid E{XB, dup ? TRS : ssq + M, dup ? TRX : XB, PM};
        pg8::gemm_phase<pg8::EpiResid, pg8::StaticOrder, true, true>(F.lds + RING_OFF, g, So, E); } SEAM(3);
    if (IN(4)) { pg8::Gemm g{XB, (const bf16*)(ws + WS_WGU0), M, 2 * FF, D}; pg8::StaticOrder So; So.init(M, 2 * FF, F.G, bid);
        pg8::EpiSwiGLU E{HB, ssq + M, PM};
        pg8::gemm_phase<pg8::EpiSwiGLU, pg8::StaticOrder, true, true>(F.lds + RING_OFF, g, So, E); } SEAM(4);
    if (IN(5)) { pg8::Gemm g{HB, (const bf16*)(ws + WS_WDN0), M, D, FF}; pg8::StaticOrder So; So.init(M, D, F.G, bid);
        pg8::EpiResid E{XB, dup ? TRS : ssq + 2 * M, dup ? TRX : XB, PM};
        pg8::gemm_phase<pg8::EpiResid, pg8::StaticOrder, true, true>(F.lds + RING_OFF, g, So, E); } SEAM(5);
    if (IN(6)) {
        { pg8::Gemm g{(const bf16*)(ws + WS_WPQ1), XB, 1024, M, D}; pg8::StaticOrder So; So.init(1024, M, F.G, bid);
          pg8::EpiPQT E{(bf16*)(ws + WS_PQT), ssq + 2 * M};
          pg8::gemm_phase<pg8::EpiPQT, pg8::StaticOrder, true, true>(F.lds + RING_OFF, g, So, E); }
        { pg8::Gemm g{XB, (const bf16*)(ws + WS_WUV1), M, 1024, D}; pg8::StaticOrder So; So.init(M, 1024, F.G, bid);
          pg8::EpiGeluUV E{(bf16*)(ws + WS_U1), (bf16*)(ws + WS_V1), ssq + 2 * M};
          pg8::gemm_phase<pg8::EpiGeluUV, pg8::StaticOrder, true, true>(F.lds + RING_OFF, g, So, E); }
    } SEAM(6);
    if (IN(7)) {
        if (PM != 12) { fft_stage1(F, P); }
        if (PM != 11) { for (int it = F.vcu; it < 1024; it += F.G) sgu_item(F, P, it); }
    } SEAM(7);
    if (IN(8)) { pg8::Gemm g{(const bf16*)(ws + WS_DFT), (const bf16*)(ws + WS_ZP), 256, NB * 16 * 512, 512}; pg8::StaticOrder So; So.init(256, NB * 16 * 512, F.G, bid);
        pg8::EpiDFT2 E{AM};
        pg8::gemm_phase<pg8::EpiDFT2, pg8::StaticOrder, true, true>(F.lds + RING_OFF, g, So, E); } SEAM(8);
    if (IN(9)) { pg8::Gemm g{AM, (const bf16*)(ws + WS_WOUT1), M, D, D}; pg8::StaticOrder So; So.init(M, D, F.G, bid);
        pg8::EpiResid E{XB, dup ? TRS : ssq + 3 * M, dup ? TRX : XB, PM};
        pg8::gemm_phase<pg8::EpiResid, pg8::StaticOrder, true, true>(F.lds + RING_OFF, g, So, E); } SEAM(9);
    if (IN(10)) { pg8::Gemm g{XB, (const bf16*)(ws + WS_WGU1), M, 2 * FF, D}; pg8::StaticOrder So; So.init(M, 2 * FF, F.G, bid);
        pg8::EpiSwiGLU E{HB, ssq + 3 * M, PM};
        pg8::gemm_phase<pg8::EpiSwiGLU, pg8::StaticOrder, true, true>(F.lds + RING_OFF, g, So, E); } SEAM(10);
    if (IN(11)) { pg8::Gemm g{HB, (const bf16*)(ws + WS_WDN1), M, D, FF}; pg8::StaticOrder So; So.init(M, D, F.G, bid);
        pg8::EpiResid E{XB, dup ? TRS : ssq + 4 * M, dup ? TRX : XB, PM};
        pg8::gemm_phase<pg8::EpiResid, pg8::StaticOrder, true, true>(F.lds + RING_OFF, g, So, E); } SEAM(11);
    if (IN(12)) {
        const float* gf = P.in[21]; const unsigned long long* ssq4 = ssq + 4 * M;
        const int gw = F.vcu * NWAVES + F.wave, NGW = F.G * NWAVES;
        for (int m = gw; m < M; m += NGW) {
            const GAS u32x2g* xr = (const GAS u32x2g*)(XB + (size_t)m * D) + F.lane; GAS f32x4* orow = (GAS f32x4*)(P.out + (size_t)m * D) + F.lane; const GAS f32x4* gr = (const GAS f32x4*)gf + F.lane;
            const float rs = pg8::rstd_of(ssq4[m]);
#pragma unroll
            for (int j = 0; j < 4; ++j) { const u32x2g xx = xr[64 * j]; const f32x4 gg = gr[64 * j];
                f32x4 v; v.x = bf_lo(xx.x); v.y = bf_hi(xx.x); v.z = bf_lo(xx.y); v.w = bf_hi(xx.y); orow[64 * j] = v * rs * gg; }
        }
    }
#undef IN
#undef SEAM
}
__global__ void __launch_bounds__(NWAVES * 64, 2) mk_fwd(Args args) { mk_body<0>(args); }
#ifdef PROBE_PHASE
#ifndef PROBE_MODE
#define PROBE_MODE 1
#endif
__global__ void __launch_bounds__(NWAVES * 64, 2) mk_probe(Args args) { mk_body<PROBE_MODE>(args); }
#endif

extern "C" void kernel_launch(void* const* d_in, const int* in_sizes, int n_in, void* d_out, int out_size, void* d_ws, size_t ws_size, hipStream_t stream) {
    static int grid = 0;
    if (grid == 0) {
        if (n_in != 22 || in_sizes[0] != M * D || out_size != M * D || ws_size < WS_END) { fprintf(stderr, "kernel_launch: unexpected shapes (n_in %d, in0 %d, out %d, ws %zu); nothing launched\n", n_in, n_in > 0 ? in_sizes[0] : -1, out_size, ws_size); grid = -1; return; }
        int dev = 0, cus = 0, per_cu = 0;
        if (hipGetDevice(&dev) != hipSuccess || hipDeviceGetAttribute(&cus, hipDeviceAttributeMultiprocessorCount, dev) != hipSuccess) { grid = -1; return; }
#ifdef PROBE_PHASE
        (void)hipFuncSetAttribute((const void*)mk_probe, hipFuncAttributeMaxDynamicSharedMemorySize, LDS_BYTES);
#endif
        if (hipFuncSetAttribute((const void*)mk_fwd, hipFuncAttributeMaxDynamicSharedMemorySize, LDS_BYTES) != hipSuccess) { fprintf(stderr, "kernel_launch: hipFuncSetAttribute failed\n"); grid = -1; return; }
        if (hipOccupancyMaxActiveBlocksPerMultiprocessor(&per_cu, (const void*)mk_fwd, NWAVES * 64, LDS_BYTES) != hipSuccess || per_cu < 1) { fprintf(stderr, "kernel_launch: occupancy query says %d blocks per CU\n", per_cu); per_cu = 1; }
        (void)hipGetLastError();
        grid = cus * 1;
    }
    if (grid < 0) return;
    if (hipMemsetAsync((char*)d_ws + WS_CTL, 0, CTL_ZERO_BYTES, stream) != hipSuccess) { fprintf(stderr, "kernel_launch: hipMemsetAsync failed\n"); return; }
    Args a{};
    for (int i = 0; i < 22; ++i) a.in[i] = (const float*)d_in[i];
    a.out = (float*)d_out; a.ws = (unsigned char*)d_ws;
#if MK_PER_PHASE
    for (int ph = 0; ph < N_PHASES; ++ph) { a.ph_lo = ph; a.ph_hi = ph + 1; a.li = ph;
        hipLaunchKernelGGL(mk_fwd, dim3(grid), dim3(NWAVES * 64), LDS_BYTES, stream, a); }
#else
    a.ph_lo = 0; a.ph_hi = N_PHASES; a.li = 0;
#ifdef PROBE_PHASE
#ifndef PROBE_MODE
#define PROBE_MODE 1
#endif
    { void* kargs0[] = {&a};
      hipError_t e0 = hipLaunchCooperativeKernel((const void*)mk_fwd, dim3(grid), dim3(NWAVES * 64), kargs0, LDS_BYTES, stream);
      if (e0 != hipSuccess) fprintf(stderr, "kernel_launch: cooperative launch failed: %s (grid %d)\n", hipGetErrorString(e0), grid);
      Args a2 = a; a2.ph_lo = PROBE_PHASE; a2.ph_hi = PROBE_PHASE + 1; a2.pad = PROBE_MODE;
      hipLaunchKernelGGL(mk_probe, dim3(grid), dim3(NWAVES * 64), LDS_BYTES, stream, a2); }
#elif defined(MK_PLAIN_LAUNCH)
    hipLaunchKernelGGL(mk_fwd, dim3(grid), dim3(NWAVES * 64), LDS_BYTES, stream, a);
#else
    void* kargs[] = {&a};
    hipError_t e = hipLaunchCooperativeKernel((const void*)mk_fwd, dim3(grid), dim3(NWAVES * 64), kargs, LDS_BYTES, stream);
    if (e != hipSuccess) fprintf(stderr, "kernel_launch: cooperative launch failed: %s (grid %d)\n", hipGetErrorString(e), grid);
#endif
#endif
}
```

```cpp
#include <hip/hip_runtime.h>
#include <cstdio>
#include <cstdint>
namespace pg8 {
#define PG8_LAS __attribute__((address_space(3)))
typedef unsigned short bf16_t;
typedef short bf16x8 __attribute__((ext_vector_type(8)));
typedef float f32x4 __attribute__((ext_vector_type(4)));
typedef unsigned u32x4 __attribute__((ext_vector_type(4)));
constexpr int BM = 256, BK = 64, HALF = 128, HTB = HALF * BK * 2  , STAGE_BYTES = 8 * HTB, NXCD = 8, WGM = 8;

__host__ __device__ __forceinline__ int lds_byte(int r, int c) { const int st = (r >> 4) * 2 + (c >> 5), rr = r & 15, cc = c & 31, ob = rr * 64 + cc * 2; return st * 1024 + (ob ^ (((ob >> 9) & 1) << 5)); }
__host__ __device__ __forceinline__ void stage_rc(int b, int& R, int& C) { const int st = b / 1024, sb = b % 1024, swz = sb ^ (((sb >> 9) & 1) << 5); R = (st >> 1) * 16 + swz / 64; C = (st & 1) * 32 + (swz % 64) / 2; }
__host__ __device__ __forceinline__ int perm32(int rho) { const int n = rho >> 4, i = rho & 15; return 8 * (i >> 2) + 4 * n + (i & 3); }

struct Unit { int pm, pn; };
struct Gemm { const bf16_t* A; const bf16_t* Bt; int M, N, K; };

struct StaticOrder {
    int nM, nN, nwg, G, c;
    __host__ __device__ void init(int M, int N, int G_, int c_) { nM = M / BM; nN = N / BM; nwg = nM * nN; G = G_; c = c_; }
    __host__ __device__ bool next(int i, Unit& u) const {
        const long L = (long)i * G + c; if (L >= nwg) return false;
        int wgid = (int)L; { const int q = nwg / NXCD, r = nwg % NXCD, xcd = wgid % NXCD, off = wgid / NXCD; wgid = (xcd < r ? xcd * (q + 1) : r * (q + 1) + (xcd - r) * q) + off; }
        const int nig = WGM * nN, gid = wgid / nig, fm = gid * WGM, gsz = (nM - fm) < WGM ? (nM - fm) : WGM;
        u.pm = fm + ((wgid % nig) % gsz); u.pn = (wgid % nig) / gsz; return true;
    }
    __device__ __forceinline__ void a_ready(const Unit&) const {}
    __device__ __forceinline__ void done(const Unit&) const {}
};

__device__ __forceinline__ unsigned cvt_pk_bf16(float lo, float hi) { unsigned r; asm volatile("v_cvt_pk_bf16_f32 %0, %1, %2" : "=v"(r) : "v"(lo), "v"(hi)); return r; }
typedef float f32x2 __attribute__((ext_vector_type(2)));
__device__ __forceinline__ f32x2 gelu_pk(f32x2 v) {
    const f32x2 av = __builtin_elementwise_abs(v), d = av * 0.2316418882f + 1.0f;
    f32x2 t; t.x = __builtin_amdgcn_rcpf(d.x); t.y = __builtin_amdgcn_rcpf(d.y);
    f32x2 q = t * 0.5307027145f + (-0.7265760135f); q = q * t + 0.7107068705f; q = q * t + (-0.142248368f); q = q * t + 0.127414796f; q = q * t;
    const f32x2 s = (v * v) * (-0.72134752044f);
    f32x2 e; e.x = __builtin_amdgcn_exp2f(s.x); e.y = __builtin_amdgcn_exp2f(s.y);
    const f32x2 m = v * (q * e), r = v - m;
    f32x2 o; o.x = v.x < 0.f ? m.x : r.x; o.y = v.y < 0.f ? m.y : r.y; return o;
}


constexpr float RMS_EPS = 1e-6f;
__device__ __forceinline__ float sigm(float x) { return __builtin_amdgcn_rcpf(1.0f + __expf(-x)); }
__device__ __forceinline__ u32x4 pack8(const f32x4 v0, const f32x4 v1) { u32x4 w; w.x = cvt_pk_bf16(v0[0], v0[1]); w.y = cvt_pk_bf16(v0[2], v0[3]); w.z = cvt_pk_bf16(v1[0], v1[1]); w.w = cvt_pk_bf16(v1[2], v1[3]); return w; }
__device__ __forceinline__ void store16_wt(void* p, u32x4 v) { asm volatile("global_store_dwordx4 %0, %1, off sc1\n\ts_nop 1" :: "v"(p), "v"(v) : "memory"); }
__device__ __forceinline__ void keep_alive(const f32x4 (&acc)[2][2][4][2]) {
#pragma unroll
    for (int a = 0; a < 2; ++a)
#pragma unroll
        for (int b = 0; b < 2; ++b)
#pragma unroll
            for (int m = 0; m < 4; ++m)
#pragma unroll
                for (int n = 0; n < 2; ++n) asm volatile("" :: "v"(acc[a][b][m][n]));
}
typedef unsigned long long u64_t;
__device__ __forceinline__ float ssq_f(u64_t v) { return fmaf((float)(unsigned)(v >> 32), 4294967296.0f, (float)(unsigned)v); }
__device__ __forceinline__ float rstd_of(u64_t ssq) { return __builtin_amdgcn_rsqf(fmaf(ssq_f(ssq), 1.0f / (1024.0f * 1048576.0f), RMS_EPS)); }
__device__ __forceinline__ u64_t ssq_fix(float s) { return (u64_t)(s * 1048576.0f); }

struct EpiInL0 {
    static constexpr bool PERM = true, AFTER_DRAIN = false;
    bf16_t* UB; bf16_t* PB; const u64_t* ssq;
    __device__ __forceinline__ void operator()(const f32x4 (&acc)[2][2][4][2], const Unit& u, int wr, int wc, int fr, int fq) const {
        const int row0 = u.pm * BM + wr * 64 + fr, cw = wc * 32 + 8 * fq;
        u64_t q[2][4];
#pragma unroll
        for (int ai = 0; ai < 2; ++ai)
#pragma unroll
            for (int m = 0; m < 4; ++m) q[ai][m] = ssq[row0 + ai * HALF + m * 16];
#pragma unroll
        for (int ai = 0; ai < 2; ++ai)
#pragma unroll
            for (int m = 0; m < 4; ++m) {
                const int row = row0 + ai * HALF + m * 16;
                const float rs = rstd_of(q[ai][m]), c1 = rs * -1.4426950408889634f;
                if (u.pn < 4) {
                    f32x4 o[2];
#pragma unroll
                    for (int n = 0; n < 2; ++n)
#pragma unroll
                        for (int j = 0; j < 4; j += 2) {
                            const f32x2 a = {acc[ai][0][m][n][j], acc[ai][0][m][n][j + 1]}, g = {acc[ai][1][m][n][j], acc[ai][1][m][n][j + 1]};
                            const f32x2 t = g * c1; f32x2 e; e.x = __builtin_amdgcn_exp2f(t.x); e.y = __builtin_amdgcn_exp2f(t.y);
                            const f32x2 d = e + 1.0f; f32x2 r; r.x = __builtin_amdgcn_rcpf(d.x); r.y = __builtin_amdgcn_rcpf(d.y);
                            const f32x2 h = a * (r * rs); o[n][j] = h.x; o[n][j + 1] = h.y; }
                    store16_wt(UB + (size_t)row * 512 + u.pn * 128 + cw, pack8(o[0], o[1]));
                } else {
#pragma unroll
                    for (int bj = 0; bj < 2; ++bj) store16_wt(PB + (size_t)row * 512 + (u.pn - 4) * 256 + bj * HALF + cw, pack8(acc[ai][bj][m][0] * rs, acc[ai][bj][m][1] * rs));
                }
            }
    }
};
struct EpiResid {
    static constexpr bool PERM = true, AFTER_DRAIN = false;
    bf16_t* XB; u64_t* ssq; bf16_t* XBw; int probe_mode;
    __device__ __forceinline__ void operator()(const f32x4 (&acc)[2][2][4][2], const Unit& u, int wr, int wc, int fr, int fq) const {
        const int row0 = u.pm * BM + wr * 64 + fr, cw = u.pn * BM + wc * 32 + 8 * fq;
        if (probe_mode == 2) { keep_alive(acc); return; }
        u32x4 r[2][4][2];
#pragma unroll
        for (int ai = 0; ai < 2; ++ai)
#pragma unroll
            for (int m = 0; m < 4; ++m)
#pragma unroll
                for (int bj = 0; bj < 2; ++bj) r[ai][m][bj] = *(const u32x4*)(XB + (size_t)(row0 + ai * HALF + m * 16) * 1024 + bj * HALF + cw);
#pragma unroll
        for (int ai = 0; ai < 2; ++ai)
#pragma unroll
            for (int m = 0; m < 4; ++m) {
                const int row = row0 + ai * HALF + m * 16;
                f32x2 s2 = {0.f, 0.f};
#pragma unroll
                for (int bj = 0; bj < 2; ++bj) {
                    const u32x4 rr = r[ai][m][bj];
                    const f32x2 a0 = {acc[ai][bj][m][0][0], acc[ai][bj][m][0][1]}, a1 = {acc[ai][bj][m][0][2], acc[ai][bj][m][0][3]}, a2 = {acc[ai][bj][m][1][0], acc[ai][bj][m][1][1]}, a3 = {acc[ai][bj][m][1][2], acc[ai][bj][m][1][3]};
                    const f32x2 v0 = a0 + (f32x2){__builtin_bit_cast(float, rr.x << 16), __builtin_bit_cast(float, rr.x & 0xffff0000u)};
                    const f32x2 v1 = a1 + (f32x2){__builtin_bit_cast(float, rr.y << 16), __builtin_bit_cast(float, rr.y & 0xffff0000u)};
                    const f32x2 v2 = a2 + (f32x2){__builtin_bit_cast(float, rr.z << 16), __builtin_bit_cast(float, rr.z & 0xffff0000u)};
                    const f32x2 v3 = a3 + (f32x2){__builtin_bit_cast(float, rr.w << 16), __builtin_bit_cast(float, rr.w & 0xffff0000u)};
                    u32x4 w; w.x = cvt_pk_bf16(v0.x, v0.y); w.y = cvt_pk_bf16(v1.x, v1.y); w.z = cvt_pk_bf16(v2.x, v2.y); w.w = cvt_pk_bf16(v3.x, v3.y);
                    *(u32x4*)(XBw + ((size_t)row * 1024 + bj * HALF + cw)) = w;
                    s2 = v0 * v0 + s2; s2 = v1 * v1 + s2; s2 = v2 * v2 + s2; s2 = v3 * v3 + s2;
                }
                float s = s2.x + s2.y;
                s += __shfl_xor(s, 16); s += __shfl_xor(s, 32);
                if (fq == 0) atomicAdd(ssq + row, ssq_fix(s));
            }
    }
};
struct EpiSwiGLU {
    static constexpr bool PERM = true, AFTER_DRAIN = false;
    bf16_t* H; const u64_t* ssq; int probe_mode;
    __device__ __forceinline__ void operator()(const f32x4 (&acc)[2][2][4][2], const Unit& u, int wr, int wc, int fr, int fq) const {
        const int row0 = u.pm * BM + wr * 64 + fr, cw = wc * 32 + 8 * fq;
        if (probe_mode == 2) { keep_alive(acc); return; }
        u64_t q[2][4];
#pragma unroll
        for (int ai = 0; ai < 2; ++ai)
#pragma unroll
            for (int m = 0; m < 4; ++m) q[ai][m] = ssq[row0 + ai * HALF + m * 16];
#pragma unroll
        for (int ai = 0; ai < 2; ++ai)
#pragma unroll
            for (int m = 0; m < 4; ++m) {
                const int row = row0 + ai * HALF + m * 16;
                const float rs = rstd_of(q[ai][m]), c1 = rs * -1.4426950408889634f, rs2 = rs * rs;
                f32x4 o[2];
#pragma unroll
                for (int n = 0; n < 2; ++n)
#pragma unroll
                    for (int j = 0; j < 4; j += 2) {
                        const f32x2 g = {acc[ai][0][m][n][j], acc[ai][0][m][n][j + 1]}, up = {acc[ai][1][m][n][j], acc[ai][1][m][n][j + 1]};
                        const f32x2 t = g * c1; f32x2 e; e.x = __builtin_amdgcn_exp2f(t.x); e.y = __builtin_amdgcn_exp2f(t.y);
                        const f32x2 d = e + 1.0f; f32x2 r; r.x = __builtin_amdgcn_rcpf(d.x); r.y = __builtin_amdgcn_rcpf(d.y);
                        const f32x2 h = (g * up) * (r * rs2); o[n][j] = h.x; o[n][j + 1] = h.y; }
                store16_wt(H + (size_t)row * 2816 + u.pn * 128 + cw, pack8(o[0], o[1]));
            }
    }
};
struct EpiPQT {
    static constexpr bool PERM = true, AFTER_DRAIN = false;
    bf16_t* PQT; const u64_t* ssq; int probe_mode;
    __device__ __forceinline__ void operator()(const f32x4 (&acc)[2][2][4][2], const Unit& u, int wr, int wc, int fr, int fq) const {
        if (probe_mode == 2) { keep_alive(acc); return; }
        const int tok0 = u.pn * BM + wc * 32 + 8 * fq, b = (u.pn * BM) >> 12;
#pragma unroll
        for (int bj = 0; bj < 2; ++bj) {
            u64_t q[8];
#pragma unroll
            for (int j = 0; j < 8; ++j) q[j] = ssq[tok0 + bj * HALF + j];
            f32x4 rs0, rs1;
#pragma unroll
            for (int j = 0; j < 4; ++j) { rs0[j] = rstd_of(q[j]); rs1[j] = rstd_of(q[4 + j]); }
#pragma unroll
            for (int ai = 0; ai < 2; ++ai)
#pragma unroll
                for (int m = 0; m < 4; ++m) {
                    const int r = u.pm * BM + ai * HALF + wr * 64 + m * 16 + fr, pq = r >> 9, ch = r & 511;
                    bf16_t* base = PQT + ((size_t)(b * 512 + ch) * 2 + pq) * 4096;
                    store16_wt(base + ((tok0 + bj * HALF) & 4095), pack8(acc[ai][bj][m][0] * rs0, acc[ai][bj][m][1] * rs1));
                }
        }
    }
};
struct EpiGeluUV {
    static constexpr bool PERM = true, AFTER_DRAIN = false;
    bf16_t* U; bf16_t* V; const u64_t* ssq; int probe_mode;
    __device__ __forceinline__ void operator()(const f32x4 (&acc)[2][2][4][2], const Unit& u, int wr, int wc, int fr, int fq) const {
        if (probe_mode == 2) { keep_alive(acc); return; }
        const int row0 = u.pm * BM + wr * 64 + fr, cw = wc * 32 + 8 * fq;
        bf16_t* dst = (u.pn < 2) ? U : V; const int colb = (u.pn & 1) * BM;
        u64_t q[2][4];
#pragma unroll
        for (int ai = 0; ai < 2; ++ai)
#pragma unroll
            for (int m = 0; m < 4; ++m) q[ai][m] = ssq[row0 + ai * HALF + m * 16];
#pragma unroll
        for (int ai = 0; ai < 2; ++ai)
#pragma unroll
            for (int m = 0; m < 4; ++m) {
                const int row = row0 + ai * HALF + m * 16;
                const float rs = rstd_of(q[ai][m]);
#pragma unroll
                for (int bj = 0; bj < 2; ++bj) {
                    const f32x4 v0 = acc[ai][bj][m][0] * rs, v1 = acc[ai][bj][m][1] * rs;
                    const f32x2 a = gelu_pk((f32x2){v0[0], v0[1]}), bq = gelu_pk((f32x2){v0[2], v0[3]}), c = gelu_pk((f32x2){v1[0], v1[1]}), d = gelu_pk((f32x2){v1[2], v1[3]});
                    store16_wt(dst + (size_t)row * 512 + colb + bj * HALF + cw, pack8((f32x4){a.x, a.y, bq.x, bq.y}, (f32x4){c.x, c.y, d.x, d.y}));
                }
            }
    }
};
struct EpiDFT2 {
    static constexpr bool PERM = true, AFTER_DRAIN = false;
    bf16_t* AM;
    __device__ __forceinline__ void operator()(const f32x4 (&acc)[2][2][4][2], const Unit& u, int wr, int wc, int fr, int fq) const {
#pragma unroll
        for (int bj = 0; bj < 2; ++bj) {
            const int n = u.pn * BM + bj * HALF + wc * 32 + 8 * fq, b = n >> 13, t1 = (n >> 9) & 15, ch = n & 511;
            bf16_t* base = AM + (size_t)(b * 4096 + t1) * 1024 + ch;
#pragma unroll
            for (int ai = 0; ai < 2; ++ai)
#pragma unroll
                for (int m = 0; m < 4; ++m) { const int t2 = ai * HALF + wr * 64 + m * 16 + fr;
                    store16_wt(base + (size_t)(16 * t2) * 1024, pack8(acc[ai][bj][m][0], acc[ai][bj][m][1])); }
        }
    }
};

template <class Epi, class Sched, bool ALIGN_EPI = false, bool SP2 = false>
__device__ __forceinline__ void gemm_phase(PG8_LAS unsigned char* lds, const Gemm g, const Sched& S, const Epi& E) {
    const int tid = threadIdx.x, wid = __builtin_amdgcn_readfirstlane(tid >> 6), lane = tid & 63, wr = wid >> 2, wc = wid & 3, fr = lane & 15, fq = lane >> 4;
    const int K = g.K, nt = K / BK;
    unsigned voffA[2], voffB[2];
#pragma unroll
    for (int i = 0; i < 2; ++i) { int R, C; stage_rc(tid * 16 + i * 8192, R, C); const int Rb = Epi::PERM ? ((R & ~31) + perm32(R & 31)) : R;
        voffA[i] = (unsigned)(R * K + C) * 2u; voffB[i] = (unsigned)(Rb * K + C) * 2u; }
    const size_t kstep = (size_t)(BK * 2);
    const size_t hstep = (size_t)HALF * K * 2;
    const size_t tstep = 2 * hstep;
    const unsigned ldsw = (unsigned)wid * 1024u;
    const int aoff = lds_byte(wr * 64 + fr, fq * 8), boff = lds_byte(wc * 32 + fr, fq * 8);
#define PG8_SA(b, h) (((b) * 2 + (h)) * HTB)
#define PG8_SB(b, h) ((4 + (b) * 2 + (h)) * HTB)
#define PG8_STAGE(bufoff, gbase, voff) do { _Pragma("unroll") for (int _i = 0; _i < 2; ++_i) \
        __builtin_amdgcn_global_load_lds((const unsigned*)((const char*)(gbase) + (voff)[_i]), (PG8_LAS unsigned*)(lds + (bufoff) + ldsw + _i * 8192), 16, 0, 0); } while (0)
#define PG8_LDA(dst, b, h) do { _Pragma("unroll") for (int m = 0; m < 4; ++m) _Pragma("unroll") for (int k = 0; k < 2; ++k) dst[m][k] = *(const PG8_LAS bf16x8*)(lds + PG8_SA(b, h) + aoff + m * 2048 + k * 1024); } while (0)
#define PG8_LDB(dst, b, h) do { _Pragma("unroll") for (int n = 0; n < 2; ++n) _Pragma("unroll") for (int k = 0; k < 2; ++k) dst[n][k] = *(const PG8_LAS bf16x8*)(lds + PG8_SB(b, h) + boff + n * 2048 + k * 1024); } while (0)
#define PG8_MMA(ai, bj, At, Bt) do { __builtin_amdgcn_s_setprio(1); _Pragma("unroll") for (int m = 0; m < 4; ++m) _Pragma("unroll") for (int n = 0; n < 2; ++n) _Pragma("unroll") for (int k = 0; k < 2; ++k) \
        acc[ai][bj][m][n] = __builtin_amdgcn_mfma_f32_16x16x32_bf16(Bt[n][k], At[m][k], acc[ai][bj][m][n], 0, 0, 0); __builtin_amdgcn_s_setprio(0); } while (0)
#define PG8_WAIT_V(n) asm volatile("s_waitcnt vmcnt(" #n ")" ::: "memory")
#define PG8_WAIT_L(n) asm volatile("s_waitcnt lgkmcnt(" #n ")" ::: "memory")
#define PG8_BAR __builtin_amdgcn_s_barrier()
#define PG8_SCHED __builtin_amdgcn_sched_barrier(0)
    Unit cur, nxt; int ui = 0;
    if (!S.next(0, cur)) return;
    f32x4 acc[2][2][4][2];
#pragma unroll
    for (int a = 0; a < 2; ++a)
#pragma unroll
        for (int b = 0; b < 2; ++b)
#pragma unroll
            for (int m = 0; m < 4; ++m)
#pragma unroll
                for (int n = 0; n < 2; ++n) acc[a][b][m][n] = (f32x4){0.f, 0.f, 0.f, 0.f};
    bf16x8 At[4][2], B0[2][2], B1[2][2];
    const char* cA = (const char*)g.A + (size_t)cur.pm * tstep; const char* cB = (const char*)g.Bt + (size_t)cur.pn * tstep;
    S.a_ready(cur);
    if constexpr (SP2) {
        PG8_STAGE(PG8_SB(0, 0), cB, voffB); PG8_STAGE(PG8_SB(0, 1), cB + hstep, voffB); PG8_STAGE(PG8_SA(0, 0), cA, voffA); PG8_STAGE(PG8_SA(0, 1), cA + hstep, voffA);
        if (wr == 1) PG8_BAR;
        PG8_WAIT_V(2); PG8_BAR;
        PG8_STAGE(PG8_SB(1, 0), cB + kstep, voffB); PG8_STAGE(PG8_SA(1, 0), cA + kstep, voffA); PG8_STAGE(PG8_SB(1, 1), cB + hstep + kstep, voffB);
        PG8_WAIT_V(6); PG8_BAR;
    } else {
        PG8_STAGE(PG8_SB(0, 0), cB, voffB); PG8_STAGE(PG8_SA(0, 0), cA, voffA); PG8_STAGE(PG8_SB(0, 1), cB + hstep, voffB); PG8_STAGE(PG8_SA(0, 1), cA + hstep, voffA);
        if (wr == 1) PG8_BAR;
        PG8_WAIT_V(4); PG8_BAR;
        PG8_STAGE(PG8_SB(1, 0), cB + kstep, voffB); PG8_STAGE(PG8_SA(1, 0), cA + kstep, voffA); PG8_STAGE(PG8_SB(1, 1), cB + hstep + kstep, voffB);
        PG8_WAIT_V(6); PG8_BAR;
    }
    for (;;) {
        const bool has_next = S.next(ui + 1, nxt);
        const char* nA = has_next ? (const char*)g.A + (size_t)nxt.pm * tstep : cA; const char* nB = has_next ? (const char*)g.Bt + (size_t)nxt.pn * tstep : cB;
        for (int t = 0; t < nt; t += 2) {
            const bool last = (t == nt - 2);
            const char* a1 = cA + (size_t)(t + 1) * kstep;
            const char* a2 = last ? nA : cA + (size_t)(t + 2) * kstep; const char* b2 = last ? nB : cB + (size_t)(t + 2) * kstep;
            const char* a3 = a2 + kstep; const char* b3 = b2 + kstep;
            if (last && has_next) S.a_ready(nxt);
            if constexpr (SP2) {
            PG8_LDB(B0, 0, 0); PG8_LDB(B1, 0, 1); PG8_SCHED; PG8_LDA(At, 0, 0); PG8_STAGE(PG8_SA(1, 1), a1 + hstep, voffA);
            PG8_WAIT_V(8); PG8_WAIT_L(0); PG8_BAR; PG8_MMA(0, 0, At, B0); PG8_MMA(0, 1, At, B1); PG8_BAR; PG8_SCHED;
            PG8_LDA(At, 0, 1); PG8_STAGE(PG8_SB(0, 0), b2, voffB); PG8_STAGE(PG8_SB(0, 1), b2 + hstep, voffB); PG8_STAGE(PG8_SA(0, 0), a2, voffA);
            PG8_WAIT_V(8); PG8_WAIT_L(0); PG8_BAR; PG8_MMA(1, 0, At, B0); PG8_MMA(1, 1, At, B1); PG8_BAR; PG8_SCHED;
            PG8_LDB(B0, 1, 0); PG8_LDB(B1, 1, 1); PG8_SCHED; PG8_LDA(At, 1, 0); PG8_STAGE(PG8_SA(0, 1), a2 + hstep, voffA);
            PG8_WAIT_V(8); PG8_WAIT_L(0); PG8_BAR; PG8_MMA(0, 0, At, B0); PG8_MMA(0, 1, At, B1); PG8_BAR; PG8_SCHED;
            PG8_LDA(At, 1, 1); PG8_STAGE(PG8_SB(1, 0), b3, voffB); PG8_STAGE(PG8_SB(1, 1), b3 + hstep, voffB); PG8_STAGE(PG8_SA(1, 0), a3, voffA);
            PG8_WAIT_V(8); PG8_WAIT_L(0); PG8_BAR; PG8_MMA(1, 0, At, B0); PG8_MMA(1, 1, At, B1); PG8_BAR; PG8_SCHED;
            } else {
            PG8_LDB(B0, 0, 0); PG8_SCHED; PG8_LDA(At, 0, 0); PG8_STAGE(PG8_SA(1, 1), a1 + hstep, voffA);
            PG8_WAIT_L(8); PG8_BAR; PG8_WAIT_L(0); PG8_MMA(0, 0, At, B0); PG8_BAR; PG8_SCHED;
            PG8_LDB(B1, 0, 1); PG8_STAGE(PG8_SB(0, 0), b2, voffB);
            PG8_BAR; PG8_WAIT_L(0); PG8_MMA(0, 1, At, B1); PG8_BAR;
            PG8_LDA(At, 0, 1); PG8_STAGE(PG8_SA(0, 0), a2, voffA);
            PG8_BAR; PG8_WAIT_L(0); PG8_MMA(1, 0, At, B0); PG8_BAR; PG8_SCHED;
            PG8_STAGE(PG8_SB(0, 1), b2 + hstep, voffB);
            PG8_WAIT_V(6); PG8_BAR; PG8_MMA(1, 1, At, B1); PG8_BAR;
            PG8_LDB(B0, 1, 0); PG8_SCHED; PG8_LDA(At, 1, 0); PG8_STAGE(PG8_SA(0, 1), a2 + hstep, voffA);
            PG8_WAIT_L(8); PG8_BAR; PG8_WAIT_L(0); PG8_MMA(0, 0, At, B0); PG8_BAR; PG8_SCHED;
            PG8_LDB(B1, 1, 1); PG8_STAGE(PG8_SB(1, 0), b3, voffB);
            PG8_BAR; PG8_WAIT_L(0); PG8_MMA(0, 1, At, B1); PG8_BAR;
            PG8_LDA(At, 1, 1); PG8_STAGE(PG8_SA(1, 0), a3, voffA);
            PG8_BAR; PG8_WAIT_L(0); PG8_MMA(1, 0, At, B0); PG8_BAR; PG8_SCHED;
            PG8_STAGE(PG8_SB(1, 1), b3 + hstep, voffB);
            PG8_WAIT_V(6); PG8_BAR; PG8_MMA(1, 1, At, B1); PG8_BAR;
            }
        }
        if constexpr (ALIGN_EPI) { if (wr == 0) PG8_BAR; }
        if constexpr (!Epi::AFTER_DRAIN) { E(acc, cur, wr, wc, fr, fq); S.done(cur); }
        if (!has_next) break;
#pragma unroll
        for (int a = 0; a < 2; ++a)
#pragma unroll
            for (int b = 0; b < 2; ++b)
#pragma unroll
                for (int m = 0; m < 4; ++m)
#pragma unroll
                    for (int n = 0; n < 2; ++n) acc[a][b][m][n] = (f32x4){0.f, 0.f, 0.f, 0.f};
        cur = nxt; cA = nA; cB = nB; ++ui;
        if constexpr (ALIGN_EPI) { if (wr == 1) PG8_BAR; }
    }
    PG8_WAIT_V(0);
    if constexpr (!ALIGN_EPI) { if (wr == 0) PG8_BAR; }
    PG8_BAR;
    if constexpr (Epi::AFTER_DRAIN) { E.fused(acc, cur, wr, wc, fr, fq, lds, wid, lane); S.done(cur); }
#undef PG8_SA
#undef PG8_SB
#undef PG8_STAGE
#undef PG8_LDA
#undef PG8_LDB
#undef PG8_MMA
#undef PG8_WAIT_V
#undef PG8_WAIT_L
#undef PG8_BAR
#undef PG8_SCHED
}
}
#define GAS __attribute__((address_space(1)))
#define LAS __attribute__((address_space(3)))
typedef unsigned short bf16;
typedef unsigned v4u __attribute__((ext_vector_type(4)));
typedef float f32x4 __attribute__((ext_vector_type(4)));
typedef short bf16x8 __attribute__((ext_vector_type(8)));
typedef GAS unsigned gu32;
typedef GAS unsigned long long gu64;
#define RLX_AGENT __ATOMIC_RELAXED, __HIP_MEMORY_SCOPE_AGENT
#define LDS_WAIT() asm volatile("s_waitcnt lgkmcnt(0)" ::: "memory")
#define VM_WAIT() asm volatile("s_waitcnt vmcnt(0)" ::: "memory")
__device__ __forceinline__ unsigned long long rt() { return __builtin_amdgcn_s_memrealtime(); }
__device__ __forceinline__ unsigned f2bf(float f) { unsigned u = __builtin_bit_cast(unsigned, f); return (u + 0x7fffu + ((u >> 16) & 1u)) >> 16; }
__device__ __forceinline__ unsigned pk2(float lo, float hi) { return f2bf(lo) | (f2bf(hi) << 16); }

#define XB_TMO      128
#define XB_XCNT(j)  (256  + 64 * (j))
#define XB_XSUB(j)  (1280 + 64 * (j))
#define XB_XGEN(j)  (2304 + 64 * (j))
#define XB_TOP      3328
#define XB_TOPGEN   3392
#define XCD_BAR_WORDS 3456
#define XB_SPIN_CAP (1u << 18)

__device__ __forceinline__ unsigned xb_ld(unsigned* p)              { return __hip_atomic_load(p, __ATOMIC_RELAXED, __HIP_MEMORY_SCOPE_AGENT); }
__device__ __forceinline__ unsigned xb_add(unsigned* p, unsigned v) { return __hip_atomic_fetch_add(p, v, __ATOMIC_RELAXED, __HIP_MEMORY_SCOPE_AGENT); }
__device__ __forceinline__ unsigned xb_xcc_id() { return (unsigned)__builtin_amdgcn_s_getreg((3 << 11) | 20) & 0xFu; }
#define XB_SPIN(cond, bar) do { unsigned _sp = 0; while (cond) { __builtin_amdgcn_s_sleep(1); \
    if ((++_sp & 255u) == 0u) { if (xb_ld(&(bar)[XB_TMO])) break; if (_sp > XB_SPIN_CAP) { atomicAdd(&(bar)[XB_TMO], 1u); break; } } } } while (0)

struct XcdBarrier {
    unsigned* bar; unsigned x;
    volatile LAS unsigned* st;
};

__device__ __forceinline__ XcdBarrier xcd_barrier_post(unsigned* bar, volatile LAS unsigned* st) {
    XcdBarrier b; b.bar = bar; b.x = xb_xcc_id(); b.st = st;
    if (threadIdx.x == 0) (void)xb_add(&bar[XB_XCNT(b.x)], 1u);
    return b;
}
__device__ __forceinline__ void xcd_barrier_complete(unsigned* bar, unsigned x, unsigned& nloc, unsigned& nx) {
    const unsigned G = gridDim.x * gridDim.y * gridDim.z;
    unsigned sum, cnt, mine, sp = 0u;
    for (;;) {
        sum = 0u; cnt = 0u; mine = 0u;
#pragma unroll
        for (unsigned j = 0; j < 16; ++j) { const unsigned c = xb_ld(&bar[XB_XCNT(j)]); sum += c; cnt += (c > 0u) ? 1u : 0u; mine = (j == x) ? c : mine; }
        if (sum == G) break;
        __builtin_amdgcn_s_sleep(1);
        if ((++sp & 255u) == 0u) { if (xb_ld(&bar[XB_TMO])) break; if (sp > XB_SPIN_CAP) { atomicAdd(&bar[XB_TMO], 1u); break; } }
    }
    nloc = mine > 0u ? mine : 1u; nx = cnt > 0u ? cnt : 1u;
}

__device__ __forceinline__ void xcd_barrier(const XcdBarrier& b) {
    asm volatile("s_waitcnt vmcnt(0)" ::: "memory");
    __syncthreads();
    if (threadIdx.x == 0) {
        unsigned* bar = b.bar;
        __builtin_amdgcn_s_waitcnt(0);
        unsigned nloc = b.st[0], nx = b.st[1];
        if (nloc == 0u) { xcd_barrier_complete(bar, b.x, nloc, nx); b.st[0] = nloc; b.st[1] = nx; }
        const unsigned old = xb_add(&bar[XB_XSUB(b.x)], 1u);
        const unsigned gen = old / nloc;
        if (old + 1u == (gen + 1u) * nloc) {
            __builtin_amdgcn_fence(__ATOMIC_RELEASE, "agent");
            asm volatile("s_waitcnt vmcnt(0)" ::: "memory");
            const unsigned og = xb_add(&bar[XB_TOP], 1u);
            const unsigned tg = og / nx;
            if (og + 1u == (tg + 1u) * nx) xb_add(&bar[XB_TOPGEN], 1u);
            else XB_SPIN(xb_ld(&bar[XB_TOPGEN]) == tg, bar);
            __builtin_amdgcn_fence(__ATOMIC_ACQUIRE, "agent");
            xb_add(&bar[XB_XGEN(b.x)], 1u);
            asm volatile("s_waitcnt vmcnt(0)" ::: "memory");
        } else {
            XB_SPIN(xb_ld(&bar[XB_XGEN(b.x)]) == gen, bar);
            __builtin_amdgcn_fence(__ATOMIC_ACQUIRE, "agent");
            asm volatile("s_waitcnt vmcnt(0)" ::: "memory");
        }
    }
    __syncthreads();
}

constexpr int NWAVES = 8;
#ifndef MK_PER_PHASE
#define MK_PER_PHASE 0
#endif
constexpr int N_PHASES = 13;

constexpr int NB = 8, S = 4096, D = 1024, FF = 2816, M = NB * S;
typedef float f32x2g __attribute__((ext_vector_type(2)));
typedef unsigned u32x2g __attribute__((ext_vector_type(2)));

constexpr size_t MiB = 1u << 20;
constexpr size_t WS_CTL = 0, CTL_ZERO_BYTES = 1 * MiB;
constexpr size_t WS_SSQ = 46 * MiB + 512 * 1024;
constexpr size_t WS_WIN0 = 2 * MiB;
constexpr size_t WS_WOUT0 = 5 * MiB;
constexpr size_t WS_WGU0 = 7 * MiB;
constexpr size_t WS_WDN0 = 18 * MiB;
constexpr size_t WS_WPQ1 = 24 * MiB;
constexpr size_t WS_WUV1 = 26 * MiB;
constexpr size_t WS_WOUT1 = 28 * MiB;
constexpr size_t WS_WGU1 = 30 * MiB;
constexpr size_t WS_WDN1 = 41 * MiB;
constexpr size_t WS_DFT = 48 * MiB;
constexpr size_t WS_XB = 112 * MiB;
constexpr size_t WS_AM = 176 * MiB;
constexpr size_t WS_H = 240 * MiB;
constexpr size_t WS_UB = WS_H, WS_PB = WS_H + 32 * MiB;
constexpr size_t WS_PQT = WS_H, WS_U1 = WS_H + 64 * MiB, WS_V1 = WS_H + 96 * MiB, WS_ZP = WS_H + 128 * MiB;
constexpr size_t WS_END = 432 * MiB;
static_assert(WS_H + (size_t)M * FF * 2 <= WS_END && WS_V1 + (size_t)M * 512 * 2 <= WS_ZP && WS_ZP + 64 * MiB <= WS_END, "d_ws map");
constexpr int CW_BAR = 4096;

constexpr int RING_OFF = 0, RING_BYTES = 131072;
constexpr int LDSCTL_OFF = RING_BYTES, MISC_OFF = LDSCTL_OFF + 320;
constexpr int LDS_BYTES = 147456;

struct Frame {
    LAS unsigned char* lds;
    volatile LAS unsigned* MISC;
    gu32* ctl;
    int tid, lane, wave;
    int vcu, G;
};
__device__ __forceinline__ float wave_sum(float v) {
#pragma unroll
    for (int o = 1; o < 64; o <<= 1) v += __shfl_xor(v, o);
    return v;
}
__device__ __forceinline__ float bf_lo(unsigned x) { return __builtin_bit_cast(float, x << 16); }
__device__ __forceinline__ float bf_hi(unsigned x) { return __builtin_bit_cast(float, x & 0xffff0000u); }
#define WG_BAR() do { asm volatile("s_waitcnt vmcnt(0) lgkmcnt(0)" ::: "memory"); __builtin_amdgcn_s_barrier(); asm volatile("" ::: "memory"); } while (0)
#define LDS_BAR() do { asm volatile("s_waitcnt lgkmcnt(0)" ::: "memory"); __builtin_amdgcn_s_barrier(); asm volatile("" ::: "memory"); } while (0)

__device__ __forceinline__ void p0_transpose_item(const float* W, int ldw, const float* gk, bf16* WT, int ldt, int k0, int n0, int dk0, int drow0, LAS float* scr, int lane) {
    float v[32];
    const float* wp = W + (size_t)(k0 + (lane >> 5)) * ldw + n0 + (lane & 31);
#pragma unroll
    for (int i = 0; i < 32; ++i) v[i] = wp[(size_t)(2 * i) * ldw];
    const int c = lane & 7;
    f32x4 g0 = {1.f, 1.f, 1.f, 1.f}, g1 = {1.f, 1.f, 1.f, 1.f};
    if (gk) { g0 = *(const GAS f32x4*)(gk + k0 + 8 * c); g1 = *(const GAS f32x4*)(gk + k0 + 8 * c + 4); }
#pragma unroll
    for (int i = 0; i < 32; ++i) scr[(2 * i + (lane >> 5)) * 33 + (lane & 31)] = v[i];
    LDS_WAIT(); asm volatile("" ::: "memory");
#pragma unroll
    for (int j = 0; j < 4; ++j) { const int n = (lane >> 3) + 8 * j; const LAS float* s = scr + (8 * c) * 33 + n;
        v4u o; o.x = pk2(s[0 * 33] * g0.x, s[1 * 33] * g0.y); o.y = pk2(s[2 * 33] * g0.z, s[3 * 33] * g0.w); o.z = pk2(s[4 * 33] * g1.x, s[5 * 33] * g1.y); o.w = pk2(s[6 * 33] * g1.z, s[7 * 33] * g1.w);
        *(GAS v4u*)(WT + (size_t)(drow0 + n) * ldt + dk0 + 8 * c) = o; }
    LDS_WAIT(); asm volatile("" ::: "memory");
}
__device__ __forceinline__ void p0_job(const float* W, int ldw, const float* gk, int kbeg, int kext, int ncol0, int next, bf16* WT, int ldt, int dkbase, int mode, int half_or_off,
                                       LAS float* scr, int lane, int gw, int NGW, int& cursor) {
    const int nkb = kext / 64, nnb = next / 32, nitems = nkb * nnb;
    int first = (gw - (cursor % NGW) + NGW) % NGW;
    for (int it = first; it < nitems; it += NGW) {
        const int kb = it / nnb, nb = it % nnb, nrel = 32 * nb;
        const int drow0 = (mode == 0) ? (half_or_off + nrel) : (256 * (nrel >> 7) + 128 * half_or_off + (nrel & 127));
        p0_transpose_item(W, ldw, gk, WT, ldt, kbeg + 64 * kb, ncol0 + nrel, dkbase + 64 * kb, drow0, scr, lane);
    }
    cursor += nitems;
}
__device__ __forceinline__ void p0_fold_item(const float* L, int lrow0, const float* sc, const float* Rm, bf16* out, int dk0, float scale, int dw, int lane) {
    const int d = 64 * dw + lane;
    float l0[8], l1[8];
    { const float s0 = sc ? sc[lane] : 1.f, s1 = sc ? sc[64 + lane] : 1.f;
#pragma unroll
      for (int j = 0; j < 8; ++j) { l0[j] = L[(size_t)(lrow0 + j) * 128 + lane] * s0; l1[j] = L[(size_t)(lrow0 + j) * 128 + 64 + lane] * s1; } }
    float acc[8];
#pragma unroll
    for (int j = 0; j < 8; ++j) acc[j] = 0.f;
#pragma unroll
    for (int cb = 0; cb < 4; ++cb) {
        float r[32];
#pragma unroll
        for (int i = 0; i < 32; ++i) r[i] = Rm[(size_t)(cb * 32 + i) * 1024 + d];
#pragma unroll
        for (int i = 0; i < 32; ++i) { const int cp = cb * 32 + i;
#pragma unroll
            for (int j = 0; j < 8; ++j) { const float lv = __builtin_bit_cast(float, __builtin_amdgcn_readlane(__builtin_bit_cast(int, cp < 64 ? l0[j] : l1[j]), cp & 63)); acc[j] = fmaf(lv, r[i], acc[j]); } }
    }
    v4u o; o.x = pk2(acc[0] * scale, acc[1] * scale); o.y = pk2(acc[2] * scale, acc[3] * scale); o.z = pk2(acc[4] * scale, acc[5] * scale); o.w = pk2(acc[6] * scale, acc[7] * scale);
    *(GAS v4u*)(out + (size_t)d * 1024 + dk0) = o;
}
__device__ __forceinline__ void p0_pq_item(const float* Win1, const float* g1, bf16* WPQ, int h, int half, int k0, const LAS float* tab, int lane) {
    const int cp = 64 * half + lane;
    float ap[8], aq[8], w0[8], w1[8];
#pragma unroll
    for (int j = 0; j < 8; ++j) { const float g = g1[k0 + j]; ap[j] = 0.f; aq[j] = 0.f; w0[j] = Win1[(size_t)(k0 + j) * 1536 + h * 128 + lane] * g; w1[j] = Win1[(size_t)(k0 + j) * 1536 + h * 128 + 64 + lane] * g; }
#pragma unroll 8
    for (int c = 0; c < 128; ++c) {
        const int ph = c * cp;
        const float cs = tab[ph & 127], sn = tab[(ph - 32) & 127];
#pragma unroll
        for (int j = 0; j < 8; ++j) { const float w = __builtin_bit_cast(float, __builtin_amdgcn_readlane(__builtin_bit_cast(int, c < 64 ? w0[j] : w1[j]), c & 63)); ap[j] = fmaf(w, cs, ap[j]); aq[j] = fmaf(w, sn, aq[j]); }
    }
    v4u o; o.x = pk2(ap[0], ap[1]); o.y = pk2(ap[2], ap[3]); o.z = pk2(ap[4], ap[5]); o.w = pk2(ap[6], ap[7]);
    *(GAS v4u*)(WPQ + (size_t)(h * 128 + cp) * 1024 + k0) = o;
    o.x = pk2(aq[0], aq[1]); o.y = pk2(aq[2], aq[3]); o.z = pk2(aq[4], aq[5]); o.w = pk2(aq[6], aq[7]);
    *(GAS v4u*)(WPQ + (size_t)(512 + h * 128 + cp) * 1024 + k0) = o;
}

struct Ptrs {
    const float* in[22]; float* out; unsigned char* ws;
};

__device__ __forceinline__ void p0_prologue(Frame& F, const Ptrs& P) {
    const float* x = P.in[0]; const float* mix_g = P.in[1]; const float* ffn_g = P.in[2];
    const float* ev_w_in = P.in[3]; const float* ev_pool_w = P.in[8]; const float* ev_pool_scale = P.in[9]; const float* ev_w_out = P.in[10];
    const float* od_w_in = P.in[11]; const float* od_fourier_w = P.in[12]; const float* od_w_out = P.in[17];
    const float* w_gate = P.in[18]; const float* w_up = P.in[19]; const float* w_down = P.in[20];
    unsigned char* ws = P.ws;
    LAS float* scr = (LAS float*)(F.lds + RING_OFF + F.wave * 8448);
    LAS float* CT = (LAS float*)(F.lds + RING_OFF + 69632);
    LAS float* tab = (LAS float*)(F.lds + RING_OFF + 69632 + 16384);
    for (int i = F.tid; i < 4096; i += NWAVES * 64) CT[i] = cospif((float)i * (1.0f / 2048.0f));
    if (F.tid < 128) tab[F.tid] = cospif((float)F.tid * (1.0f / 64.0f));
    WG_BAR();
    const int gw = F.vcu * NWAVES + F.wave, NGW = F.G * NWAVES, lane = F.lane;
    { unsigned long long* z = (unsigned long long*)(ws + WS_SSQ) + M; const int gt = F.vcu * NWAVES * 64 + F.tid, NT = F.G * NWAVES * 64;
      for (int i = gt; i < 4 * M; i += NT) z[i] = 0ull; }
    int cur = 0;
    p0_job(ev_w_in, 1536, mix_g, 0, 1024, 0, 512, (bf16*)(ws + WS_WIN0), 1024, 0, 1, 0, scr, lane, gw, NGW, cur);
    p0_job(ev_w_in, 1536, mix_g, 0, 1024, 512, 512, (bf16*)(ws + WS_WIN0), 1024, 0, 1, 1, scr, lane, gw, NGW, cur);
    p0_job(ev_w_in, 1536, mix_g, 0, 1024, 1024, 512, (bf16*)(ws + WS_WIN0), 1024, 0, 0, 1024, scr, lane, gw, NGW, cur);
    p0_job(ev_w_out, 1024, nullptr, 0, 512, 0, 1024, (bf16*)(ws + WS_WOUT0), 1024, 0, 0, 0, scr, lane, gw, NGW, cur);
    p0_job(w_gate, FF, ffn_g, 0, 1024, 0, FF, (bf16*)(ws + WS_WGU0), 1024, 0, 1, 0, scr, lane, gw, NGW, cur);
    p0_job(w_up, FF, ffn_g, 0, 1024, 0, FF, (bf16*)(ws + WS_WGU0), 1024, 0, 1, 1, scr, lane, gw, NGW, cur);
    p0_job(w_down, 1024, nullptr, 0, FF, 0, 1024, (bf16*)(ws + WS_WDN0), FF, 0, 0, 0, scr, lane, gw, NGW, cur);
    p0_job(od_w_in, 1536, mix_g + D, 0, 1024, 512, 1024, (bf16*)(ws + WS_WUV1), 1024, 0, 0, 0, scr, lane, gw, NGW, cur);
    p0_job(od_w_out, 1024, nullptr, 512, 512, 0, 1024, (bf16*)(ws + WS_WOUT1), 1024, 512, 0, 0, scr, lane, gw, NGW, cur);
    p0_job(w_gate + (size_t)D * FF, FF, ffn_g + D, 0, 1024, 0, FF, (bf16*)(ws + WS_WGU1), 1024, 0, 1, 0, scr, lane, gw, NGW, cur);
    p0_job(w_up + (size_t)D * FF, FF, ffn_g + D, 0, 1024, 0, FF, (bf16*)(ws + WS_WGU1), 1024, 0, 1, 1, scr, lane, gw, NGW, cur);
    p0_job(w_down + (size_t)FF * D, 1024, nullptr, 0, FF, 0, 1024, (bf16*)(ws + WS_WDN1), FF, 0, 0, 0, scr, lane, gw, NGW, cur);
    {
        int first = (gw - (cur % NGW) + NGW) % NGW;
        for (int it = first; it < 1024; it += NGW) { const int g = it >> 8, cc = (it >> 4) & 15, dw = it & 15;
            p0_fold_item(ev_pool_w, g * 128 + cc * 8, ev_pool_scale + g * 128, ev_w_out + (size_t)(512 + g * 128) * 1024, (bf16*)(ws + WS_WOUT0), 512 + g * 128 + cc * 8, 1.0f, dw, lane); }
        cur += 1024;
        first = (gw - (cur % NGW) + NGW) % NGW;
        for (int it = first; it < 1024; it += NGW) { const int h = it >> 8, cc = (it >> 4) & 15, dw = it & 15;
            p0_fold_item(od_fourier_w, h * 128 + cc * 8, nullptr, od_w_out + (size_t)(h * 128) * 1024, (bf16*)(ws + WS_WOUT1), h * 128 + cc * 8, 1.0f / 724.0773439350247f, dw, lane); }
        cur += 1024;
        first = (gw - (cur % NGW) + NGW) % NGW;
        for (int it = first; it < 1024; it += NGW) { const int h = it >> 8, half = (it >> 7) & 1, kc = it & 127;
            p0_pq_item(od_w_in, mix_g + D, (bf16*)(ws + WS_WPQ1), h, half, kc * 8, tab, lane); }
        cur += 1024;
    }
    {
        bf16* A2 = (bf16*)(ws + WS_DFT);
        int first = (gw - (cur % NGW) + NGW) % NGW;
        for (int t2 = first; t2 < 256; t2 += NGW) {
            const int k0 = lane * 8, sinpart = k0 >> 8, s0 = k0 & 255;
            float v[8];
#pragma unroll
            for (int e = 0; e < 8; ++e) v[e] = CT[((((s0 + e) * t2) & 255) * 16 - (sinpart ? 1024 : 0)) & (S - 1)];
            v4u o; o.x = pk2(v[0], v[1]); o.y = pk2(v[2], v[3]); o.z = pk2(v[4], v[5]); o.w = pk2(v[6], v[7]);
            *(GAS v4u*)(A2 + (size_t)t2 * 512 + k0) = o;
        }
        cur += 256;
    }
    {
        bf16* XB = (bf16*)(ws + WS_XB); unsigned long long* ssq0 = (unsigned long long*)(ws + WS_SSQ);
        for (int m0 = 4 * gw; m0 < M; m0 += 4 * NGW) {
            f32x4 v[4][4];
#pragma unroll
            for (int r = 0; r < 4; ++r) { const GAS f32x4* xr = (const GAS f32x4*)(x + (size_t)(m0 + r) * D) + lane;
#pragma unroll
                for (int j = 0; j < 4; ++j) v[r][j] = xr[64 * j]; }
#pragma unroll
            for (int r = 0; r < 4; ++r) { float s = 0.f;
#pragma unroll
                for (int j = 0; j < 4; ++j) s += (v[r][j].x * v[r][j].x + v[r][j].y * v[r][j].y) + (v[r][j].z * v[r][j].z + v[r][j].w * v[r][j].w);
                s = wave_sum(s);
                if (lane == 0) ssq0[m0 + r] = pg8::ssq_fix(s);
                GAS unsigned long long* o8 = (GAS unsigned long long*)(XB + (size_t)(m0 + r) * D) + lane;
#pragma unroll
                for (int j = 0; j < 4; ++j) o8[64 * j] = (unsigned long long)pk2(v[r][j].x, v[r][j].y) | ((unsigned long long)pk2(v[r][j].z, v[r][j].w) << 32); }
        }
    }
}

__device__ __forceinline__ float fsel(bool c, float a, float b) { return c ? a : b; }
__device__ __forceinline__ float reduce_scatter32(float (&v)[32], int lane) {
#pragma unroll
    for (int o = 16; o >= 1; o >>= 1) {
        const bool up = (lane & o) != 0;
#pragma unroll
        for (int i = 0; i < o; ++i) { const float lo_ = v[i], hi_ = v[i + o]; const float send = fsel(up, lo_, hi_), keep = fsel(up, hi_, lo_); v[i] = keep + __shfl_xor(send, o); }
#pragma unroll
        for (int i = 0; i < o; ++i) asm volatile("" : "+v"(v[i]));
    }
    return v[0] + __shfl_xor(v[0], 32);
}
__device__ __forceinline__ float reduce_scatter16(float (&v)[16], int lane) {
#pragma unroll
    for (int o = 8; o >= 1; o >>= 1) {
        const bool up = (lane & o) != 0;
#pragma unroll
        for (int i = 0; i < o; ++i) { const float lo_ = v[i], hi_ = v[i + o]; const float send = fsel(up, lo_, hi_), keep = fsel(up, hi_, lo_); v[i] = keep + __shfl_xor(send, o); }
#pragma unroll
        for (int i = 0; i < o; ++i) asm volatile("" : "+v"(v[i]));
    }
    float t = v[0] + __shfl_xor(v[0], 16);
    return t + __shfl_xor(t, 32);
}
template <int pmode> __device__ __forceinline__ void mix0_conv_item(Frame& F, const Ptrs& P, int item) {
    const bf16* UB = (const bf16*)(P.ws + WS_UB); bf16* AM = (bf16*)(P.ws + WS_AM);
    const float* cw = P.in[4]; const float* cb = P.in[5]; const float* lg = P.in[6]; const float* lb = P.in[7];
    const int b = item >> 6, t0 = (item & 63) * 64, rowbase = b * S;
    LAS unsigned* tile = (LAS unsigned*)(F.lds + RING_OFF);
    LAS float* red = (LAS float*)(F.lds + RING_OFF + 98304);
    int tidl = F.tid; asm volatile("" : "+v"(tidl));
    const int rg = tidl >> 8, cp = tidl & 255, lanel = tidl & 63;
    const f32x2g bb = *(const GAS f32x2g*)(cb + 2 * cp);
    const f32x2g g2 = *(const GAS f32x2g*)(lg + 2 * cp), b2 = *(const GAS f32x2g*)(lb + 2 * cp);
    float w0[31], w1[31];
#pragma unroll
    for (int j = 0; j < 31; ++j) { const f32x2g w = *(const GAS f32x2g*)(cw + j * 512 + 2 * cp); w0[j] = w.x; w1[j] = w.y; }
    if (pmode != 7) { v4u tv[12];
#pragma unroll
      for (int i = 0; i < 12; ++i) { const int t = t0 - 15 + F.wave + NWAVES * i, tc = t < 0 ? 0 : (t > S - 1 ? S - 1 : t);
          tv[i] = *(const GAS v4u*)(UB + (size_t)(rowbase + tc) * 512 + F.lane * 8); }
#pragma unroll
      for (int i = 0; i < 12; ++i) { const int r = F.wave + NWAVES * i, t = t0 - 15 + r; const bool ok = (t >= 0 && t < S);
          v4u w = tv[i]; w.x = ok ? w.x : 0u; w.y = ok ? w.y : 0u; w.z = ok ? w.z : 0u; w.w = ok ? w.w : 0u;
          *(LAS v4u*)(tile + r * 256 + F.lane * 4) = w; } }
    LDS_BAR();
#pragma unroll 1
    for (int p = 0; p < 2; ++p) {
        float a0[16], a1[16];
#pragma unroll
        for (int o = 0; o < 16; ++o) { a0[o] = bb.x; a1[o] = bb.y; }
        const LAS unsigned* tp = tile + (32 * rg + 16 * p) * 256 + cp;
#pragma unroll
        for (int ii = 0; ii < 46; ++ii) {
            const unsigned xx = tp[ii * 256];
            const float x0 = bf_lo(xx), x1 = bf_hi(xx);
#pragma unroll
            for (int o = 0; o < 16; ++o) { const int j = ii - o; if (j >= 0 && j <= 30) { a0[o] = fmaf(w0[j], x0, a0[o]); a1[o] = fmaf(w1[j], x1, a1[o]); } }
        }
        float v[32];
#pragma unroll
        for (int o = 0; o < 16; ++o) { v[2 * o] = a0[o] + a1[o]; v[2 * o + 1] = a0[o] * a0[o] + a1[o] * a1[o]; }
        LAS float* redp = red + (p & 1) * 256;
        const float tot = reduce_scatter32(v, lanel);
        if (lanel < 32) redp[(F.wave & 3) * 32 + lanel + rg * 128] = tot;
        LDS_BAR();
        float mean16[16], rstd16[16];
        {
            const LAS f32x4* rp = (const LAS f32x4*)(redp + rg * 128);
            f32x4 acc4[8];
#pragma unroll
            for (int k = 0; k < 8; ++k) acc4[k] = rp[k];
#pragma unroll
            for (int w = 1; w < 4; ++w)
#pragma unroll
                for (int k = 0; k < 8; ++k) acc4[k] = acc4[k] + rp[w * 8 + k];
#pragma unroll
            for (int o = 0; o < 16; ++o) { const float sm = acc4[o >> 1][(o & 1) * 2], sq = acc4[o >> 1][(o & 1) * 2 + 1];
                const float mean = sm * (1.0f / 512.0f), var = sq * (1.0f / 512.0f) - mean * mean; mean16[o] = mean; rstd16[o] = __builtin_amdgcn_rsqf(var + 1e-6f); }
        }
#pragma unroll
        for (int o = 0; o < 16; ++o) {
            const float mean = mean16[o], rstd = rstd16[o];
            float y0 = (a0[o] - mean) * rstd * g2.x + b2.x, y1 = (a1[o] - mean) * rstd * g2.y + b2.y;
            y0 = y0 * __builtin_amdgcn_rcpf(1.0f + __expf(-y0)); y1 = y1 * __builtin_amdgcn_rcpf(1.0f + __expf(-y1));
            *(GAS unsigned*)(AM + (size_t)(rowbase + t0 + 32 * rg + 16 * p + o) * 1024 + 2 * cp) = pk2(y0, y1);
        }
    }
    LDS_BAR();
}
template <int H> __device__ __forceinline__ void pool_rows(const LAS unsigned* tp  , bf16* orow  , int tfirst) {
    unsigned x[32 + 2 * H];
#pragma unroll
    for (int i = 0; i < 32 + 2 * H; ++i) x[i] = tp[i * 256];
    float s0 = 0.f, s1 = 0.f;
#pragma unroll
    for (int i = 0; i < 2 * H; ++i) { s0 += bf_lo(x[i]); s1 += bf_hi(x[i]); }
#pragma unroll
    for (int o = 0; o < 32; ++o) {
        const int t = tfirst + o;
        const int lo = (t - H) < 0 ? 0 : (t - H), hi = (t + H - 1) > (S - 1) ? (S - 1) : (t + H - 1);
        const float inv = 1.0f / (float)(hi - lo + 1);
        *(GAS unsigned*)(orow + (size_t)o * 1024) = pk2(s0 * inv - bf_lo(x[o + H]), s1 * inv - bf_hi(x[o + H]));
        if (o < 31) { s0 += bf_lo(x[o + 2 * H]) - bf_lo(x[o]); s1 += bf_hi(x[o + 2 * H]) - bf_hi(x[o]); }
    }
}
__device__ __forceinline__ void mix0_pool_item(Frame& F, const Ptrs& P, int item) {
    const bf16* PB = (const bf16*)(P.ws + WS_PB); bf16* AM = (bf16*)(P.ws + WS_AM);
    const int b = item >> 6, t0 = (item & 63) * 64, rowbase = b * S;
    LAS unsigned* tile = (LAS unsigned*)(F.lds + RING_OFF);
    { v4u tv[10];
#pragma unroll
      for (int i = 0; i < 10; ++i) { const int t = t0 - 8 + F.wave + NWAVES * i, tc = t < 0 ? 0 : (t > S - 1 ? S - 1 : t);
          tv[i] = *(const GAS v4u*)(PB + (size_t)(rowbase + tc) * 512 + F.lane * 8); }
#pragma unroll
      for (int i = 0; i < 10; ++i) { const int r = F.wave + NWAVES * i, t = t0 - 8 + r; const bool ok = (t >= 0 && t < S);
          v4u w = tv[i]; w.x = ok ? w.x : 0u; w.y = ok ? w.y : 0u; w.z = ok ? w.z : 0u; w.w = ok ? w.w : 0u;
          *(LAS v4u*)(tile + r * 256 + F.lane * 4) = w; } }
    LDS_BAR();
    const int rg = F.tid >> 8, cp = F.tid & 255, g = __builtin_amdgcn_readfirstlane(cp >> 6);
    bf16* orow = AM + (size_t)(rowbase + t0 + 32 * rg) * 1024 + 512 + 2 * cp;
    const int tfirst = t0 + 32 * rg;
    if (g == 0) pool_rows<1>(tile + (32 * rg + 8 - 1) * 256 + cp, orow, tfirst);
    else if (g == 1) pool_rows<2>(tile + (32 * rg + 8 - 2) * 256 + cp, orow, tfirst);
    else if (g == 2) pool_rows<4>(tile + (32 * rg + 8 - 4) * 256 + cp, orow, tfirst);
    else pool_rows<8>(tile + (32 * rg + 8 - 8) * 256 + cp, orow, tfirst);
    LDS_BAR();
}

struct SguIn { u32x2g uu[8]; unsigned xv[16]; };
__device__ __forceinline__ void sgu_load(const bf16* U, const bf16* V, int item, int wave, int lane, SguIn& R) {
    const int h = item & 3, rowbase = (item >> 2) * 128, fr = lane & 15, fq = lane >> 4, q = 16 * wave + fr;
#pragma unroll
    for (int nt = 0; nt < 8; ++nt) R.uu[nt] = *(const GAS u32x2g*)(U + (size_t)(rowbase + q) * 512 + h * 128 + 16 * nt + 4 * fq);
#pragma unroll
    for (int i = 0; i < 16; ++i) R.xv[i] = *(const GAS unsigned*)(V + (size_t)(rowbase + 16 * wave + i) * 512 + h * 128 + 2 * lane);
}
__device__ __forceinline__ void sgu_compute(Frame& F, bf16* AM, int item, int lane, const SguIn& R, const pg8::bf16x8 (&wf)[4], float bias, f32x2g g2, f32x2g b2) {
    const int h = item & 3, rowbase = (item >> 2) * 128, fr = lane & 15, fq = lane >> 4, q = 16 * F.wave + fr;
    LAS bf16* vnT = (LAS bf16*)(F.lds + RING_OFF);
    {
        float st[32];
#pragma unroll
        for (int i = 0; i < 16; ++i) { const float v0 = bf_lo(R.xv[i]), v1 = bf_hi(R.xv[i]); st[2 * i] = v0 + v1; st[2 * i + 1] = v0 * v0 + v1 * v1; }
        const float tot = reduce_scatter32(st, lane);
        unsigned y0[8], y1[8];
#pragma unroll
        for (int i = 0; i < 16; ++i) {
            const float sm = __builtin_bit_cast(float, __builtin_amdgcn_readlane(__builtin_bit_cast(int, tot), 2 * i)), sq = __builtin_bit_cast(float, __builtin_amdgcn_readlane(__builtin_bit_cast(int, tot), 2 * i + 1));
            const float mean = sm * (1.0f / 128.0f), rstd = __builtin_amdgcn_rsqf(sq * (1.0f / 128.0f) - mean * mean + 1e-6f);
            const unsigned a0 = f2bf((bf_lo(R.xv[i]) - mean) * rstd * g2.x + b2.x), a1 = f2bf((bf_hi(R.xv[i]) - mean) * rstd * g2.y + b2.y);
            if (i & 1) { y0[i >> 1] |= a0 << 16; y1[i >> 1] |= a1 << 16; } else { y0[i >> 1] = a0; y1[i >> 1] = a1; }
        }
        LAS bf16* d0 = vnT + (2 * lane) * 136 + 16 * F.wave;
        *(LAS v4u*)d0 = (v4u){y0[0], y0[1], y0[2], y0[3]}; *(LAS v4u*)(d0 + 8) = (v4u){y0[4], y0[5], y0[6], y0[7]};
        *(LAS v4u*)(d0 + 136) = (v4u){y1[0], y1[1], y1[2], y1[3]}; *(LAS v4u*)(d0 + 136 + 8) = (v4u){y1[4], y1[5], y1[6], y1[7]};
    }
    LDS_BAR();
    {
        pg8::f32x4 acc[8];
#pragma unroll
        for (int nt = 0; nt < 8; ++nt) acc[nt] = (pg8::f32x4){0.f, 0.f, 0.f, 0.f};
#pragma unroll
        for (int ks = 0; ks < 4; ++ks) {
#pragma unroll
            for (int nt = 0; nt < 8; ++nt) {
                const pg8::bf16x8 vf = *(const LAS pg8::bf16x8*)(vnT + (16 * nt + fr) * 136 + ks * 32 + 8 * fq);
                acc[nt] = __builtin_amdgcn_mfma_f32_16x16x32_bf16(vf, wf[ks], acc[nt], 0, 0, 0);
            }
        }
        const size_t t = (size_t)(rowbase + q);
#pragma unroll
        for (int nt = 0; nt < 8; ++nt) { const int c0 = h * 128 + 16 * nt + 4 * fq;
            u32x2g o; o.x = pk2(bf_lo(R.uu[nt].x) * (acc[nt][0] + bias), bf_hi(R.uu[nt].x) * (acc[nt][1] + bias)); o.y = pk2(bf_lo(R.uu[nt].y) * (acc[nt][2] + bias), bf_hi(R.uu[nt].y) * (acc[nt][3] + bias));
            *(GAS u32x2g*)(AM + t * 1024 + 512 + c0) = o; }
    }
    LDS_BAR();
}
__device__ __forceinline__ void sgu_phase(Frame& F, const Ptrs& P) {
    const bf16* U = (const bf16*)(P.ws + WS_U1); const bf16* V = (const bf16*)(P.ws + WS_V1); bf16* AM = (bf16*)(P.ws + WS_AM);
    const float* lng = P.in[13]; const float* lnb = P.in[14]; const float* sw = P.in[15]; const float* sb = P.in[16];
    int lane = F.lane; asm volatile("" : "+v"(lane));
    const int it0 = F.vcu, G = F.G;
    if (it0 >= 1024) return;
    const int h = it0 & 3, fr = lane & 15, fq = lane >> 4, q = 16 * F.wave + fr;
    pg8::bf16x8 wf[4];
#pragma unroll
    for (int ks = 0; ks < 4; ++ks) { const GAS pg8::f32x4* wp = (const GAS pg8::f32x4*)(sw + (size_t)(h * 128 + q) * 128 + ks * 32 + 8 * fq); const pg8::f32x4 wa = wp[0], wb = wp[1];
        pg8::u32x4 wq; wq.x = pk2(wa[0], wa[1]); wq.y = pk2(wa[2], wa[3]); wq.z = pk2(wb[0], wb[1]); wq.w = pk2(wb[2], wb[3]); wf[ks] = __builtin_bit_cast(pg8::bf16x8, wq); }
    const float bias = sb[h * 128 + q];
    const f32x2g g2 = *(const GAS f32x2g*)(lng + h * 128 + 2 * lane), b2 = *(const GAS f32x2g*)(lnb + h * 128 + 2 * lane);
    SguIn Ra, Rb;
    sgu_load(U, V, it0, F.wave, lane, Ra);
    for (int it = it0; it < 1024; it += 2 * G) {
        const int it1 = it + G, it2 = it + 2 * G;
        if (it1 < 1024) sgu_load(U, V, it1, F.wave, lane, Rb);
        sgu_compute(F, AM, it, lane, Ra, wf, bias, g2, b2);
        if (it1 >= 1024) break;
        if (it2 < 1024) sgu_load(U, V, it2, F.wave, lane, Ra);
        sgu_compute(F, AM, it1, lane, Rb, wf, bias, g2, b2);
    }
}

struct cpx { float r, i; };
__device__ __forceinline__ cpx cadd(cpx a, cpx b) { return {a.r + b.r, a.i + b.i}; }
__device__ __forceinline__ cpx csub(cpx a, cpx b) { return {a.r - b.r, a.i - b.i}; }
__device__ __forceinline__ cpx cmulc(cpx a, float c, float s) { return {a.r * c + a.i * s, a.i * c - a.r * s}; }
__device__ __forceinline__ cpx cmni(cpx a) { return {a.i, -a.r}; }
__device__ __forceinline__ void dft4(cpx& x0, cpx& x1, cpx& x2, cpx& x3) {
    const cpx s02 = cadd(x0, x2), d02 = csub(x0, x2), s13 = cadd(x1, x3), d13 = cmni(csub(x1, x3));
    x0 = cadd(s02, s13); x1 = cadd(d02, d13); x2 = csub(s02, s13); x3 = csub(d02, d13);
}
__device__ __forceinline__ void fft16(cpx (&x)[16], cpx (&z)[16]) {
    constexpr float C1 = 0.92387953251128674f, S1 = 0.38268343236508977f, R2 = 0.70710678118654752f;
#pragma unroll
    for (int b = 0; b < 4; ++b) dft4(x[b], x[4 + b], x[8 + b], x[12 + b]);
    x[4 + 1] = cmulc(x[4 + 1], C1, S1);  x[8 + 1] = cmulc(x[8 + 1], R2, R2);   x[12 + 1] = cmulc(x[12 + 1], S1, C1);
    x[4 + 2] = cmulc(x[4 + 2], R2, R2);  x[8 + 2] = cmni(x[8 + 2]);            x[12 + 2] = cmulc(x[12 + 2], -R2, R2);
    x[4 + 3] = cmulc(x[4 + 3], S1, C1);  x[8 + 3] = cmulc(x[8 + 3], -R2, R2);  x[12 + 3] = cmulc(x[12 + 3], -C1, -S1);
#pragma unroll
    for (int c = 0; c < 4; ++c) { dft4(x[4 * c], x[4 * c + 1], x[4 * c + 2], x[4 * c + 3]);
        z[c] = x[4 * c]; z[c + 4] = x[4 * c + 1]; z[c + 8] = x[4 * c + 2]; z[c + 12] = x[4 * c + 3]; }
}
__device__ __forceinline__ void fft_stage1(Frame& F, const Ptrs& P) {
    const bf16* PQT = (const bf16*)(P.ws + WS_PQT); bf16* ZP = (bf16*)(P.ws + WS_ZP);
    LAS float* CT = (LAS float*)(F.lds + RING_OFF + 65536);
    { int tl = F.tid; asm volatile("" : "+v"(tl)); for (int i = tl; i < 4096; i += NWAVES * 64) CT[i] = cospif((float)i * (1.0f / 2048.0f)); }
    LDS_BAR();
    int gw = F.vcu * NWAVES + F.wave; asm volatile("" : "+s"(gw)); const int NGW = F.G * NWAVES;
    for (int item = gw; item < NB * 512 * 2; item += NGW) {
        int lane = F.lane; asm volatile("" : "+v"(lane));
        const int row = item >> 1, s20 = 128 * (item & 1) + 2 * lane, b = row >> 9, ch = row & 511;
        const bf16* src = PQT + (size_t)row * 2 * S + s20;
        unsigned xp[16], xq[16];
#pragma unroll
        for (int s1 = 0; s1 < 16; ++s1) { xp[s1] = *(const GAS unsigned*)(src + 256 * s1); xq[s1] = *(const GAS unsigned*)(src + S + 256 * s1); }
        unsigned zr[16], zi[16];
#pragma unroll
        for (int e = 0; e < 2; ++e) {
            cpx x[16], z[16];
#pragma unroll
            for (int s1 = 0; s1 < 16; ++s1) { x[s1].r = e ? bf_hi(xp[s1]) : bf_lo(xp[s1]); x[s1].i = -(e ? bf_hi(xq[s1]) : bf_lo(xq[s1])); }
            fft16(x, z);
            const int s2 = s20 + e;
#pragma unroll
            for (int t1 = 0; t1 < 16; ++t1) {
                const int idx = s2 * t1;
                const cpx w = cmulc(z[t1], CT[idx], CT[(idx - 1024) & (S - 1)]);
                const unsigned hr = f2bf(w.r), hi = f2bf(w.i);
                if (e == 0) { zr[t1] = hr; zi[t1] = hi; } else { zr[t1] |= hr << 16; zi[t1] |= hi << 16; }
            }
        }
#pragma unroll
        for (int t1 = 0; t1 < 16; ++t1) { bf16* dst = ZP + ((size_t)((b * 16 + t1) * 512 + ch)) * 512 + s20;
            *(GAS unsigned*)dst = zr[t1]; *(GAS unsigned*)(dst + 256) = zi[t1]; }
    }
}

struct Args { const float* in[22]; float* out; unsigned char* ws; int ph_lo, ph_hi, li, pad; };
template <int PM> __device__ __forceinline__ void mk_body(const Args& args) {
    extern __shared__ __attribute__((aligned(16))) unsigned char lds[];
    Frame F;
    F.lds = (LAS unsigned char*)lds;
    F.MISC = (volatile LAS unsigned*)(F.lds + MISC_OFF);
    F.tid = threadIdx.x; F.lane = F.tid & 63; F.wave = __builtin_amdgcn_readfirstlane(F.tid >> 6);
    F.G = gridDim.x; { const int bx = blockIdx.x; F.vcu = (F.G % 8 == 0) ? (bx % 8) * (F.G / 8) + bx / 8 : bx; }
    Ptrs P;
#pragma unroll
    for (int i = 0; i < 22; ++i) P.in[i] = args.in[i];
    P.out = args.out; P.ws = args.ws;
    unsigned char* ws = args.ws;
    F.ctl = (gu32*)(ws + WS_CTL);
    for (int u = F.tid; u < (LDS_BYTES - LDSCTL_OFF) / 4; u += NWAVES * 64) ((LAS unsigned*)(F.lds + LDSCTL_OFF))[u] = 0u;
    __syncthreads();
    XcdBarrier bar; bar.bar = (unsigned*)(F.ctl + CW_BAR); bar.x = 0; bar.st = nullptr;
    if (!MK_PER_PHASE) bar = xcd_barrier_post((unsigned*)(F.ctl + CW_BAR), F.MISC + 8);
    const int lo = args.ph_lo, hi = args.ph_hi;
#ifndef PH_MASK
#define PH_MASK 0x1FFF
#endif
#define IN(k) ((((PH_MASK) >> (k)) & 1) && lo <= (k) && (k) < hi)
#ifndef PROBE_BARX
#define PROBE_BARX 1
#endif
#define SEAM(k) do { if (IN(k) && IN((k) + 1)) { for (int bx_ = 0; bx_ < PROBE_BARX; ++bx_) xcd_barrier(bar); } } while (0)
    unsigned long long* ssq = (unsigned long long*)(ws + WS_SSQ);
    bf16* XB = (bf16*)(ws + WS_XB); bf16* AM = (bf16*)(ws + WS_AM); bf16* HB = (bf16*)(ws + WS_H);
    const int bid = (int)blockIdx.x;
    constexpr bool dup = PM != 0;
    bf16* TRX = (bf16*)(ws + WS_END); unsigned long long* TRS = (unsigned long long*)(ws + WS_END + 64 * MiB);

    if (IN(0)) { p0_prologue(F, P); } SEAM(0);
    if (IN(1)) { pg8::Gemm g{XB, (const bf16*)(ws + WS_WIN0), M, 1536, D}; pg8::StaticOrder So; So.init(M, 1536, F.G, bid);
        pg8::EpiInL0 E{(bf16*)(ws + WS_UB), (bf16*)(ws + WS_PB), ssq};
        pg8::gemm_phase<pg8::EpiInL0, pg8::StaticOrder, true, true>(F.lds + RING_OFF, g, So, E); } SEAM(1);
    if (IN(2)) { for (int it = F.vcu; it < 1024; it += F.G) {
#ifndef NO_CONV
            if (it < 512 && PM != 4 && PM != 9) mix0_conv_item<PM>(F, P, it);
#endif
#ifndef NO_POOL
            if (it >= 512 && PM != 3 && PM != 9) mix0_pool_item(F, P, it - 512);
#endif
 } } SEAM(2);
    if (IN(3)) { pg8::Gemm g{AM, (const bf16*)(ws + WS_WOUT0), M, D, D}; pg8::StaticOrder So; So.init(M, D, F.G, bid);
        pg8::EpiResid E{XB, dup ? TRS : ssq + M, dup ? TRX : XB, PM};
        pg8::gemm_phase<pg8::EpiResid, pg8::StaticOrder, true, true>(F.lds + RING_OFF, g, So, E); } SEAM(3);
    if (IN(4)) { pg8::Gemm g{XB, (const bf16*)(ws + WS_WGU0), M, 2 * FF, D}; pg8::StaticOrder So; So.init(M, 2 * FF, F.G, bid);
        pg8::EpiSwiGLU E{HB, ssq + M, PM};
        pg8::gemm_phase<pg8::EpiSwiGLU, pg8::StaticOrder, (PM != 20 && PM != 22), (PM != 21 && PM != 22)>(F.lds + RING_OFF, g, So, E); } SEAM(4);
    if (IN(5)) { pg8::Gemm g{HB, (const bf16*)(ws + WS_WDN0), M, D, FF}; pg8::StaticOrder So; So.init(M, D, F.G, bid);
        pg8::EpiResid E{XB, dup ? TRS : ssq + 2 * M, dup ? TRX : XB, PM};
        pg8::gemm_phase<pg8::EpiResid, pg8::StaticOrder, true, true>(F.lds + RING_OFF, g, So, E); } SEAM(5);
    if (IN(6)) {
        { pg8::Gemm g{(const bf16*)(ws + WS_WPQ1), XB, 1024, M, D}; pg8::StaticOrder So; So.init(1024, M, F.G, bid);
          pg8::EpiPQT E{(bf16*)(ws + WS_PQT), ssq + 2 * M, PM};
          pg8::gemm_phase<pg8::EpiPQT, pg8::StaticOrder, true, true>(F.lds + RING_OFF, g, So, E); }
        { pg8::Gemm g{XB, (const bf16*)(ws + WS_WUV1), M, 1024, D}; pg8::StaticOrder So; So.init(M, 1024, F.G, bid);
          pg8::EpiGeluUV E{(bf16*)(ws + WS_U1), (bf16*)(ws + WS_V1), ssq + 2 * M, PM};
          pg8::gemm_phase<pg8::EpiGeluUV, pg8::StaticOrder, true, true>(F.lds + RING_OFF, g, So, E); }
    } SEAM(6);
    if (IN(7)) {
        if (PM != 12) { fft_stage1(F, P); }
        if (PM != 11) { sgu_phase(F, P); }
    } SEAM(7);
    if (IN(8)) { pg8::Gemm g{(const bf16*)(ws + WS_DFT), (const bf16*)(ws + WS_ZP), 256, NB * 16 * 512, 512}; pg8::StaticOrder So; So.init(256, NB * 16 * 512, F.G, bid);
        pg8::EpiDFT2 E{AM};
        pg8::gemm_phase<pg8::EpiDFT2, pg8::StaticOrder, true, true>(F.lds + RING_OFF, g, So, E); } SEAM(8);
    if (IN(9)) { pg8::Gemm g{AM, (const bf16*)(ws + WS_WOUT1), M, D, D}; pg8::StaticOrder So; So.init(M, D, F.G, bid);
        pg8::EpiResid E{XB, dup ? TRS : ssq + 3 * M, dup ? TRX : XB, PM};
        pg8::gemm_phase<pg8::EpiResid, pg8::StaticOrder, true, true>(F.lds + RING_OFF, g, So, E); } SEAM(9);
    if (IN(10)) { pg8::Gemm g{XB, (const bf16*)(ws + WS_WGU1), M, 2 * FF, D}; pg8::StaticOrder So; So.init(M, 2 * FF, F.G, bid);
        pg8::EpiSwiGLU E{HB, ssq + 3 * M, PM};
        pg8::gemm_phase<pg8::EpiSwiGLU, pg8::StaticOrder, true, true>(F.lds + RING_OFF, g, So, E); } SEAM(10);
    if (IN(11)) { pg8::Gemm g{HB, (const bf16*)(ws + WS_WDN1), M, D, FF}; pg8::StaticOrder So; So.init(M, D, F.G, bid);
        pg8::EpiResid E{XB, dup ? TRS : ssq + 4 * M, dup ? TRX : XB, PM};
        pg8::gemm_phase<pg8::EpiResid, pg8::StaticOrder, true, true>(F.lds + RING_OFF, g, So, E); } SEAM(11);
    if (IN(12)) {
        const float* gf = P.in[21]; const unsigned long long* ssq4 = ssq + 4 * M;
        const int gw = F.vcu * NWAVES + F.wave, NGW = F.G * NWAVES;
        for (int m = gw; m < M; m += NGW) {
            const GAS u32x2g* xr = (const GAS u32x2g*)(XB + (size_t)m * D) + F.lane; GAS f32x4* orow = (GAS f32x4*)(P.out + (size_t)m * D) + F.lane; const GAS f32x4* gr = (const GAS f32x4*)gf + F.lane;
            const float rs = pg8::rstd_of(ssq4[m]);
#pragma unroll
            for (int j = 0; j < 4; ++j) { const u32x2g xx = xr[64 * j]; const f32x4 gg = gr[64 * j];
                f32x4 v; v.x = bf_lo(xx.x); v.y = bf_hi(xx.x); v.z = bf_lo(xx.y); v.w = bf_hi(xx.y); orow[64 * j] = v * rs * gg; }
        }
    }
#undef IN
#undef SEAM
}
__global__ void __launch_bounds__(NWAVES * 64, 2) mk_fwd(Args args) { mk_body<0>(args); }
#ifdef PROBE_PHASE
#ifndef PROBE_MODE
#define PROBE_MODE 1
#endif
__global__ void __launch_bounds__(NWAVES * 64, 2) mk_probe(Args args) { mk_body<PROBE_MODE>(args); }
#endif

extern "C" void kernel_launch(void* const* d_in, const int* in_sizes, int n_in, void* d_out, int out_size, void* d_ws, size_t ws_size, hipStream_t stream) {
    static int grid = 0;
    if (grid == 0) {
        if (n_in != 22 || in_sizes[0] != M * D || out_size != M * D || ws_size < WS_END) { fprintf(stderr, "kernel_launch: unexpected shapes (n_in %d, in0 %d, out %d, ws %zu); nothing launched\n", n_in, n_in > 0 ? in_sizes[0] : -1, out_size, ws_size); grid = -1; return; }
        int dev = 0, cus = 0, per_cu = 0;
        if (hipGetDevice(&dev) != hipSuccess || hipDeviceGetAttribute(&cus, hipDeviceAttributeMultiprocessorCount, dev) != hipSuccess) { grid = -1; return; }
#ifdef PROBE_PHASE
        (void)hipFuncSetAttribute((const void*)mk_probe, hipFuncAttributeMaxDynamicSharedMemorySize, LDS_BYTES);
#endif
        if (hipFuncSetAttribute((const void*)mk_fwd, hipFuncAttributeMaxDynamicSharedMemorySize, LDS_BYTES) != hipSuccess) { fprintf(stderr, "kernel_launch: hipFuncSetAttribute failed\n"); grid = -1; return; }
        if (hipOccupancyMaxActiveBlocksPerMultiprocessor(&per_cu, (const void*)mk_fwd, NWAVES * 64, LDS_BYTES) != hipSuccess || per_cu < 1) { fprintf(stderr, "kernel_launch: occupancy query says %d blocks per CU\n", per_cu); per_cu = 1; }
        (void)hipGetLastError();
        grid = cus * 1;
    }
    if (grid < 0) return;
    if (hipMemsetAsync((char*)d_ws + WS_CTL, 0, CTL_ZERO_BYTES, stream) != hipSuccess) { fprintf(stderr, "kernel_launch: hipMemsetAsync failed\n"); return; }
    Args a{};
    for (int i = 0; i < 22; ++i) a.in[i] = (const float*)d_in[i];
    a.out = (float*)d_out; a.ws = (unsigned char*)d_ws;
#if MK_PER_PHASE
    for (int ph = 0; ph < N_PHASES; ++ph) { a.ph_lo = ph; a.ph_hi = ph + 1; a.li = ph;
        hipLaunchKernelGGL(mk_fwd, dim3(grid), dim3(NWAVES * 64), LDS_BYTES, stream, a); }
#else
    a.ph_lo = 0; a.ph_hi = N_PHASES; a.li = 0;
#ifdef PROBE_PHASE
#ifndef PROBE_MODE
#define PROBE_MODE 1
#endif
    { void* kargs0[] = {&a};
      hipError_t e0 = hipLaunchCooperativeKernel((const void*)mk_fwd, dim3(grid), dim3(NWAVES * 64), kargs0, LDS_BYTES, stream);
      if (e0 != hipSuccess) fprintf(stderr, "kernel_launch: cooperative launch failed: %s (grid %d)\n", hipGetErrorString(e0), grid);
      Args a2 = a; a2.ph_lo = PROBE_PHASE; a2.ph_hi = PROBE_PHASE + 1; a2.pad = PROBE_MODE;
      hipLaunchKernelGGL(mk_probe, dim3(grid), dim3(NWAVES * 64), LDS_BYTES, stream, a2); }
#elif defined(MK_PLAIN_LAUNCH)
    hipLaunchKernelGGL(mk_fwd, dim3(grid), dim3(NWAVES * 64), LDS_BYTES, stream, a);
#else
    void* kargs[] = {&a};
    hipError_t e = hipLaunchCooperativeKernel((const void*)mk_fwd, dim3(grid), dim3(NWAVES * 64), kargs, LDS_BYTES, stream);
    if (e != hipSuccess) fprintf(stderr, "kernel_launch: cooperative launch failed: %s (grid %d)\n", hipGetErrorString(e), grid);
#endif
#endif
}
```

```cpp
#include <hip/hip_runtime.h>
#include <cstdio>
#include <cstdint>
namespace pg8 {
#define PG8_LAS __attribute__((address_space(3)))
typedef unsigned short bf16_t;
typedef short bf16x8 __attribute__((ext_vector_type(8)));
typedef float f32x4 __attribute__((ext_vector_type(4)));
typedef unsigned u32x4 __attribute__((ext_vector_type(4)));
constexpr int BM = 256, BK = 64, HALF = 128, HTB = HALF * BK * 2  , STAGE_BYTES = 8 * HTB, NXCD = 8, WGM = 8;

__host__ __device__ __forceinline__ int lds_byte(int r, int c) { const int st = (r >> 4) * 2 + (c >> 5), rr = r & 15, cc = c & 31, ob = rr * 64 + cc * 2; return st * 1024 + (ob ^ (((ob >> 9) & 1) << 5)); }
__host__ __device__ __forceinline__ void stage_rc(int b, int& R, int& C) { const int st = b / 1024, sb = b % 1024, swz = sb ^ (((sb >> 9) & 1) << 5); R = (st >> 1) * 16 + swz / 64; C = (st & 1) * 32 + (swz % 64) / 2; }
__host__ __device__ __forceinline__ int perm32(int rho) { const int n = rho >> 4, i = rho & 15; return 8 * (i >> 2) + 4 * n + (i & 3); }

struct Unit { int pm, pn; };
struct Gemm { const bf16_t* A; const bf16_t* Bt; int M, N, K; };

struct StaticOrder {
    int nM, nN, nwg, G, c;
    __host__ __device__ void init(int M, int N, int G_, int c_) { nM = M / BM; nN = N / BM; nwg = nM * nN; G = G_; c = c_; }
    __host__ __device__ bool next(int i, Unit& u) const {
        const long L = (long)i * G + c; if (L >= nwg) return false;
        int wgid = (int)L; { const int q = nwg / NXCD, r = nwg % NXCD, xcd = wgid % NXCD, off = wgid / NXCD; wgid = (xcd < r ? xcd * (q + 1) : r * (q + 1) + (xcd - r) * q) + off; }
        const int nig = WGM * nN, gid = wgid / nig, fm = gid * WGM, gsz = (nM - fm) < WGM ? (nM - fm) : WGM;
        u.pm = fm + ((wgid % nig) % gsz); u.pn = (wgid % nig) / gsz; return true;
    }
    __device__ __forceinline__ void a_ready(const Unit&) const {}
    __device__ __forceinline__ void done(const Unit&) const {}
};

__device__ __forceinline__ unsigned cvt_pk_bf16(float lo, float hi) { unsigned r; asm volatile("v_cvt_pk_bf16_f32 %0, %1, %2" : "=v"(r) : "v"(lo), "v"(hi)); return r; }
typedef float f32x2 __attribute__((ext_vector_type(2)));
__device__ __forceinline__ f32x2 gelu_pk(f32x2 v) {
    const f32x2 av = __builtin_elementwise_abs(v), d = av * 0.2316418882f + 1.0f;
    f32x2 t; t.x = __builtin_amdgcn_rcpf(d.x); t.y = __builtin_amdgcn_rcpf(d.y);
    f32x2 q = t * 0.5307027145f + (-0.7265760135f); q = q * t + 0.7107068705f; q = q * t + (-0.142248368f); q = q * t + 0.127414796f; q = q * t;
    const f32x2 s = (v * v) * (-0.72134752044f);
    f32x2 e; e.x = __builtin_amdgcn_exp2f(s.x); e.y = __builtin_amdgcn_exp2f(s.y);
    const f32x2 m = v * (q * e), r = v - m;
    f32x2 o; o.x = v.x < 0.f ? m.x : r.x; o.y = v.y < 0.f ? m.y : r.y; return o;
}


constexpr float RMS_EPS = 1e-6f;
__device__ __forceinline__ float sigm(float x) { return __builtin_amdgcn_rcpf(1.0f + __expf(-x)); }
__device__ __forceinline__ u32x4 pack8(const f32x4 v0, const f32x4 v1) { u32x4 w; w.x = cvt_pk_bf16(v0[0], v0[1]); w.y = cvt_pk_bf16(v0[2], v0[3]); w.z = cvt_pk_bf16(v1[0], v1[1]); w.w = cvt_pk_bf16(v1[2], v1[3]); return w; }
__device__ __forceinline__ void store16_wt(void* p, u32x4 v) { asm volatile("global_store_dwordx4 %0, %1, off sc1\n\ts_nop 1" :: "v"(p), "v"(v) : "memory"); }
__device__ __forceinline__ void keep_alive(const f32x4 (&acc)[2][2][4][2]) {
#pragma unroll
    for (int a = 0; a < 2; ++a)
#pragma unroll
        for (int b = 0; b < 2; ++b)
#pragma unroll
            for (int m = 0; m < 4; ++m)
#pragma unroll
                for (int n = 0; n < 2; ++n) asm volatile("" :: "v"(acc[a][b][m][n]));
}
typedef unsigned long long u64_t;
__device__ __forceinline__ float ssq_f(u64_t v) { return fmaf((float)(unsigned)(v >> 32), 4294967296.0f, (float)(unsigned)v); }
__device__ __forceinline__ float rstd_of(u64_t ssq) { return __builtin_amdgcn_rsqf(fmaf(ssq_f(ssq), 1.0f / (1024.0f * 1048576.0f), RMS_EPS)); }
__device__ __forceinline__ u64_t ssq_fix(float s) { return (u64_t)(s * 1048576.0f); }

struct EpiInL0 {
    static constexpr bool PERM = true, AFTER_DRAIN = false;
    bf16_t* UB; bf16_t* PB; const u64_t* ssq;
    __device__ __forceinline__ void operator()(const f32x4 (&acc)[2][2][4][2], const Unit& u, int wr, int wc, int fr, int fq) const {
        const int row0 = u.pm * BM + wr * 64 + fr, cw = wc * 32 + 8 * fq;
        u64_t q[2][4];
#pragma unroll
        for (int ai = 0; ai < 2; ++ai)
#pragma unroll
            for (int m = 0; m < 4; ++m) q[ai][m] = ssq[row0 + ai * HALF + m * 16];
#pragma unroll
        for (int ai = 0; ai < 2; ++ai)
#pragma unroll
            for (int m = 0; m < 4; ++m) {
                const int row = row0 + ai * HALF + m * 16;
                const float rs = rstd_of(q[ai][m]), c1 = rs * -1.4426950408889634f;
                if (u.pn < 4) {
                    f32x4 o[2];
#pragma unroll
                    for (int n = 0; n < 2; ++n)
#pragma unroll
                        for (int j = 0; j < 4; j += 2) {
                            const f32x2 a = {acc[ai][0][m][n][j], acc[ai][0][m][n][j + 1]}, g = {acc[ai][1][m][n][j], acc[ai][1][m][n][j + 1]};
                            const f32x2 t = g * c1; f32x2 e; e.x = __builtin_amdgcn_exp2f(t.x); e.y = __builtin_amdgcn_exp2f(t.y);
                            const f32x2 d = e + 1.0f; f32x2 r; r.x = __builtin_amdgcn_rcpf(d.x); r.y = __builtin_amdgcn_rcpf(d.y);
                            const f32x2 h = a * (r * rs); o[n][j] = h.x; o[n][j + 1] = h.y; }
                    store16_wt(UB + (size_t)row * 512 + u.pn * 128 + cw, pack8(o[0], o[1]));
                } else {
#pragma unroll
                    for (int bj = 0; bj < 2; ++bj) store16_wt(PB + (size_t)row * 512 + (u.pn - 4) * 256 + bj * HALF + cw, pack8(acc[ai][bj][m][0] * rs, acc[ai][bj][m][1] * rs));
                }
            }
    }
};
struct EpiResid {
    static constexpr bool PERM = true, AFTER_DRAIN = false;
    bf16_t* XB; u64_t* ssq; bf16_t* XBw; int probe_mode;
    __device__ __forceinline__ void operator()(const f32x4 (&acc)[2][2][4][2], const Unit& u, int wr, int wc, int fr, int fq) const {
        const int row0 = u.pm * BM + wr * 64 + fr, cw = u.pn * BM + wc * 32 + 8 * fq;
        if (probe_mode == 2) { keep_alive(acc); return; }
        u32x4 r[2][4][2];
#pragma unroll
        for (int ai = 0; ai < 2; ++ai)
#pragma unroll
            for (int m = 0; m < 4; ++m)
#pragma unroll
                for (int bj = 0; bj < 2; ++bj) r[ai][m][bj] = *(const u32x4*)(XB + (size_t)(row0 + ai * HALF + m * 16) * 1024 + bj * HALF + cw);
#pragma unroll
        for (int ai = 0; ai < 2; ++ai)
#pragma unroll
            for (int m = 0; m < 4; ++m) {
                const int row = row0 + ai * HALF + m * 16;
                f32x2 s2 = {0.f, 0.f};
#pragma unroll
                for (int bj = 0; bj < 2; ++bj) {
                    const u32x4 rr = r[ai][m][bj];
                    const f32x2 a0 = {acc[ai][bj][m][0][0], acc[ai][bj][m][0][1]}, a1 = {acc[ai][bj][m][0][2], acc[ai][bj][m][0][3]}, a2 = {acc[ai][bj][m][1][0], acc[ai][bj][m][1][1]}, a3 = {acc[ai][bj][m][1][2], acc[ai][bj][m][1][3]};
                    const f32x2 v0 = a0 + (f32x2){__builtin_bit_cast(float, rr.x << 16), __builtin_bit_cast(float, rr.x & 0xffff0000u)};
                    const f32x2 v1 = a1 + (f32x2){__builtin_bit_cast(float, rr.y << 16), __builtin_bit_cast(float, rr.y & 0xffff0000u)};
                    const f32x2 v2 = a2 + (f32x2){__builtin_bit_cast(float, rr.z << 16), __builtin_bit_cast(float, rr.z & 0xffff0000u)};
                    const f32x2 v3 = a3 + (f32x2){__builtin_bit_cast(float, rr.w << 16), __builtin_bit_cast(float, rr.w & 0xffff0000u)};
                    u32x4 w; w.x = cvt_pk_bf16(v0.x, v0.y); w.y = cvt_pk_bf16(v1.x, v1.y); w.z = cvt_pk_bf16(v2.x, v2.y); w.w = cvt_pk_bf16(v3.x, v3.y);
                    *(u32x4*)(XBw + ((size_t)row * 1024 + bj * HALF + cw)) = w;
                    s2 = v0 * v0 + s2; s2 = v1 * v1 + s2; s2 = v2 * v2 + s2; s2 = v3 * v3 + s2;
                }
                float s = s2.x + s2.y;
                s += __shfl_xor(s, 16); s += __shfl_xor(s, 32);
                if (fq == 0) atomicAdd(ssq + row, ssq_fix(s));
            }
    }
};
struct EpiSwiGLU {
    static constexpr bool PERM = true, AFTER_DRAIN = false;
    bf16_t* H; const u64_t* ssq; int probe_mode;
    __device__ __forceinline__ void operator()(const f32x4 (&acc)[2][2][4][2], const Unit& u, int wr, int wc, int fr, int fq) const {
        const int row0 = u.pm * BM + wr * 64 + fr, cw = wc * 32 + 8 * fq;
        if (probe_mode == 2) { keep_alive(acc); return; }
        u64_t q[2][4];
#pragma unroll
        for (int ai = 0; ai < 2; ++ai)
#pragma unroll
            for (int m = 0; m < 4; ++m) q[ai][m] = ssq[row0 + ai * HALF + m * 16];
#pragma unroll
        for (int ai = 0; ai < 2; ++ai)
#pragma unroll
            for (int m = 0; m < 4; ++m) {
                const int row = row0 + ai * HALF + m * 16;
                const float rs = rstd_of(q[ai][m]), c1 = rs * -1.4426950408889634f, rs2 = rs * rs;
                f32x4 o[2];
#pragma unroll
                for (int n = 0; n < 2; ++n)
#pragma unroll
                    for (int j = 0; j < 4; j += 2) {
                        const f32x2 g = {acc[ai][0][m][n][j], acc[ai][0][m][n][j + 1]}, up = {acc[ai][1][m][n][j], acc[ai][1][m][n][j + 1]};
                        const f32x2 t = g * c1; f32x2 e; e.x = __builtin_amdgcn_exp2f(t.x); e.y = __builtin_amdgcn_exp2f(t.y);
                        const f32x2 d = e + 1.0f; f32x2 r; r.x = __builtin_amdgcn_rcpf(d.x); r.y = __builtin_amdgcn_rcpf(d.y);
                        const f32x2 h = (g * up) * (r * rs2); o[n][j] = h.x; o[n][j + 1] = h.y; }
                store16_wt(H + (size_t)row * 2816 + u.pn * 128 + cw, pack8(o[0], o[1]));
            }
    }
};
struct EpiPQT {
    static constexpr bool PERM = true, AFTER_DRAIN = false;
    bf16_t* PQT; const u64_t* ssq; int probe_mode;
    __device__ __forceinline__ void operator()(const f32x4 (&acc)[2][2][4][2], const Unit& u, int wr, int wc, int fr, int fq) const {
        if (probe_mode == 2) { keep_alive(acc); return; }
        const int tok0 = u.pn * BM + wc * 32 + 8 * fq, b = (u.pn * BM) >> 12;
#pragma unroll
        for (int bj = 0; bj < 2; ++bj) {
            u64_t q[8];
#pragma unroll
            for (int j = 0; j < 8; ++j) q[j] = ssq[tok0 + bj * HALF + j];
            f32x4 rs0, rs1;
#pragma unroll
            for (int j = 0; j < 4; ++j) { rs0[j] = rstd_of(q[j]); rs1[j] = rstd_of(q[4 + j]); }
#pragma unroll
            for (int ai = 0; ai < 2; ++ai)
#pragma unroll
                for (int m = 0; m < 4; ++m) {
                    const int r = u.pm * BM + ai * HALF + wr * 64 + m * 16 + fr, pq = r >> 9, ch = r & 511;
                    bf16_t* base = PQT + ((size_t)(b * 512 + ch) * 2 + pq) * 4096;
                    store16_wt(base + ((tok0 + bj * HALF) & 4095), pack8(acc[ai][bj][m][0] * rs0, acc[ai][bj][m][1] * rs1));
                }
        }
    }
};
struct EpiGeluUV {
    static constexpr bool PERM = true, AFTER_DRAIN = false;
    bf16_t* U; bf16_t* V; const u64_t* ssq; int probe_mode;
    __device__ __forceinline__ void operator()(const f32x4 (&acc)[2][2][4][2], const Unit& u, int wr, int wc, int fr, int fq) const {
        if (probe_mode == 2) { keep_alive(acc); return; }
        const int row0 = u.pm * BM + wr * 64 + fr, cw = wc * 32 + 8 * fq;
        bf16_t* dst = (u.pn < 2) ? U : V; const int colb = (u.pn & 1) * BM;
        u64_t q[2][4];
#pragma unroll
        for (int ai = 0; ai < 2; ++ai)
#pragma unroll
            for (int m = 0; m < 4; ++m) q[ai][m] = ssq[row0 + ai * HALF + m * 16];
#pragma unroll
        for (int ai = 0; ai < 2; ++ai)
#pragma unroll
            for (int m = 0; m < 4; ++m) {
                const int row = row0 + ai * HALF + m * 16;
                const float rs = rstd_of(q[ai][m]);
#pragma unroll
                for (int bj = 0; bj < 2; ++bj) {
                    const f32x4 v0 = acc[ai][bj][m][0] * rs, v1 = acc[ai][bj][m][1] * rs;
                    const f32x2 a = gelu_pk((f32x2){v0[0], v0[1]}), bq = gelu_pk((f32x2){v0[2], v0[3]}), c = gelu_pk((f32x2){v1[0], v1[1]}), d = gelu_pk((f32x2){v1[2], v1[3]});
                    store16_wt(dst + (size_t)row * 512 + colb + bj * HALF + cw, pack8((f32x4){a.x, a.y, bq.x, bq.y}, (f32x4){c.x, c.y, d.x, d.y}));
                }
            }
    }
};
struct EpiDFT2 {
    static constexpr bool PERM = true, AFTER_DRAIN = false;
    bf16_t* AM;
    __device__ __forceinline__ void operator()(const f32x4 (&acc)[2][2][4][2], const Unit& u, int wr, int wc, int fr, int fq) const {
#pragma unroll
        for (int bj = 0; bj < 2; ++bj) {
            const int n = u.pn * BM + bj * HALF + wc * 32 + 8 * fq, b = n >> 13, t1 = (n >> 9) & 15, ch = n & 511;
            bf16_t* base = AM + (size_t)(b * 4096 + t1) * 1024 + ch;
#pragma unroll
            for (int ai = 0; ai < 2; ++ai)
#pragma unroll
                for (int m = 0; m < 4; ++m) { const int t2 = ai * HALF + wr * 64 + m * 16 + fr;
                    store16_wt(base + (size_t)(16 * t2) * 1024, pack8(acc[ai][bj][m][0], acc[ai][bj][m][1])); }
        }
    }
};

template <class Epi, class Sched, bool ALIGN_EPI = false, bool SP2 = false>
__device__ __forceinline__ void gemm_phase(PG8_LAS unsigned char* lds, const Gemm g, const Sched& S, const Epi& E) {
    const int tid = threadIdx.x, wid = __builtin_amdgcn_readfirstlane(tid >> 6), lane = tid & 63, wr = wid >> 2, wc = wid & 3, fr = lane & 15, fq = lane >> 4;
    const int K = g.K, nt = K / BK;
    unsigned voffA[2], voffB[2];
#pragma unroll
    for (int i = 0; i < 2; ++i) { int R, C; stage_rc(tid * 16 + i * 8192, R, C); const int Rb = Epi::PERM ? ((R & ~31) + perm32(R & 31)) : R;
        voffA[i] = (unsigned)(R * K + C) * 2u; voffB[i] = (unsigned)(Rb * K + C) * 2u; }
    const size_t kstep = (size_t)(BK * 2);
    const size_t hstep = (size_t)HALF * K * 2;
    const size_t tstep = 2 * hstep;
    const unsigned ldsw = (unsigned)wid * 1024u;
    const int aoff = lds_byte(wr * 64 + fr, fq * 8), boff = lds_byte(wc * 32 + fr, fq * 8);
#define PG8_SA(b, h) (((b) * 2 + (h)) * HTB)
#define PG8_SB(b, h) ((4 + (b) * 2 + (h)) * HTB)
#define PG8_STAGE(bufoff, gbase, voff) do { _Pragma("unroll") for (int _i = 0; _i < 2; ++_i) \
        __builtin_amdgcn_global_load_lds((const unsigned*)((const char*)(gbase) + (voff)[_i]), (PG8_LAS unsigned*)(lds + (bufoff) + ldsw + _i * 8192), 16, 0, 0); } while (0)
#define PG8_LDA(dst, b, h) do { _Pragma("unroll") for (int m = 0; m < 4; ++m) _Pragma("unroll") for (int k = 0; k < 2; ++k) dst[m][k] = *(const PG8_LAS bf16x8*)(lds + PG8_SA(b, h) + aoff + m * 2048 + k * 1024); } while (0)
#define PG8_LDB(dst, b, h) do { _Pragma("unroll") for (int n = 0; n < 2; ++n) _Pragma("unroll") for (int k = 0; k < 2; ++k) dst[n][k] = *(const PG8_LAS bf16x8*)(lds + PG8_SB(b, h) + boff + n * 2048 + k * 1024); } while (0)
#define PG8_MMA(ai, bj, At, Bt) do { __builtin_amdgcn_s_setprio(1); _Pragma("unroll") for (int m = 0; m < 4; ++m) _Pragma("unroll") for (int n = 0; n < 2; ++n) _Pragma("unroll") for (int k = 0; k < 2; ++k) \
        acc[ai][bj][m][n] = __builtin_amdgcn_mfma_f32_16x16x32_bf16(Bt[n][k], At[m][k], acc[ai][bj][m][n], 0, 0, 0); __builtin_amdgcn_s_setprio(0); } while (0)
#define PG8_WAIT_V(n) asm volatile("s_waitcnt vmcnt(" #n ")" ::: "memory")
#define PG8_WAIT_L(n) asm volatile("s_waitcnt lgkmcnt(" #n ")" ::: "memory")
#define PG8_BAR __builtin_amdgcn_s_barrier()
#define PG8_SCHED __builtin_amdgcn_sched_barrier(0)
    Unit cur, nxt; int ui = 0;
    if (!S.next(0, cur)) return;
    f32x4 acc[2][2][4][2];
#pragma unroll
    for (int a = 0; a < 2; ++a)
#pragma unroll
        for (int b = 0; b < 2; ++b)
#pragma unroll
            for (int m = 0; m < 4; ++m)
#pragma unroll
                for (int n = 0; n < 2; ++n) acc[a][b][m][n] = (f32x4){0.f, 0.f, 0.f, 0.f};
    bf16x8 At[4][2], B0[2][2], B1[2][2];
    const char* cA = (const char*)g.A + (size_t)cur.pm * tstep; const char* cB = (const char*)g.Bt + (size_t)cur.pn * tstep;
    S.a_ready(cur);
    if constexpr (SP2) {
        PG8_STAGE(PG8_SB(0, 0), cB, voffB); PG8_STAGE(PG8_SB(0, 1), cB + hstep, voffB); PG8_STAGE(PG8_SA(0, 0), cA, voffA); PG8_STAGE(PG8_SA(0, 1), cA + hstep, voffA);
        if (wr == 1) PG8_BAR;
        PG8_WAIT_V(2); PG8_BAR;
        PG8_STAGE(PG8_SB(1, 0), cB + kstep, voffB); PG8_STAGE(PG8_SA(1, 0), cA + kstep, voffA); PG8_STAGE(PG8_SB(1, 1), cB + hstep + kstep, voffB);
        PG8_WAIT_V(6); PG8_BAR;
    } else {
        PG8_STAGE(PG8_SB(0, 0), cB, voffB); PG8_STAGE(PG8_SA(0, 0), cA, voffA); PG8_STAGE(PG8_SB(0, 1), cB + hstep, voffB); PG8_STAGE(PG8_SA(0, 1), cA + hstep, voffA);
        if (wr == 1) PG8_BAR;
        PG8_WAIT_V(4); PG8_BAR;
        PG8_STAGE(PG8_SB(1, 0), cB + kstep, voffB); PG8_STAGE(PG8_SA(1, 0), cA + kstep, voffA); PG8_STAGE(PG8_SB(1, 1), cB + hstep + kstep, voffB);
        PG8_WAIT_V(6); PG8_BAR;
    }
    for (;;) {
        const bool has_next = S.next(ui + 1, nxt);
        const char* nA = has_next ? (const char*)g.A + (size_t)nxt.pm * tstep : cA; const char* nB = has_next ? (const char*)g.Bt + (size_t)nxt.pn * tstep : cB;
        for (int t = 0; t < nt; t += 2) {
            const bool last = (t == nt - 2);
            const char* a1 = cA + (size_t)(t + 1) * kstep;
            const char* a2 = last ? nA : cA + (size_t)(t + 2) * kstep; const char* b2 = last ? nB : cB + (size_t)(t + 2) * kstep;
            const char* a3 = a2 + kstep; const char* b3 = b2 + kstep;
            if (last && has_next) S.a_ready(nxt);
            if constexpr (SP2) {
            PG8_LDB(B0, 0, 0); PG8_LDB(B1, 0, 1); PG8_SCHED; PG8_LDA(At, 0, 0); PG8_STAGE(PG8_SA(1, 1), a1 + hstep, voffA);
            PG8_WAIT_V(8); PG8_WAIT_L(0); PG8_BAR; PG8_MMA(0, 0, At, B0); PG8_MMA(0, 1, At, B1); PG8_BAR; PG8_SCHED;
            PG8_LDA(At, 0, 1); PG8_STAGE(PG8_SB(0, 0), b2, voffB); PG8_STAGE(PG8_SB(0, 1), b2 + hstep, voffB); PG8_STAGE(PG8_SA(0, 0), a2, voffA);
            PG8_WAIT_V(8); PG8_WAIT_L(0); PG8_BAR; PG8_MMA(1, 0, At, B0); PG8_MMA(1, 1, At, B1); PG8_BAR; PG8_SCHED;
            PG8_LDB(B0, 1, 0); PG8_LDB(B1, 1, 1); PG8_SCHED; PG8_LDA(At, 1, 0); PG8_STAGE(PG8_SA(0, 1), a2 + hstep, voffA);
            PG8_WAIT_V(8); PG8_WAIT_L(0); PG8_BAR; PG8_MMA(0, 0, At, B0); PG8_MMA(0, 1, At, B1); PG8_BAR; PG8_SCHED;
            PG8_LDA(At, 1, 1); PG8_STAGE(PG8_SB(1, 0), b3, voffB); PG8_STAGE(PG8_SB(1, 1), b3 + hstep, voffB); PG8_STAGE(PG8_SA(1, 0), a3, voffA);
            PG8_WAIT_V(8); PG8_WAIT_L(0); PG8_BAR; PG8_MMA(1, 0, At, B0); PG8_MMA(1, 1, At, B1); PG8_BAR; PG8_SCHED;
            } else {
            PG8_LDB(B0, 0, 0); PG8_SCHED; PG8_LDA(At, 0, 0); PG8_STAGE(PG8_SA(1, 1), a1 + hstep, voffA);
            PG8_WAIT_L(8); PG8_BAR; PG8_WAIT_L(0); PG8_MMA(0, 0, At, B0); PG8_BAR; PG8_SCHED;
            PG8_LDB(B1, 0, 1); PG8_STAGE(PG8_SB(0, 0), b2, voffB);
            PG8_BAR; PG8_WAIT_L(0); PG8_MMA(0, 1, At, B1); PG8_BAR;
            PG8_LDA(At, 0, 1); PG8_STAGE(PG8_SA(0, 0), a2, voffA);
            PG8_BAR; PG8_WAIT_L(0); PG8_MMA(1, 0, At, B0); PG8_BAR; PG8_SCHED;
            PG8_STAGE(PG8_SB(0, 1), b2 + hstep, voffB);
            PG8_WAIT_V(6); PG8_BAR; PG8_MMA(1, 1, At, B1); PG8_BAR;
            PG8_LDB(B0, 1, 0); PG8_SCHED; PG8_LDA(At, 1, 0); PG8_STAGE(PG8_SA(0, 1), a2 + hstep, voffA);
            PG8_WAIT_L(8); PG8_BAR; PG8_WAIT_L(0); PG8_MMA(0, 0, At, B0); PG8_BAR; PG8_SCHED;
            PG8_LDB(B1, 1, 1); PG8_STAGE(PG8_SB(1, 0), b3, voffB);
            PG8_BAR; PG8_WAIT_L(0); PG8_MMA(0, 1, At, B1); PG8_BAR;
            PG8_LDA(At, 1, 1); PG8_STAGE(PG8_SA(1, 0), a3, voffA);
            PG8_BAR; PG8_WAIT_L(0); PG8_MMA(1, 0, At, B0); PG8_BAR; PG8_SCHED;
            PG8_STAGE(PG8_SB(1, 1), b3 + hstep, voffB);
            PG8_WAIT_V(6); PG8_BAR; PG8_MMA(1, 1, At, B1); PG8_BAR;
            }
        }
        if constexpr (ALIGN_EPI) { if (wr == 0) PG8_BAR; }
        if constexpr (!Epi::AFTER_DRAIN) { E(acc, cur, wr, wc, fr, fq); S.done(cur); }
        if (!has_next) break;
#pragma unroll
        for (int a = 0; a < 2; ++a)
#pragma unroll
            for (int b = 0; b < 2; ++b)
#pragma unroll
                for (int m = 0; m < 4; ++m)
#pragma unroll
                    for (int n = 0; n < 2; ++n) acc[a][b][m][n] = (f32x4){0.f, 0.f, 0.f, 0.f};
        cur = nxt; cA = nA; cB = nB; ++ui;
        if constexpr (ALIGN_EPI) { if (wr == 1) PG8_BAR; }
    }
    PG8_WAIT_V(0);
    if constexpr (!ALIGN_EPI) { if (wr == 0) PG8_BAR; }
    PG8_BAR;
    if constexpr (Epi::AFTER_DRAIN) { E.fused(acc, cur, wr, wc, fr, fq, lds, wid, lane); S.done(cur); }
#undef PG8_SA
#undef PG8_SB
#undef PG8_STAGE
#undef PG8_LDA
#undef PG8_LDB
#undef PG8_MMA
#undef PG8_WAIT_V
#undef PG8_WAIT_L
#undef PG8_BAR
#undef PG8_SCHED
}
}
#define GAS __attribute__((address_space(1)))
#define LAS __attribute__((address_space(3)))
typedef unsigned short bf16;
typedef unsigned v4u __attribute__((ext_vector_type(4)));
typedef float f32x4 __attribute__((ext_vector_type(4)));
typedef short bf16x8 __attribute__((ext_vector_type(8)));
typedef GAS unsigned gu32;
typedef GAS unsigned long long gu64;
#define RLX_AGENT __ATOMIC_RELAXED, __HIP_MEMORY_SCOPE_AGENT
#define LDS_WAIT() asm volatile("s_waitcnt lgkmcnt(0)" ::: "memory")
#define VM_WAIT() asm volatile("s_waitcnt vmcnt(0)" ::: "memory")
__device__ __forceinline__ unsigned long long rt() { return __builtin_amdgcn_s_memrealtime(); }
__device__ __forceinline__ unsigned f2bf(float f) { unsigned u = __builtin_bit_cast(unsigned, f); return (u + 0x7fffu + ((u >> 16) & 1u)) >> 16; }
__device__ __forceinline__ unsigned pk2(float lo, float hi) { return f2bf(lo) | (f2bf(hi) << 16); }

#define XB_TMO      128
#define XB_XCNT(j)  (256  + 64 * (j))
#define XB_XSUB(j)  (1280 + 64 * (j))
#define XB_XGEN(j)  (2304 + 64 * (j))
#define XB_TOP      3328
#define XB_TOPGEN   3392
#define XCD_BAR_WORDS 3456
#define XB_SPIN_CAP (1u << 18)

__device__ __forceinline__ unsigned xb_ld(unsigned* p)              { return __hip_atomic_load(p, __ATOMIC_RELAXED, __HIP_MEMORY_SCOPE_AGENT); }
__device__ __forceinline__ unsigned xb_add(unsigned* p, unsigned v) { return __hip_atomic_fetch_add(p, v, __ATOMIC_RELAXED, __HIP_MEMORY_SCOPE_AGENT); }
__device__ __forceinline__ unsigned xb_xcc_id() { return (unsigned)__builtin_amdgcn_s_getreg((3 << 11) | 20) & 0xFu; }
#define XB_SPIN(cond, bar) do { unsigned _sp = 0; while (cond) { __builtin_amdgcn_s_sleep(1); \
    if ((++_sp & 255u) == 0u) { if (xb_ld(&(bar)[XB_TMO])) break; if (_sp > XB_SPIN_CAP) { atomicAdd(&(bar)[XB_TMO], 1u); break; } } } } while (0)

struct XcdBarrier {
    unsigned* bar; unsigned x;
    volatile LAS unsigned* st;
};

__device__ __forceinline__ XcdBarrier xcd_barrier_post(unsigned* bar, volatile LAS unsigned* st) {
    XcdBarrier b; b.bar = bar; b.x = xb_xcc_id(); b.st = st;
    if (threadIdx.x == 0) (void)xb_add(&bar[XB_XCNT(b.x)], 1u);
    return b;
}
__device__ __forceinline__ void xcd_barrier_complete(unsigned* bar, unsigned x, unsigned& nloc, unsigned& nx) {
    const unsigned G = gridDim.x * gridDim.y * gridDim.z;
    unsigned sum, cnt, mine, sp = 0u;
    for (;;) {
        sum = 0u; cnt = 0u; mine = 0u;
#pragma unroll
        for (unsigned j = 0; j < 16; ++j) { const unsigned c = xb_ld(&bar[XB_XCNT(j)]); sum += c; cnt += (c > 0u) ? 1u : 0u; mine = (j == x) ? c : mine; }
        if (sum == G) break;
        __builtin_amdgcn_s_sleep(1);
        if ((++sp & 255u) == 0u) { if (xb_ld(&bar[XB_TMO])) break; if (sp > XB_SPIN_CAP) { atomicAdd(&bar[XB_TMO], 1u); break; } }
    }
    nloc = mine > 0u ? mine : 1u; nx = cnt > 0u ? cnt : 1u;
}

__device__ __forceinline__ void xcd_barrier(const XcdBarrier& b) {
    asm volatile("s_waitcnt vmcnt(0)" ::: "memory");
    __syncthreads();
    if (threadIdx.x == 0) {
        unsigned* bar = b.bar;
        __builtin_amdgcn_s_waitcnt(0);
        unsigned nloc = b.st[0], nx = b.st[1];
        if (nloc == 0u) { xcd_barrier_complete(bar, b.x, nloc, nx); b.st[0] = nloc; b.st[1] = nx; }
        const unsigned old = xb_add(&bar[XB_XSUB(b.x)], 1u);
        const unsigned gen = old / nloc;
        if (old + 1u == (gen + 1u) * nloc) {
            __builtin_amdgcn_fence(__ATOMIC_RELEASE, "agent");
            asm volatile("s_waitcnt vmcnt(0)" ::: "memory");
            const unsigned og = xb_add(&bar[XB_TOP], 1u);
            const unsigned tg = og / nx;
            if (og + 1u == (tg + 1u) * nx) xb_add(&bar[XB_TOPGEN], 1u);
            else XB_SPIN(xb_ld(&bar[XB_TOPGEN]) == tg, bar);
            __builtin_amdgcn_fence(__ATOMIC_ACQUIRE, "agent");
            xb_add(&bar[XB_XGEN(b.x)], 1u);
            asm volatile("s_waitcnt vmcnt(0)" ::: "memory");
        } else {
            XB_SPIN(xb_ld(&bar[XB_XGEN(b.x)]) == gen, bar);
            __builtin_amdgcn_fence(__ATOMIC_ACQUIRE, "agent");
            asm volatile("s_waitcnt vmcnt(0)" ::: "memory");
        }
    }
    __syncthreads();
}

constexpr int NWAVES = 8;
#ifndef MK_PER_PHASE
#define MK_PER_PHASE 0
#endif
constexpr int N_PHASES = 13;

constexpr int NB = 8, S = 4096, D = 1024, FF = 2816, M = NB * S;
typedef float f32x2g __attribute__((ext_vector_type(2)));
typedef unsigned u32x2g __attribute__((ext_vector_type(2)));

constexpr size_t MiB = 1u << 20;
constexpr size_t WS_CTL = 0, CTL_ZERO_BYTES = 1 * MiB;
constexpr size_t WS_SSQ = 46 * MiB + 512 * 1024;
constexpr size_t WS_WIN0 = 2 * MiB;
constexpr size_t WS_WOUT0 = 5 * MiB;
constexpr size_t WS_WGU0 = 7 * MiB;
constexpr size_t WS_WDN0 = 18 * MiB;
constexpr size_t WS_WPQ1 = 24 * MiB;
constexpr size_t WS_WUV1 = 26 * MiB;
constexpr size_t WS_WOUT1 = 28 * MiB;
constexpr size_t WS_WGU1 = 30 * MiB;
constexpr size_t WS_WDN1 = 41 * MiB;
constexpr size_t WS_DFT = 48 * MiB;
constexpr size_t WS_XB = 112 * MiB;
constexpr size_t WS_AM = 176 * MiB;
constexpr size_t WS_H = 240 * MiB;
constexpr size_t WS_UB = WS_H, WS_PB = WS_H + 32 * MiB;
constexpr size_t WS_PQT = WS_H, WS_U1 = WS_H + 64 * MiB, WS_V1 = WS_H + 96 * MiB, WS_ZP = WS_H + 128 * MiB;
constexpr size_t WS_END = 432 * MiB;
static_assert(WS_H + (size_t)M * FF * 2 <= WS_END && WS_V1 + (size_t)M * 512 * 2 <= WS_ZP && WS_ZP + 64 * MiB <= WS_END, "d_ws map");
constexpr int CW_BAR = 4096;

constexpr int RING_OFF = 0, RING_BYTES = 131072;
constexpr int LDSCTL_OFF = RING_BYTES, MISC_OFF = LDSCTL_OFF + 320;
constexpr int LDS_BYTES = 147456;

struct Frame {
    LAS unsigned char* lds;
    volatile LAS unsigned* MISC;
    gu32* ctl;
    int tid, lane, wave;
    int vcu, G;
};
__device__ __forceinline__ float wave_sum(float v) {
#pragma unroll
    for (int o = 1; o < 64; o <<= 1) v += __shfl_xor(v, o);
    return v;
}
__device__ __forceinline__ float bf_lo(unsigned x) { return __builtin_bit_cast(float, x << 16); }
__device__ __forceinline__ float bf_hi(unsigned x) { return __builtin_bit_cast(float, x & 0xffff0000u); }
#define WG_BAR() do { asm volatile("s_waitcnt vmcnt(0) lgkmcnt(0)" ::: "memory"); __builtin_amdgcn_s_barrier(); asm volatile("" ::: "memory"); } while (0)
#define LDS_BAR() do { asm volatile("s_waitcnt lgkmcnt(0)" ::: "memory"); __builtin_amdgcn_s_barrier(); asm volatile("" ::: "memory"); } while (0)

__device__ __forceinline__ void p0_transpose_item(const float* W, int ldw, const float* gk, bf16* WT, int ldt, int k0, int n0, int dk0, int drow0, LAS float* scr, int lane) {
    float v[32];
    const float* wp = W + (size_t)(k0 + (lane >> 5)) * ldw + n0 + (lane & 31);
#pragma unroll
    for (int i = 0; i < 32; ++i) v[i] = wp[(size_t)(2 * i) * ldw];
    const int c = lane & 7;
    f32x4 g0 = {1.f, 1.f, 1.f, 1.f}, g1 = {1.f, 1.f, 1.f, 1.f};
    if (gk) { g0 = *(const GAS f32x4*)(gk + k0 + 8 * c); g1 = *(const GAS f32x4*)(gk + k0 + 8 * c + 4); }
#pragma unroll
    for (int i = 0; i < 32; ++i) scr[(2 * i + (lane >> 5)) * 33 + (lane & 31)] = v[i];
    LDS_WAIT(); asm volatile("" ::: "memory");
#pragma unroll
    for (int j = 0; j < 4; ++j) { const int n = (lane >> 3) + 8 * j; const LAS float* s = scr + (8 * c) * 33 + n;
        v4u o; o.x = pk2(s[0 * 33] * g0.x, s[1 * 33] * g0.y); o.y = pk2(s[2 * 33] * g0.z, s[3 * 33] * g0.w); o.z = pk2(s[4 * 33] * g1.x, s[5 * 33] * g1.y); o.w = pk2(s[6 * 33] * g1.z, s[7 * 33] * g1.w);
        *(GAS v4u*)(WT + (size_t)(drow0 + n) * ldt + dk0 + 8 * c) = o; }
    LDS_WAIT(); asm volatile("" ::: "memory");
}
__device__ __forceinline__ void p0_job(const float* W, int ldw, const float* gk, int kbeg, int kext, int ncol0, int next, bf16* WT, int ldt, int dkbase, int mode, int half_or_off,
                                       LAS float* scr, int lane, int gw, int NGW, int& cursor) {
    const int nkb = kext / 64, nnb = next / 32, nitems = nkb * nnb;
    int first = (gw - (cursor % NGW) + NGW) % NGW;
    for (int it = first; it < nitems; it += NGW) {
        const int kb = it / nnb, nb = it % nnb, nrel = 32 * nb;
        const int drow0 = (mode == 0) ? (half_or_off + nrel) : (256 * (nrel >> 7) + 128 * half_or_off + (nrel & 127));
        p0_transpose_item(W, ldw, gk, WT, ldt, kbeg + 64 * kb, ncol0 + nrel, dkbase + 64 * kb, drow0, scr, lane);
    }
    cursor += nitems;
}
__device__ __forceinline__ void p0_fold_item(const float* L, int lrow0, const float* sc, const float* Rm, bf16* out, int dk0, float scale, int dw, int lane) {
    const int d = 64 * dw + lane;
    float l0[8], l1[8];
    { const float s0 = sc ? sc[lane] : 1.f, s1 = sc ? sc[64 + lane] : 1.f;
#pragma unroll
      for (int j = 0; j < 8; ++j) { l0[j] = L[(size_t)(lrow0 + j) * 128 + lane] * s0; l1[j] = L[(size_t)(lrow0 + j) * 128 + 64 + lane] * s1; } }
    float acc[8];
#pragma unroll
    for (int j = 0; j < 8; ++j) acc[j] = 0.f;
#pragma unroll
    for (int cb = 0; cb < 4; ++cb) {
        float r[32];
#pragma unroll
        for (int i = 0; i < 32; ++i) r[i] = Rm[(size_t)(cb * 32 + i) * 1024 + d];
#pragma unroll
        for (int i = 0; i < 32; ++i) { const int cp = cb * 32 + i;
#pragma unroll
            for (int j = 0; j < 8; ++j) { const float lv = __builtin_bit_cast(float, __builtin_amdgcn_readlane(__builtin_bit_cast(int, cp < 64 ? l0[j] : l1[j]), cp & 63)); acc[j] = fmaf(lv, r[i], acc[j]); } }
    }
    v4u o; o.x = pk2(acc[0] * scale, acc[1] * scale); o.y = pk2(acc[2] * scale, acc[3] * scale); o.z = pk2(acc[4] * scale, acc[5] * scale); o.w = pk2(acc[6] * scale, acc[7] * scale);
    *(GAS v4u*)(out + (size_t)d * 1024 + dk0) = o;
}
__device__ __forceinline__ void p0_pq_item(const float* Win1, const float* g1, bf16* WPQ, int h, int half, int k0, const LAS float* tab, int lane) {
    const int cp = 64 * half + lane;
    float ap[8], aq[8], w0[8], w1[8];
#pragma unroll
    for (int j = 0; j < 8; ++j) { const float g = g1[k0 + j]; ap[j] = 0.f; aq[j] = 0.f; w0[j] = Win1[(size_t)(k0 + j) * 1536 + h * 128 + lane] * g; w1[j] = Win1[(size_t)(k0 + j) * 1536 + h * 128 + 64 + lane] * g; }
#pragma unroll 8
    for (int c = 0; c < 128; ++c) {
        const int ph = c * cp;
        const float cs = tab[ph & 127], sn = tab[(ph - 32) & 127];
#pragma unroll
        for (int j = 0; j < 8; ++j) { const float w = __builtin_bit_cast(float, __builtin_amdgcn_readlane(__builtin_bit_cast(int, c < 64 ? w0[j] : w1[j]), c & 63)); ap[j] = fmaf(w, cs, ap[j]); aq[j] = fmaf(w, sn, aq[j]); }
    }
    v4u o; o.x = pk2(ap[0], ap[1]); o.y = pk2(ap[2], ap[3]); o.z = pk2(ap[4], ap[5]); o.w = pk2(ap[6], ap[7]);
    *(GAS v4u*)(WPQ + (size_t)(h * 128 + cp) * 1024 + k0) = o;
    o.x = pk2(aq[0], aq[1]); o.y = pk2(aq[2], aq[3]); o.z = pk2(aq[4], aq[5]); o.w = pk2(aq[6], aq[7]);
    *(GAS v4u*)(WPQ + (size_t)(512 + h * 128 + cp) * 1024 + k0) = o;
}

struct Ptrs {
    const float* in[22]; float* out; unsigned char* ws;
};

__device__ __forceinline__ void p0_prologue(Frame& F, const Ptrs& P) {
    const float* x = P.in[0]; const float* mix_g = P.in[1]; const float* ffn_g = P.in[2];
    const float* ev_w_in = P.in[3]; const float* ev_pool_w = P.in[8]; const float* ev_pool_scale = P.in[9]; const float* ev_w_out = P.in[10];
    const float* od_w_in = P.in[11]; const float* od_fourier_w = P.in[12]; const float* od_w_out = P.in[17];
    const float* w_gate = P.in[18]; const float* w_up = P.in[19]; const float* w_down = P.in[20];
    unsigned char* ws = P.ws;
    LAS float* scr = (LAS float*)(F.lds + RING_OFF + F.wave * 8448);
    LAS float* CT = (LAS float*)(F.lds + RING_OFF + 69632);
    LAS float* tab = (LAS float*)(F.lds + RING_OFF + 69632 + 16384);
    for (int i = F.tid; i < 4096; i += NWAVES * 64) CT[i] = cospif((float)i * (1.0f / 2048.0f));
    if (F.tid < 128) tab[F.tid] = cospif((float)F.tid * (1.0f / 64.0f));
    WG_BAR();
    const int gw = F.vcu * NWAVES + F.wave, NGW = F.G * NWAVES, lane = F.lane;
    { unsigned long long* z = (unsigned long long*)(ws + WS_SSQ) + M; const int gt = F.vcu * NWAVES * 64 + F.tid, NT = F.G * NWAVES * 64;
      for (int i = gt; i < 4 * M; i += NT) z[i] = 0ull; }
    int cur = 0;
    p0_job(ev_w_in, 1536, mix_g, 0, 1024, 0, 512, (bf16*)(ws + WS_WIN0), 1024, 0, 1, 0, scr, lane, gw, NGW, cur);
    p0_job(ev_w_in, 1536, mix_g, 0, 1024, 512, 512, (bf16*)(ws + WS_WIN0), 1024, 0, 1, 1, scr, lane, gw, NGW, cur);
    p0_job(ev_w_in, 1536, mix_g, 0, 1024, 1024, 512, (bf16*)(ws + WS_WIN0), 1024, 0, 0, 1024, scr, lane, gw, NGW, cur);
    p0_job(ev_w_out, 1024, nullptr, 0, 512, 0, 1024, (bf16*)(ws + WS_WOUT0), 1024, 0, 0, 0, scr, lane, gw, NGW, cur);
    p0_job(w_gate, FF, ffn_g, 0, 1024, 0, FF, (bf16*)(ws + WS_WGU0), 1024, 0, 1, 0, scr, lane, gw, NGW, cur);
    p0_job(w_up, FF, ffn_g, 0, 1024, 0, FF, (bf16*)(ws + WS_WGU0), 1024, 0, 1, 1, scr, lane, gw, NGW, cur);
    p0_job(w_down, 1024, nullptr, 0, FF, 0, 1024, (bf16*)(ws + WS_WDN0), FF, 0, 0, 0, scr, lane, gw, NGW, cur);
    p0_job(od_w_in, 1536, mix_g + D, 0, 1024, 512, 1024, (bf16*)(ws + WS_WUV1), 1024, 0, 0, 0, scr, lane, gw, NGW, cur);
    p0_job(od_w_out, 1024, nullptr, 512, 512, 0, 1024, (bf16*)(ws + WS_WOUT1), 1024, 512, 0, 0, scr, lane, gw, NGW, cur);
    p0_job(w_gate + (size_t)D * FF, FF, ffn_g + D, 0, 1024, 0, FF, (bf16*)(ws + WS_WGU1), 1024, 0, 1, 0, scr, lane, gw, NGW, cur);
    p0_job(w_up + (size_t)D * FF, FF, ffn_g + D, 0, 1024, 0, FF, (bf16*)(ws + WS_WGU1), 1024, 0, 1, 1, scr, lane, gw, NGW, cur);
    p0_job(w_down + (size_t)FF * D, 1024, nullptr, 0, FF, 0, 1024, (bf16*)(ws + WS_WDN1), FF, 0, 0, 0, scr, lane, gw, NGW, cur);
    {
        int first = (gw - (cur % NGW) + NGW) % NGW;
        for (int it = first; it < 1024; it += NGW) { const int g = it >> 8, cc = (it >> 4) & 15, dw = it & 15;
            p0_fold_item(ev_pool_w, g * 128 + cc * 8, ev_pool_scale + g * 128, ev_w_out + (size_t)(512 + g * 128) * 1024, (bf16*)(ws + WS_WOUT0), 512 + g * 128 + cc * 8, 1.0f, dw, lane); }
        cur += 1024;
        first = (gw - (cur % NGW) + NGW) % NGW;
        for (int it = first; it < 1024; it += NGW) { const int h = it >> 8, cc = (it >> 4) & 15, dw = it & 15;
            p0_fold_item(od_fourier_w, h * 128 + cc * 8, nullptr, od_w_out + (size_t)(h * 128) * 1024, (bf16*)(ws + WS_WOUT1), h * 128 + cc * 8, 1.0f / 724.0773439350247f, dw, lane); }
        cur += 1024;
        first = (gw - (cur % NGW) + NGW) % NGW;
        for (int it = first; it < 1024; it += NGW) { const int h = it >> 8, half = (it >> 7) & 1, kc = it & 127;
            p0_pq_item(od_w_in, mix_g + D, (bf16*)(ws + WS_WPQ1), h, half, kc * 8, tab, lane); }
        cur += 1024;
    }
    {
        bf16* A2 = (bf16*)(ws + WS_DFT);
        int first = (gw - (cur % NGW) + NGW) % NGW;
        for (int t2 = first; t2 < 256; t2 += NGW) {
            const int k0 = lane * 8, sinpart = k0 >> 8, s0 = k0 & 255;
            float v[8];
#pragma unroll
            for (int e = 0; e < 8; ++e) v[e] = CT[((((s0 + e) * t2) & 255) * 16 - (sinpart ? 1024 : 0)) & (S - 1)];
            v4u o; o.x = pk2(v[0], v[1]); o.y = pk2(v[2], v[3]); o.z = pk2(v[4], v[5]); o.w = pk2(v[6], v[7]);
            *(GAS v4u*)(A2 + (size_t)t2 * 512 + k0) = o;
        }
        cur += 256;
    }
    {
        bf16* XB = (bf16*)(ws + WS_XB); unsigned long long* ssq0 = (unsigned long long*)(ws + WS_SSQ);
        for (int m0 = 8 * gw; m0 < M; m0 += 8 * NGW) {
            f32x4 v[8][4];
#pragma unroll
            for (int r = 0; r < 8; ++r) { const GAS f32x4* xr = (const GAS f32x4*)(x + (size_t)(m0 + r) * D) + lane;
#pragma unroll
                for (int j = 0; j < 4; ++j) v[r][j] = xr[64 * j]; }
#pragma unroll
            for (int r = 0; r < 8; ++r) { float s = 0.f;
#pragma unroll
                for (int j = 0; j < 4; ++j) s += (v[r][j].x * v[r][j].x + v[r][j].y * v[r][j].y) + (v[r][j].z * v[r][j].z + v[r][j].w * v[r][j].w);
                s = wave_sum(s);
                if (lane == 0) ssq0[m0 + r] = pg8::ssq_fix(s);
                GAS unsigned long long* o8 = (GAS unsigned long long*)(XB + (size_t)(m0 + r) * D) + lane;
#pragma unroll
                for (int j = 0; j < 4; ++j) o8[64 * j] = (unsigned long long)pk2(v[r][j].x, v[r][j].y) | ((unsigned long long)pk2(v[r][j].z, v[r][j].w) << 32); }
        }
    }
}

__device__ __forceinline__ float fsel(bool c, float a, float b) { return c ? a : b; }
__device__ __forceinline__ float reduce_scatter32(float (&v)[32], int lane) {
#pragma unroll
    for (int o = 16; o >= 1; o >>= 1) {
        const bool up = (lane & o) != 0;
#pragma unroll
        for (int i = 0; i < o; ++i) { const float lo_ = v[i], hi_ = v[i + o]; const float send = fsel(up, lo_, hi_), keep = fsel(up, hi_, lo_); v[i] = keep + __shfl_xor(send, o); }
#pragma unroll
        for (int i = 0; i < o; ++i) asm volatile("" : "+v"(v[i]));
    }
    return v[0] + __shfl_xor(v[0], 32);
}
__device__ __forceinline__ float reduce_scatter16(float (&v)[16], int lane) {
#pragma unroll
    for (int o = 8; o >= 1; o >>= 1) {
        const bool up = (lane & o) != 0;
#pragma unroll
        for (int i = 0; i < o; ++i) { const float lo_ = v[i], hi_ = v[i + o]; const float send = fsel(up, lo_, hi_), keep = fsel(up, hi_, lo_); v[i] = keep + __shfl_xor(send, o); }
#pragma unroll
        for (int i = 0; i < o; ++i) asm volatile("" : "+v"(v[i]));
    }
    float t = v[0] + __shfl_xor(v[0], 16);
    return t + __shfl_xor(t, 32);
}
template <int pmode> __device__ __forceinline__ void mix0_conv_item(Frame& F, const Ptrs& P, int item) {
    const bf16* UB = (const bf16*)(P.ws + WS_UB); bf16* AM = (bf16*)(P.ws + WS_AM);
    const float* cw = P.in[4]; const float* cb = P.in[5]; const float* lg = P.in[6]; const float* lb = P.in[7];
    const int b = item >> 6, t0 = (item & 63) * 64, rowbase = b * S;
    LAS unsigned* tile = (LAS unsigned*)(F.lds + RING_OFF);
    LAS float* red = (LAS float*)(F.lds + RING_OFF + 98304);
    int tidl = F.tid; asm volatile("" : "+v"(tidl));
    const int rg = tidl >> 8, cp = tidl & 255, lanel = tidl & 63;
    const f32x2g bb = *(const GAS f32x2g*)(cb + 2 * cp);
    const f32x2g g2 = *(const GAS f32x2g*)(lg + 2 * cp), b2 = *(const GAS f32x2g*)(lb + 2 * cp);
    float w0[31], w1[31];
#pragma unroll
    for (int j = 0; j < 31; ++j) { const f32x2g w = *(const GAS f32x2g*)(cw + j * 512 + 2 * cp); w0[j] = w.x; w1[j] = w.y; }
    if (pmode != 7) { v4u tv[12];
#pragma unroll
      for (int i = 0; i < 12; ++i) { const int t = t0 - 15 + F.wave + NWAVES * i, tc = t < 0 ? 0 : (t > S - 1 ? S - 1 : t);
          tv[i] = *(const GAS v4u*)(UB + (size_t)(rowbase + tc) * 512 + F.lane * 8); }
#pragma unroll
      for (int i = 0; i < 12; ++i) { const int r = F.wave + NWAVES * i, t = t0 - 15 + r; const bool ok = (t >= 0 && t < S);
          v4u w = tv[i]; w.x = ok ? w.x : 0u; w.y = ok ? w.y : 0u; w.z = ok ? w.z : 0u; w.w = ok ? w.w : 0u;
          *(LAS v4u*)(tile + r * 256 + F.lane * 4) = w; } }
    LDS_BAR();
#pragma unroll 1
    for (int p = 0; p < 2; ++p) {
        float a0[16], a1[16];
#pragma unroll
        for (int o = 0; o < 16; ++o) { a0[o] = bb.x; a1[o] = bb.y; }
        const LAS unsigned* tp = tile + (32 * rg + 16 * p) * 256 + cp;
#pragma unroll
        for (int ii = 0; ii < 46; ++ii) {
            const unsigned xx = tp[ii * 256];
            const float x0 = bf_lo(xx), x1 = bf_hi(xx);
#pragma unroll
            for (int o = 0; o < 16; ++o) { const int j = ii - o; if (j >= 0 && j <= 30) { a0[o] = fmaf(w0[j], x0, a0[o]); a1[o] = fmaf(w1[j], x1, a1[o]); } }
        }
        float v[32];
#pragma unroll
        for (int o = 0; o < 16; ++o) { v[2 * o] = a0[o] + a1[o]; v[2 * o + 1] = a0[o] * a0[o] + a1[o] * a1[o]; }
        LAS float* redp = red + (p & 1) * 256;
        const float tot = reduce_scatter32(v, lanel);
        if (lanel < 32) redp[(F.wave & 3) * 32 + lanel + rg * 128] = tot;
        LDS_BAR();
        float mean16[16], rstd16[16];
        {
            const LAS f32x4* rp = (const LAS f32x4*)(redp + rg * 128);
            f32x4 acc4[8];
#pragma unroll
            for (int k = 0; k < 8; ++k) acc4[k] = rp[k];
#pragma unroll
            for (int w = 1; w < 4; ++w)
#pragma unroll
                for (int k = 0; k < 8; ++k) acc4[k] = acc4[k] + rp[w * 8 + k];
#pragma unroll
            for (int o = 0; o < 16; ++o) { const float sm = acc4[o >> 1][(o & 1) * 2], sq = acc4[o >> 1][(o & 1) * 2 + 1];
                const float mean = sm * (1.0f / 512.0f), var = sq * (1.0f / 512.0f) - mean * mean; mean16[o] = mean; rstd16[o] = __builtin_amdgcn_rsqf(var + 1e-6f); }
        }
#pragma unroll
        for (int o = 0; o < 16; ++o) {
            const float mean = mean16[o], rstd = rstd16[o];
            float y0 = (a0[o] - mean) * rstd * g2.x + b2.x, y1 = (a1[o] - mean) * rstd * g2.y + b2.y;
            y0 = y0 * __builtin_amdgcn_rcpf(1.0f + __expf(-y0)); y1 = y1 * __builtin_amdgcn_rcpf(1.0f + __expf(-y1));
            *(GAS unsigned*)(AM + (size_t)(rowbase + t0 + 32 * rg + 16 * p + o) * 1024 + 2 * cp) = pk2(y0, y1);
        }
    }
    LDS_BAR();
}
template <int H> __device__ __forceinline__ void pool_rows(const LAS unsigned* tp  , bf16* orow  , int tfirst) {
    unsigned x[32 + 2 * H];
#pragma unroll
    for (int i = 0; i < 32 + 2 * H; ++i) x[i] = tp[i * 256];
    float s0 = 0.f, s1 = 0.f;
#pragma unroll
    for (int i = 0; i < 2 * H; ++i) { s0 += bf_lo(x[i]); s1 += bf_hi(x[i]); }
#pragma unroll
    for (int o = 0; o < 32; ++o) {
        const int t = tfirst + o;
        const int lo = (t - H) < 0 ? 0 : (t - H), hi = (t + H - 1) > (S - 1) ? (S - 1) : (t + H - 1);
        const float inv = 1.0f / (float)(hi - lo + 1);
        *(GAS unsigned*)(orow + (size_t)o * 1024) = pk2(s0 * inv - bf_lo(x[o + H]), s1 * inv - bf_hi(x[o + H]));
        if (o < 31) { s0 += bf_lo(x[o + 2 * H]) - bf_lo(x[o]); s1 += bf_hi(x[o + 2 * H]) - bf_hi(x[o]); }
    }
}
__device__ __forceinline__ void mix0_pool_item(Frame& F, const Ptrs& P, int item) {
    const bf16* PB = (const bf16*)(P.ws + WS_PB); bf16* AM = (bf16*)(P.ws + WS_AM);
    const int b = item >> 6, t0 = (item & 63) * 64, rowbase = b * S;
    LAS unsigned* tile = (LAS unsigned*)(F.lds + RING_OFF);
    { v4u tv[10];
#pragma unroll
      for (int i = 0; i < 10; ++i) { const int t = t0 - 8 + F.wave + NWAVES * i, tc = t < 0 ? 0 : (t > S - 1 ? S - 1 : t);
          tv[i] = *(const GAS v4u*)(PB + (size_t)(rowbase + tc) * 512 + F.lane * 8); }
#pragma unroll
      for (int i = 0; i < 10; ++i) { const int r = F.wave + NWAVES * i, t = t0 - 8 + r; const bool ok = (t >= 0 && t < S);
          v4u w = tv[i]; w.x = ok ? w.x : 0u; w.y = ok ? w.y : 0u; w.z = ok ? w.z : 0u; w.w = ok ? w.w : 0u;
          *(LAS v4u*)(tile + r * 256 + F.lane * 4) = w; } }
    LDS_BAR();
    const int rg = F.tid >> 8, cp = F.tid & 255, g = __builtin_amdgcn_readfirstlane(cp >> 6);
    bf16* orow = AM + (size_t)(rowbase + t0 + 32 * rg) * 1024 + 512 + 2 * cp;
    const int tfirst = t0 + 32 * rg;
    if (g == 0) pool_rows<1>(tile + (32 * rg + 8 - 1) * 256 + cp, orow, tfirst);
    else if (g == 1) pool_rows<2>(tile + (32 * rg + 8 - 2) * 256 + cp, orow, tfirst);
    else if (g == 2) pool_rows<4>(tile + (32 * rg + 8 - 4) * 256 + cp, orow, tfirst);
    else pool_rows<8>(tile + (32 * rg + 8 - 8) * 256 + cp, orow, tfirst);
    LDS_BAR();
}

struct SguIn { u32x2g uu[8]; unsigned xv[16]; };
__device__ __forceinline__ void sgu_load(const bf16* U, const bf16* V, int item, int wave, int lane, SguIn& R) {
    const int h = item & 3, rowbase = (item >> 2) * 128, fr = lane & 15, fq = lane >> 4, q = 16 * wave + fr;
#pragma unroll
    for (int nt = 0; nt < 8; ++nt) R.uu[nt] = *(const GAS u32x2g*)(U + (size_t)(rowbase + q) * 512 + h * 128 + 16 * nt + 4 * fq);
#pragma unroll
    for (int i = 0; i < 16; ++i) R.xv[i] = *(const GAS unsigned*)(V + (size_t)(rowbase + 16 * wave + i) * 512 + h * 128 + 2 * lane);
}
__device__ __forceinline__ void sgu_compute(Frame& F, bf16* AM, int item, int lane, const SguIn& R, const pg8::bf16x8 (&wf)[4], float bias, f32x2g g2, f32x2g b2) {
    const int h = item & 3, rowbase = (item >> 2) * 128, fr = lane & 15, fq = lane >> 4, q = 16 * F.wave + fr;
    LAS bf16* vnT = (LAS bf16*)(F.lds + RING_OFF);
    {
        float st[32];
#pragma unroll
        for (int i = 0; i < 16; ++i) { const float v0 = bf_lo(R.xv[i]), v1 = bf_hi(R.xv[i]); st[2 * i] = v0 + v1; st[2 * i + 1] = v0 * v0 + v1 * v1; }
        const float tot = reduce_scatter32(st, lane);
        unsigned y0[8], y1[8];
#pragma unroll
        for (int i = 0; i < 16; ++i) {
            const float sm = __builtin_bit_cast(float, __builtin_amdgcn_readlane(__builtin_bit_cast(int, tot), 2 * i)), sq = __builtin_bit_cast(float, __builtin_amdgcn_readlane(__builtin_bit_cast(int, tot), 2 * i + 1));
            const float mean = sm * (1.0f / 128.0f), rstd = __builtin_amdgcn_rsqf(sq * (1.0f / 128.0f) - mean * mean + 1e-6f);
            const unsigned a0 = f2bf((bf_lo(R.xv[i]) - mean) * rstd * g2.x + b2.x), a1 = f2bf((bf_hi(R.xv[i]) - mean) * rstd * g2.y + b2.y);
            if (i & 1) { y0[i >> 1] |= a0 << 16; y1[i >> 1] |= a1 << 16; } else { y0[i >> 1] = a0; y1[i >> 1] = a1; }
        }
        LAS bf16* d0 = vnT + (2 * lane) * 136 + 16 * F.wave;
        *(LAS v4u*)d0 = (v4u){y0[0], y0[1], y0[2], y0[3]}; *(LAS v4u*)(d0 + 8) = (v4u){y0[4], y0[5], y0[6], y0[7]};
        *(LAS v4u*)(d0 + 136) = (v4u){y1[0], y1[1], y1[2], y1[3]}; *(LAS v4u*)(d0 + 136 + 8) = (v4u){y1[4], y1[5], y1[6], y1[7]};
    }
    LDS_BAR();
    {
        pg8::f32x4 acc[8];
#pragma unroll
        for (int nt = 0; nt < 8; ++nt) acc[nt] = (pg8::f32x4){0.f, 0.f, 0.f, 0.f};
#pragma unroll
        for (int ks = 0; ks < 4; ++ks) {
#pragma unroll
            for (int nt = 0; nt < 8; ++nt) {
                const pg8::bf16x8 vf = *(const LAS pg8::bf16x8*)(vnT + (16 * nt + fr) * 136 + ks * 32 + 8 * fq);
                acc[nt] = __builtin_amdgcn_mfma_f32_16x16x32_bf16(vf, wf[ks], acc[nt], 0, 0, 0);
            }
        }
        const size_t t = (size_t)(rowbase + q);
#pragma unroll
        for (int nt = 0; nt < 8; ++nt) { const int c0 = h * 128 + 16 * nt + 4 * fq;
            u32x2g o; o.x = pk2(bf_lo(R.uu[nt].x) * (acc[nt][0] + bias), bf_hi(R.uu[nt].x) * (acc[nt][1] + bias)); o.y = pk2(bf_lo(R.uu[nt].y) * (acc[nt][2] + bias), bf_hi(R.uu[nt].y) * (acc[nt][3] + bias));
            *(GAS u32x2g*)(AM + t * 1024 + 512 + c0) = o; }
    }
    LDS_BAR();
}
__device__ __forceinline__ void sgu_phase(Frame& F, const Ptrs& P) {
    const bf16* U = (const bf16*)(P.ws + WS_U1); const bf16* V = (const bf16*)(P.ws + WS_V1); bf16* AM = (bf16*)(P.ws + WS_AM);
    const float* lng = P.in[13]; const float* lnb = P.in[14]; const float* sw = P.in[15]; const float* sb = P.in[16];
    int lane = F.lane; asm volatile("" : "+v"(lane));
    const int it0 = F.vcu, G = F.G;
    if (it0 >= 1024) return;
    const int h = it0 & 3, fr = lane & 15, fq = lane >> 4, q = 16 * F.wave + fr;
    pg8::bf16x8 wf[4];
#pragma unroll
    for (int ks = 0; ks < 4; ++ks) { const GAS pg8::f32x4* wp = (const GAS pg8::f32x4*)(sw + (size_t)(h * 128 + q) * 128 + ks * 32 + 8 * fq); const pg8::f32x4 wa = wp[0], wb = wp[1];
        pg8::u32x4 wq; wq.x = pk2(wa[0], wa[1]); wq.y = pk2(wa[2], wa[3]); wq.z = pk2(wb[0], wb[1]); wq.w = pk2(wb[2], wb[3]); wf[ks] = __builtin_bit_cast(pg8::bf16x8, wq); }
    const float bias = sb[h * 128 + q];
    const f32x2g g2 = *(const GAS f32x2g*)(lng + h * 128 + 2 * lane), b2 = *(const GAS f32x2g*)(lnb + h * 128 + 2 * lane);
    SguIn Ra, Rb;
    sgu_load(U, V, it0, F.wave, lane, Ra);
    for (int it = it0; it < 1024; it += 2 * G) {
        const int it1 = it + G, it2 = it + 2 * G;
        if (it1 < 1024) sgu_load(U, V, it1, F.wave, lane, Rb);
        sgu_compute(F, AM, it, lane, Ra, wf, bias, g2, b2);
        if (it1 >= 1024) break;
        if (it2 < 1024) sgu_load(U, V, it2, F.wave, lane, Ra);
        sgu_compute(F, AM, it1, lane, Rb, wf, bias, g2, b2);
    }
}

struct cpx { float r, i; };
__device__ __forceinline__ cpx cadd(cpx a, cpx b) { return {a.r + b.r, a.i + b.i}; }
__device__ __forceinline__ cpx csub(cpx a, cpx b) { return {a.r - b.r, a.i - b.i}; }
__device__ __forceinline__ cpx cmulc(cpx a, float c, float s) { return {a.r * c + a.i * s, a.i * c - a.r * s}; }
__device__ __forceinline__ cpx cmni(cpx a) { return {a.i, -a.r}; }
__device__ __forceinline__ void dft4(cpx& x0, cpx& x1, cpx& x2, cpx& x3) {
    const cpx s02 = cadd(x0, x2), d02 = csub(x0, x2), s13 = cadd(x1, x3), d13 = cmni(csub(x1, x3));
    x0 = cadd(s02, s13); x1 = cadd(d02, d13); x2 = csub(s02, s13); x3 = csub(d02, d13);
}
__device__ __forceinline__ void fft16(cpx (&x)[16], cpx (&z)[16]) {
    constexpr float C1 = 0.92387953251128674f, S1 = 0.38268343236508977f, R2 = 0.70710678118654752f;
#pragma unroll
    for (int b = 0; b < 4; ++b) dft4(x[b], x[4 + b], x[8 + b], x[12 + b]);
    x[4 + 1] = cmulc(x[4 + 1], C1, S1);  x[8 + 1] = cmulc(x[8 + 1], R2, R2);   x[12 + 1] = cmulc(x[12 + 1], S1, C1);
    x[4 + 2] = cmulc(x[4 + 2], R2, R2);  x[8 + 2] = cmni(x[8 + 2]);            x[12 + 2] = cmulc(x[12 + 2], -R2, R2);
    x[4 + 3] = cmulc(x[4 + 3], S1, C1);  x[8 + 3] = cmulc(x[8 + 3], -R2, R2);  x[12 + 3] = cmulc(x[12 + 3], -C1, -S1);
#pragma unroll
    for (int c = 0; c < 4; ++c) { dft4(x[4 * c], x[4 * c + 1], x[4 * c + 2], x[4 * c + 3]);
        z[c] = x[4 * c]; z[c + 4] = x[4 * c + 1]; z[c + 8] = x[4 * c + 2]; z[c + 12] = x[4 * c + 3]; }
}
__device__ __forceinline__ void fft_stage1(Frame& F, const Ptrs& P) {
    const bf16* PQT = (const bf16*)(P.ws + WS_PQT); bf16* ZP = (bf16*)(P.ws + WS_ZP);
    LAS float* CT = (LAS float*)(F.lds + RING_OFF + 65536);
    { int tl = F.tid; asm volatile("" : "+v"(tl)); for (int i = tl; i < 4096; i += NWAVES * 64) CT[i] = cospif((float)i * (1.0f / 2048.0f)); }
    LDS_BAR();
    int gw = F.vcu * NWAVES + F.wave; asm volatile("" : "+s"(gw)); const int NGW = F.G * NWAVES;
    for (int item = gw; item < NB * 512 * 2; item += NGW) {
        int lane = F.lane; asm volatile("" : "+v"(lane));
        const int row = item >> 1, s20 = 128 * (item & 1) + 2 * lane, b = row >> 9, ch = row & 511;
        const bf16* src = PQT + (size_t)row * 2 * S + s20;
        unsigned xp[16], xq[16];
#pragma unroll
        for (int s1 = 0; s1 < 16; ++s1) { xp[s1] = *(const GAS unsigned*)(src + 256 * s1); xq[s1] = *(const GAS unsigned*)(src + S + 256 * s1); }
        unsigned zr[16], zi[16];
#pragma unroll
        for (int e = 0; e < 2; ++e) {
            cpx x[16], z[16];
#pragma unroll
            for (int s1 = 0; s1 < 16; ++s1) { x[s1].r = e ? bf_hi(xp[s1]) : bf_lo(xp[s1]); x[s1].i = -(e ? bf_hi(xq[s1]) : bf_lo(xq[s1])); }
            fft16(x, z);
            const int s2 = s20 + e;
#pragma unroll
            for (int t1 = 0; t1 < 16; ++t1) {
                const int idx = s2 * t1;
                const cpx w = cmulc(z[t1], CT[idx], CT[(idx - 1024) & (S - 1)]);
                const unsigned hr = f2bf(w.r), hi = f2bf(w.i);
                if (e == 0) { zr[t1] = hr; zi[t1] = hi; } else { zr[t1] |= hr << 16; zi[t1] |= hi << 16; }
            }
        }
#pragma unroll
        for (int t1 = 0; t1 < 16; ++t1) { bf16* dst = ZP + ((size_t)((b * 16 + t1) * 512 + ch)) * 512 + s20;
            *(GAS unsigned*)dst = zr[t1]; *(GAS unsigned*)(dst + 256) = zi[t1]; }
    }
}

struct Args { const float* in[22]; float* out; unsigned char* ws; int ph_lo, ph_hi, li, pad; };
template <int PM> __device__ __forceinline__ void mk_body(const Args& args) {
    extern __shared__ __attribute__((aligned(16))) unsigned char lds[];
    Frame F;
    F.lds = (LAS unsigned char*)lds;
    F.MISC = (volatile LAS unsigned*)(F.lds + MISC_OFF);
    F.tid = threadIdx.x; F.lane = F.tid & 63; F.wave = __builtin_amdgcn_readfirstlane(F.tid >> 6);
    F.G = gridDim.x; { const int bx = blockIdx.x; F.vcu = (F.G % 8 == 0) ? (bx % 8) * (F.G / 8) + bx / 8 : bx; }
    Ptrs P;
#pragma unroll
    for (int i = 0; i < 22; ++i) P.in[i] = args.in[i];
    P.out = args.out; P.ws = args.ws;
    unsigned char* ws = args.ws;
    F.ctl = (gu32*)(ws + WS_CTL);
    for (int u = F.tid; u < (LDS_BYTES - LDSCTL_OFF) / 4; u += NWAVES * 64) ((LAS unsigned*)(F.lds + LDSCTL_OFF))[u] = 0u;
    __syncthreads();
    XcdBarrier bar; bar.bar = (unsigned*)(F.ctl + CW_BAR); bar.x = 0; bar.st = nullptr;
    if (!MK_PER_PHASE) bar = xcd_barrier_post((unsigned*)(F.ctl + CW_BAR), F.MISC + 8);
    const int lo = args.ph_lo, hi = args.ph_hi;
#ifndef PH_MASK
#define PH_MASK 0x1FFF
#endif
#define IN(k) ((((PH_MASK) >> (k)) & 1) && lo <= (k) && (k) < hi)
#ifndef PROBE_BARX
#define PROBE_BARX 1
#endif
#define SEAM(k) do { if (IN(k) && IN((k) + 1)) { for (int bx_ = 0; bx_ < PROBE_BARX; ++bx_) xcd_barrier(bar); } } while (0)
    unsigned long long* ssq = (unsigned long long*)(ws + WS_SSQ);
    bf16* XB = (bf16*)(ws + WS_XB); bf16* AM = (bf16*)(ws + WS_AM); bf16* HB = (bf16*)(ws + WS_H);
    const int bid = (int)blockIdx.x;
    constexpr bool dup = PM != 0;
    bf16* TRX = (bf16*)(ws + WS_END); unsigned long long* TRS = (unsigned long long*)(ws + WS_END + 64 * MiB);

    if (IN(0)) { p0_prologue(F, P); } SEAM(0);
    if (IN(1)) { pg8::Gemm g{XB, (const bf16*)(ws + WS_WIN0), M, 1536, D}; pg8::StaticOrder So; So.init(M, 1536, F.G, bid);
        pg8::EpiInL0 E{(bf16*)(ws + WS_UB), (bf16*)(ws + WS_PB), ssq};
        pg8::gemm_phase<pg8::EpiInL0, pg8::StaticOrder, true, true>(F.lds + RING_OFF, g, So, E); } SEAM(1);
    if (IN(2)) { for (int it = F.vcu; it < 1024; it += F.G) {
#ifndef NO_CONV
            if (it < 512 && PM != 4 && PM != 9) mix0_conv_item<PM>(F, P, it);
#endif
#ifndef NO_POOL
            if (it >= 512 && PM != 3 && PM != 9) mix0_pool_item(F, P, it - 512);
#endif
 } } SEAM(2);
    if (IN(3)) { pg8::Gemm g{AM, (const bf16*)(ws + WS_WOUT0), M, D, D}; pg8::StaticOrder So; So.init(M, D, F.G, bid);
        pg8::EpiResid E{XB, dup ? TRS : ssq + M, dup ? TRX : XB, PM};
        pg8::gemm_phase<pg8::EpiResid, pg8::StaticOrder, true, true>(F.lds + RING_OFF, g, So, E); } SEAM(3);
    if (IN(4)) { pg8::Gemm g{XB, (const bf16*)(ws + WS_WGU0), M, 2 * FF, D}; pg8::StaticOrder So; So.init(M, 2 * FF, F.G, bid);
        pg8::EpiSwiGLU E{HB, ssq + M, PM};
        pg8::gemm_phase<pg8::EpiSwiGLU, pg8::StaticOrder, (PM != 20 && PM != 22), (PM != 21 && PM != 22)>(F.lds + RING_OFF, g, So, E); } SEAM(4);
    if (IN(5)) { pg8::Gemm g{HB, (const bf16*)(ws + WS_WDN0), M, D, FF}; pg8::StaticOrder So; So.init(M, D, F.G, bid);
        pg8::EpiResid E{XB, dup ? TRS : ssq + 2 * M, dup ? TRX : XB, PM};
        pg8::gemm_phase<pg8::EpiResid, pg8::StaticOrder, true, true>(F.lds + RING_OFF, g, So, E); } SEAM(5);
    if (IN(6)) {
        { pg8::Gemm g{(const bf16*)(ws + WS_WPQ1), XB, 1024, M, D}; pg8::StaticOrder So; So.init(1024, M, F.G, bid);
          pg8::EpiPQT E{(bf16*)(ws + WS_PQT), ssq + 2 * M, PM};
          pg8::gemm_phase<pg8::EpiPQT, pg8::StaticOrder, true, true>(F.lds + RING_OFF, g, So, E); }
        { pg8::Gemm g{XB, (const bf16*)(ws + WS_WUV1), M, 1024, D}; pg8::StaticOrder So; So.init(M, 1024, F.G, bid);
          pg8::EpiGeluUV E{(bf16*)(ws + WS_U1), (bf16*)(ws + WS_V1), ssq + 2 * M, PM};
          pg8::gemm_phase<pg8::EpiGeluUV, pg8::StaticOrder, true, true>(F.lds + RING_OFF, g, So, E); }
    } SEAM(6);
    if (IN(7)) {
        if (PM != 12) { fft_stage1(F, P); }
        if (PM != 11) { sgu_phase(F, P); }
    } SEAM(7);
    if (IN(8)) { pg8::Gemm g{(const bf16*)(ws + WS_DFT), (const bf16*)(ws + WS_ZP), 256, NB * 16 * 512, 512}; pg8::StaticOrder So; So.init(256, NB * 16 * 512, F.G, bid);
        pg8::EpiDFT2 E{AM};
        pg8::gemm_phase<pg8::EpiDFT2, pg8::StaticOrder, true, true>(F.lds + RING_OFF, g, So, E); } SEAM(8);
    if (IN(9)) { pg8::Gemm g{AM, (const bf16*)(ws + WS_WOUT1), M, D, D}; pg8::StaticOrder So; So.init(M, D, F.G, bid);
        pg8::EpiResid E{XB, dup ? TRS : ssq + 3 * M, dup ? TRX : XB, PM};
        pg8::gemm_phase<pg8::EpiResid, pg8::StaticOrder, true, true>(F.lds + RING_OFF, g, So, E); } SEAM(9);
    if (IN(10)) { pg8::Gemm g{XB, (const bf16*)(ws + WS_WGU1), M, 2 * FF, D}; pg8::StaticOrder So; So.init(M, 2 * FF, F.G, bid);
        pg8::EpiSwiGLU E{HB, ssq + 3 * M, PM};
        pg8::gemm_phase<pg8::EpiSwiGLU, pg8::StaticOrder, true, true>(F.lds + RING_OFF, g, So, E); } SEAM(10);
    if (IN(11)) { pg8::Gemm g{HB, (const bf16*)(ws + WS_WDN1), M, D, FF}; pg8::StaticOrder So; So.init(M, D, F.G, bid);
        pg8::EpiResid E{XB, dup ? TRS : ssq + 4 * M, dup ? TRX : XB, PM};
        pg8::gemm_phase<pg8::EpiResid, pg8::StaticOrder, true, true>(F.lds + RING_OFF, g, So, E); } SEAM(11);
    if (IN(12)) {
        const float* gf = P.in[21]; const unsigned long long* ssq4 = ssq + 4 * M;
        const int gw = F.vcu * NWAVES + F.wave, NGW = F.G * NWAVES;
        for (int m0 = 4 * gw; m0 < M; m0 += 4 * NGW) {
            u32x2g xx[4][4]; unsigned long long q[4];
#pragma unroll
            for (int r = 0; r < 4; ++r) { const GAS u32x2g* xr = (const GAS u32x2g*)(XB + (size_t)(m0 + r) * D) + F.lane; q[r] = ssq4[m0 + r];
#pragma unroll
                for (int j = 0; j < 4; ++j) xx[r][j] = xr[64 * j]; }
            const GAS f32x4* gr = (const GAS f32x4*)gf + F.lane;
            f32x4 gg[4];
#pragma unroll
            for (int j = 0; j < 4; ++j) gg[j] = gr[64 * j];
#pragma unroll
            for (int r = 0; r < 4; ++r) { const float rs = pg8::rstd_of(q[r]); GAS f32x4* orow = (GAS f32x4*)(P.out + (size_t)(m0 + r) * D) + F.lane;
#pragma unroll
                for (int j = 0; j < 4; ++j) { f32x4 v; v.x = bf_lo(xx[r][j].x); v.y = bf_hi(xx[r][j].x); v.z = bf_lo(xx[r][j].y); v.w = bf_hi(xx[r][j].y); orow[64 * j] = v * rs * gg[j]; } }
        }
    }
#undef IN
#undef SEAM
}
__global__ void __launch_bounds__(NWAVES * 64, 2) mk_fwd(Args args) { mk_body<0>(args); }
#ifdef PROBE_PHASE
#ifndef PROBE_MODE
#define PROBE_MODE 1
#endif
__global__ void __launch_bounds__(NWAVES * 64, 2) mk_probe(Args args) { mk_body<PROBE_MODE>(args); }
#endif

extern "C" void kernel_launch(void* const* d_in, const int* in_sizes, int n_in, void* d_out, int out_size, void* d_ws, size_t ws_size, hipStream_t stream) {
    static int grid = 0;
    if (grid == 0) {
        if (n_in != 22 || in_sizes[0] != M * D || out_size != M * D || ws_size < WS_END) { fprintf(stderr, "kernel_launch: unexpected shapes (n_in %d, in0 %d, out %d, ws %zu); nothing launched\n", n_in, n_in > 0 ? in_sizes[0] : -1, out_size, ws_size); grid = -1; return; }
        int dev = 0, cus = 0, per_cu = 0;
        if (hipGetDevice(&dev) != hipSuccess || hipDeviceGetAttribute(&cus, hipDeviceAttributeMultiprocessorCount, dev) != hipSuccess) { grid = -1; return; }
#ifdef PROBE_PHASE
        (void)hipFuncSetAttribute((const void*)mk_probe, hipFuncAttributeMaxDynamicSharedMemorySize, LDS_BYTES);
#endif
        if (hipFuncSetAttribute((const void*)mk_fwd, hipFuncAttributeMaxDynamicSharedMemorySize, LDS_BYTES) != hipSuccess) { fprintf(stderr, "kernel_launch: hipFuncSetAttribute failed\n"); grid = -1; return; }
        if (hipOccupancyMaxActiveBlocksPerMultiprocessor(&per_cu, (const void*)mk_fwd, NWAVES * 64, LDS_BYTES) != hipSuccess || per_cu < 1) { fprintf(stderr, "kernel_launch: occupancy query says %d blocks per CU\n", per_cu); per_cu = 1; }
        (void)hipGetLastError();
        grid = cus * 1;
    }
    if (grid < 0) return;
    if (hipMemsetAsync((char*)d_ws + WS_CTL, 0, CTL_ZERO_BYTES, stream) != hipSuccess) { fprintf(stderr, "kernel_launch: hipMemsetAsync failed\n"); return; }
    Args a{};
    for (int i = 0; i < 22; ++i) a.in[i] = (const float*)d_in[i];
    a.out = (float*)d_out; a.ws = (unsigned char*)d_ws;
#if MK_PER_PHASE
    for (int ph = 0; ph < N_PHASES; ++ph) { a.ph_lo = ph; a.ph_hi = ph + 1; a.li = ph;
        hipLaunchKernelGGL(mk_fwd, dim3(grid), dim3(NWAVES * 64), LDS_BYTES, stream, a); }
#else
    a.ph_lo = 0; a.ph_hi = N_PHASES; a.li = 0;
#ifdef PROBE_PHASE
#ifndef PROBE_MODE
#define PROBE_MODE 1
#endif
    { void* kargs0[] = {&a};
      hipError_t e0 = hipLaunchCooperativeKernel((const void*)mk_fwd, dim3(grid), dim3(NWAVES * 64), kargs0, LDS_BYTES, stream);
      if (e0 != hipSuccess) fprintf(stderr, "kernel_launch: cooperative launch failed: %s (grid %d)\n", hipGetErrorString(e0), grid);
      Args a2 = a; a2.ph_lo = PROBE_PHASE; a2.ph_hi = PROBE_PHASE + 1; a2.pad = PROBE_MODE;
      hipLaunchKernelGGL(mk_probe, dim3(grid), dim3(NWAVES * 64), LDS_BYTES, stream, a2); }
#elif defined(MK_PLAIN_LAUNCH)
    hipLaunchKernelGGL(mk_fwd, dim3(grid), dim3(NWAVES * 64), LDS_BYTES, stream, a);
#else
    void* kargs[] = {&a};
    hipError_t e = hipLaunchCooperativeKernel((const void*)mk_fwd, dim3(grid), dim3(NWAVES * 64), kargs, LDS_BYTES, stream);
    if (e != hipSuccess) fprintf(stderr, "kernel_launch: cooperative launch failed: %s (grid %d)\n", hipGetErrorString(e), grid);
#endif
#endif
}
```

```cpp
#include <hip/hip_runtime.h>
#include <cstdio>
#include <cstdint>
namespace pg8 {
#define PG8_LAS __attribute__((address_space(3)))
typedef unsigned short bf16_t;
typedef short bf16x8 __attribute__((ext_vector_type(8)));
typedef float f32x4 __attribute__((ext_vector_type(4)));
typedef unsigned u32x4 __attribute__((ext_vector_type(4)));
constexpr int BM = 256, BK = 64, HALF = 128, HTB = HALF * BK * 2  , STAGE_BYTES = 8 * HTB, NXCD = 8, WGM = 8;

__host__ __device__ __forceinline__ int lds_byte(int r, int c) { const int st = (r >> 4) * 2 + (c >> 5), rr = r & 15, cc = c & 31, ob = rr * 64 + cc * 2; return st * 1024 + (ob ^ (((ob >> 9) & 1) << 5)); }
__host__ __device__ __forceinline__ void stage_rc(int b, int& R, int& C) { const int st = b / 1024, sb = b % 1024, swz = sb ^ (((sb >> 9) & 1) << 5); R = (st >> 1) * 16 + swz / 64; C = (st & 1) * 32 + (swz % 64) / 2; }
__host__ __device__ __forceinline__ int perm32(int rho) { const int n = rho >> 4, i = rho & 15; return 8 * (i >> 2) + 4 * n + (i & 3); }

struct Unit { int pm, pn; };
struct Gemm { const bf16_t* A; const bf16_t* Bt; int M, N, K; };

struct StaticOrder {
    int nM, nN, nwg, G, c;
    __host__ __device__ void init(int M, int N, int G_, int c_) { nM = M / BM; nN = N / BM; nwg = nM * nN; G = G_; c = c_; }
    __host__ __device__ bool next(int i, Unit& u) const {
        const long L = (long)i * G + c; if (L >= nwg) return false;
        int wgid = (int)L; { const int q = nwg / NXCD, r = nwg % NXCD, xcd = wgid % NXCD, off = wgid / NXCD; wgid = (xcd < r ? xcd * (q + 1) : r * (q + 1) + (xcd - r) * q) + off; }
        const int nig = WGM * nN, gid = wgid / nig, fm = gid * WGM, gsz = (nM - fm) < WGM ? (nM - fm) : WGM;
        u.pm = fm + ((wgid % nig) % gsz); u.pn = (wgid % nig) / gsz; return true;
    }
    __device__ __forceinline__ void a_ready(const Unit&) const {}
    __device__ __forceinline__ void done(const Unit&) const {}
};
struct RoundOrder : StaticOrder {
    int round;
    __host__ __device__ bool next(int i, Unit& u) const { return i == 0 && StaticOrder::next(round, u); }
};
template <int WG_M> struct StaticOrderT {
    int nM, nN, nwg, G, c;
    __host__ __device__ void init(int M, int N, int G_, int c_) { nM = M / BM; nN = N / BM; nwg = nM * nN; G = G_; c = c_; }
    __host__ __device__ bool next(int i, Unit& u) const {
        const long L = (long)i * G + c; if (L >= nwg) return false;
        int wgid = (int)L; { const int q = nwg / NXCD, r = nwg % NXCD, xcd = wgid % NXCD, off = wgid / NXCD; wgid = (xcd < r ? xcd * (q + 1) : r * (q + 1) + (xcd - r) * q) + off; }
        const int nig = WG_M * nN, gid = wgid / nig, fm = gid * WG_M, gsz = (nM - fm) < WG_M ? (nM - fm) : WG_M;
        u.pm = fm + ((wgid % nig) % gsz); u.pn = (wgid % nig) / gsz; return true;
    }
    __device__ __forceinline__ void a_ready(const Unit&) const {}
    __device__ __forceinline__ void done(const Unit&) const {}
};

__device__ __forceinline__ unsigned cvt_pk_bf16(float lo, float hi) { unsigned r; asm volatile("v_cvt_pk_bf16_f32 %0, %1, %2" : "=v"(r) : "v"(lo), "v"(hi)); return r; }
typedef float f32x2 __attribute__((ext_vector_type(2)));
__device__ __forceinline__ f32x2 gelu_pk(f32x2 v) {
    const f32x2 av = __builtin_elementwise_abs(v), d = av * 0.2316418882f + 1.0f;
    f32x2 t; t.x = __builtin_amdgcn_rcpf(d.x); t.y = __builtin_amdgcn_rcpf(d.y);
    f32x2 q = t * 0.5307027145f + (-0.7265760135f); q = q * t + 0.7107068705f; q = q * t + (-0.142248368f); q = q * t + 0.127414796f; q = q * t;
    const f32x2 s = (v * v) * (-0.72134752044f);
    f32x2 e; e.x = __builtin_amdgcn_exp2f(s.x); e.y = __builtin_amdgcn_exp2f(s.y);
    const f32x2 m = v * (q * e), r = v - m;
    f32x2 o; o.x = v.x < 0.f ? m.x : r.x; o.y = v.y < 0.f ? m.y : r.y; return o;
}


constexpr float RMS_EPS = 1e-6f;
__device__ __forceinline__ float sigm(float x) { return __builtin_amdgcn_rcpf(1.0f + __expf(-x)); }
__device__ __forceinline__ u32x4 pack8(const f32x4 v0, const f32x4 v1) { u32x4 w; w.x = cvt_pk_bf16(v0[0], v0[1]); w.y = cvt_pk_bf16(v0[2], v0[3]); w.z = cvt_pk_bf16(v1[0], v1[1]); w.w = cvt_pk_bf16(v1[2], v1[3]); return w; }
__device__ __forceinline__ void store16_wt(void* p, u32x4 v) { asm volatile("global_store_dwordx4 %0, %1, off sc1\n\ts_nop 1" :: "v"(p), "v"(v) : "memory"); }
__device__ __forceinline__ void keep_alive(const f32x4 (&acc)[2][2][4][2]) {
#pragma unroll
    for (int a = 0; a < 2; ++a)
#pragma unroll
        for (int b = 0; b < 2; ++b)
#pragma unroll
            for (int m = 0; m < 4; ++m)
#pragma unroll
                for (int n = 0; n < 2; ++n) asm volatile("" :: "v"(acc[a][b][m][n]));
}
typedef unsigned long long u64_t;
__device__ __forceinline__ float ssq_f(u64_t v) { return fmaf((float)(unsigned)(v >> 32), 4294967296.0f, (float)(unsigned)v); }
__device__ __forceinline__ float rstd_of(u64_t ssq) { return __builtin_amdgcn_rsqf(fmaf(ssq_f(ssq), 1.0f / (1024.0f * 1048576.0f), RMS_EPS)); }
__device__ __forceinline__ u64_t ssq_fix(float s) { return (u64_t)(s * 1048576.0f); }

struct EpiInL0 {
    static constexpr bool PERM = true, AFTER_DRAIN = false;
    bf16_t* UB; bf16_t* PB; const u64_t* ssq;
    __device__ __forceinline__ void operator()(const f32x4 (&acc)[2][2][4][2], const Unit& u, int wr, int wc, int fr, int fq) const {
        const int row0 = u.pm * BM + wr * 64 + fr, cw = wc * 32 + 8 * fq;
        u64_t q[2][4];
#pragma unroll
        for (int ai = 0; ai < 2; ++ai)
#pragma unroll
            for (int m = 0; m < 4; ++m) q[ai][m] = ssq[row0 + ai * HALF + m * 16];
#pragma unroll
        for (int ai = 0; ai < 2; ++ai)
#pragma unroll
            for (int m = 0; m < 4; ++m) {
                const int row = row0 + ai * HALF + m * 16;
                const float rs = rstd_of(q[ai][m]), c1 = rs * -1.4426950408889634f;
                if (u.pn < 4) {
                    f32x4 o[2];
#pragma unroll
                    for (int n = 0; n < 2; ++n)
#pragma unroll
                        for (int j = 0; j < 4; j += 2) {
                            const f32x2 a = {acc[ai][0][m][n][j], acc[ai][0][m][n][j + 1]}, g = {acc[ai][1][m][n][j], acc[ai][1][m][n][j + 1]};
                            const f32x2 t = g * c1; f32x2 e; e.x = __builtin_amdgcn_exp2f(t.x); e.y = __builtin_amdgcn_exp2f(t.y);
                            const f32x2 d = e + 1.0f; f32x2 r; r.x = __builtin_amdgcn_rcpf(d.x); r.y = __builtin_amdgcn_rcpf(d.y);
                            const f32x2 h = a * (r * rs); o[n][j] = h.x; o[n][j + 1] = h.y; }
                    store16_wt(UB + (size_t)row * 512 + u.pn * 128 + cw, pack8(o[0], o[1]));
                } else {
#pragma unroll
                    for (int bj = 0; bj < 2; ++bj) store16_wt(PB + (size_t)row * 512 + (u.pn - 4) * 256 + bj * HALF + cw, pack8(acc[ai][bj][m][0] * rs, acc[ai][bj][m][1] * rs));
                }
            }
    }
};
struct EpiResid {
    static constexpr bool PERM = true, AFTER_DRAIN = false;
    bf16_t* XB; u64_t* ssq; bf16_t* XBw; int probe_mode; bool wt;
    __device__ __forceinline__ void operator()(const f32x4 (&acc)[2][2][4][2], const Unit& u, int wr, int wc, int fr, int fq) const {
        const int row0 = u.pm * BM + wr * 64 + fr, cw = u.pn * BM + wc * 32 + 8 * fq;
        if (probe_mode == 2) { keep_alive(acc); return; }
        u32x4 r[2][4][2];
#pragma unroll
        for (int ai = 0; ai < 2; ++ai)
#pragma unroll
            for (int m = 0; m < 4; ++m)
#pragma unroll
                for (int bj = 0; bj < 2; ++bj) r[ai][m][bj] = *(const u32x4*)(XB + (size_t)(row0 + ai * HALF + m * 16) * 1024 + bj * HALF + cw);
#pragma unroll
        for (int ai = 0; ai < 2; ++ai)
#pragma unroll
            for (int m = 0; m < 4; ++m) {
                const int row = row0 + ai * HALF + m * 16;
                f32x2 s2 = {0.f, 0.f};
#pragma unroll
                for (int bj = 0; bj < 2; ++bj) {
                    const u32x4 rr = r[ai][m][bj];
                    const f32x2 a0 = {acc[ai][bj][m][0][0], acc[ai][bj][m][0][1]}, a1 = {acc[ai][bj][m][0][2], acc[ai][bj][m][0][3]}, a2 = {acc[ai][bj][m][1][0], acc[ai][bj][m][1][1]}, a3 = {acc[ai][bj][m][1][2], acc[ai][bj][m][1][3]};
                    const f32x2 v0 = a0 + (f32x2){__builtin_bit_cast(float, rr.x << 16), __builtin_bit_cast(float, rr.x & 0xffff0000u)};
                    const f32x2 v1 = a1 + (f32x2){__builtin_bit_cast(float, rr.y << 16), __builtin_bit_cast(float, rr.y & 0xffff0000u)};
                    const f32x2 v2 = a2 + (f32x2){__builtin_bit_cast(float, rr.z << 16), __builtin_bit_cast(float, rr.z & 0xffff0000u)};
                    const f32x2 v3 = a3 + (f32x2){__builtin_bit_cast(float, rr.w << 16), __builtin_bit_cast(float, rr.w & 0xffff0000u)};
                    u32x4 w; w.x = cvt_pk_bf16(v0.x, v0.y); w.y = cvt_pk_bf16(v1.x, v1.y); w.z = cvt_pk_bf16(v2.x, v2.y); w.w = cvt_pk_bf16(v3.x, v3.y);
                    if (wt) store16_wt(XBw + ((size_t)row * 1024 + bj * HALF + cw), w); else *(u32x4*)(XBw + ((size_t)row * 1024 + bj * HALF + cw)) = w;
                    s2 = v0 * v0 + s2; s2 = v1 * v1 + s2; s2 = v2 * v2 + s2; s2 = v3 * v3 + s2;
                }
                float s = s2.x + s2.y;
                s += __shfl_xor(s, 16); s += __shfl_xor(s, 32);
                if (fq == 0) atomicAdd(ssq + row, ssq_fix(s));
            }
    }
};
struct EpiSwiGLU {
    static constexpr bool PERM = true, AFTER_DRAIN = false;
    bf16_t* H; const u64_t* ssq; int probe_mode;
    __device__ __forceinline__ void operator()(const f32x4 (&acc)[2][2][4][2], const Unit& u, int wr, int wc, int fr, int fq) const {
        const int row0 = u.pm * BM + wr * 64 + fr, cw = wc * 32 + 8 * fq;
        if (probe_mode == 2) { keep_alive(acc); return; }
        u64_t q[2][4];
#pragma unroll
        for (int ai = 0; ai < 2; ++ai)
#pragma unroll
            for (int m = 0; m < 4; ++m) q[ai][m] = ssq[row0 + ai * HALF + m * 16];
#pragma unroll
        for (int ai = 0; ai < 2; ++ai)
#pragma unroll
            for (int m = 0; m < 4; ++m) {
                const int row = row0 + ai * HALF + m * 16;
                const float rs = rstd_of(q[ai][m]), c1 = rs * -1.4426950408889634f, rs2 = rs * rs;
                f32x4 o[2];
#pragma unroll
                for (int n = 0; n < 2; ++n)
#pragma unroll
                    for (int j = 0; j < 4; j += 2) {
                        const f32x2 g = {acc[ai][0][m][n][j], acc[ai][0][m][n][j + 1]}, up = {acc[ai][1][m][n][j], acc[ai][1][m][n][j + 1]};
                        const f32x2 t = g * c1; f32x2 e; e.x = __builtin_amdgcn_exp2f(t.x); e.y = __builtin_amdgcn_exp2f(t.y);
                        const f32x2 d = e + 1.0f; f32x2 r; r.x = __builtin_amdgcn_rcpf(d.x); r.y = __builtin_amdgcn_rcpf(d.y);
                        const f32x2 h = (g * up) * (r * rs2); o[n][j] = h.x; o[n][j + 1] = h.y; }
                { const u32x4 hw = pack8(o[0], o[1]); if (probe_mode == 30) asm volatile("" :: "v"(hw)); else store16_wt(H + (size_t)row * 2816 + u.pn * 128 + cw, hw); }
            }
    }
};
struct EpiPQT {
    static constexpr bool PERM = true, AFTER_DRAIN = false;
    bf16_t* PQT; const u64_t* ssq; int probe_mode;
    __device__ __forceinline__ void operator()(const f32x4 (&acc)[2][2][4][2], const Unit& u, int wr, int wc, int fr, int fq) const {
        if (probe_mode == 2) { keep_alive(acc); return; }
        const int tok0 = u.pn * BM + wc * 32 + 8 * fq, b = (u.pn * BM) >> 12;
#pragma unroll
        for (int bj = 0; bj < 2; ++bj) {
            u64_t q[8];
#pragma unroll
            for (int j = 0; j < 8; ++j) q[j] = ssq[tok0 + bj * HALF + j];
            f32x4 rs0, rs1;
#pragma unroll
            for (int j = 0; j < 4; ++j) { rs0[j] = rstd_of(q[j]); rs1[j] = rstd_of(q[4 + j]); }
#pragma unroll
            for (int ai = 0; ai < 2; ++ai)
#pragma unroll
                for (int m = 0; m < 4; ++m) {
                    const int r = u.pm * BM + ai * HALF + wr * 64 + m * 16 + fr, pq = r >> 9, ch = r & 511;
                    bf16_t* base = PQT + ((size_t)(b * 512 + ch) * 2 + pq) * 4096;
                    store16_wt(base + ((tok0 + bj * HALF) & 4095), pack8(acc[ai][bj][m][0] * rs0, acc[ai][bj][m][1] * rs1));
                }
        }
    }
};
struct EpiGeluUV {
    static constexpr bool PERM = true, AFTER_DRAIN = false;
    bf16_t* U; bf16_t* V; const u64_t* ssq; int probe_mode;
    __device__ __forceinline__ void operator()(const f32x4 (&acc)[2][2][4][2], const Unit& u, int wr, int wc, int fr, int fq) const {
        if (probe_mode == 2) { keep_alive(acc); return; }
        const int row0 = u.pm * BM + wr * 64 + fr, cw = wc * 32 + 8 * fq;
        bf16_t* dst = (u.pn < 2) ? U : V; const int colb = (u.pn & 1) * BM;
        u64_t q[2][4];
#pragma unroll
        for (int ai = 0; ai < 2; ++ai)
#pragma unroll
            for (int m = 0; m < 4; ++m) q[ai][m] = ssq[row0 + ai * HALF + m * 16];
#pragma unroll
        for (int ai = 0; ai < 2; ++ai)
#pragma unroll
            for (int m = 0; m < 4; ++m) {
                const int row = row0 + ai * HALF + m * 16;
                const float rs = rstd_of(q[ai][m]);
#pragma unroll
                for (int bj = 0; bj < 2; ++bj) {
                    const f32x4 v0 = acc[ai][bj][m][0] * rs, v1 = acc[ai][bj][m][1] * rs;
                    const f32x2 a = gelu_pk((f32x2){v0[0], v0[1]}), bq = gelu_pk((f32x2){v0[2], v0[3]}), c = gelu_pk((f32x2){v1[0], v1[1]}), d = gelu_pk((f32x2){v1[2], v1[3]});
                    store16_wt(dst + (size_t)row * 512 + colb + bj * HALF + cw, pack8((f32x4){a.x, a.y, bq.x, bq.y}, (f32x4){c.x, c.y, d.x, d.y}));
                }
            }
    }
};
struct EpiDFT2 {
    static constexpr bool PERM = true, AFTER_DRAIN = false;
    bf16_t* AM;
    __device__ __forceinline__ void operator()(const f32x4 (&acc)[2][2][4][2], const Unit& u, int wr, int wc, int fr, int fq) const {
#pragma unroll
        for (int bj = 0; bj < 2; ++bj) {
            const int n = u.pn * BM + bj * HALF + wc * 32 + 8 * fq, b = n >> 13, t1 = (n >> 9) & 15, ch = n & 511;
            bf16_t* base = AM + (size_t)(b * 4096 + t1) * 1024 + ch;
#pragma unroll
            for (int ai = 0; ai < 2; ++ai)
#pragma unroll
                for (int m = 0; m < 4; ++m) { const int t2 = ai * HALF + wr * 64 + m * 16 + fr;
                    store16_wt(base + (size_t)(16 * t2) * 1024, pack8(acc[ai][bj][m][0], acc[ai][bj][m][1])); }
        }
    }
};


struct EpiSGU {
    static constexpr bool PERM = true, AFTER_DRAIN = true;
    bf16_t* AM; const u64_t* ssq; const float* lng; const float* lnb; const bf16_t* WSB; const float* sb;
    __device__ __forceinline__ void fused(f32x4 (&acc)[2][2][4][2], const Unit& u, int wr, int wc, int fr, int fq, PG8_LAS unsigned char* lds, int wid, int lane) const {
        const int h = u.pn, row0 = u.pm * BM + wr * 64 + fr, cw = wc * 32 + 8 * fq;
        PG8_LAS f32x2* Pt = (PG8_LAS f32x2*)lds;
        PG8_LAS bf16_t* vnT = (PG8_LAS bf16_t*)(lds + 8192);
        u64_t q[2][4];
#pragma unroll
        for (int ai = 0; ai < 2; ++ai)
#pragma unroll
            for (int m = 0; m < 4; ++m) q[ai][m] = ssq[row0 + ai * HALF + m * 16];
#pragma unroll
        for (int ai = 0; ai < 2; ++ai)
#pragma unroll
            for (int m = 0; m < 4; ++m) {
                const float rs = rstd_of(q[ai][m]);
                float s = 0.f, s2 = 0.f;
#pragma unroll
                for (int bj = 0; bj < 2; ++bj)
#pragma unroll
                    for (int n = 0; n < 2; ++n) {
                        const f32x4 v = acc[ai][bj][m][n] * rs;
                        const f32x2 a = gelu_pk((f32x2){v[0], v[1]}), b = gelu_pk((f32x2){v[2], v[3]});
                        acc[ai][bj][m][n] = (f32x4){a.x, a.y, b.x, b.y};
                        if (bj == 1) { s += (a.x + a.y) + (b.x + b.y); s2 += (a.x * a.x + a.y * a.y) + (b.x * b.x + b.y * b.y); }
                    }
                s += __shfl_xor(s, 16); s += __shfl_xor(s, 32); s2 += __shfl_xor(s2, 16); s2 += __shfl_xor(s2, 32);
                if (fq == 0) Pt[(ai * HALF + wr * 64 + m * 16 + fr) * 4 + wc] = (f32x2){s, s2};
            }
        asm volatile("s_waitcnt lgkmcnt(0)" ::: "memory"); __builtin_amdgcn_s_barrier(); asm volatile("" ::: "memory");
        f32x4 g0 = *(const f32x4*)(lng + h * 128 + cw), g1 = *(const f32x4*)(lng + h * 128 + cw + 4), b0 = *(const f32x4*)(lnb + h * 128 + cw), b1 = *(const f32x4*)(lnb + h * 128 + cw + 4);
#pragma unroll
        for (int ai = 0; ai < 2; ++ai)
#pragma unroll
            for (int m = 0; m < 4; ++m) {
                const int k = wr * 64 + m * 16 + fr;
                const PG8_LAS f32x2* pp = Pt + (ai * HALF + k) * 4;
                const f32x2 p0 = pp[0], p1 = pp[1], p2 = pp[2], p3 = pp[3];
                const float sm = (p0.x + p1.x) + (p2.x + p3.x), sq = (p0.y + p1.y) + (p2.y + p3.y);
                const float mean = sm * (1.0f / 128.0f), rstd = __builtin_amdgcn_rsqf(fmaxf(sq * (1.0f / 128.0f) - mean * mean, 0.f) + 1e-6f);
                PG8_LAS bf16_t* dst = vnT + (size_t)ai * (128 * 136) + (size_t)cw * 136 + k;
                const f32x4 v0 = (acc[ai][1][m][0] - mean) * rstd * g0 + b0, v1 = (acc[ai][1][m][1] - mean) * rstd * g1 + b1;
                const unsigned w0 = cvt_pk_bf16(v0[0], v0[1]), w1 = cvt_pk_bf16(v0[2], v0[3]), w2 = cvt_pk_bf16(v1[0], v1[1]), w3 = cvt_pk_bf16(v1[2], v1[3]);
                dst[0 * 136] = (bf16_t)w0; dst[1 * 136] = (bf16_t)(w0 >> 16); dst[2 * 136] = (bf16_t)w1; dst[3 * 136] = (bf16_t)(w1 >> 16);
                dst[4 * 136] = (bf16_t)w2; dst[5 * 136] = (bf16_t)(w2 >> 16); dst[6 * 136] = (bf16_t)w3; dst[7 * 136] = (bf16_t)(w3 >> 16);
            }
        asm volatile("s_waitcnt lgkmcnt(0)" ::: "memory"); __builtin_amdgcn_s_barrier(); asm volatile("" ::: "memory");
        f32x4 sv[2][4][2];
#pragma unroll
        for (int ai = 0; ai < 2; ++ai)
#pragma unroll
            for (int m = 0; m < 4; ++m)
#pragma unroll
                for (int n = 0; n < 2; ++n) sv[ai][m][n] = (f32x4){0.f, 0.f, 0.f, 0.f};
        const int crow = wc * 32 + 8 * (fr >> 2) + (fr & 3);
#pragma unroll
        for (int ks = 0; ks < 4; ++ks) {
            bf16x8 xf[2][2];
#pragma unroll
            for (int ai = 0; ai < 2; ++ai)
#pragma unroll
                for (int n = 0; n < 2; ++n) xf[ai][n] = *(const PG8_LAS bf16x8*)(vnT + (size_t)ai * (128 * 136) + (size_t)(crow + 4 * n) * 136 + ks * 32 + 8 * fq);
#pragma unroll
            for (int m = 0; m < 4; ++m) {
                const bf16x8 yf = *(const bf16x8*)(WSB + (size_t)(h * 128 + wr * 64 + m * 16 + fr) * 128 + ks * 32 + 8 * fq);
#pragma unroll
                for (int ai = 0; ai < 2; ++ai)
#pragma unroll
                    for (int n = 0; n < 2; ++n) sv[ai][m][n] = __builtin_amdgcn_mfma_f32_16x16x32_bf16(xf[ai][n], yf, sv[ai][m][n], 0, 0, 0);
            }
        }
#pragma unroll
        for (int m = 0; m < 4; ++m) {
            const float bias = sb[h * 128 + wr * 64 + m * 16 + fr];
#pragma unroll
            for (int ai = 0; ai < 2; ++ai) {
                const f32x4 o0 = acc[ai][0][m][0] * (sv[ai][m][0] + bias), o1 = acc[ai][0][m][1] * (sv[ai][m][1] + bias);
                store16_wt(AM + (size_t)(row0 + ai * HALF + m * 16) * 1024 + 512 + h * 128 + cw, pack8(o0, o1));
            }
        }
        asm volatile("s_waitcnt lgkmcnt(0)" ::: "memory"); __builtin_amdgcn_s_barrier(); asm volatile("" ::: "memory");
    }
};
template <class Epi, class Sched, bool ALIGN_EPI = false, bool SP2 = false>
__device__ __forceinline__ void gemm_phase(PG8_LAS unsigned char* lds, const Gemm g, const Sched& S, const Epi& E) {
    const int tid = threadIdx.x, wid = __builtin_amdgcn_readfirstlane(tid >> 6), lane = tid & 63, wr = wid >> 2, wc = wid & 3, fr = lane & 15, fq = lane >> 4;
    const int K = g.K, nt = K / BK;
    unsigned voffA[2], voffB[2];
#pragma unroll
    for (int i = 0; i < 2; ++i) { int R, C; stage_rc(tid * 16 + i * 8192, R, C); const int Rb = Epi::PERM ? ((R & ~31) + perm32(R & 31)) : R;
        voffA[i] = (unsigned)(R * K + C) * 2u; voffB[i] = (unsigned)(Rb * K + C) * 2u; }
    const size_t kstep = (size_t)(BK * 2);
    const size_t hstep = (size_t)HALF * K * 2;
    const size_t tstep = 2 * hstep;
    const unsigned ldsw = (unsigned)wid * 1024u;
    const int aoff = lds_byte(wr * 64 + fr, fq * 8), boff = lds_byte(wc * 32 + fr, fq * 8);
#define PG8_SA(b, h) (((b) * 2 + (h)) * HTB)
#define PG8_SB(b, h) ((4 + (b) * 2 + (h)) * HTB)
#define PG8_STAGE(bufoff, gbase, voff) do { _Pragma("unroll") for (int _i = 0; _i < 2; ++_i) \
        __builtin_amdgcn_global_load_lds((const unsigned*)((const char*)(gbase) + (voff)[_i]), (PG8_LAS unsigned*)(lds + (bufoff) + ldsw + _i * 8192), 16, 0, 0); } while (0)
#define PG8_LDA(dst, b, h) do { _Pragma("unroll") for (int m = 0; m < 4; ++m) _Pragma("unroll") for (int k = 0; k < 2; ++k) dst[m][k] = *(const PG8_LAS bf16x8*)(lds + PG8_SA(b, h) + aoff + m * 2048 + k * 1024); } while (0)
#define PG8_LDB(dst, b, h) do { _Pragma("unroll") for (int n = 0; n < 2; ++n) _Pragma("unroll") for (int k = 0; k < 2; ++k) dst[n][k] = *(const PG8_LAS bf16x8*)(lds + PG8_SB(b, h) + boff + n * 2048 + k * 1024); } while (0)
#define PG8_MMA(ai, bj, At, Bt) do { __builtin_amdgcn_s_setprio(1); _Pragma("unroll") for (int m = 0; m < 4; ++m) _Pragma("unroll") for (int n = 0; n < 2; ++n) _Pragma("unroll") for (int k = 0; k < 2; ++k) \
        acc[ai][bj][m][n] = __builtin_amdgcn_mfma_f32_16x16x32_bf16(Bt[n][k], At[m][k], acc[ai][bj][m][n], 0, 0, 0); __builtin_amdgcn_s_setprio(0); } while (0)
#define PG8_WAIT_V(n) asm volatile("s_waitcnt vmcnt(" #n ")" ::: "memory")
#define PG8_WAIT_L(n) asm volatile("s_waitcnt lgkmcnt(" #n ")" ::: "memory")
#define PG8_BAR __builtin_amdgcn_s_barrier()
#define PG8_SCHED __builtin_amdgcn_sched_barrier(0)
    Unit cur, nxt; int ui = 0;
    if (!S.next(0, cur)) return;
    f32x4 acc[2][2][4][2];
#pragma unroll
    for (int a = 0; a < 2; ++a)
#pragma unroll
        for (int b = 0; b < 2; ++b)
#pragma unroll
            for (int m = 0; m < 4; ++m)
#pragma unroll
                for (int n = 0; n < 2; ++n) acc[a][b][m][n] = (f32x4){0.f, 0.f, 0.f, 0.f};
    bf16x8 At[4][2], B0[2][2], B1[2][2];
    const char* cA = (const char*)g.A + (size_t)cur.pm * tstep; const char* cB = (const char*)g.Bt + (size_t)cur.pn * tstep;
    S.a_ready(cur);
    if constexpr (SP2) {
        PG8_STAGE(PG8_SB(0, 0), cB, voffB); PG8_STAGE(PG8_SB(0, 1), cB + hstep, voffB); PG8_STAGE(PG8_SA(0, 0), cA, voffA); PG8_STAGE(PG8_SA(0, 1), cA + hstep, voffA);
        if (wr == 1) PG8_BAR;
        PG8_WAIT_V(2); PG8_BAR;
        PG8_STAGE(PG8_SB(1, 0), cB + kstep, voffB); PG8_STAGE(PG8_SA(1, 0), cA + kstep, voffA); PG8_STAGE(PG8_SB(1, 1), cB + hstep + kstep, voffB);
        PG8_WAIT_V(6); PG8_BAR;
    } else {
        PG8_STAGE(PG8_SB(0, 0), cB, voffB); PG8_STAGE(PG8_SA(0, 0), cA, voffA); PG8_STAGE(PG8_SB(0, 1), cB + hstep, voffB); PG8_STAGE(PG8_SA(0, 1), cA + hstep, voffA);
        if (wr == 1) PG8_BAR;
        PG8_WAIT_V(4); PG8_BAR;
        PG8_STAGE(PG8_SB(1, 0), cB + kstep, voffB); PG8_STAGE(PG8_SA(1, 0), cA + kstep, voffA); PG8_STAGE(PG8_SB(1, 1), cB + hstep + kstep, voffB);
        PG8_WAIT_V(6); PG8_BAR;
    }
    for (;;) {
        const bool has_next = S.next(ui + 1, nxt);
        const char* nA = has_next ? (const char*)g.A + (size_t)nxt.pm * tstep : cA; const char* nB = has_next ? (const char*)g.Bt + (size_t)nxt.pn * tstep : cB;
        for (int t = 0; t < nt; t += 2) {
            const bool last = (t == nt - 2);
            const char* a1 = cA + (size_t)(t + 1) * kstep;
            const char* a2 = last ? nA : cA + (size_t)(t + 2) * kstep; const char* b2 = last ? nB : cB + (size_t)(t + 2) * kstep;
            const char* a3 = a2 + kstep; const char* b3 = b2 + kstep;
            if (last && has_next) S.a_ready(nxt);
            if constexpr (SP2) {
            PG8_LDB(B0, 0, 0); PG8_LDB(B1, 0, 1); PG8_SCHED; PG8_LDA(At, 0, 0); PG8_STAGE(PG8_SA(1, 1), a1 + hstep, voffA);
            PG8_WAIT_V(8); PG8_WAIT_L(0); PG8_BAR; PG8_MMA(0, 0, At, B0); PG8_MMA(0, 1, At, B1); PG8_BAR; PG8_SCHED;
            PG8_LDA(At, 0, 1); PG8_STAGE(PG8_SB(0, 0), b2, voffB); PG8_STAGE(PG8_SB(0, 1), b2 + hstep, voffB); PG8_STAGE(PG8_SA(0, 0), a2, voffA);
            PG8_WAIT_V(8); PG8_WAIT_L(0); PG8_BAR; PG8_MMA(1, 0, At, B0); PG8_MMA(1, 1, At, B1); PG8_BAR; PG8_SCHED;
            PG8_LDB(B0, 1, 0); PG8_LDB(B1, 1, 1); PG8_SCHED; PG8_LDA(At, 1, 0); PG8_STAGE(PG8_SA(0, 1), a2 + hstep, voffA);
            PG8_WAIT_V(8); PG8_WAIT_L(0); PG8_BAR; PG8_MMA(0, 0, At, B0); PG8_MMA(0, 1, At, B1); PG8_BAR; PG8_SCHED;
            PG8_LDA(At, 1, 1); PG8_STAGE(PG8_SB(1, 0), b3, voffB); PG8_STAGE(PG8_SB(1, 1), b3 + hstep, voffB); PG8_STAGE(PG8_SA(1, 0), a3, voffA);
            PG8_WAIT_V(8); PG8_WAIT_L(0); PG8_BAR; PG8_MMA(1, 0, At, B0); PG8_MMA(1, 1, At, B1); PG8_BAR; PG8_SCHED;
            } else {
            PG8_LDB(B0, 0, 0); PG8_SCHED; PG8_LDA(At, 0, 0); PG8_STAGE(PG8_SA(1, 1), a1 + hstep, voffA);
            PG8_WAIT_L(8); PG8_BAR; PG8_WAIT_L(0); PG8_MMA(0, 0, At, B0); PG8_BAR; PG8_SCHED;
            PG8_LDB(B1, 0, 1); PG8_STAGE(PG8_SB(0, 0), b2, voffB);
            PG8_BAR; PG8_WAIT_L(0); PG8_MMA(0, 1, At, B1); PG8_BAR;
            PG8_LDA(At, 0, 1); PG8_STAGE(PG8_SA(0, 0), a2, voffA);
            PG8_BAR; PG8_WAIT_L(0); PG8_MMA(1, 0, At, B0); PG8_BAR; PG8_SCHED;
            PG8_STAGE(PG8_SB(0, 1), b2 + hstep, voffB);
            PG8_WAIT_V(6); PG8_BAR; PG8_MMA(1, 1, At, B1); PG8_BAR;
            PG8_LDB(B0, 1, 0); PG8_SCHED; PG8_LDA(At, 1, 0); PG8_STAGE(PG8_SA(0, 1), a2 + hstep, voffA);
            PG8_WAIT_L(8); PG8_BAR; PG8_WAIT_L(0); PG8_MMA(0, 0, At, B0); PG8_BAR; PG8_SCHED;
            PG8_LDB(B1, 1, 1); PG8_STAGE(PG8_SB(1, 0), b3, voffB);
            PG8_BAR; PG8_WAIT_L(0); PG8_MMA(0, 1, At, B1); PG8_BAR;
            PG8_LDA(At, 1, 1); PG8_STAGE(PG8_SA(1, 0), a3, voffA);
            PG8_BAR; PG8_WAIT_L(0); PG8_MMA(1, 0, At, B0); PG8_BAR; PG8_SCHED;
            PG8_STAGE(PG8_SB(1, 1), b3 + hstep, voffB);
            PG8_WAIT_V(6); PG8_BAR; PG8_MMA(1, 1, At, B1); PG8_BAR;
            }
        }
        if constexpr (ALIGN_EPI) { if (wr == 0) PG8_BAR; }
        if constexpr (!Epi::AFTER_DRAIN) { E(acc, cur, wr, wc, fr, fq); S.done(cur); }
        if (!has_next) break;
#pragma unroll
        for (int a = 0; a < 2; ++a)
#pragma unroll
            for (int b = 0; b < 2; ++b)
#pragma unroll
                for (int m = 0; m < 4; ++m)
#pragma unroll
                    for (int n = 0; n < 2; ++n) acc[a][b][m][n] = (f32x4){0.f, 0.f, 0.f, 0.f};
        cur = nxt; cA = nA; cB = nB; ++ui;
        if constexpr (ALIGN_EPI) { if (wr == 1) PG8_BAR; }
    }
    PG8_WAIT_V(0);
    if constexpr (!ALIGN_EPI) { if (wr == 0) PG8_BAR; }
    PG8_BAR;
    if constexpr (Epi::AFTER_DRAIN) { E.fused(acc, cur, wr, wc, fr, fq, lds, wid, lane); S.done(cur); }
#undef PG8_SA
#undef PG8_SB
#undef PG8_STAGE
#undef PG8_LDA
#undef PG8_LDB
#undef PG8_MMA
#undef PG8_WAIT_V
#undef PG8_WAIT_L
#undef PG8_BAR
#undef PG8_SCHED
}
}
#define GAS __attribute__((address_space(1)))
#define LAS __attribute__((address_space(3)))
typedef unsigned short bf16;
typedef unsigned v4u __attribute__((ext_vector_type(4)));
typedef float f32x4 __attribute__((ext_vector_type(4)));
typedef short bf16x8 __attribute__((ext_vector_type(8)));
typedef GAS unsigned gu32;
typedef GAS unsigned long long gu64;
#define RLX_AGENT __ATOMIC_RELAXED, __HIP_MEMORY_SCOPE_AGENT
#define LDS_WAIT() asm volatile("s_waitcnt lgkmcnt(0)" ::: "memory")
#define VM_WAIT() asm volatile("s_waitcnt vmcnt(0)" ::: "memory")
__device__ __forceinline__ unsigned long long rt() { return __builtin_amdgcn_s_memrealtime(); }
__device__ __forceinline__ unsigned f2bf(float f) { unsigned u = __builtin_bit_cast(unsigned, f); return (u + 0x7fffu + ((u >> 16) & 1u)) >> 16; }
__device__ __forceinline__ unsigned pk2(float lo, float hi) { return f2bf(lo) | (f2bf(hi) << 16); }

#define XB_TMO      128
#define XB_XCNT(j)  (256  + 64 * (j))
#define XB_XSUB(j)  (1280 + 64 * (j))
#define XB_XGEN(j)  (2304 + 64 * (j))
#define XB_TOP      3328
#define XB_TOPGEN   3392
#define XCD_BAR_WORDS 3456
#define XB_SPIN_CAP (1u << 18)

__device__ __forceinline__ unsigned xb_ld(unsigned* p)              { return __hip_atomic_load(p, __ATOMIC_RELAXED, __HIP_MEMORY_SCOPE_AGENT); }
__device__ __forceinline__ unsigned xb_add(unsigned* p, unsigned v) { return __hip_atomic_fetch_add(p, v, __ATOMIC_RELAXED, __HIP_MEMORY_SCOPE_AGENT); }
__device__ __forceinline__ unsigned xb_xcc_id() { return (unsigned)__builtin_amdgcn_s_getreg((3 << 11) | 20) & 0xFu; }
#define XB_SPIN(cond, bar) do { unsigned _sp = 0; while (cond) { __builtin_amdgcn_s_sleep(1); \
    if ((++_sp & 255u) == 0u) { if (xb_ld(&(bar)[XB_TMO])) break; if (_sp > XB_SPIN_CAP) { atomicAdd(&(bar)[XB_TMO], 1u); break; } } } } while (0)

struct XcdBarrier {
    unsigned* bar; unsigned x;
    volatile LAS unsigned* st;
};

__device__ __forceinline__ XcdBarrier xcd_barrier_post(unsigned* bar, volatile LAS unsigned* st) {
    XcdBarrier b; b.bar = bar; b.x = xb_xcc_id(); b.st = st;
    if (threadIdx.x == 0) (void)xb_add(&bar[XB_XCNT(b.x)], 1u);
    return b;
}
__device__ __forceinline__ void xcd_barrier_complete(unsigned* bar, unsigned x, unsigned& nloc, unsigned& nx) {
    const unsigned G = gridDim.x * gridDim.y * gridDim.z;
    unsigned sum, cnt, mine, sp = 0u;
    for (;;) {
        sum = 0u; cnt = 0u; mine = 0u;
#pragma unroll
        for (unsigned j = 0; j < 16; ++j) { const unsigned c = xb_ld(&bar[XB_XCNT(j)]); sum += c; cnt += (c > 0u) ? 1u : 0u; mine = (j == x) ? c : mine; }
        if (sum == G) break;
        __builtin_amdgcn_s_sleep(1);
        if ((++sp & 255u) == 0u) { if (xb_ld(&bar[XB_TMO])) break; if (sp > XB_SPIN_CAP) { atomicAdd(&bar[XB_TMO], 1u); break; } }
    }
    nloc = mine > 0u ? mine : 1u; nx = cnt > 0u ? cnt : 1u;
}

__device__ __forceinline__ void xcd_barrier(const XcdBarrier& b) {
    asm volatile("s_waitcnt vmcnt(0)" ::: "memory");
    __syncthreads();
    if (threadIdx.x == 0) {
        unsigned* bar = b.bar;
        __builtin_amdgcn_s_waitcnt(0);
        unsigned nloc = b.st[0], nx = b.st[1];
        if (nloc == 0u) { xcd_barrier_complete(bar, b.x, nloc, nx); b.st[0] = nloc; b.st[1] = nx; }
        const unsigned old = xb_add(&bar[XB_XSUB(b.x)], 1u);
        const unsigned gen = old / nloc;
        if (old + 1u == (gen + 1u) * nloc) {
            __builtin_amdgcn_fence(__ATOMIC_RELEASE, "agent");
            asm volatile("s_waitcnt vmcnt(0)" ::: "memory");
            const unsigned og = xb_add(&bar[XB_TOP], 1u);
            const unsigned tg = og / nx;
            if (og + 1u == (tg + 1u) * nx) xb_add(&bar[XB_TOPGEN], 1u);
            else XB_SPIN(xb_ld(&bar[XB_TOPGEN]) == tg, bar);
            __builtin_amdgcn_fence(__ATOMIC_ACQUIRE, "agent");
            xb_add(&bar[XB_XGEN(b.x)], 1u);
            asm volatile("s_waitcnt vmcnt(0)" ::: "memory");
        } else {
            XB_SPIN(xb_ld(&bar[XB_XGEN(b.x)]) == gen, bar);
            __builtin_amdgcn_fence(__ATOMIC_ACQUIRE, "agent");
            asm volatile("s_waitcnt vmcnt(0)" ::: "memory");
        }
    }
    __syncthreads();
}

constexpr int NWAVES = 8;
#ifndef MK_PER_PHASE
#define MK_PER_PHASE 0
#endif
constexpr int N_PHASES = 13;

constexpr int NB = 8, S = 4096, D = 1024, FF = 2816, M = NB * S;
typedef float f32x2g __attribute__((ext_vector_type(2)));
typedef unsigned u32x2g __attribute__((ext_vector_type(2)));

constexpr size_t MiB = 1u << 20;
constexpr size_t WS_CTL = 0, CTL_ZERO_BYTES = 32 * 1024;
constexpr size_t WS_SSQ = 46 * MiB + 512 * 1024;
constexpr size_t WS_WIN0 = 2 * MiB;
constexpr size_t WS_WOUT0 = 5 * MiB;
constexpr size_t WS_WGU0 = 7 * MiB;
constexpr size_t WS_WDN0 = 18 * MiB;
constexpr size_t WS_WPQ1 = 24 * MiB;
constexpr size_t WS_WUV1 = 26 * MiB;
constexpr size_t WS_WOUT1 = 28 * MiB;
constexpr size_t WS_WGU1 = 30 * MiB;
constexpr size_t WS_WDN1 = 41 * MiB;
constexpr size_t WS_DFT = 48 * MiB;
constexpr size_t WS_WSB = 49 * MiB;
constexpr size_t WS_XB = 112 * MiB;
constexpr size_t WS_AM = 176 * MiB;
constexpr size_t WS_H = 240 * MiB;
constexpr size_t WS_UB = WS_H, WS_PB = WS_H + 32 * MiB;
constexpr size_t WS_PQT = WS_H, WS_U1 = WS_H + 64 * MiB, WS_V1 = WS_H + 96 * MiB, WS_ZP = WS_H + 128 * MiB;
constexpr size_t WS_END = 432 * MiB;
static_assert(WS_H + (size_t)M * FF * 2 <= WS_END && WS_V1 + (size_t)M * 512 * 2 <= WS_ZP && WS_ZP + 64 * MiB <= WS_END, "d_ws map");
constexpr int CW_BAR = 4096;
static_assert((CW_BAR + 3456) * 4 <= (int)CTL_ZERO_BYTES, "barrier words inside the memset region");

constexpr int RING_OFF = 0, RING_BYTES = 131072;
constexpr int LDSCTL_OFF = RING_BYTES, MISC_OFF = LDSCTL_OFF + 320;
constexpr int LDS_BYTES = 147456;

struct Frame {
    LAS unsigned char* lds;
    volatile LAS unsigned* MISC;
    gu32* ctl;
    int tid, lane, wave;
    int vcu, G;
};
__device__ __forceinline__ float wave_sum(float v) {
#pragma unroll
    for (int o = 1; o < 64; o <<= 1) v += __shfl_xor(v, o);
    return v;
}
__device__ __forceinline__ float bf_lo(unsigned x) { return __builtin_bit_cast(float, x << 16); }
__device__ __forceinline__ float bf_hi(unsigned x) { return __builtin_bit_cast(float, x & 0xffff0000u); }
#define WG_BAR() do { asm volatile("s_waitcnt vmcnt(0) lgkmcnt(0)" ::: "memory"); __builtin_amdgcn_s_barrier(); asm volatile("" ::: "memory"); } while (0)
#define LDS_BAR() do { asm volatile("s_waitcnt lgkmcnt(0)" ::: "memory"); __builtin_amdgcn_s_barrier(); asm volatile("" ::: "memory"); } while (0)

__device__ __forceinline__ void p0_transpose_item(const float* W, int ldw, const float* gk, bf16* WT, int ldt, int k0, int n0, int dk0, int drow0, LAS float* scr, int lane) {
    float v[32];
    const float* wp = W + (size_t)(k0 + (lane >> 5)) * ldw + n0 + (lane & 31);
#pragma unroll
    for (int i = 0; i < 32; ++i) v[i] = wp[(size_t)(2 * i) * ldw];
    const int c = lane & 7;
    f32x4 g0 = {1.f, 1.f, 1.f, 1.f}, g1 = {1.f, 1.f, 1.f, 1.f};
    if (gk) { g0 = *(const GAS f32x4*)(gk + k0 + 8 * c); g1 = *(const GAS f32x4*)(gk + k0 + 8 * c + 4); }
#pragma unroll
    for (int i = 0; i < 32; ++i) scr[(2 * i + (lane >> 5)) * 33 + (lane & 31)] = v[i];
    LDS_WAIT(); asm volatile("" ::: "memory");
#pragma unroll
    for (int j = 0; j < 4; ++j) { const int n = (lane >> 3) + 8 * j; const LAS float* s = scr + (8 * c) * 33 + n;
        v4u o; o.x = pk2(s[0 * 33] * g0.x, s[1 * 33] * g0.y); o.y = pk2(s[2 * 33] * g0.z, s[3 * 33] * g0.w); o.z = pk2(s[4 * 33] * g1.x, s[5 * 33] * g1.y); o.w = pk2(s[6 * 33] * g1.z, s[7 * 33] * g1.w);
        *(GAS v4u*)(WT + (size_t)(drow0 + n) * ldt + dk0 + 8 * c) = o; }
    LDS_WAIT(); asm volatile("" ::: "memory");
}
__device__ __forceinline__ void p0_job(const float* W, int ldw, const float* gk, int kbeg, int kext, int ncol0, int next, bf16* WT, int ldt, int dkbase, int mode, int half_or_off,
                                       LAS float* scr, int lane, int gw, int NGW, int& cursor) {
    const int nkb = kext / 64, nnb = next / 32, nitems = nkb * nnb;
    int first = (gw - (cursor % NGW) + NGW) % NGW;
    for (int it = first; it < nitems; it += NGW) {
        const int kb = it / nnb, nb = it % nnb, nrel = 32 * nb;
        const int drow0 = (mode == 0) ? (half_or_off + nrel) : (256 * (nrel >> 7) + 128 * half_or_off + (nrel & 127));
        p0_transpose_item(W, ldw, gk, WT, ldt, kbeg + 64 * kb, ncol0 + nrel, dkbase + 64 * kb, drow0, scr, lane);
    }
    cursor += nitems;
}
__device__ __forceinline__ void p0_fold_item(const float* L, int lrow0, const float* sc, const float* Rm, bf16* out, int dk0, float scale, int dw, int lane) {
    const int d = 64 * dw + lane;
    float l0[8], l1[8];
    { const float s0 = sc ? sc[lane] : 1.f, s1 = sc ? sc[64 + lane] : 1.f;
#pragma unroll
      for (int j = 0; j < 8; ++j) { l0[j] = L[(size_t)(lrow0 + j) * 128 + lane] * s0; l1[j] = L[(size_t)(lrow0 + j) * 128 + 64 + lane] * s1; } }
    float acc[8];
#pragma unroll
    for (int j = 0; j < 8; ++j) acc[j] = 0.f;
#pragma unroll
    for (int cb = 0; cb < 4; ++cb) {
        float r[32];
#pragma unroll
        for (int i = 0; i < 32; ++i) r[i] = Rm[(size_t)(cb * 32 + i) * 1024 + d];
#pragma unroll
        for (int i = 0; i < 32; ++i) { const int cp = cb * 32 + i;
#pragma unroll
            for (int j = 0; j < 8; ++j) { const float lv = __builtin_bit_cast(float, __builtin_amdgcn_readlane(__builtin_bit_cast(int, cp < 64 ? l0[j] : l1[j]), cp & 63)); acc[j] = fmaf(lv, r[i], acc[j]); } }
    }
    v4u o; o.x = pk2(acc[0] * scale, acc[1] * scale); o.y = pk2(acc[2] * scale, acc[3] * scale); o.z = pk2(acc[4] * scale, acc[5] * scale); o.w = pk2(acc[6] * scale, acc[7] * scale);
    *(GAS v4u*)(out + (size_t)d * 1024 + dk0) = o;
}
__device__ __forceinline__ void p0_pq_item(const float* Win1, const float* g1, bf16* WPQ, int h, int half, int k0, const LAS float* tab, int lane) {
    const int cp = 64 * half + lane;
    float ap[8], aq[8], w0[8], w1[8];
#pragma unroll
    for (int j = 0; j < 8; ++j) { const float g = g1[k0 + j]; ap[j] = 0.f; aq[j] = 0.f; w0[j] = Win1[(size_t)(k0 + j) * 1536 + h * 128 + lane] * g; w1[j] = Win1[(size_t)(k0 + j) * 1536 + h * 128 + 64 + lane] * g; }
#pragma unroll 8
    for (int c = 0; c < 128; ++c) {
        const int ph = c * cp;
        const float cs = tab[ph & 127], sn = tab[(ph - 32) & 127];
#pragma unroll
        for (int j = 0; j < 8; ++j) { const float w = __builtin_bit_cast(float, __builtin_amdgcn_readlane(__builtin_bit_cast(int, c < 64 ? w0[j] : w1[j]), c & 63)); ap[j] = fmaf(w, cs, ap[j]); aq[j] = fmaf(w, sn, aq[j]); }
    }
    v4u o; o.x = pk2(ap[0], ap[1]); o.y = pk2(ap[2], ap[3]); o.z = pk2(ap[4], ap[5]); o.w = pk2(ap[6], ap[7]);
    *(GAS v4u*)(WPQ + (size_t)(h * 128 + cp) * 1024 + k0) = o;
    o.x = pk2(aq[0], aq[1]); o.y = pk2(aq[2], aq[3]); o.z = pk2(aq[4], aq[5]); o.w = pk2(aq[6], aq[7]);
    *(GAS v4u*)(WPQ + (size_t)(512 + h * 128 + cp) * 1024 + k0) = o;
}

struct Ptrs {
    const float* in[22]; float* out; unsigned char* ws;
};

__device__ __forceinline__ void p0_prologue(Frame& F, const Ptrs& P) {
    const float* x = P.in[0]; const float* mix_g = P.in[1]; const float* ffn_g = P.in[2];
    const float* ev_w_in = P.in[3]; const float* ev_pool_w = P.in[8]; const float* ev_pool_scale = P.in[9]; const float* ev_w_out = P.in[10];
    const float* od_w_in = P.in[11]; const float* od_fourier_w = P.in[12]; const float* od_w_out = P.in[17];
    const float* w_gate = P.in[18]; const float* w_up = P.in[19]; const float* w_down = P.in[20];
    unsigned char* ws = P.ws;
    LAS float* scr = (LAS float*)(F.lds + RING_OFF + F.wave * 8448);
    LAS float* CT = (LAS float*)(F.lds + RING_OFF + 69632);
    LAS float* tab = (LAS float*)(F.lds + RING_OFF + 69632 + 16384);
    for (int i = F.tid; i < 4096; i += NWAVES * 64) CT[i] = cospif((float)i * (1.0f / 2048.0f));
    if (F.tid < 128) tab[F.tid] = cospif((float)F.tid * (1.0f / 64.0f));
    WG_BAR();
    const int gw = F.vcu * NWAVES + F.wave, NGW = F.G * NWAVES, lane = F.lane;
    { const float* sw = P.in[15]; bf16* WSB = (bf16*)(ws + WS_WSB); const int gt = F.vcu * NWAVES * 64 + F.tid, NT = F.G * NWAVES * 64;
      for (int i = gt; i < 4 * 128 * 128 / 2; i += NT) { const f32x2g w2 = *(const GAS f32x2g*)(sw + 2 * i); *(GAS unsigned*)(WSB + 2 * i) = pk2(w2.x, w2.y); } }
    { unsigned long long* z = (unsigned long long*)(ws + WS_SSQ) + M; const int gt = F.vcu * NWAVES * 64 + F.tid, NT = F.G * NWAVES * 64;
      for (int i = gt; i < 4 * M; i += NT) z[i] = 0ull; }
    int cur = 0;
    p0_job(ev_w_in, 1536, mix_g, 0, 1024, 0, 512, (bf16*)(ws + WS_WIN0), 1024, 0, 1, 0, scr, lane, gw, NGW, cur);
    p0_job(ev_w_in, 1536, mix_g, 0, 1024, 512, 512, (bf16*)(ws + WS_WIN0), 1024, 0, 1, 1, scr, lane, gw, NGW, cur);
    p0_job(ev_w_in, 1536, mix_g, 0, 1024, 1024, 512, (bf16*)(ws + WS_WIN0), 1024, 0, 0, 1024, scr, lane, gw, NGW, cur);
    p0_job(ev_w_out, 1024, nullptr, 0, 512, 0, 1024, (bf16*)(ws + WS_WOUT0), 1024, 0, 0, 0, scr, lane, gw, NGW, cur);
    p0_job(w_gate, FF, ffn_g, 0, 1024, 0, FF, (bf16*)(ws + WS_WGU0), 1024, 0, 1, 0, scr, lane, gw, NGW, cur);
    p0_job(w_up, FF, ffn_g, 0, 1024, 0, FF, (bf16*)(ws + WS_WGU0), 1024, 0, 1, 1, scr, lane, gw, NGW, cur);
    p0_job(w_down, 1024, nullptr, 0, FF, 0, 1024, (bf16*)(ws + WS_WDN0), FF, 0, 0, 0, scr, lane, gw, NGW, cur);
    p0_job(od_w_in, 1536, mix_g + D, 0, 1024, 512, 512, (bf16*)(ws + WS_WUV1), 1024, 0, 1, 0, scr, lane, gw, NGW, cur);
    p0_job(od_w_in, 1536, mix_g + D, 0, 1024, 1024, 512, (bf16*)(ws + WS_WUV1), 1024, 0, 1, 1, scr, lane, gw, NGW, cur);
    p0_job(od_w_out, 1024, nullptr, 512, 512, 0, 1024, (bf16*)(ws + WS_WOUT1), 1024, 512, 0, 0, scr, lane, gw, NGW, cur);
    p0_job(w_gate + (size_t)D * FF, FF, ffn_g + D, 0, 1024, 0, FF, (bf16*)(ws + WS_WGU1), 1024, 0, 1, 0, scr, lane, gw, NGW, cur);
    p0_job(w_up + (size_t)D * FF, FF, ffn_g + D, 0, 1024, 0, FF, (bf16*)(ws + WS_WGU1), 1024, 0, 1, 1, scr, lane, gw, NGW, cur);
    p0_job(w_down + (size_t)FF * D, 1024, nullptr, 0, FF, 0, 1024, (bf16*)(ws + WS_WDN1), FF, 0, 0, 0, scr, lane, gw, NGW, cur);
    {
        int first = (gw - (cur % NGW) + NGW) % NGW;
        for (int it = first; it < 1024; it += NGW) { const int g = it >> 8, cc = (it >> 4) & 15, dw = it & 15;
            p0_fold_item(ev_pool_w, g * 128 + cc * 8, ev_pool_scale + g * 128, ev_w_out + (size_t)(512 + g * 128) * 1024, (bf16*)(ws + WS_WOUT0), 512 + g * 128 + cc * 8, 1.0f, dw, lane); }
        cur += 1024;
        first = (gw - (cur % NGW) + NGW) % NGW;
        for (int it = first; it < 1024; it += NGW) { const int h = it >> 8, cc = (it >> 4) & 15, dw = it & 15;
            p0_fold_item(od_fourier_w, h * 128 + cc * 8, nullptr, od_w_out + (size_t)(h * 128) * 1024, (bf16*)(ws + WS_WOUT1), h * 128 + cc * 8, 1.0f / 724.0773439350247f, dw, lane); }
        cur += 1024;
        first = (gw - (cur % NGW) + NGW) % NGW;
        for (int it = first; it < 1024; it += NGW) { const int h = it >> 8, half = (it >> 7) & 1, kc = it & 127;
            p0_pq_item(od_w_in, mix_g + D, (bf16*)(ws + WS_WPQ1), h, half, kc * 8, tab, lane); }
        cur += 1024;
    }
    {
        bf16* A2 = (bf16*)(ws + WS_DFT);
        int first = (gw - (cur % NGW) + NGW) % NGW;
        for (int t2 = first; t2 < 256; t2 += NGW) {
            const int k0 = lane * 8, sinpart = k0 >> 8, s0 = k0 & 255;
            float v[8];
#pragma unroll
            for (int e = 0; e < 8; ++e) v[e] = CT[((((s0 + e) * t2) & 255) * 16 - (sinpart ? 1024 : 0)) & (S - 1)];
            v4u o; o.x = pk2(v[0], v[1]); o.y = pk2(v[2], v[3]); o.z = pk2(v[4], v[5]); o.w = pk2(v[6], v[7]);
            *(GAS v4u*)(A2 + (size_t)t2 * 512 + k0) = o;
        }
        cur += 256;
    }
    {
        bf16* XB = (bf16*)(ws + WS_XB); unsigned long long* ssq0 = (unsigned long long*)(ws + WS_SSQ);
        for (int m0 = 8 * gw; m0 < M; m0 += 8 * NGW) {
            f32x4 v[8][4];
#pragma unroll
            for (int r = 0; r < 8; ++r) { const GAS f32x4* xr = (const GAS f32x4*)(x + (size_t)(m0 + r) * D) + lane;
#pragma unroll
                for (int j = 0; j < 4; ++j) v[r][j] = xr[64 * j]; }
#pragma unroll
            for (int r = 0; r < 8; ++r) { float s = 0.f;
#pragma unroll
                for (int j = 0; j < 4; ++j) s += (v[r][j].x * v[r][j].x + v[r][j].y * v[r][j].y) + (v[r][j].z * v[r][j].z + v[r][j].w * v[r][j].w);
                s = wave_sum(s);
                if (lane == 0) ssq0[m0 + r] = pg8::ssq_fix(s);
                GAS unsigned long long* o8 = (GAS unsigned long long*)(XB + (size_t)(m0 + r) * D) + lane;
#pragma unroll
                for (int j = 0; j < 4; ++j) o8[64 * j] = (unsigned long long)pk2(v[r][j].x, v[r][j].y) | ((unsigned long long)pk2(v[r][j].z, v[r][j].w) << 32); }
        }
    }
}

__device__ __forceinline__ float fsel(bool c, float a, float b) { return c ? a : b; }
__device__ __forceinline__ float reduce_scatter32(float (&v)[32], int lane) {
#pragma unroll
    for (int o = 16; o >= 1; o >>= 1) {
        const bool up = (lane & o) != 0;
#pragma unroll
        for (int i = 0; i < o; ++i) { const float lo_ = v[i], hi_ = v[i + o]; const float send = fsel(up, lo_, hi_), keep = fsel(up, hi_, lo_); v[i] = keep + __shfl_xor(send, o); }
#pragma unroll
        for (int i = 0; i < o; ++i) asm volatile("" : "+v"(v[i]));
    }
    return v[0] + __shfl_xor(v[0], 32);
}
__device__ __forceinline__ float reduce_scatter16(float (&v)[16], int lane) {
#pragma unroll
    for (int o = 8; o >= 1; o >>= 1) {
        const bool up = (lane & o) != 0;
#pragma unroll
        for (int i = 0; i < o; ++i) { const float lo_ = v[i], hi_ = v[i + o]; const float send = fsel(up, lo_, hi_), keep = fsel(up, hi_, lo_); v[i] = keep + __shfl_xor(send, o); }
#pragma unroll
        for (int i = 0; i < o; ++i) asm volatile("" : "+v"(v[i]));
    }
    float t = v[0] + __shfl_xor(v[0], 16);
    return t + __shfl_xor(t, 32);
}
template <int pmode> __device__ __forceinline__ void mix0_conv_item(Frame& F, const Ptrs& P, int item) {
    const bf16* UB = (const bf16*)(P.ws + WS_UB); bf16* AM = (bf16*)(P.ws + WS_AM);
    const float* cw = P.in[4]; const float* cb = P.in[5]; const float* lg = P.in[6]; const float* lb = P.in[7];
    const int b = item >> 6, t0 = (item & 63) * 64, rowbase = b * S;
    LAS unsigned* tile = (LAS unsigned*)(F.lds + RING_OFF);
    LAS float* red = (LAS float*)(F.lds + RING_OFF + 98304);
    int tidl = F.tid; asm volatile("" : "+v"(tidl));
    const int rg = tidl >> 8, cp = tidl & 255, lanel = tidl & 63;
    const f32x2g bb = *(const GAS f32x2g*)(cb + 2 * cp);
    const f32x2g g2 = *(const GAS f32x2g*)(lg + 2 * cp), b2 = *(const GAS f32x2g*)(lb + 2 * cp);
    float w0[31], w1[31];
#pragma unroll
    for (int j = 0; j < 31; ++j) { const f32x2g w = *(const GAS f32x2g*)(cw + j * 512 + 2 * cp); w0[j] = w.x; w1[j] = w.y; }
    if (pmode != 7) { v4u tv[12];
#pragma unroll
      for (int i = 0; i < 12; ++i) { const int t = t0 - 15 + F.wave + NWAVES * i, tc = t < 0 ? 0 : (t > S - 1 ? S - 1 : t);
          tv[i] = *(const GAS v4u*)(UB + (size_t)(rowbase + tc) * 512 + F.lane * 8); }
#pragma unroll
      for (int i = 0; i < 12; ++i) { const int r = F.wave + NWAVES * i, t = t0 - 15 + r; const bool ok = (t >= 0 && t < S);
          v4u w = tv[i]; w.x = ok ? w.x : 0u; w.y = ok ? w.y : 0u; w.z = ok ? w.z : 0u; w.w = ok ? w.w : 0u;
          *(LAS v4u*)(tile + r * 256 + F.lane * 4) = w; } }
    LDS_BAR();
#pragma unroll 1
    for (int p = 0; p < 2; ++p) {
        float a0[16], a1[16];
#pragma unroll
        for (int o = 0; o < 16; ++o) { a0[o] = bb.x; a1[o] = bb.y; }
        const LAS unsigned* tp = tile + (32 * rg + 16 * p) * 256 + cp;
#pragma unroll
        for (int ii = 0; ii < 46; ++ii) {
            const unsigned xx = tp[ii * 256];
            const float x0 = bf_lo(xx), x1 = bf_hi(xx);
#pragma unroll
            for (int o = 0; o < 16; ++o) { const int j = ii - o; if (j >= 0 && j <= 30) { a0[o] = fmaf(w0[j], x0, a0[o]); a1[o] = fmaf(w1[j], x1, a1[o]); } }
        }
        float v[32];
#pragma unroll
        for (int o = 0; o < 16; ++o) { v[2 * o] = a0[o] + a1[o]; v[2 * o + 1] = a0[o] * a0[o] + a1[o] * a1[o]; }
        LAS float* redp = red + (p & 1) * 256;
        const float tot = reduce_scatter32(v, lanel);
        if (lanel < 32) redp[(F.wave & 3) * 32 + lanel + rg * 128] = tot;
        LDS_BAR();
        float mean16[16], rstd16[16];
        {
            const LAS f32x4* rp = (const LAS f32x4*)(redp + rg * 128);
            f32x4 acc4[8];
#pragma unroll
            for (int k = 0; k < 8; ++k) acc4[k] = rp[k];
#pragma unroll
            for (int w = 1; w < 4; ++w)
#pragma unroll
                for (int k = 0; k < 8; ++k) acc4[k] = acc4[k] + rp[w * 8 + k];
#pragma unroll
            for (int o = 0; o < 16; ++o) { const float sm = acc4[o >> 1][(o & 1) * 2], sq = acc4[o >> 1][(o & 1) * 2 + 1];
                const float mean = sm * (1.0f / 512.0f), var = fmaxf(sq * (1.0f / 512.0f) - mean * mean, 0.f); mean16[o] = mean; rstd16[o] = __builtin_amdgcn_rsqf(var + 1e-6f); }
        }
#pragma unroll
        for (int o = 0; o < 16; ++o) {
            const float mean = mean16[o], rstd = rstd16[o];
            float y0 = (a0[o] - mean) * rstd * g2.x + b2.x, y1 = (a1[o] - mean) * rstd * g2.y + b2.y;
            y0 = y0 * __builtin_amdgcn_rcpf(1.0f + __expf(-y0)); y1 = y1 * __builtin_amdgcn_rcpf(1.0f + __expf(-y1));
            *(GAS unsigned*)(AM + (size_t)(rowbase + t0 + 32 * rg + 16 * p + o) * 1024 + 2 * cp) = pk2(y0, y1);
        }
    }
    LDS_BAR();
}
template <int H> __device__ __forceinline__ void pool_rows(const LAS unsigned* tp  , bf16* orow  , int tfirst) {
    unsigned x[32 + 2 * H];
#pragma unroll
    for (int i = 0; i < 32 + 2 * H; ++i) x[i] = tp[i * 256];
    float s0 = 0.f, s1 = 0.f;
#pragma unroll
    for (int i = 0; i < 2 * H; ++i) { s0 += bf_lo(x[i]); s1 += bf_hi(x[i]); }
#pragma unroll
    for (int o = 0; o < 32; ++o) {
        const int t = tfirst + o;
        const int lo = (t - H) < 0 ? 0 : (t - H), hi = (t + H - 1) > (S - 1) ? (S - 1) : (t + H - 1);
        const float inv = 1.0f / (float)(hi - lo + 1);
        *(GAS unsigned*)(orow + (size_t)o * 1024) = pk2(s0 * inv - bf_lo(x[o + H]), s1 * inv - bf_hi(x[o + H]));
        if (o < 31) { s0 += bf_lo(x[o + 2 * H]) - bf_lo(x[o]); s1 += bf_hi(x[o + 2 * H]) - bf_hi(x[o]); }
    }
}
__device__ __forceinline__ void mix0_pool_item(Frame& F, const Ptrs& P, int item) {
    const bf16* PB = (const bf16*)(P.ws + WS_PB); bf16* AM = (bf16*)(P.ws + WS_AM);
    const int b = item >> 6, t0 = (item & 63) * 64, rowbase = b * S;
    LAS unsigned* tile = (LAS unsigned*)(F.lds + RING_OFF);
    { v4u tv[10];
#pragma unroll
      for (int i = 0; i < 10; ++i) { const int t = t0 - 8 + F.wave + NWAVES * i, tc = t < 0 ? 0 : (t > S - 1 ? S - 1 : t);
          tv[i] = *(const GAS v4u*)(PB + (size_t)(rowbase + tc) * 512 + F.lane * 8); }
#pragma unroll
      for (int i = 0; i < 10; ++i) { const int r = F.wave + NWAVES * i, t = t0 - 8 + r; const bool ok = (t >= 0 && t < S);
          v4u w = tv[i]; w.x = ok ? w.x : 0u; w.y = ok ? w.y : 0u; w.z = ok ? w.z : 0u; w.w = ok ? w.w : 0u;
          *(LAS v4u*)(tile + r * 256 + F.lane * 4) = w; } }
    LDS_BAR();
    const int rg = F.tid >> 8, cp = F.tid & 255, g = __builtin_amdgcn_readfirstlane(cp >> 6);
    bf16* orow = AM + (size_t)(rowbase + t0 + 32 * rg) * 1024 + 512 + 2 * cp;
    const int tfirst = t0 + 32 * rg;
    if (g == 0) pool_rows<1>(tile + (32 * rg + 8 - 1) * 256 + cp, orow, tfirst);
    else if (g == 1) pool_rows<2>(tile + (32 * rg + 8 - 2) * 256 + cp, orow, tfirst);
    else if (g == 2) pool_rows<4>(tile + (32 * rg + 8 - 4) * 256 + cp, orow, tfirst);
    else pool_rows<8>(tile + (32 * rg + 8 - 8) * 256 + cp, orow, tfirst);
    LDS_BAR();
}

struct SguIn { u32x2g uu[8]; unsigned xv[16]; };
__device__ __forceinline__ void sgu_load(const bf16* U, const bf16* V, int item, int wave, int lane, SguIn& R) {
    const int h = item & 3, rowbase = (item >> 2) * 128, fr = lane & 15, fq = lane >> 4, q = 16 * wave + fr;
#pragma unroll
    for (int nt = 0; nt < 8; ++nt) R.uu[nt] = *(const GAS u32x2g*)(U + (size_t)(rowbase + q) * 512 + h * 128 + 16 * nt + 4 * fq);
#pragma unroll
    for (int i = 0; i < 16; ++i) R.xv[i] = *(const GAS unsigned*)(V + (size_t)(rowbase + 16 * wave + i) * 512 + h * 128 + 2 * lane);
}
__device__ __forceinline__ void sgu_compute(Frame& F, bf16* AM, int item, int lane, const SguIn& R, const pg8::bf16x8 (&wf)[4], float bias, f32x2g g2, f32x2g b2) {
    const int h = item & 3, rowbase = (item >> 2) * 128, fr = lane & 15, fq = lane >> 4, q = 16 * F.wave + fr;
    LAS bf16* vnT = (LAS bf16*)(F.lds + RING_OFF);
    {
        float st[32];
#pragma unroll
        for (int i = 0; i < 16; ++i) { const float v0 = bf_lo(R.xv[i]), v1 = bf_hi(R.xv[i]); st[2 * i] = v0 + v1; st[2 * i + 1] = v0 * v0 + v1 * v1; }
        const float tot = reduce_scatter32(st, lane);
        unsigned y0[8], y1[8];
#pragma unroll
        for (int i = 0; i < 16; ++i) {
            const float sm = __builtin_bit_cast(float, __builtin_amdgcn_readlane(__builtin_bit_cast(int, tot), 2 * i)), sq = __builtin_bit_cast(float, __builtin_amdgcn_readlane(__builtin_bit_cast(int, tot), 2 * i + 1));
            const float mean = sm * (1.0f / 128.0f), rstd = __builtin_amdgcn_rsqf(sq * (1.0f / 128.0f) - mean * mean + 1e-6f);
            const unsigned a0 = f2bf((bf_lo(R.xv[i]) - mean) * rstd * g2.x + b2.x), a1 = f2bf((bf_hi(R.xv[i]) - mean) * rstd * g2.y + b2.y);
            if (i & 1) { y0[i >> 1] |= a0 << 16; y1[i >> 1] |= a1 << 16; } else { y0[i >> 1] = a0; y1[i >> 1] = a1; }
        }
        LAS bf16* d0 = vnT + (2 * lane) * 136 + 16 * F.wave;
        *(LAS v4u*)d0 = (v4u){y0[0], y0[1], y0[2], y0[3]}; *(LAS v4u*)(d0 + 8) = (v4u){y0[4], y0[5], y0[6], y0[7]};
        *(LAS v4u*)(d0 + 136) = (v4u){y1[0], y1[1], y1[2], y1[3]}; *(LAS v4u*)(d0 + 136 + 8) = (v4u){y1[4], y1[5], y1[6], y1[7]};
    }
    LDS_BAR();
    {
        pg8::f32x4 acc[8];
#pragma unroll
        for (int nt = 0; nt < 8; ++nt) acc[nt] = (pg8::f32x4){0.f, 0.f, 0.f, 0.f};
#pragma unroll
        for (int ks = 0; ks < 4; ++ks) {
#pragma unroll
            for (int nt = 0; nt < 8; ++nt) {
                const pg8::bf16x8 vf = *(const LAS pg8::bf16x8*)(vnT + (16 * nt + fr) * 136 + ks * 32 + 8 * fq);
                acc[nt] = __builtin_amdgcn_mfma_f32_16x16x32_bf16(vf, wf[ks], acc[nt], 0, 0, 0);
            }
        }
        const size_t t = (size_t)(rowbase + q);
#pragma unroll
        for (int nt = 0; nt < 8; ++nt) { const int c0 = h * 128 + 16 * nt + 4 * fq;
            u32x2g o; o.x = pk2(bf_lo(R.uu[nt].x) * (acc[nt][0] + bias), bf_hi(R.uu[nt].x) * (acc[nt][1] + bias)); o.y = pk2(bf_lo(R.uu[nt].y) * (acc[nt][2] + bias), bf_hi(R.uu[nt].y) * (acc[nt][3] + bias));
            *(GAS u32x2g*)(AM + t * 1024 + 512 + c0) = o; }
    }
    LDS_BAR();
}
__device__ __forceinline__ void sgu_phase(Frame& F, const Ptrs& P) {
    const bf16* U = (const bf16*)(P.ws + WS_U1); const bf16* V = (const bf16*)(P.ws + WS_V1); bf16* AM = (bf16*)(P.ws + WS_AM);
    const float* lng = P.in[13]; const float* lnb = P.in[14]; const float* sw = P.in[15]; const float* sb = P.in[16];
    int lane = F.lane; asm volatile("" : "+v"(lane));
    const int it0 = F.vcu, G = F.G;
    if (it0 >= 1024) return;
    const int h = it0 & 3, fr = lane & 15, fq = lane >> 4, q = 16 * F.wave + fr;
    pg8::bf16x8 wf[4];
#pragma unroll
    for (int ks = 0; ks < 4; ++ks) { const GAS pg8::f32x4* wp = (const GAS pg8::f32x4*)(sw + (size_t)(h * 128 + q) * 128 + ks * 32 + 8 * fq); const pg8::f32x4 wa = wp[0], wb = wp[1];
        pg8::u32x4 wq; wq.x = pk2(wa[0], wa[1]); wq.y = pk2(wa[2], wa[3]); wq.z = pk2(wb[0], wb[1]); wq.w = pk2(wb[2], wb[3]); wf[ks] = __builtin_bit_cast(pg8::bf16x8, wq); }
    const float bias = sb[h * 128 + q];
    const f32x2g g2 = *(const GAS f32x2g*)(lng + h * 128 + 2 * lane), b2 = *(const GAS f32x2g*)(lnb + h * 128 + 2 * lane);
    SguIn Ra, Rb;
    sgu_load(U, V, it0, F.wave, lane, Ra);
    for (int it = it0; it < 1024; it += 2 * G) {
        const int it1 = it + G, it2 = it + 2 * G;
        if (it1 < 1024) sgu_load(U, V, it1, F.wave, lane, Rb);
        sgu_compute(F, AM, it, lane, Ra, wf, bias, g2, b2);
        if (it1 >= 1024) break;
        if (it2 < 1024) sgu_load(U, V, it2, F.wave, lane, Ra);
        sgu_compute(F, AM, it1, lane, Rb, wf, bias, g2, b2);
    }
}

struct cpx { float r, i; };
__device__ __forceinline__ cpx cadd(cpx a, cpx b) { return {a.r + b.r, a.i + b.i}; }
__device__ __forceinline__ cpx csub(cpx a, cpx b) { return {a.r - b.r, a.i - b.i}; }
__device__ __forceinline__ cpx cmulc(cpx a, float c, float s) { return {a.r * c + a.i * s, a.i * c - a.r * s}; }
__device__ __forceinline__ cpx cmni(cpx a) { return {a.i, -a.r}; }
__device__ __forceinline__ void dft4(cpx& x0, cpx& x1, cpx& x2, cpx& x3) {
    const cpx s02 = cadd(x0, x2), d02 = csub(x0, x2), s13 = cadd(x1, x3), d13 = cmni(csub(x1, x3));
    x0 = cadd(s02, s13); x1 = cadd(d02, d13); x2 = csub(s02, s13); x3 = csub(d02, d13);
}
__device__ __forceinline__ void fft16(cpx (&x)[16], cpx (&z)[16]) {
    constexpr float C1 = 0.92387953251128674f, S1 = 0.38268343236508977f, R2 = 0.70710678118654752f;
#pragma unroll
    for (int b = 0; b < 4; ++b) dft4(x[b], x[4 + b], x[8 + b], x[12 + b]);
    x[4 + 1] = cmulc(x[4 + 1], C1, S1);  x[8 + 1] = cmulc(x[8 + 1], R2, R2);   x[12 + 1] = cmulc(x[12 + 1], S1, C1);
    x[4 + 2] = cmulc(x[4 + 2], R2, R2);  x[8 + 2] = cmni(x[8 + 2]);            x[12 + 2] = cmulc(x[12 + 2], -R2, R2);
    x[4 + 3] = cmulc(x[4 + 3], S1, C1);  x[8 + 3] = cmulc(x[8 + 3], -R2, R2);  x[12 + 3] = cmulc(x[12 + 3], -C1, -S1);
#pragma unroll
    for (int c = 0; c < 4; ++c) { dft4(x[4 * c], x[4 * c + 1], x[4 * c + 2], x[4 * c + 3]);
        z[c] = x[4 * c]; z[c + 4] = x[4 * c + 1]; z[c + 8] = x[4 * c + 2]; z[c + 12] = x[4 * c + 3]; }
}
__device__ __forceinline__ void fft_stage1(Frame& F, const Ptrs& P) {
    const bf16* PQT = (const bf16*)(P.ws + WS_PQT); bf16* ZP = (bf16*)(P.ws + WS_ZP);
    LAS float* CT = (LAS float*)(F.lds + RING_OFF + 65536);
    { int tl = F.tid; asm volatile("" : "+v"(tl)); for (int i = tl; i < 4096; i += NWAVES * 64) CT[i] = cospif((float)i * (1.0f / 2048.0f)); }
    LDS_BAR();
    int gw = F.vcu * NWAVES + F.wave; asm volatile("" : "+s"(gw)); const int NGW = F.G * NWAVES;
    for (int item = gw; item < NB * 512 * 2; item += NGW) {
        int lane = F.lane; asm volatile("" : "+v"(lane));
        const int row = item >> 1, s20 = 128 * (item & 1) + 2 * lane, b = row >> 9, ch = row & 511;
        const bf16* src = PQT + (size_t)row * 2 * S + s20;
        unsigned xp[16], xq[16];
#pragma unroll
        for (int s1 = 0; s1 < 16; ++s1) { xp[s1] = *(const GAS unsigned*)(src + 256 * s1); xq[s1] = *(const GAS unsigned*)(src + S + 256 * s1); }
        unsigned zr[16], zi[16];
#pragma unroll
        for (int e = 0; e < 2; ++e) {
            cpx x[16], z[16];
#pragma unroll
            for (int s1 = 0; s1 < 16; ++s1) { x[s1].r = e ? bf_hi(xp[s1]) : bf_lo(xp[s1]); x[s1].i = -(e ? bf_hi(xq[s1]) : bf_lo(xq[s1])); }
            fft16(x, z);
            const int s2 = s20 + e;
#pragma unroll
            for (int t1 = 0; t1 < 16; ++t1) {
                const int idx = s2 * t1;
                const cpx w = cmulc(z[t1], CT[idx], CT[(idx - 1024) & (S - 1)]);
                const unsigned hr = f2bf(w.r), hi = f2bf(w.i);
                if (e == 0) { zr[t1] = hr; zi[t1] = hi; } else { zr[t1] |= hr << 16; zi[t1] |= hi << 16; }
            }
        }
#pragma unroll
        for (int t1 = 0; t1 < 16; ++t1) { bf16* dst = ZP + ((size_t)((b * 16 + t1) * 512 + ch)) * 512 + s20;
            *(GAS unsigned*)dst = zr[t1]; *(GAS unsigned*)(dst + 256) = zi[t1]; }
    }
}

struct Args { const float* in[22]; float* out; unsigned char* ws; int ph_lo, ph_hi, li, pad; };
template <int PM> __device__ __forceinline__ void mk_body(const Args& args) {
    extern __shared__ __attribute__((aligned(16))) unsigned char lds[];
    Frame F;
    F.lds = (LAS unsigned char*)lds;
    F.MISC = (volatile LAS unsigned*)(F.lds + MISC_OFF);
    F.tid = threadIdx.x; F.lane = F.tid & 63; F.wave = __builtin_amdgcn_readfirstlane(F.tid >> 6);
    F.G = gridDim.x; { const int bx = blockIdx.x; F.vcu = (F.G % 8 == 0) ? (bx % 8) * (F.G / 8) + bx / 8 : bx; }
    Ptrs P;
#pragma unroll
    for (int i = 0; i < 22; ++i) P.in[i] = args.in[i];
    P.out = args.out; P.ws = args.ws;
    unsigned char* ws = args.ws;
    F.ctl = (gu32*)(ws + WS_CTL);
    for (int u = F.tid; u < (LDS_BYTES - LDSCTL_OFF) / 4; u += NWAVES * 64) ((LAS unsigned*)(F.lds + LDSCTL_OFF))[u] = 0u;
    __syncthreads();
    XcdBarrier bar; bar.bar = (unsigned*)(F.ctl + CW_BAR); bar.x = 0; bar.st = nullptr;
    if (!MK_PER_PHASE) bar = xcd_barrier_post((unsigned*)(F.ctl + CW_BAR), F.MISC + 8);
    const int lo = args.ph_lo, hi = args.ph_hi;
#ifndef PH_MASK
#define PH_MASK 0x1FFF
#endif
#define IN(k) ((((PH_MASK) >> (k)) & 1) && lo <= (k) && (k) < hi)
#ifndef PROBE_BARX
#define PROBE_BARX 1
#endif
#define SEAM(k) do { if (IN(k) && IN((k) + 1)) { for (int bx_ = 0; bx_ < PROBE_BARX; ++bx_) xcd_barrier(bar); } } while (0)
    unsigned long long* ssq = (unsigned long long*)(ws + WS_SSQ);
    bf16* XB = (bf16*)(ws + WS_XB); bf16* AM = (bf16*)(ws + WS_AM); bf16* HB = (bf16*)(ws + WS_H);
    const int bid = (int)blockIdx.x;
    constexpr bool dup = PM != 0;
    bf16* TRX = (bf16*)(ws + WS_END); unsigned long long* TRS = (unsigned long long*)(ws + WS_END + 64 * MiB);

    if (IN(0)) { p0_prologue(F, P); } SEAM(0);
    if (IN(1)) { pg8::Gemm g{XB, (const bf16*)(ws + WS_WIN0), M, 1536, D}; pg8::StaticOrder So; So.init(M, 1536, F.G, bid);
        pg8::EpiInL0 E{(bf16*)(ws + WS_UB), (bf16*)(ws + WS_PB), ssq};
        pg8::gemm_phase<pg8::EpiInL0, pg8::StaticOrder, true, true>(F.lds + RING_OFF, g, So, E); } SEAM(1);
    if (IN(2)) { for (int it = F.vcu; it < 1024; it += F.G) {
#ifndef NO_CONV
            if (it < 512 && PM != 4 && PM != 9) mix0_conv_item<PM>(F, P, it);
#endif
#ifndef NO_POOL
            if (it >= 512 && PM != 3 && PM != 9) mix0_pool_item(F, P, it - 512);
#endif
 } } SEAM(2);
    if (IN(3)) { pg8::Gemm g{AM, (const bf16*)(ws + WS_WOUT0), M, D, D}; pg8::StaticOrder So; So.init(M, D, F.G, bid);
        pg8::EpiResid E{XB, dup ? TRS : ssq + M, dup ? TRX : XB, PM, false};
        pg8::gemm_phase<pg8::EpiResid, pg8::StaticOrder, true, true>(F.lds + RING_OFF, g, So, E); } SEAM(3);
    if (IN(4)) { pg8::Gemm g{XB, (const bf16*)(ws + WS_WGU0), M, 2 * FF, D}; pg8::StaticOrderT<(PM == 40 ? 4 : PM == 41 ? 16 : PM == 42 ? 32 : PM == 43 ? 2 : 8)> So; So.init(M, 2 * FF, F.G, bid);
        pg8::EpiSwiGLU E{HB, ssq + M, PM};
        pg8::gemm_phase<pg8::EpiSwiGLU, decltype(So), (PM != 20 && PM != 22), (PM != 21 && PM != 22)>(F.lds + RING_OFF, g, So, E); } SEAM(4);
    if (IN(5)) { pg8::Gemm g{HB, (const bf16*)(ws + WS_WDN0), M, D, FF}; pg8::StaticOrder So; So.init(M, D, F.G, bid);
        pg8::EpiResid E{XB, dup ? TRS : ssq + 2 * M, dup ? TRX : XB, PM, false};
        pg8::gemm_phase<pg8::EpiResid, pg8::StaticOrder, true, true>(F.lds + RING_OFF, g, So, E); } SEAM(5);
    if (IN(6)) {
        { pg8::Gemm g{(const bf16*)(ws + WS_WPQ1), XB, 1024, M, D}; pg8::StaticOrder So; So.init(1024, M, F.G, bid);
          pg8::EpiPQT E{(bf16*)(ws + WS_PQT), ssq + 2 * M, PM};
          pg8::gemm_phase<pg8::EpiPQT, pg8::StaticOrder, true, true>(F.lds + RING_OFF, g, So, E); }
#pragma unroll 1
        for (int rnd = 0; rnd < 2; ++rnd) { pg8::Gemm g{XB, (const bf16*)(ws + WS_WUV1), M, 1024, D}; pg8::RoundOrder So; So.init(M, 1024, F.G, bid); So.round = rnd;
          pg8::EpiSGU E{AM, ssq + 2 * M, P.in[13], P.in[14], (const bf16*)(ws + WS_WSB), P.in[16]};
          pg8::gemm_phase<pg8::EpiSGU, pg8::RoundOrder, false, true>(F.lds + RING_OFF, g, So, E); }
    } SEAM(6);
    if (IN(7)) {
        if (PM != 12) { fft_stage1(F, P); }
    } SEAM(7);
    if (IN(8)) { pg8::Gemm g{(const bf16*)(ws + WS_DFT), (const bf16*)(ws + WS_ZP), 256, NB * 16 * 512, 512}; pg8::StaticOrder So; So.init(256, NB * 16 * 512, F.G, bid);
        pg8::EpiDFT2 E{AM};
        pg8::gemm_phase<pg8::EpiDFT2, pg8::StaticOrder, true, true>(F.lds + RING_OFF, g, So, E); } SEAM(8);
    if (IN(9)) { pg8::Gemm g{AM, (const bf16*)(ws + WS_WOUT1), M, D, D}; pg8::StaticOrder So; So.init(M, D, F.G, bid);
        pg8::EpiResid E{XB, dup ? TRS : ssq + 3 * M, dup ? TRX : XB, PM, false};
        pg8::gemm_phase<pg8::EpiResid, pg8::StaticOrder, true, true>(F.lds + RING_OFF, g, So, E); } SEAM(9);
    if (IN(10)) { pg8::Gemm g{XB, (const bf16*)(ws + WS_WGU1), M, 2 * FF, D}; pg8::StaticOrder So; So.init(M, 2 * FF, F.G, bid);
        pg8::EpiSwiGLU E{HB, ssq + 3 * M, PM};
        pg8::gemm_phase<pg8::EpiSwiGLU, pg8::StaticOrder, true, true>(F.lds + RING_OFF, g, So, E); } SEAM(10);
    if (IN(11)) { pg8::Gemm g{HB, (const bf16*)(ws + WS_WDN1), M, D, FF}; pg8::StaticOrder So; So.init(M, D, F.G, bid);
        pg8::EpiResid E{XB, dup ? TRS : ssq + 4 * M, dup ? TRX : XB, PM, true};
        pg8::gemm_phase<pg8::EpiResid, pg8::StaticOrder, true, true>(F.lds + RING_OFF, g, So, E); } SEAM(11);
    if (IN(12)) {
        const float* gf = P.in[21]; const unsigned long long* ssq4 = ssq + 4 * M;
        const int gw = F.vcu * NWAVES + F.wave, NGW = F.G * NWAVES;
        for (int m0 = 4 * gw; m0 < M; m0 += 4 * NGW) {
            u32x2g xx[4][4]; unsigned long long q[4];
#pragma unroll
            for (int r = 0; r < 4; ++r) { const GAS u32x2g* xr = (const GAS u32x2g*)(XB + (size_t)(m0 + r) * D) + F.lane; q[r] = ssq4[m0 + r];
#pragma unroll
                for (int j = 0; j < 4; ++j) xx[r][j] = xr[64 * j]; }
            const GAS f32x4* gr = (const GAS f32x4*)gf + F.lane;
            f32x4 gg[4];
#pragma unroll
            for (int j = 0; j < 4; ++j) gg[j] = gr[64 * j];
#pragma unroll
            for (int r = 0; r < 4; ++r) { const float rs = pg8::rstd_of(q[r]); GAS f32x4* orow = (GAS f32x4*)(P.out + (size_t)(m0 + r) * D) + F.lane;
#pragma unroll
                for (int j = 0; j < 4; ++j) { f32x4 v; v.x = bf_lo(xx[r][j].x); v.y = bf_hi(xx[r][j].x); v.z = bf_lo(xx[r][j].y); v.w = bf_hi(xx[r][j].y); orow[64 * j] = v * rs * gg[j]; } }
        }
    }
#undef IN
#undef SEAM
}
__global__ void __launch_bounds__(NWAVES * 64, 2) mk_fwd(Args args) { mk_body<0>(args); }
#ifdef PROBE_PHASE
#ifndef PROBE_MODE
#define PROBE_MODE 1
#endif
__global__ void __launch_bounds__(NWAVES * 64, 2) mk_probe(Args args) { mk_body<PROBE_MODE>(args); }
#endif

extern "C" void kernel_launch(void* const* d_in, const int* in_sizes, int n_in, void* d_out, int out_size, void* d_ws, size_t ws_size, hipStream_t stream) {
    static int grid = 0;
    if (grid == 0) {
        if (n_in != 22 || in_sizes[0] != M * D || out_size != M * D || ws_size < WS_END) { fprintf(stderr, "kernel_launch: unexpected shapes (n_in %d, in0 %d, out %d, ws %zu); nothing launched\n", n_in, n_in > 0 ? in_sizes[0] : -1, out_size, ws_size); grid = -1; return; }
        int dev = 0, cus = 0, per_cu = 0;
        if (hipGetDevice(&dev) != hipSuccess || hipDeviceGetAttribute(&cus, hipDeviceAttributeMultiprocessorCount, dev) != hipSuccess) { grid = -1; return; }
#ifdef PROBE_PHASE
        (void)hipFuncSetAttribute((const void*)mk_probe, hipFuncAttributeMaxDynamicSharedMemorySize, LDS_BYTES);
#endif
        if (hipFuncSetAttribute((const void*)mk_fwd, hipFuncAttributeMaxDynamicSharedMemorySize, LDS_BYTES) != hipSuccess) { fprintf(stderr, "kernel_launch: hipFuncSetAttribute failed\n"); grid = -1; return; }
        if (hipOccupancyMaxActiveBlocksPerMultiprocessor(&per_cu, (const void*)mk_fwd, NWAVES * 64, LDS_BYTES) != hipSuccess || per_cu < 1) { fprintf(stderr, "kernel_launch: occupancy query says %d blocks per CU\n", per_cu); per_cu = 1; }
        (void)hipGetLastError();
        grid = (cus / 8) * 8;
    }
    if (grid < 0) return;
    if (hipMemsetAsync((char*)d_ws + WS_CTL, 0, CTL_ZERO_BYTES, stream) != hipSuccess) { fprintf(stderr, "kernel_launch: hipMemsetAsync failed\n"); return; }
    Args a{};
    for (int i = 0; i < 22; ++i) a.in[i] = (const float*)d_in[i];
    a.out = (float*)d_out; a.ws = (unsigned char*)d_ws;
#if MK_PER_PHASE
    for (int ph = 0; ph < N_PHASES; ++ph) { a.ph_lo = ph; a.ph_hi = ph + 1; a.li = ph;
        hipLaunchKernelGGL(mk_fwd, dim3(grid), dim3(NWAVES * 64), LDS_BYTES, stream, a); }
#else
    a.ph_lo = 0; a.ph_hi = N_PHASES; a.li = 0;
#ifdef PROBE_PHASE
#ifndef PROBE_MODE
#define PROBE_MODE 1
#endif
    { void* kargs0[] = {&a};
      hipError_t e0 = hipLaunchCooperativeKernel((const void*)mk_fwd, dim3(grid), dim3(NWAVES * 64), kargs0, LDS_BYTES, stream);
      if (e0 != hipSuccess) fprintf(stderr, "kernel_launch: cooperative launch failed: %s (grid %d)\n", hipGetErrorString(e0), grid);
      Args a2 = a; a2.ph_lo = PROBE_PHASE; a2.ph_hi = PROBE_PHASE + 1; a2.pad = PROBE_MODE;
      hipLaunchKernelGGL(mk_probe, dim3(grid), dim3(NWAVES * 64), LDS_BYTES, stream, a2); }
#elif defined(MK_PLAIN_LAUNCH)
    hipLaunchKernelGGL(mk_fwd, dim3(grid), dim3(NWAVES * 64), LDS_BYTES, stream, a);
#else
    void* kargs[] = {&a};
    hipError_t e = hipLaunchCooperativeKernel((const void*)mk_fwd, dim3(grid), dim3(NWAVES * 64), kargs, LDS_BYTES, stream);
    if (e != hipSuccess) fprintf(stderr, "kernel_launch: cooperative launch failed: %s (grid %d)\n", hipGetErrorString(e), grid);
#endif
#endif
}
```

```cpp
#include <hip/hip_runtime.h>
#include <cstdio>
#include <cstdint>
namespace pg8 {
#define PG8_LAS __attribute__((address_space(3)))
typedef unsigned short bf16_t;
typedef short bf16x8 __attribute__((ext_vector_type(8)));
typedef float f32x4 __attribute__((ext_vector_type(4)));
typedef unsigned u32x4 __attribute__((ext_vector_type(4)));
constexpr int BM = 256, BK = 64, HALF = 128, HTB = HALF * BK * 2  , STAGE_BYTES = 8 * HTB, NXCD = 8, WGM = 8;

__host__ __device__ __forceinline__ int lds_byte(int r, int c) { const int st = (r >> 4) * 2 + (c >> 5), rr = r & 15, cc = c & 31, ob = rr * 64 + cc * 2; return st * 1024 + (ob ^ (((ob >> 9) & 1) << 5)); }
__host__ __device__ __forceinline__ void stage_rc(int b, int& R, int& C) { const int st = b / 1024, sb = b % 1024, swz = sb ^ (((sb >> 9) & 1) << 5); R = (st >> 1) * 16 + swz / 64; C = (st & 1) * 32 + (swz % 64) / 2; }
__host__ __device__ __forceinline__ int perm32(int rho) { const int n = rho >> 4, i = rho & 15; return 8 * (i >> 2) + 4 * n + (i & 3); }

struct Unit { int pm, pn; };
struct Gemm { const bf16_t* A; const bf16_t* Bt; int M, N, K; };

struct StaticOrder {
    int nM, nN, nwg, G, c;
    __host__ __device__ void init(int M, int N, int G_, int c_) { nM = M / BM; nN = N / BM; nwg = nM * nN; G = G_; c = c_; }
    __host__ __device__ bool next(int i, Unit& u) const {
        const long L = (long)i * G + c; if (L >= nwg) return false;
        int wgid = (int)L; { const int q = nwg / NXCD, r = nwg % NXCD, xcd = wgid % NXCD, off = wgid / NXCD; wgid = (xcd < r ? xcd * (q + 1) : r * (q + 1) + (xcd - r) * q) + off; }
        const int nig = WGM * nN, gid = wgid / nig, fm = gid * WGM, gsz = (nM - fm) < WGM ? (nM - fm) : WGM;
        u.pm = fm + ((wgid % nig) % gsz); u.pn = (wgid % nig) / gsz; return true;
    }
    __device__ __forceinline__ void a_ready(const Unit&) const {}
    __device__ __forceinline__ void done(const Unit&) const {}
};
struct RoundOrder : StaticOrder {
    int round;
    __host__ __device__ bool next(int i, Unit& u) const { return i == 0 && StaticOrder::next(round, u); }
};
template <int WG_M> struct StaticOrderT {
    int nM, nN, nwg, G, c;
    __host__ __device__ void init(int M, int N, int G_, int c_) { nM = M / BM; nN = N / BM; nwg = nM * nN; G = G_; c = c_; }
    __host__ __device__ bool next(int i, Unit& u) const {
        const long L = (long)i * G + c; if (L >= nwg) return false;
        int wgid = (int)L; { const int q = nwg / NXCD, r = nwg % NXCD, xcd = wgid % NXCD, off = wgid / NXCD; wgid = (xcd < r ? xcd * (q + 1) : r * (q + 1) + (xcd - r) * q) + off; }
        const int nig = WG_M * nN, gid = wgid / nig, fm = gid * WG_M, gsz = (nM - fm) < WG_M ? (nM - fm) : WG_M;
        u.pm = fm + ((wgid % nig) % gsz); u.pn = (wgid % nig) / gsz; return true;
    }
    __device__ __forceinline__ void a_ready(const Unit&) const {}
    __device__ __forceinline__ void done(const Unit&) const {}
};

__device__ __forceinline__ unsigned cvt_pk_bf16(float lo, float hi) { unsigned r; asm volatile("v_cvt_pk_bf16_f32 %0, %1, %2" : "=v"(r) : "v"(lo), "v"(hi)); return r; }
typedef float f32x2 __attribute__((ext_vector_type(2)));
__device__ __forceinline__ f32x2 gelu_pk(f32x2 v) {
    const f32x2 av = __builtin_elementwise_abs(v), d = av * 0.2316418882f + 1.0f;
    f32x2 t; t.x = __builtin_amdgcn_rcpf(d.x); t.y = __builtin_amdgcn_rcpf(d.y);
    f32x2 q = t * 0.5307027145f + (-0.7265760135f); q = q * t + 0.7107068705f; q = q * t + (-0.142248368f); q = q * t + 0.127414796f; q = q * t;
    const f32x2 s = (v * v) * (-0.72134752044f);
    f32x2 e; e.x = __builtin_amdgcn_exp2f(s.x); e.y = __builtin_amdgcn_exp2f(s.y);
    const f32x2 m = v * (q * e), r = v - m;
    f32x2 o; o.x = v.x < 0.f ? m.x : r.x; o.y = v.y < 0.f ? m.y : r.y; return o;
}


constexpr float RMS_EPS = 1e-6f;
__device__ __forceinline__ float sigm(float x) { return __builtin_amdgcn_rcpf(1.0f + __expf(-x)); }
__device__ __forceinline__ u32x4 pack8(const f32x4 v0, const f32x4 v1) { u32x4 w; w.x = cvt_pk_bf16(v0[0], v0[1]); w.y = cvt_pk_bf16(v0[2], v0[3]); w.z = cvt_pk_bf16(v1[0], v1[1]); w.w = cvt_pk_bf16(v1[2], v1[3]); return w; }
__device__ __forceinline__ void store16_wt(void* p, u32x4 v) { asm volatile("global_store_dwordx4 %0, %1, off sc1 nt\n\ts_nop 1" :: "v"(p), "v"(v) : "memory"); }
__device__ __forceinline__ void store16_nt(void* p, u32x4 v) { asm volatile("global_store_dwordx4 %0, %1, off sc1 nt\n\ts_nop 1" :: "v"(p), "v"(v) : "memory"); }
__device__ __forceinline__ void keep_alive(const f32x4 (&acc)[2][2][4][2]) {
#pragma unroll
    for (int a = 0; a < 2; ++a)
#pragma unroll
        for (int b = 0; b < 2; ++b)
#pragma unroll
            for (int m = 0; m < 4; ++m)
#pragma unroll
                for (int n = 0; n < 2; ++n) asm volatile("" :: "v"(acc[a][b][m][n]));
}
typedef unsigned long long u64_t;
__device__ __forceinline__ float ssq_f(u64_t v) { return fmaf((float)(unsigned)(v >> 32), 4294967296.0f, (float)(unsigned)v); }
__device__ __forceinline__ float rstd_of(u64_t ssq) { return __builtin_amdgcn_rsqf(fmaf(ssq_f(ssq), 1.0f / (1024.0f * 1048576.0f), RMS_EPS)); }
__device__ __forceinline__ u64_t ssq_fix(float s) { return (u64_t)(s * 1048576.0f); }

struct EpiInL0 {
    static constexpr bool PERM = true, AFTER_DRAIN = false;
    bf16_t* UB; bf16_t* PB; const u64_t* ssq;
    __device__ __forceinline__ void operator()(const f32x4 (&acc)[2][2][4][2], const Unit& u, int wr, int wc, int fr, int fq) const {
        const int row0 = u.pm * BM + wr * 64 + fr, cw = wc * 32 + 8 * fq;
        u64_t q[2][4];
#pragma unroll
        for (int ai = 0; ai < 2; ++ai)
#pragma unroll
            for (int m = 0; m < 4; ++m) q[ai][m] = ssq[row0 + ai * HALF + m * 16];
#pragma unroll
        for (int ai = 0; ai < 2; ++ai)
#pragma unroll
            for (int m = 0; m < 4; ++m) {
                const int row = row0 + ai * HALF + m * 16;
                const float rs = rstd_of(q[ai][m]), c1 = rs * -1.4426950408889634f;
                if (u.pn < 4) {
                    f32x4 o[2];
#pragma unroll
                    for (int n = 0; n < 2; ++n)
#pragma unroll
                        for (int j = 0; j < 4; j += 2) {
                            const f32x2 a = {acc[ai][0][m][n][j], acc[ai][0][m][n][j + 1]}, g = {acc[ai][1][m][n][j], acc[ai][1][m][n][j + 1]};
                            const f32x2 t = g * c1; f32x2 e; e.x = __builtin_amdgcn_exp2f(t.x); e.y = __builtin_amdgcn_exp2f(t.y);
                            const f32x2 d = e + 1.0f; f32x2 r; r.x = __builtin_amdgcn_rcpf(d.x); r.y = __builtin_amdgcn_rcpf(d.y);
                            const f32x2 h = a * (r * rs); o[n][j] = h.x; o[n][j + 1] = h.y; }
                    store16_wt(UB + (size_t)row * 512 + u.pn * 128 + cw, pack8(o[0], o[1]));
                } else {
#pragma unroll
                    for (int bj = 0; bj < 2; ++bj) store16_wt(PB + (size_t)row * 512 + (u.pn - 4) * 256 + bj * HALF + cw, pack8(acc[ai][bj][m][0] * rs, acc[ai][bj][m][1] * rs));
                }
            }
    }
};
struct EpiResid {
    static constexpr bool PERM = true, AFTER_DRAIN = false;
    bf16_t* XB; u64_t* ssq; bf16_t* XBw; int probe_mode; bool wt;
    __device__ __forceinline__ void operator()(const f32x4 (&acc)[2][2][4][2], const Unit& u, int wr, int wc, int fr, int fq) const {
        const int row0 = u.pm * BM + wr * 64 + fr, cw = u.pn * BM + wc * 32 + 8 * fq;
        if (probe_mode == 2) { keep_alive(acc); return; }
        u32x4 r[2][4][2];
#pragma unroll
        for (int ai = 0; ai < 2; ++ai)
#pragma unroll
            for (int m = 0; m < 4; ++m)
#pragma unroll
                for (int bj = 0; bj < 2; ++bj) r[ai][m][bj] = *(const u32x4*)(XB + (size_t)(row0 + ai * HALF + m * 16) * 1024 + bj * HALF + cw);
#pragma unroll
        for (int ai = 0; ai < 2; ++ai)
#pragma unroll
            for (int m = 0; m < 4; ++m) {
                const int row = row0 + ai * HALF + m * 16;
                f32x2 s2 = {0.f, 0.f};
#pragma unroll
                for (int bj = 0; bj < 2; ++bj) {
                    const u32x4 rr = r[ai][m][bj];
                    const f32x2 a0 = {acc[ai][bj][m][0][0], acc[ai][bj][m][0][1]}, a1 = {acc[ai][bj][m][0][2], acc[ai][bj][m][0][3]}, a2 = {acc[ai][bj][m][1][0], acc[ai][bj][m][1][1]}, a3 = {acc[ai][bj][m][1][2], acc[ai][bj][m][1][3]};
                    const f32x2 v0 = a0 + (f32x2){__builtin_bit_cast(float, rr.x << 16), __builtin_bit_cast(float, rr.x & 0xffff0000u)};
                    const f32x2 v1 = a1 + (f32x2){__builtin_bit_cast(float, rr.y << 16), __builtin_bit_cast(float, rr.y & 0xffff0000u)};
                    const f32x2 v2 = a2 + (f32x2){__builtin_bit_cast(float, rr.z << 16), __builtin_bit_cast(float, rr.z & 0xffff0000u)};
                    const f32x2 v3 = a3 + (f32x2){__builtin_bit_cast(float, rr.w << 16), __builtin_bit_cast(float, rr.w & 0xffff0000u)};
                    u32x4 w; w.x = cvt_pk_bf16(v0.x, v0.y); w.y = cvt_pk_bf16(v1.x, v1.y); w.z = cvt_pk_bf16(v2.x, v2.y); w.w = cvt_pk_bf16(v3.x, v3.y);
                    if (wt) store16_wt(XBw + ((size_t)row * 1024 + bj * HALF + cw), w); else *(u32x4*)(XBw + ((size_t)row * 1024 + bj * HALF + cw)) = w;
                    s2 = v0 * v0 + s2; s2 = v1 * v1 + s2; s2 = v2 * v2 + s2; s2 = v3 * v3 + s2;
                }
                float s = s2.x + s2.y;
                s += __shfl_xor(s, 16); s += __shfl_xor(s, 32);
                if (fq == 0) atomicAdd(ssq + row, ssq_fix(s));
            }
    }
};
struct EpiSwiGLU {
    static constexpr bool PERM = true, AFTER_DRAIN = false;
    bf16_t* H; const u64_t* ssq; int probe_mode;
    __device__ __forceinline__ void operator()(const f32x4 (&acc)[2][2][4][2], const Unit& u, int wr, int wc, int fr, int fq) const {
        const int row0 = u.pm * BM + wr * 64 + fr, cw = wc * 32 + 8 * fq;
        if (probe_mode == 2) { keep_alive(acc); return; }
        u64_t q[2][4];
#pragma unroll
        for (int ai = 0; ai < 2; ++ai)
#pragma unroll
            for (int m = 0; m < 4; ++m) q[ai][m] = ssq[row0 + ai * HALF + m * 16];
#pragma unroll
        for (int ai = 0; ai < 2; ++ai)
#pragma unroll
            for (int m = 0; m < 4; ++m) {
                const int row = row0 + ai * HALF + m * 16;
                const float rs = rstd_of(q[ai][m]), c1 = rs * -1.4426950408889634f, rs2 = rs * rs;
                f32x4 o[2];
#pragma unroll
                for (int n = 0; n < 2; ++n)
#pragma unroll
                    for (int j = 0; j < 4; j += 2) {
                        const f32x2 g = {acc[ai][0][m][n][j], acc[ai][0][m][n][j + 1]}, up = {acc[ai][1][m][n][j], acc[ai][1][m][n][j + 1]};
                        const f32x2 t = g * c1; f32x2 e; e.x = __builtin_amdgcn_exp2f(t.x); e.y = __builtin_amdgcn_exp2f(t.y);
                        const f32x2 d = e + 1.0f; f32x2 r; r.x = __builtin_amdgcn_rcpf(d.x); r.y = __builtin_amdgcn_rcpf(d.y);
                        const f32x2 h = (g * up) * (r * rs2); o[n][j] = h.x; o[n][j + 1] = h.y; }
                { const u32x4 hw = pack8(o[0], o[1]); if (probe_mode == 30) asm volatile("" :: "v"(hw)); else store16_nt(H + (size_t)row * 2816 + u.pn * 128 + cw, hw); }
            }
    }
};
struct EpiPQT {
    static constexpr bool PERM = true, AFTER_DRAIN = false;
    bf16_t* PQT; const u64_t* ssq; int probe_mode;
    __device__ __forceinline__ void operator()(const f32x4 (&acc)[2][2][4][2], const Unit& u, int wr, int wc, int fr, int fq) const {
        if (probe_mode == 2) { keep_alive(acc); return; }
        const int tok0 = u.pn * BM + wc * 32 + 8 * fq, b = (u.pn * BM) >> 12;
#pragma unroll
        for (int bj = 0; bj < 2; ++bj) {
            u64_t q[8];
#pragma unroll
            for (int j = 0; j < 8; ++j) q[j] = ssq[tok0 + bj * HALF + j];
            f32x4 rs0, rs1;
#pragma unroll
            for (int j = 0; j < 4; ++j) { rs0[j] = rstd_of(q[j]); rs1[j] = rstd_of(q[4 + j]); }
#pragma unroll
            for (int ai = 0; ai < 2; ++ai)
#pragma unroll
                for (int m = 0; m < 4; ++m) {
                    const int r = u.pm * BM + ai * HALF + wr * 64 + m * 16 + fr, pq = r >> 9, ch = r & 511;
                    bf16_t* base = PQT + ((size_t)(b * 512 + ch) * 2 + pq) * 4096;
                    store16_wt(base + ((tok0 + bj * HALF) & 4095), pack8(acc[ai][bj][m][0] * rs0, acc[ai][bj][m][1] * rs1));
                }
        }
    }
};
struct EpiGeluUV {
    static constexpr bool PERM = true, AFTER_DRAIN = false;
    bf16_t* U; bf16_t* V; const u64_t* ssq; int probe_mode;
    __device__ __forceinline__ void operator()(const f32x4 (&acc)[2][2][4][2], const Unit& u, int wr, int wc, int fr, int fq) const {
        if (probe_mode == 2) { keep_alive(acc); return; }
        const int row0 = u.pm * BM + wr * 64 + fr, cw = wc * 32 + 8 * fq;
        bf16_t* dst = (u.pn < 2) ? U : V; const int colb = (u.pn & 1) * BM;
        u64_t q[2][4];
#pragma unroll
        for (int ai = 0; ai < 2; ++ai)
#pragma unroll
            for (int m = 0; m < 4; ++m) q[ai][m] = ssq[row0 + ai * HALF + m * 16];
#pragma unroll
        for (int ai = 0; ai < 2; ++ai)
#pragma unroll
            for (int m = 0; m < 4; ++m) {
                const int row = row0 + ai * HALF + m * 16;
                const float rs = rstd_of(q[ai][m]);
#pragma unroll
                for (int bj = 0; bj < 2; ++bj) {
                    const f32x4 v0 = acc[ai][bj][m][0] * rs, v1 = acc[ai][bj][m][1] * rs;
                    const f32x2 a = gelu_pk((f32x2){v0[0], v0[1]}), bq = gelu_pk((f32x2){v0[2], v0[3]}), c = gelu_pk((f32x2){v1[0], v1[1]}), d = gelu_pk((f32x2){v1[2], v1[3]});
                    store16_wt(dst + (size_t)row * 512 + colb + bj * HALF + cw, pack8((f32x4){a.x, a.y, bq.x, bq.y}, (f32x4){c.x, c.y, d.x, d.y}));
                }
            }
    }
};
struct EpiDFT2 {
    static constexpr bool PERM = true, AFTER_DRAIN = false;
    bf16_t* AM;
    __device__ __forceinline__ void operator()(const f32x4 (&acc)[2][2][4][2], const Unit& u, int wr, int wc, int fr, int fq) const {
#pragma unroll
        for (int bj = 0; bj < 2; ++bj) {
            const int n = u.pn * BM + bj * HALF + wc * 32 + 8 * fq, b = n >> 13, t1 = (n >> 9) & 15, ch = n & 511;
            bf16_t* base = AM + (size_t)(b * 4096 + t1) * 1024 + ch;
#pragma unroll
            for (int ai = 0; ai < 2; ++ai)
#pragma unroll
                for (int m = 0; m < 4; ++m) { const int t2 = ai * HALF + wr * 64 + m * 16 + fr;
                    store16_wt(base + (size_t)(16 * t2) * 1024, pack8(acc[ai][bj][m][0], acc[ai][bj][m][1])); }
        }
    }
};


struct EpiSGU {
    static constexpr bool PERM = true, AFTER_DRAIN = true;
    bf16_t* AM; const u64_t* ssq; const float* lng; const float* lnb; const bf16_t* WSB; const float* sb;
    __device__ __forceinline__ void fused(f32x4 (&acc)[2][2][4][2], const Unit& u, int wr, int wc, int fr, int fq, PG8_LAS unsigned char* lds, int wid, int lane) const {
        const int h = u.pn, row0 = u.pm * BM + wr * 64 + fr, cw = wc * 32 + 8 * fq;
        PG8_LAS f32x2* Pt = (PG8_LAS f32x2*)lds;
        PG8_LAS bf16_t* vnT = (PG8_LAS bf16_t*)(lds + 8192);
        u64_t q[2][4];
#pragma unroll
        for (int ai = 0; ai < 2; ++ai)
#pragma unroll
            for (int m = 0; m < 4; ++m) q[ai][m] = ssq[row0 + ai * HALF + m * 16];
#pragma unroll
        for (int ai = 0; ai < 2; ++ai)
#pragma unroll
            for (int m = 0; m < 4; ++m) {
                const float rs = rstd_of(q[ai][m]);
                float s = 0.f, s2 = 0.f;
#pragma unroll
                for (int bj = 0; bj < 2; ++bj)
#pragma unroll
                    for (int n = 0; n < 2; ++n) {
                        const f32x4 v = acc[ai][bj][m][n] * rs;
                        const f32x2 a = gelu_pk((f32x2){v[0], v[1]}), b = gelu_pk((f32x2){v[2], v[3]});
                        acc[ai][bj][m][n] = (f32x4){a.x, a.y, b.x, b.y};
                        if (bj == 1) { s += (a.x + a.y) + (b.x + b.y); s2 += (a.x * a.x + a.y * a.y) + (b.x * b.x + b.y * b.y); }
                    }
                s += __shfl_xor(s, 16); s += __shfl_xor(s, 32); s2 += __shfl_xor(s2, 16); s2 += __shfl_xor(s2, 32);
                if (fq == 0) Pt[(ai * HALF + wr * 64 + m * 16 + fr) * 4 + wc] = (f32x2){s, s2};
            }
        asm volatile("s_waitcnt lgkmcnt(0)" ::: "memory"); __builtin_amdgcn_s_barrier(); asm volatile("" ::: "memory");
        f32x4 g0 = *(const f32x4*)(lng + h * 128 + cw), g1 = *(const f32x4*)(lng + h * 128 + cw + 4), b0 = *(const f32x4*)(lnb + h * 128 + cw), b1 = *(const f32x4*)(lnb + h * 128 + cw + 4);
#pragma unroll
        for (int ai = 0; ai < 2; ++ai)
#pragma unroll
            for (int m = 0; m < 4; ++m) {
                const int k = wr * 64 + m * 16 + fr;
                const PG8_LAS f32x2* pp = Pt + (ai * HALF + k) * 4;
                const f32x2 p0 = pp[0], p1 = pp[1], p2 = pp[2], p3 = pp[3];
                const float sm = (p0.x + p1.x) + (p2.x + p3.x), sq = (p0.y + p1.y) + (p2.y + p3.y);
                const float mean = sm * (1.0f / 128.0f), rstd = __builtin_amdgcn_rsqf(fmaxf(sq * (1.0f / 128.0f) - mean * mean, 0.f) + 1e-6f);
                PG8_LAS bf16_t* dst = vnT + (size_t)ai * (128 * 136) + (size_t)cw * 136 + k;
                const f32x4 v0 = (acc[ai][1][m][0] - mean) * rstd * g0 + b0, v1 = (acc[ai][1][m][1] - mean) * rstd * g1 + b1;
                const unsigned w0 = cvt_pk_bf16(v0[0], v0[1]), w1 = cvt_pk_bf16(v0[2], v0[3]), w2 = cvt_pk_bf16(v1[0], v1[1]), w3 = cvt_pk_bf16(v1[2], v1[3]);
                dst[0 * 136] = (bf16_t)w0; dst[1 * 136] = (bf16_t)(w0 >> 16); dst[2 * 136] = (bf16_t)w1; dst[3 * 136] = (bf16_t)(w1 >> 16);
                dst[4 * 136] = (bf16_t)w2; dst[5 * 136] = (bf16_t)(w2 >> 16); dst[6 * 136] = (bf16_t)w3; dst[7 * 136] = (bf16_t)(w3 >> 16);
            }
        asm volatile("s_waitcnt lgkmcnt(0)" ::: "memory"); __builtin_amdgcn_s_barrier(); asm volatile("" ::: "memory");
        f32x4 sv[2][4][2];
#pragma unroll
        for (int ai = 0; ai < 2; ++ai)
#pragma unroll
            for (int m = 0; m < 4; ++m)
#pragma unroll
                for (int n = 0; n < 2; ++n) sv[ai][m][n] = (f32x4){0.f, 0.f, 0.f, 0.f};
        const int crow = wc * 32 + 8 * (fr >> 2) + (fr & 3);
#pragma unroll
        for (int ks = 0; ks < 4; ++ks) {
            bf16x8 xf[2][2];
#pragma unroll
            for (int ai = 0; ai < 2; ++ai)
#pragma unroll
                for (int n = 0; n < 2; ++n) xf[ai][n] = *(const PG8_LAS bf16x8*)(vnT + (size_t)ai * (128 * 136) + (size_t)(crow + 4 * n) * 136 + ks * 32 + 8 * fq);
#pragma unroll
            for (int m = 0; m < 4; ++m) {
                const bf16x8 yf = *(const bf16x8*)(WSB + (size_t)(h * 128 + wr * 64 + m * 16 + fr) * 128 + ks * 32 + 8 * fq);
#pragma unroll
                for (int ai = 0; ai < 2; ++ai)
#pragma unroll
                    for (int n = 0; n < 2; ++n) sv[ai][m][n] = __builtin_amdgcn_mfma_f32_16x16x32_bf16(xf[ai][n], yf, sv[ai][m][n], 0, 0, 0);
            }
        }
#pragma unroll
        for (int m = 0; m < 4; ++m) {
            const float bias = sb[h * 128 + wr * 64 + m * 16 + fr];
#pragma unroll
            for (int ai = 0; ai < 2; ++ai) {
                const f32x4 o0 = acc[ai][0][m][0] * (sv[ai][m][0] + bias), o1 = acc[ai][0][m][1] * (sv[ai][m][1] + bias);
                store16_wt(AM + (size_t)(row0 + ai * HALF + m * 16) * 1024 + 512 + h * 128 + cw, pack8(o0, o1));
            }
        }
        asm volatile("s_waitcnt lgkmcnt(0)" ::: "memory"); __builtin_amdgcn_s_barrier(); asm volatile("" ::: "memory");
    }
};
template <class Epi, class Sched, bool ALIGN_EPI = false, bool SP2 = false>
__device__ __forceinline__ void gemm_phase(PG8_LAS unsigned char* lds, const Gemm g, const Sched& S, const Epi& E) {
    const int tid = threadIdx.x, wid = __builtin_amdgcn_readfirstlane(tid >> 6), lane = tid & 63, wr = wid >> 2, wc = wid & 3, fr = lane & 15, fq = lane >> 4;
    const int K = g.K, nt = K / BK;
    unsigned voffA[2], voffB[2];
#pragma unroll
    for (int i = 0; i < 2; ++i) { int R, C; stage_rc(tid * 16 + i * 8192, R, C); const int Rb = Epi::PERM ? ((R & ~31) + perm32(R & 31)) : R;
        voffA[i] = (unsigned)(R * K + C) * 2u; voffB[i] = (unsigned)(Rb * K + C) * 2u; }
    const size_t kstep = (size_t)(BK * 2);
    const size_t hstep = (size_t)HALF * K * 2;
    const size_t tstep = 2 * hstep;
    const unsigned ldsw = (unsigned)wid * 1024u;
    const int aoff = lds_byte(wr * 64 + fr, fq * 8), boff = lds_byte(wc * 32 + fr, fq * 8);
#define PG8_SA(b, h) (((b) * 2 + (h)) * HTB)
#define PG8_SB(b, h) ((4 + (b) * 2 + (h)) * HTB)
#define PG8_STAGE(bufoff, gbase, voff) do { _Pragma("unroll") for (int _i = 0; _i < 2; ++_i) \
        __builtin_amdgcn_global_load_lds((const unsigned*)((const char*)(gbase) + (voff)[_i]), (PG8_LAS unsigned*)(lds + (bufoff) + ldsw + _i * 8192), 16, 0, 0); } while (0)
#define PG8_LDA(dst, b, h) do { _Pragma("unroll") for (int m = 0; m < 4; ++m) _Pragma("unroll") for (int k = 0; k < 2; ++k) dst[m][k] = *(const PG8_LAS bf16x8*)(lds + PG8_SA(b, h) + aoff + m * 2048 + k * 1024); } while (0)
#define PG8_LDB(dst, b, h) do { _Pragma("unroll") for (int n = 0; n < 2; ++n) _Pragma("unroll") for (int k = 0; k < 2; ++k) dst[n][k] = *(const PG8_LAS bf16x8*)(lds + PG8_SB(b, h) + boff + n * 2048 + k * 1024); } while (0)
#define PG8_MMA(ai, bj, At, Bt) do { __builtin_amdgcn_s_setprio(1); _Pragma("unroll") for (int m = 0; m < 4; ++m) _Pragma("unroll") for (int n = 0; n < 2; ++n) _Pragma("unroll") for (int k = 0; k < 2; ++k) \
        acc[ai][bj][m][n] = __builtin_amdgcn_mfma_f32_16x16x32_bf16(Bt[n][k], At[m][k], acc[ai][bj][m][n], 0, 0, 0); __builtin_amdgcn_s_setprio(0); } while (0)
#define PG8_WAIT_V(n) asm volatile("s_waitcnt vmcnt(" #n ")" ::: "memory")
#define PG8_WAIT_L(n) asm volatile("s_waitcnt lgkmcnt(" #n ")" ::: "memory")
#define PG8_BAR __builtin_amdgcn_s_barrier()
#define PG8_SCHED __builtin_amdgcn_sched_barrier(0)
    Unit cur, nxt; int ui = 0;
    if (!S.next(0, cur)) return;
    f32x4 acc[2][2][4][2];
#pragma unroll
    for (int a = 0; a < 2; ++a)
#pragma unroll
        for (int b = 0; b < 2; ++b)
#pragma unroll
            for (int m = 0; m < 4; ++m)
#pragma unroll
                for (int n = 0; n < 2; ++n) acc[a][b][m][n] = (f32x4){0.f, 0.f, 0.f, 0.f};
    bf16x8 At[4][2], B0[2][2], B1[2][2];
    const char* cA = (const char*)g.A + (size_t)cur.pm * tstep; const char* cB = (const char*)g.Bt + (size_t)cur.pn * tstep;
    S.a_ready(cur);
    if constexpr (SP2) {
        PG8_STAGE(PG8_SB(0, 0), cB, voffB); PG8_STAGE(PG8_SB(0, 1), cB + hstep, voffB); PG8_STAGE(PG8_SA(0, 0), cA, voffA); PG8_STAGE(PG8_SA(0, 1), cA + hstep, voffA);
        if (wr == 1) PG8_BAR;
        PG8_WAIT_V(2); PG8_BAR;
        PG8_STAGE(PG8_SB(1, 0), cB + kstep, voffB); PG8_STAGE(PG8_SA(1, 0), cA + kstep, voffA); PG8_STAGE(PG8_SB(1, 1), cB + hstep + kstep, voffB);
        PG8_WAIT_V(6); PG8_BAR;
    } else {
        PG8_STAGE(PG8_SB(0, 0), cB, voffB); PG8_STAGE(PG8_SA(0, 0), cA, voffA); PG8_STAGE(PG8_SB(0, 1), cB + hstep, voffB); PG8_STAGE(PG8_SA(0, 1), cA + hstep, voffA);
        if (wr == 1) PG8_BAR;
        PG8_WAIT_V(4); PG8_BAR;
        PG8_STAGE(PG8_SB(1, 0), cB + kstep, voffB); PG8_STAGE(PG8_SA(1, 0), cA + kstep, voffA); PG8_STAGE(PG8_SB(1, 1), cB + hstep + kstep, voffB);
        PG8_WAIT_V(6); PG8_BAR;
    }
    for (;;) {
        const bool has_next = S.next(ui + 1, nxt);
        const char* nA = has_next ? (const char*)g.A + (size_t)nxt.pm * tstep : cA; const char* nB = has_next ? (const char*)g.Bt + (size_t)nxt.pn * tstep : cB;
        for (int t = 0; t < nt; t += 2) {
            const bool last = (t == nt - 2);
            const char* a1 = cA + (size_t)(t + 1) * kstep;
            const char* a2 = last ? nA : cA + (size_t)(t + 2) * kstep; const char* b2 = last ? nB : cB + (size_t)(t + 2) * kstep;
            const char* a3 = a2 + kstep; const char* b3 = b2 + kstep;
            if (last && has_next) S.a_ready(nxt);
            if constexpr (SP2) {
            PG8_LDB(B0, 0, 0); PG8_LDB(B1, 0, 1); PG8_SCHED; PG8_LDA(At, 0, 0); PG8_STAGE(PG8_SA(1, 1), a1 + hstep, voffA);
            PG8_WAIT_V(8); PG8_WAIT_L(0); PG8_BAR; PG8_MMA(0, 0, At, B0); PG8_MMA(0, 1, At, B1); PG8_BAR; PG8_SCHED;
            PG8_LDA(At, 0, 1); PG8_STAGE(PG8_SB(0, 0), b2, voffB); PG8_STAGE(PG8_SB(0, 1), b2 + hstep, voffB); PG8_STAGE(PG8_SA(0, 0), a2, voffA);
            PG8_WAIT_V(8); PG8_WAIT_L(0); PG8_BAR; PG8_MMA(1, 0, At, B0); PG8_MMA(1, 1, At, B1); PG8_BAR; PG8_SCHED;
            PG8_LDB(B0, 1, 0); PG8_LDB(B1, 1, 1); PG8_SCHED; PG8_LDA(At, 1, 0); PG8_STAGE(PG8_SA(0, 1), a2 + hstep, voffA);
            PG8_WAIT_V(8); PG8_WAIT_L(0); PG8_BAR; PG8_MMA(0, 0, At, B0); PG8_MMA(0, 1, At, B1); PG8_BAR; PG8_SCHED;
            PG8_LDA(At, 1, 1); PG8_STAGE(PG8_SB(1, 0), b3, voffB); PG8_STAGE(PG8_SB(1, 1), b3 + hstep, voffB); PG8_STAGE(PG8_SA(1, 0), a3, voffA);
            PG8_WAIT_V(8); PG8_WAIT_L(0); PG8_BAR; PG8_MMA(1, 0, At, B0); PG8_MMA(1, 1, At, B1); PG8_BAR; PG8_SCHED;
            } else {
            PG8_LDB(B0, 0, 0); PG8_SCHED; PG8_LDA(At, 0, 0); PG8_STAGE(PG8_SA(1, 1), a1 + hstep, voffA);
            PG8_WAIT_L(8); PG8_BAR; PG8_WAIT_L(0); PG8_MMA(0, 0, At, B0); PG8_BAR; PG8_SCHED;
            PG8_LDB(B1, 0, 1); PG8_STAGE(PG8_SB(0, 0), b2, voffB);
            PG8_BAR; PG8_WAIT_L(0); PG8_MMA(0, 1, At, B1); PG8_BAR;
            PG8_LDA(At, 0, 1); PG8_STAGE(PG8_SA(0, 0), a2, voffA);
            PG8_BAR; PG8_WAIT_L(0); PG8_MMA(1, 0, At, B0); PG8_BAR; PG8_SCHED;
            PG8_STAGE(PG8_SB(0, 1), b2 + hstep, voffB);
            PG8_WAIT_V(6); PG8_BAR; PG8_MMA(1, 1, At, B1); PG8_BAR;
            PG8_LDB(B0, 1, 0); PG8_SCHED; PG8_LDA(At, 1, 0); PG8_STAGE(PG8_SA(0, 1), a2 + hstep, voffA);
            PG8_WAIT_L(8); PG8_BAR; PG8_WAIT_L(0); PG8_MMA(0, 0, At, B0); PG8_BAR; PG8_SCHED;
            PG8_LDB(B1, 1, 1); PG8_STAGE(PG8_SB(1, 0), b3, voffB);
            PG8_BAR; PG8_WAIT_L(0); PG8_MMA(0, 1, At, B1); PG8_BAR;
            PG8_LDA(At, 1, 1); PG8_STAGE(PG8_SA(1, 0), a3, voffA);
            PG8_BAR; PG8_WAIT_L(0); PG8_MMA(1, 0, At, B0); PG8_BAR; PG8_SCHED;
            PG8_STAGE(PG8_SB(1, 1), b3 + hstep, voffB);
            PG8_WAIT_V(6); PG8_BAR; PG8_MMA(1, 1, At, B1); PG8_BAR;
            }
        }
        if constexpr (ALIGN_EPI) { if (wr == 0) PG8_BAR; }
        if constexpr (!Epi::AFTER_DRAIN) { E(acc, cur, wr, wc, fr, fq); S.done(cur); }
        if (!has_next) break;
#pragma unroll
        for (int a = 0; a < 2; ++a)
#pragma unroll
            for (int b = 0; b < 2; ++b)
#pragma unroll
                for (int m = 0; m < 4; ++m)
#pragma unroll
                    for (int n = 0; n < 2; ++n) acc[a][b][m][n] = (f32x4){0.f, 0.f, 0.f, 0.f};
        cur = nxt; cA = nA; cB = nB; ++ui;
        if constexpr (ALIGN_EPI) { if (wr == 1) PG8_BAR; }
    }
    PG8_WAIT_V(0);
    if constexpr (!ALIGN_EPI) { if (wr == 0) PG8_BAR; }
    PG8_BAR;
    if constexpr (Epi::AFTER_DRAIN) { E.fused(acc, cur, wr, wc, fr, fq, lds, wid, lane); S.done(cur); }
#undef PG8_SA
#undef PG8_SB
#undef PG8_STAGE
#undef PG8_LDA
#undef PG8_LDB
#undef PG8_MMA
#undef PG8_WAIT_V
#undef PG8_WAIT_L
#undef PG8_BAR
#undef PG8_SCHED
}
}
#define GAS __attribute__((address_space(1)))
#define LAS __attribute__((address_space(3)))
typedef unsigned short bf16;
typedef unsigned v4u __attribute__((ext_vector_type(4)));
typedef float f32x4 __attribute__((ext_vector_type(4)));
typedef short bf16x8 __attribute__((ext_vector_type(8)));
typedef GAS unsigned gu32;
typedef GAS unsigned long long gu64;
#define RLX_AGENT __ATOMIC_RELAXED, __HIP_MEMORY_SCOPE_AGENT
#define LDS_WAIT() asm volatile("s_waitcnt lgkmcnt(0)" ::: "memory")
#define VM_WAIT() asm volatile("s_waitcnt vmcnt(0)" ::: "memory")
__device__ __forceinline__ unsigned long long rt() { return __builtin_amdgcn_s_memrealtime(); }
__device__ __forceinline__ unsigned f2bf(float f) { unsigned u = __builtin_bit_cast(unsigned, f); return (u + 0x7fffu + ((u >> 16) & 1u)) >> 16; }
__device__ __forceinline__ unsigned pk2(float lo, float hi) { return f2bf(lo) | (f2bf(hi) << 16); }

#define XB_TMO      128
#define XB_XCNT(j)  (256  + 64 * (j))
#define XB_XSUB(j)  (1280 + 64 * (j))
#define XB_XGEN(j)  (2304 + 64 * (j))
#define XB_TOP      3328
#define XB_TOPGEN   3392
#define XCD_BAR_WORDS 3456
#define XB_SPIN_CAP (1u << 18)

__device__ __forceinline__ unsigned xb_ld(unsigned* p)              { return __hip_atomic_load(p, __ATOMIC_RELAXED, __HIP_MEMORY_SCOPE_AGENT); }
__device__ __forceinline__ unsigned xb_add(unsigned* p, unsigned v) { return __hip_atomic_fetch_add(p, v, __ATOMIC_RELAXED, __HIP_MEMORY_SCOPE_AGENT); }
__device__ __forceinline__ unsigned xb_xcc_id() { return (unsigned)__builtin_amdgcn_s_getreg((3 << 11) | 20) & 0xFu; }
#define XB_SPIN(cond, bar) do { unsigned _sp = 0; while (cond) { __builtin_amdgcn_s_sleep(1); \
    if ((++_sp & 255u) == 0u) { if (xb_ld(&(bar)[XB_TMO])) break; if (_sp > XB_SPIN_CAP) { atomicAdd(&(bar)[XB_TMO], 1u); break; } } } } while (0)

struct XcdBarrier {
    unsigned* bar; unsigned x;
    volatile LAS unsigned* st;
};

__device__ __forceinline__ XcdBarrier xcd_barrier_post(unsigned* bar, volatile LAS unsigned* st) {
    XcdBarrier b; b.bar = bar; b.x = xb_xcc_id(); b.st = st;
    if (threadIdx.x == 0) (void)xb_add(&bar[XB_XCNT(b.x)], 1u);
    return b;
}
__device__ __forceinline__ void xcd_barrier_complete(unsigned* bar, unsigned x, unsigned& nloc, unsigned& nx) {
    const unsigned G = gridDim.x * gridDim.y * gridDim.z;
    unsigned sum, cnt, mine, sp = 0u;
    for (;;) {
        sum = 0u; cnt = 0u; mine = 0u;
#pragma unroll
        for (unsigned j = 0; j < 16; ++j) { const unsigned c = xb_ld(&bar[XB_XCNT(j)]); sum += c; cnt += (c > 0u) ? 1u : 0u; mine = (j == x) ? c : mine; }
        if (sum == G) break;
        __builtin_amdgcn_s_sleep(1);
        if ((++sp & 255u) == 0u) { if (xb_ld(&bar[XB_TMO])) break; if (sp > XB_SPIN_CAP) { atomicAdd(&bar[XB_TMO], 1u); break; } }
    }
    nloc = mine > 0u ? mine : 1u; nx = cnt > 0u ? cnt : 1u;
}

__device__ __forceinline__ void xcd_barrier(const XcdBarrier& b) {
    asm volatile("s_waitcnt vmcnt(0)" ::: "memory");
    __syncthreads();
    if (threadIdx.x == 0) {
        unsigned* bar = b.bar;
        __builtin_amdgcn_s_waitcnt(0);
        unsigned nloc = b.st[0], nx = b.st[1];
        if (nloc == 0u) { xcd_barrier_complete(bar, b.x, nloc, nx); b.st[0] = nloc; b.st[1] = nx; }
        const unsigned old = xb_add(&bar[XB_XSUB(b.x)], 1u);
        const unsigned gen = old / nloc;
        if (old + 1u == (gen + 1u) * nloc) {
            __builtin_amdgcn_fence(__ATOMIC_RELEASE, "agent");
            asm volatile("s_waitcnt vmcnt(0)" ::: "memory");
            const unsigned og = xb_add(&bar[XB_TOP], 1u);
            const unsigned tg = og / nx;
            if (og + 1u == (tg + 1u) * nx) xb_add(&bar[XB_TOPGEN], 1u);
            else XB_SPIN(xb_ld(&bar[XB_TOPGEN]) == tg, bar);
            __builtin_amdgcn_fence(__ATOMIC_ACQUIRE, "agent");
            xb_add(&bar[XB_XGEN(b.x)], 1u);
            asm volatile("s_waitcnt vmcnt(0)" ::: "memory");
        } else {
            XB_SPIN(xb_ld(&bar[XB_XGEN(b.x)]) == gen, bar);
            __builtin_amdgcn_fence(__ATOMIC_ACQUIRE, "agent");
            asm volatile("s_waitcnt vmcnt(0)" ::: "memory");
        }
    }
    __syncthreads();
}

constexpr int NWAVES = 8;
#ifndef MK_PER_PHASE
#define MK_PER_PHASE 0
#endif
constexpr int N_PHASES = 13;

constexpr int NB = 8, S = 4096, D = 1024, FF = 2816, M = NB * S;
typedef float f32x2g __attribute__((ext_vector_type(2)));
typedef unsigned u32x2g __attribute__((ext_vector_type(2)));

constexpr size_t MiB = 1u << 20;
constexpr size_t WS_CTL = 0, CTL_ZERO_BYTES = 32 * 1024;
constexpr size_t WS_SSQ = 46 * MiB + 512 * 1024;
constexpr size_t WS_WIN0 = 2 * MiB;
constexpr size_t WS_WOUT0 = 5 * MiB;
constexpr size_t WS_WGU0 = 7 * MiB;
constexpr size_t WS_WDN0 = 18 * MiB;
constexpr size_t WS_WPQ1 = 24 * MiB;
constexpr size_t WS_WUV1 = 26 * MiB;
constexpr size_t WS_WOUT1 = 28 * MiB;
constexpr size_t WS_WGU1 = 30 * MiB;
constexpr size_t WS_WDN1 = 41 * MiB;
constexpr size_t WS_DFT = 48 * MiB;
constexpr size_t WS_WSB = 49 * MiB;
constexpr size_t WS_XB = 112 * MiB;
constexpr size_t WS_AM = 176 * MiB;
constexpr size_t WS_H = 240 * MiB;
constexpr size_t WS_UB = WS_H, WS_PB = WS_H + 32 * MiB;
constexpr size_t WS_PQT = WS_H, WS_U1 = WS_H + 64 * MiB, WS_V1 = WS_H + 96 * MiB, WS_ZP = WS_H + 128 * MiB;
constexpr size_t WS_END = 432 * MiB;
static_assert(WS_H + (size_t)M * FF * 2 <= WS_END && WS_V1 + (size_t)M * 512 * 2 <= WS_ZP && WS_ZP + 64 * MiB <= WS_END, "d_ws map");
constexpr int CW_BAR = 4096;
static_assert((CW_BAR + 3456) * 4 <= (int)CTL_ZERO_BYTES, "barrier words inside the memset region");

constexpr int RING_OFF = 0, RING_BYTES = 131072;
constexpr int LDSCTL_OFF = RING_BYTES, MISC_OFF = LDSCTL_OFF + 320;
constexpr int LDS_BYTES = 147456;

struct Frame {
    LAS unsigned char* lds;
    volatile LAS unsigned* MISC;
    gu32* ctl;
    int tid, lane, wave;
    int vcu, G;
};
__device__ __forceinline__ float wave_sum(float v) {
#pragma unroll
    for (int o = 1; o < 64; o <<= 1) v += __shfl_xor(v, o);
    return v;
}
__device__ __forceinline__ float bf_lo(unsigned x) { return __builtin_bit_cast(float, x << 16); }
__device__ __forceinline__ float bf_hi(unsigned x) { return __builtin_bit_cast(float, x & 0xffff0000u); }
#define WG_BAR() do { asm volatile("s_waitcnt vmcnt(0) lgkmcnt(0)" ::: "memory"); __builtin_amdgcn_s_barrier(); asm volatile("" ::: "memory"); } while (0)
#define LDS_BAR() do { asm volatile("s_waitcnt lgkmcnt(0)" ::: "memory"); __builtin_amdgcn_s_barrier(); asm volatile("" ::: "memory"); } while (0)

__device__ __forceinline__ void p0_transpose_item(const float* W, int ldw, const float* gk, bf16* WT, int ldt, int k0, int n0, int dk0, int drow0, LAS float* scr, int lane) {
    float v[32];
    const float* wp = W + (size_t)(k0 + (lane >> 5)) * ldw + n0 + (lane & 31);
#pragma unroll
    for (int i = 0; i < 32; ++i) v[i] = wp[(size_t)(2 * i) * ldw];
    const int c = lane & 7;
    f32x4 g0 = {1.f, 1.f, 1.f, 1.f}, g1 = {1.f, 1.f, 1.f, 1.f};
    if (gk) { g0 = *(const GAS f32x4*)(gk + k0 + 8 * c); g1 = *(const GAS f32x4*)(gk + k0 + 8 * c + 4); }
#pragma unroll
    for (int i = 0; i < 32; ++i) scr[(2 * i + (lane >> 5)) * 33 + (lane & 31)] = v[i];
    LDS_WAIT(); asm volatile("" ::: "memory");
#pragma unroll
    for (int j = 0; j < 4; ++j) { const int n = (lane >> 3) + 8 * j; const LAS float* s = scr + (8 * c) * 33 + n;
        v4u o; o.x = pk2(s[0 * 33] * g0.x, s[1 * 33] * g0.y); o.y = pk2(s[2 * 33] * g0.z, s[3 * 33] * g0.w); o.z = pk2(s[4 * 33] * g1.x, s[5 * 33] * g1.y); o.w = pk2(s[6 * 33] * g1.z, s[7 * 33] * g1.w);
        *(GAS v4u*)(WT + (size_t)(drow0 + n) * ldt + dk0 + 8 * c) = o; }
    LDS_WAIT(); asm volatile("" ::: "memory");
}
__device__ __forceinline__ void p0_job(const float* W, int ldw, const float* gk, int kbeg, int kext, int ncol0, int next, bf16* WT, int ldt, int dkbase, int mode, int half_or_off,
                                       LAS float* scr, int lane, int gw, int NGW, int& cursor) {
    const int nkb = kext / 64, nnb = next / 32, nitems = nkb * nnb;
    int first = (gw - (cursor % NGW) + NGW) % NGW;
    for (int it = first; it < nitems; it += NGW) {
        const int kb = it / nnb, nb = it % nnb, nrel = 32 * nb;
        const int drow0 = (mode == 0) ? (half_or_off + nrel) : (256 * (nrel >> 7) + 128 * half_or_off + (nrel & 127));
        p0_transpose_item(W, ldw, gk, WT, ldt, kbeg + 64 * kb, ncol0 + nrel, dkbase + 64 * kb, drow0, scr, lane);
    }
    cursor += nitems;
}
__device__ __forceinline__ void p0_fold_item(const float* L, int lrow0, const float* sc, const float* Rm, bf16* out, int dk0, float scale, int dw, int lane) {
    const int d = 64 * dw + lane;
    float l0[8], l1[8];
    { const float s0 = sc ? sc[lane] : 1.f, s1 = sc ? sc[64 + lane] : 1.f;
#pragma unroll
      for (int j = 0; j < 8; ++j) { l0[j] = L[(size_t)(lrow0 + j) * 128 + lane] * s0; l1[j] = L[(size_t)(lrow0 + j) * 128 + 64 + lane] * s1; } }
    float acc[8];
#pragma unroll
    for (int j = 0; j < 8; ++j) acc[j] = 0.f;
#pragma unroll
    for (int cb = 0; cb < 4; ++cb) {
        float r[32];
#pragma unroll
        for (int i = 0; i < 32; ++i) r[i] = Rm[(size_t)(cb * 32 + i) * 1024 + d];
#pragma unroll
        for (int i = 0; i < 32; ++i) { const int cp = cb * 32 + i;
#pragma unroll
            for (int j = 0; j < 8; ++j) { const float lv = __builtin_bit_cast(float, __builtin_amdgcn_readlane(__builtin_bit_cast(int, cp < 64 ? l0[j] : l1[j]), cp & 63)); acc[j] = fmaf(lv, r[i], acc[j]); } }
    }
    v4u o; o.x = pk2(acc[0] * scale, acc[1] * scale); o.y = pk2(acc[2] * scale, acc[3] * scale); o.z = pk2(acc[4] * scale, acc[5] * scale); o.w = pk2(acc[6] * scale, acc[7] * scale);
    *(GAS v4u*)(out + (size_t)d * 1024 + dk0) = o;
}
__device__ __forceinline__ void p0_pq_item(const float* Win1, const float* g1, bf16* WPQ, int h, int half, int k0, const LAS float* tab, int lane) {
    const int cp = 64 * half + lane;
    float ap[8], aq[8], w0[8], w1[8];
#pragma unroll
    for (int j = 0; j < 8; ++j) { const float g = g1[k0 + j]; ap[j] = 0.f; aq[j] = 0.f; w0[j] = Win1[(size_t)(k0 + j) * 1536 + h * 128 + lane] * g; w1[j] = Win1[(size_t)(k0 + j) * 1536 + h * 128 + 64 + lane] * g; }
#pragma unroll 8
    for (int c = 0; c < 128; ++c) {
        const int ph = c * cp;
        const float cs = tab[ph & 127], sn = tab[(ph - 32) & 127];
#pragma unroll
        for (int j = 0; j < 8; ++j) { const float w = __builtin_bit_cast(float, __builtin_amdgcn_readlane(__builtin_bit_cast(int, c < 64 ? w0[j] : w1[j]), c & 63)); ap[j] = fmaf(w, cs, ap[j]); aq[j] = fmaf(w, sn, aq[j]); }
    }
    v4u o; o.x = pk2(ap[0], ap[1]); o.y = pk2(ap[2], ap[3]); o.z = pk2(ap[4], ap[5]); o.w = pk2(ap[6], ap[7]);
    *(GAS v4u*)(WPQ + (size_t)(h * 128 + cp) * 1024 + k0) = o;
    o.x = pk2(aq[0], aq[1]); o.y = pk2(aq[2], aq[3]); o.z = pk2(aq[4], aq[5]); o.w = pk2(aq[6], aq[7]);
    *(GAS v4u*)(WPQ + (size_t)(512 + h * 128 + cp) * 1024 + k0) = o;
}

struct Ptrs {
    const float* in[22]; float* out; unsigned char* ws;
};

__device__ __forceinline__ void p0_prologue(Frame& F, const Ptrs& P) {
    const float* x = P.in[0]; const float* mix_g = P.in[1]; const float* ffn_g = P.in[2];
    const float* ev_w_in = P.in[3]; const float* ev_pool_w = P.in[8]; const float* ev_pool_scale = P.in[9]; const float* ev_w_out = P.in[10];
    const float* od_w_in = P.in[11]; const float* od_fourier_w = P.in[12]; const float* od_w_out = P.in[17];
    const float* w_gate = P.in[18]; const float* w_up = P.in[19]; const float* w_down = P.in[20];
    unsigned char* ws = P.ws;
    LAS float* scr = (LAS float*)(F.lds + RING_OFF + F.wave * 8448);
    LAS float* CT = (LAS float*)(F.lds + RING_OFF + 69632);
    LAS float* tab = (LAS float*)(F.lds + RING_OFF + 69632 + 16384);
    for (int i = F.tid; i < 4096; i += NWAVES * 64) CT[i] = cospif((float)i * (1.0f / 2048.0f));
    if (F.tid < 128) tab[F.tid] = cospif((float)F.tid * (1.0f / 64.0f));
    WG_BAR();
    const int gw = F.vcu * NWAVES + F.wave, NGW = F.G * NWAVES, lane = F.lane;
    { const float* sw = P.in[15]; bf16* WSB = (bf16*)(ws + WS_WSB); const int gt = F.vcu * NWAVES * 64 + F.tid, NT = F.G * NWAVES * 64;
      for (int i = gt; i < 4 * 128 * 128 / 2; i += NT) { const f32x2g w2 = *(const GAS f32x2g*)(sw + 2 * i); *(GAS unsigned*)(WSB + 2 * i) = pk2(w2.x, w2.y); } }
    { unsigned long long* z = (unsigned long long*)(ws + WS_SSQ) + M; const int gt = F.vcu * NWAVES * 64 + F.tid, NT = F.G * NWAVES * 64;
      for (int i = gt; i < 4 * M; i += NT) z[i] = 0ull; }
    int cur = 0;
    p0_job(ev_w_in, 1536, mix_g, 0, 1024, 0, 512, (bf16*)(ws + WS_WIN0), 1024, 0, 1, 0, scr, lane, gw, NGW, cur);
    p0_job(ev_w_in, 1536, mix_g, 0, 1024, 512, 512, (bf16*)(ws + WS_WIN0), 1024, 0, 1, 1, scr, lane, gw, NGW, cur);
    p0_job(ev_w_in, 1536, mix_g, 0, 1024, 1024, 512, (bf16*)(ws + WS_WIN0), 1024, 0, 0, 1024, scr, lane, gw, NGW, cur);
    p0_job(ev_w_out, 1024, nullptr, 0, 512, 0, 1024, (bf16*)(ws + WS_WOUT0), 1024, 0, 0, 0, scr, lane, gw, NGW, cur);
    p0_job(w_gate, FF, ffn_g, 0, 1024, 0, FF, (bf16*)(ws + WS_WGU0), 1024, 0, 1, 0, scr, lane, gw, NGW, cur);
    p0_job(w_up, FF, ffn_g, 0, 1024, 0, FF, (bf16*)(ws + WS_WGU0), 1024, 0, 1, 1, scr, lane, gw, NGW, cur);
    p0_job(w_down, 1024, nullptr, 0, FF, 0, 1024, (bf16*)(ws + WS_WDN0), FF, 0, 0, 0, scr, lane, gw, NGW, cur);
    p0_job(od_w_in, 1536, mix_g + D, 0, 1024, 512, 512, (bf16*)(ws + WS_WUV1), 1024, 0, 1, 0, scr, lane, gw, NGW, cur);
    p0_job(od_w_in, 1536, mix_g + D, 0, 1024, 1024, 512, (bf16*)(ws + WS_WUV1), 1024, 0, 1, 1, scr, lane, gw, NGW, cur);
    p0_job(od_w_out, 1024, nullptr, 512, 512, 0, 1024, (bf16*)(ws + WS_WOUT1), 1024, 512, 0, 0, scr, lane, gw, NGW, cur);
    p0_job(w_gate + (size_t)D * FF, FF, ffn_g + D, 0, 1024, 0, FF, (bf16*)(ws + WS_WGU1), 1024, 0, 1, 0, scr, lane, gw, NGW, cur);
    p0_job(w_up + (size_t)D * FF, FF, ffn_g + D, 0, 1024, 0, FF, (bf16*)(ws + WS_WGU1), 1024, 0, 1, 1, scr, lane, gw, NGW, cur);
    p0_job(w_down + (size_t)FF * D, 1024, nullptr, 0, FF, 0, 1024, (bf16*)(ws + WS_WDN1), FF, 0, 0, 0, scr, lane, gw, NGW, cur);
    {
        int first = (gw - (cur % NGW) + NGW) % NGW;
        for (int it = first; it < 1024; it += NGW) { const int g = it >> 8, cc = (it >> 4) & 15, dw = it & 15;
            p0_fold_item(ev_pool_w, g * 128 + cc * 8, ev_pool_scale + g * 128, ev_w_out + (size_t)(512 + g * 128) * 1024, (bf16*)(ws + WS_WOUT0), 512 + g * 128 + cc * 8, 1.0f, dw, lane); }
        cur += 1024;
        first = (gw - (cur % NGW) + NGW) % NGW;
        for (int it = first; it < 1024; it += NGW) { const int h = it >> 8, cc = (it >> 4) & 15, dw = it & 15;
            p0_fold_item(od_fourier_w, h * 128 + cc * 8, nullptr, od_w_out + (size_t)(h * 128) * 1024, (bf16*)(ws + WS_WOUT1), h * 128 + cc * 8, 1.0f / 724.0773439350247f, dw, lane); }
        cur += 1024;
        first = (gw - (cur % NGW) + NGW) % NGW;
        for (int it = first; it < 1024; it += NGW) { const int h = it >> 8, half = (it >> 7) & 1, kc = it & 127;
            p0_pq_item(od_w_in, mix_g + D, (bf16*)(ws + WS_WPQ1), h, half, kc * 8, tab, lane); }
        cur += 1024;
    }
    {
        bf16* A2 = (bf16*)(ws + WS_DFT);
        int first = (gw - (cur % NGW) + NGW) % NGW;
        for (int t2 = first; t2 < 256; t2 += NGW) {
            const int k0 = lane * 8, sinpart = k0 >> 8, s0 = k0 & 255;
            float v[8];
#pragma unroll
            for (int e = 0; e < 8; ++e) v[e] = CT[((((s0 + e) * t2) & 255) * 16 - (sinpart ? 1024 : 0)) & (S - 1)];
            v4u o; o.x = pk2(v[0], v[1]); o.y = pk2(v[2], v[3]); o.z = pk2(v[4], v[5]); o.w = pk2(v[6], v[7]);
            *(GAS v4u*)(A2 + (size_t)t2 * 512 + k0) = o;
        }
        cur += 256;
    }
    {
        bf16* XB = (bf16*)(ws + WS_XB); unsigned long long* ssq0 = (unsigned long long*)(ws + WS_SSQ);
        for (int m0 = 8 * gw; m0 < M; m0 += 8 * NGW) {
            f32x4 v[8][4];
#pragma unroll
            for (int r = 0; r < 8; ++r) { const GAS f32x4* xr = (const GAS f32x4*)(x + (size_t)(m0 + r) * D) + lane;
#pragma unroll
                for (int j = 0; j < 4; ++j) v[r][j] = xr[64 * j]; }
#pragma unroll
            for (int r = 0; r < 8; ++r) { float s = 0.f;
#pragma unroll
                for (int j = 0; j < 4; ++j) s += (v[r][j].x * v[r][j].x + v[r][j].y * v[r][j].y) + (v[r][j].z * v[r][j].z + v[r][j].w * v[r][j].w);
                s = wave_sum(s);
                if (lane == 0) ssq0[m0 + r] = pg8::ssq_fix(s);
                GAS unsigned long long* o8 = (GAS unsigned long long*)(XB + (size_t)(m0 + r) * D) + lane;
#pragma unroll
                for (int j = 0; j < 4; ++j) o8[64 * j] = (unsigned long long)pk2(v[r][j].x, v[r][j].y) | ((unsigned long long)pk2(v[r][j].z, v[r][j].w) << 32); }
        }
    }
}

__device__ __forceinline__ float fsel(bool c, float a, float b) { return c ? a : b; }
__device__ __forceinline__ float reduce_scatter32(float (&v)[32], int lane) {
#pragma unroll
    for (int o = 16; o >= 1; o >>= 1) {
        const bool up = (lane & o) != 0;
#pragma unroll
        for (int i = 0; i < o; ++i) { const float lo_ = v[i], hi_ = v[i + o]; const float send = fsel(up, lo_, hi_), keep = fsel(up, hi_, lo_); v[i] = keep + __shfl_xor(send, o); }
#pragma unroll
        for (int i = 0; i < o; ++i) asm volatile("" : "+v"(v[i]));
    }
    return v[0] + __shfl_xor(v[0], 32);
}
__device__ __forceinline__ float reduce_scatter16(float (&v)[16], int lane) {
#pragma unroll
    for (int o = 8; o >= 1; o >>= 1) {
        const bool up = (lane & o) != 0;
#pragma unroll
        for (int i = 0; i < o; ++i) { const float lo_ = v[i], hi_ = v[i + o]; const float send = fsel(up, lo_, hi_), keep = fsel(up, hi_, lo_); v[i] = keep + __shfl_xor(send, o); }
#pragma unroll
        for (int i = 0; i < o; ++i) asm volatile("" : "+v"(v[i]));
    }
    float t = v[0] + __shfl_xor(v[0], 16);
    return t + __shfl_xor(t, 32);
}
template <int pmode> __device__ __forceinline__ void mix0_conv_item(Frame& F, const Ptrs& P, int item) {
    const bf16* UB = (const bf16*)(P.ws + WS_UB); bf16* AM = (bf16*)(P.ws + WS_AM);
    const float* cw = P.in[4]; const float* cb = P.in[5]; const float* lg = P.in[6]; const float* lb = P.in[7];
    const int b = item >> 6, t0 = (item & 63) * 64, rowbase = b * S;
    LAS unsigned* tile = (LAS unsigned*)(F.lds + RING_OFF);
    LAS float* red = (LAS float*)(F.lds + RING_OFF + 98304);
    int tidl = F.tid; asm volatile("" : "+v"(tidl));
    const int rg = tidl >> 8, cp = tidl & 255, lanel = tidl & 63;
    const f32x2g bb = *(const GAS f32x2g*)(cb + 2 * cp);
    const f32x2g g2 = *(const GAS f32x2g*)(lg + 2 * cp), b2 = *(const GAS f32x2g*)(lb + 2 * cp);
    f32x2g w2[31];
#pragma unroll
    for (int j = 0; j < 31; ++j) w2[j] = *(const GAS f32x2g*)(cw + j * 512 + 2 * cp);
    if (pmode != 7) { v4u tv[12];
#pragma unroll
      for (int i = 0; i < 12; ++i) { const int t = t0 - 15 + F.wave + NWAVES * i, tc = t < 0 ? 0 : (t > S - 1 ? S - 1 : t);
          tv[i] = *(const GAS v4u*)(UB + (size_t)(rowbase + tc) * 512 + F.lane * 8); }
#pragma unroll
      for (int i = 0; i < 12; ++i) { const int r = F.wave + NWAVES * i, t = t0 - 15 + r; const bool ok = (t >= 0 && t < S);
          v4u w = tv[i]; w.x = ok ? w.x : 0u; w.y = ok ? w.y : 0u; w.z = ok ? w.z : 0u; w.w = ok ? w.w : 0u;
          *(LAS v4u*)(tile + r * 256 + F.lane * 4) = w; } }
    LDS_BAR();
#pragma unroll 1
    for (int p = 0; p < 2; ++p) {
        f32x2g a2[16];
#pragma unroll
        for (int o = 0; o < 16; ++o) a2[o] = bb;
        const LAS unsigned* tp = tile + (32 * rg + 16 * p) * 256 + cp;
#pragma unroll
        for (int ii = 0; ii < 46; ++ii) {
            const unsigned xx = tp[ii * 256];
            const f32x2g x2 = {bf_lo(xx), bf_hi(xx)};
#pragma unroll
            for (int o = 0; o < 16; ++o) { const int j = ii - o; if (j >= 0 && j <= 30) a2[o] = __builtin_elementwise_fma(w2[j], x2, a2[o]); }
        }
        float a0[16], a1[16];
#pragma unroll
        for (int o = 0; o < 16; ++o) { a0[o] = a2[o].x; a1[o] = a2[o].y; }
        float v[32];
#pragma unroll
        for (int o = 0; o < 16; ++o) { v[2 * o] = a0[o] + a1[o]; v[2 * o + 1] = a0[o] * a0[o] + a1[o] * a1[o]; }
        LAS float* redp = red + (p & 1) * 256;
        const float tot = reduce_scatter32(v, lanel);
        if (lanel < 32) redp[(F.wave & 3) * 32 + lanel + rg * 128] = tot;
        LDS_BAR();
        float mean16[16], rstd16[16];
        {
            const LAS f32x4* rp = (const LAS f32x4*)(redp + rg * 128);
            f32x4 acc4[8];
#pragma unroll
            for (int k = 0; k < 8; ++k) acc4[k] = rp[k];
#pragma unroll
            for (int w = 1; w < 4; ++w)
#pragma unroll
                for (int k = 0; k < 8; ++k) acc4[k] = acc4[k] + rp[w * 8 + k];
#pragma unroll
            for (int o = 0; o < 16; ++o) { const float sm = acc4[o >> 1][(o & 1) * 2], sq = acc4[o >> 1][(o & 1) * 2 + 1];
                const float mean = sm * (1.0f / 512.0f), var = fmaxf(sq * (1.0f / 512.0f) - mean * mean, 0.f); mean16[o] = mean; rstd16[o] = __builtin_amdgcn_rsqf(var + 1e-6f); }
        }
#pragma unroll
        for (int o = 0; o < 16; ++o) {
            const float mean = mean16[o], rstd = rstd16[o];
            float y0 = (a0[o] - mean) * rstd * g2.x + b2.x, y1 = (a1[o] - mean) * rstd * g2.y + b2.y;
            y0 = y0 * __builtin_amdgcn_rcpf(1.0f + __expf(-y0)); y1 = y1 * __builtin_amdgcn_rcpf(1.0f + __expf(-y1));
            *(GAS unsigned*)(AM + (size_t)(rowbase + t0 + 32 * rg + 16 * p + o) * 1024 + 2 * cp) = pk2(y0, y1);
        }
    }
    LDS_BAR();
}
template <int H> __device__ __forceinline__ void pool_rows(const LAS unsigned* tp  , bf16* orow  , int tfirst) {
    unsigned x[32 + 2 * H];
#pragma unroll
    for (int i = 0; i < 32 + 2 * H; ++i) x[i] = tp[i * 256];
    float s0 = 0.f, s1 = 0.f;
#pragma unroll
    for (int i = 0; i < 2 * H; ++i) { s0 += bf_lo(x[i]); s1 += bf_hi(x[i]); }
#pragma unroll
    for (int o = 0; o < 32; ++o) {
        const int t = tfirst + o;
        const int lo = (t - H) < 0 ? 0 : (t - H), hi = (t + H - 1) > (S - 1) ? (S - 1) : (t + H - 1);
        const float inv = 1.0f / (float)(hi - lo + 1);
        *(GAS unsigned*)(orow + (size_t)o * 1024) = pk2(s0 * inv - bf_lo(x[o + H]), s1 * inv - bf_hi(x[o + H]));
        if (o < 31) { s0 += bf_lo(x[o + 2 * H]) - bf_lo(x[o]); s1 += bf_hi(x[o + 2 * H]) - bf_hi(x[o]); }
    }
}
__device__ __forceinline__ void mix0_pool_item(Frame& F, const Ptrs& P, int item) {
    const bf16* PB = (const bf16*)(P.ws + WS_PB); bf16* AM = (bf16*)(P.ws + WS_AM);
    const int b = item >> 6, t0 = (item & 63) * 64, rowbase = b * S;
    LAS unsigned* tile = (LAS unsigned*)(F.lds + RING_OFF);
    { v4u tv[10];
#pragma unroll
      for (int i = 0; i < 10; ++i) { const int t = t0 - 8 + F.wave + NWAVES * i, tc = t < 0 ? 0 : (t > S - 1 ? S - 1 : t);
          tv[i] = *(const GAS v4u*)(PB + (size_t)(rowbase + tc) * 512 + F.lane * 8); }
#pragma unroll
      for (int i = 0; i < 10; ++i) { const int r = F.wave + NWAVES * i, t = t0 - 8 + r; const bool ok = (t >= 0 && t < S);
          v4u w = tv[i]; w.x = ok ? w.x : 0u; w.y = ok ? w.y : 0u; w.z = ok ? w.z : 0u; w.w = ok ? w.w : 0u;
          *(LAS v4u*)(tile + r * 256 + F.lane * 4) = w; } }
    LDS_BAR();
    const int rg = F.tid >> 8, cp = F.tid & 255, g = __builtin_amdgcn_readfirstlane(cp >> 6);
    bf16* orow = AM + (size_t)(rowbase + t0 + 32 * rg) * 1024 + 512 + 2 * cp;
    const int tfirst = t0 + 32 * rg;
    if (g == 0) pool_rows<1>(tile + (32 * rg + 8 - 1) * 256 + cp, orow, tfirst);
    else if (g == 1) pool_rows<2>(tile + (32 * rg + 8 - 2) * 256 + cp, orow, tfirst);
    else if (g == 2) pool_rows<4>(tile + (32 * rg + 8 - 4) * 256 + cp, orow, tfirst);
    else pool_rows<8>(tile + (32 * rg + 8 - 8) * 256 + cp, orow, tfirst);
    LDS_BAR();
}

struct SguIn { u32x2g uu[8]; unsigned xv[16]; };
__device__ __forceinline__ void sgu_load(const bf16* U, const bf16* V, int item, int wave, int lane, SguIn& R) {
    const int h = item & 3, rowbase = (item >> 2) * 128, fr = lane & 15, fq = lane >> 4, q = 16 * wave + fr;
#pragma unroll
    for (int nt = 0; nt < 8; ++nt) R.uu[nt] = *(const GAS u32x2g*)(U + (size_t)(rowbase + q) * 512 + h * 128 + 16 * nt + 4 * fq);
#pragma unroll
    for (int i = 0; i < 16; ++i) R.xv[i] = *(const GAS unsigned*)(V + (size_t)(rowbase + 16 * wave + i) * 512 + h * 128 + 2 * lane);
}
__device__ __forceinline__ void sgu_compute(Frame& F, bf16* AM, int item, int lane, const SguIn& R, const pg8::bf16x8 (&wf)[4], float bias, f32x2g g2, f32x2g b2) {
    const int h = item & 3, rowbase = (item >> 2) * 128, fr = lane & 15, fq = lane >> 4, q = 16 * F.wave + fr;
    LAS bf16* vnT = (LAS bf16*)(F.lds + RING_OFF);
    {
        float st[32];
#pragma unroll
        for (int i = 0; i < 16; ++i) { const float v0 = bf_lo(R.xv[i]), v1 = bf_hi(R.xv[i]); st[2 * i] = v0 + v1; st[2 * i + 1] = v0 * v0 + v1 * v1; }
        const float tot = reduce_scatter32(st, lane);
        unsigned y0[8], y1[8];
#pragma unroll
        for (int i = 0; i < 16; ++i) {
            const float sm = __builtin_bit_cast(float, __builtin_amdgcn_readlane(__builtin_bit_cast(int, tot), 2 * i)), sq = __builtin_bit_cast(float, __builtin_amdgcn_readlane(__builtin_bit_cast(int, tot), 2 * i + 1));
            const float mean = sm * (1.0f / 128.0f), rstd = __builtin_amdgcn_rsqf(sq * (1.0f / 128.0f) - mean * mean + 1e-6f);
            const unsigned a0 = f2bf((bf_lo(R.xv[i]) - mean) * rstd * g2.x + b2.x), a1 = f2bf((bf_hi(R.xv[i]) - mean) * rstd * g2.y + b2.y);
            if (i & 1) { y0[i >> 1] |= a0 << 16; y1[i >> 1] |= a1 << 16; } else { y0[i >> 1] = a0; y1[i >> 1] = a1; }
        }
        LAS bf16* d0 = vnT + (2 * lane) * 136 + 16 * F.wave;
        *(LAS v4u*)d0 = (v4u){y0[0], y0[1], y0[2], y0[3]}; *(LAS v4u*)(d0 + 8) = (v4u){y0[4], y0[5], y0[6], y0[7]};
        *(LAS v4u*)(d0 + 136) = (v4u){y1[0], y1[1], y1[2], y1[3]}; *(LAS v4u*)(d0 + 136 + 8) = (v4u){y1[4], y1[5], y1[6], y1[7]};
    }
    LDS_BAR();
    {
        pg8::f32x4 acc[8];
#pragma unroll
        for (int nt = 0; nt < 8; ++nt) acc[nt] = (pg8::f32x4){0.f, 0.f, 0.f, 0.f};
#pragma unroll
        for (int ks = 0; ks < 4; ++ks) {
#pragma unroll
            for (int nt = 0; nt < 8; ++nt) {
                const pg8::bf16x8 vf = *(const LAS pg8::bf16x8*)(vnT + (16 * nt + fr) * 136 + ks * 32 + 8 * fq);
                acc[nt] = __builtin_amdgcn_mfma_f32_16x16x32_bf16(vf, wf[ks], acc[nt], 0, 0, 0);
            }
        }
        const size_t t = (size_t)(rowbase + q);
#pragma unroll
        for (int nt = 0; nt < 8; ++nt) { const int c0 = h * 128 + 16 * nt + 4 * fq;
            u32x2g o; o.x = pk2(bf_lo(R.uu[nt].x) * (acc[nt][0] + bias), bf_hi(R.uu[nt].x) * (acc[nt][1] + bias)); o.y = pk2(bf_lo(R.uu[nt].y) * (acc[nt][2] + bias), bf_hi(R.uu[nt].y) * (acc[nt][3] + bias));
            *(GAS u32x2g*)(AM + t * 1024 + 512 + c0) = o; }
    }
    LDS_BAR();
}
__device__ __forceinline__ void sgu_phase(Frame& F, const Ptrs& P) {
    const bf16* U = (const bf16*)(P.ws + WS_U1); const bf16* V = (const bf16*)(P.ws + WS_V1); bf16* AM = (bf16*)(P.ws + WS_AM);
    const float* lng = P.in[13]; const float* lnb = P.in[14]; const float* sw = P.in[15]; const float* sb = P.in[16];
    int lane = F.lane; asm volatile("" : "+v"(lane));
    const int it0 = F.vcu, G = F.G;
    if (it0 >= 1024) return;
    const int h = it0 & 3, fr = lane & 15, fq = lane >> 4, q = 16 * F.wave + fr;
    pg8::bf16x8 wf[4];
#pragma unroll
    for (int ks = 0; ks < 4; ++ks) { const GAS pg8::f32x4* wp = (const GAS pg8::f32x4*)(sw + (size_t)(h * 128 + q) * 128 + ks * 32 + 8 * fq); const pg8::f32x4 wa = wp[0], wb = wp[1];
        pg8::u32x4 wq; wq.x = pk2(wa[0], wa[1]); wq.y = pk2(wa[2], wa[3]); wq.z = pk2(wb[0], wb[1]); wq.w = pk2(wb[2], wb[3]); wf[ks] = __builtin_bit_cast(pg8::bf16x8, wq); }
    const float bias = sb[h * 128 + q];
    const f32x2g g2 = *(const GAS f32x2g*)(lng + h * 128 + 2 * lane), b2 = *(const GAS f32x2g*)(lnb + h * 128 + 2 * lane);
    SguIn Ra, Rb;
    sgu_load(U, V, it0, F.wave, lane, Ra);
    for (int it = it0; it < 1024; it += 2 * G) {
        const int it1 = it + G, it2 = it + 2 * G;
        if (it1 < 1024) sgu_load(U, V, it1, F.wave, lane, Rb);
        sgu_compute(F, AM, it, lane, Ra, wf, bias, g2, b2);
        if (it1 >= 1024) break;
        if (it2 < 1024) sgu_load(U, V, it2, F.wave, lane, Ra);
        sgu_compute(F, AM, it1, lane, Rb, wf, bias, g2, b2);
    }
}

struct cpx { float r, i; };
__device__ __forceinline__ cpx cadd(cpx a, cpx b) { return {a.r + b.r, a.i + b.i}; }
__device__ __forceinline__ cpx csub(cpx a, cpx b) { return {a.r - b.r, a.i - b.i}; }
__device__ __forceinline__ cpx cmulc(cpx a, float c, float s) { return {a.r * c + a.i * s, a.i * c - a.r * s}; }
__device__ __forceinline__ cpx cmni(cpx a) { return {a.i, -a.r}; }
__device__ __forceinline__ void dft4(cpx& x0, cpx& x1, cpx& x2, cpx& x3) {
    const cpx s02 = cadd(x0, x2), d02 = csub(x0, x2), s13 = cadd(x1, x3), d13 = cmni(csub(x1, x3));
    x0 = cadd(s02, s13); x1 = cadd(d02, d13); x2 = csub(s02, s13); x3 = csub(d02, d13);
}
__device__ __forceinline__ void fft16(cpx (&x)[16], cpx (&z)[16]) {
    constexpr float C1 = 0.92387953251128674f, S1 = 0.38268343236508977f, R2 = 0.70710678118654752f;
#pragma unroll
    for (int b = 0; b < 4; ++b) dft4(x[b], x[4 + b], x[8 + b], x[12 + b]);
    x[4 + 1] = cmulc(x[4 + 1], C1, S1);  x[8 + 1] = cmulc(x[8 + 1], R2, R2);   x[12 + 1] = cmulc(x[12 + 1], S1, C1);
    x[4 + 2] = cmulc(x[4 + 2], R2, R2);  x[8 + 2] = cmni(x[8 + 2]);            x[12 + 2] = cmulc(x[12 + 2], -R2, R2);
    x[4 + 3] = cmulc(x[4 + 3], S1, C1);  x[8 + 3] = cmulc(x[8 + 3], -R2, R2);  x[12 + 3] = cmulc(x[12 + 3], -C1, -S1);
#pragma unroll
    for (int c = 0; c < 4; ++c) { dft4(x[4 * c], x[4 * c + 1], x[4 * c + 2], x[4 * c + 3]);
        z[c] = x[4 * c]; z[c + 4] = x[4 * c + 1]; z[c + 8] = x[4 * c + 2]; z[c + 12] = x[4 * c + 3]; }
}
__device__ __forceinline__ void fft_stage1(Frame& F, const Ptrs& P) {
    const bf16* PQT = (const bf16*)(P.ws + WS_PQT); bf16* ZP = (bf16*)(P.ws + WS_ZP);
    LAS float* CT = (LAS float*)(F.lds + RING_OFF + 65536);
    { int tl = F.tid; asm volatile("" : "+v"(tl)); for (int i = tl; i < 4096; i += NWAVES * 64) CT[i] = cospif((float)i * (1.0f / 2048.0f)); }
    LDS_BAR();
    int gw = F.vcu * NWAVES + F.wave; asm volatile("" : "+s"(gw)); const int NGW = F.G * NWAVES;
    for (int item = gw; item < NB * 512 * 2; item += NGW) {
        int lane = F.lane; asm volatile("" : "+v"(lane));
        const int row = item >> 1, s20 = 128 * (item & 1) + 2 * lane, b = row >> 9, ch = row & 511;
        const bf16* src = PQT + (size_t)row * 2 * S + s20;
        unsigned xp[16], xq[16];
#pragma unroll
        for (int s1 = 0; s1 < 16; ++s1) { xp[s1] = *(const GAS unsigned*)(src + 256 * s1); xq[s1] = *(const GAS unsigned*)(src + S + 256 * s1); }
        unsigned zr[16], zi[16];
#pragma unroll
        for (int e = 0; e < 2; ++e) {
            cpx x[16], z[16];
#pragma unroll
            for (int s1 = 0; s1 < 16; ++s1) { x[s1].r = e ? bf_hi(xp[s1]) : bf_lo(xp[s1]); x[s1].i = -(e ? bf_hi(xq[s1]) : bf_lo(xq[s1])); }
            fft16(x, z);
            const int s2 = s20 + e;
#pragma unroll
            for (int t1 = 0; t1 < 16; ++t1) {
                const int idx = s2 * t1;
                const cpx w = cmulc(z[t1], CT[idx], CT[(idx - 1024) & (S - 1)]);
                const unsigned hr = f2bf(w.r), hi = f2bf(w.i);
                if (e == 0) { zr[t1] = hr; zi[t1] = hi; } else { zr[t1] |= hr << 16; zi[t1] |= hi << 16; }
            }
        }
#pragma unroll
        for (int t1 = 0; t1 < 16; ++t1) { bf16* dst = ZP + ((size_t)((b * 16 + t1) * 512 + ch)) * 512 + s20;
            *(GAS unsigned*)dst = zr[t1]; *(GAS unsigned*)(dst + 256) = zi[t1]; }
    }
}

struct Args { const float* in[22]; float* out; unsigned char* ws; int ph_lo, ph_hi, li, pad; };
template <int PM> __device__ __forceinline__ void mk_body(const Args& args) {
    extern __shared__ __attribute__((aligned(16))) unsigned char lds[];
    Frame F;
    F.lds = (LAS unsigned char*)lds;
    F.MISC = (volatile LAS unsigned*)(F.lds + MISC_OFF);
    F.tid = threadIdx.x; F.lane = F.tid & 63; F.wave = __builtin_amdgcn_readfirstlane(F.tid >> 6);
    F.G = gridDim.x; { const int bx = blockIdx.x; F.vcu = (F.G % 8 == 0) ? (bx % 8) * (F.G / 8) + bx / 8 : bx; }
    Ptrs P;
#pragma unroll
    for (int i = 0; i < 22; ++i) P.in[i] = args.in[i];
    P.out = args.out; P.ws = args.ws;
    unsigned char* ws = args.ws;
    F.ctl = (gu32*)(ws + WS_CTL);
    for (int u = F.tid; u < (LDS_BYTES - LDSCTL_OFF) / 4; u += NWAVES * 64) ((LAS unsigned*)(F.lds + LDSCTL_OFF))[u] = 0u;
    __syncthreads();
    XcdBarrier bar; bar.bar = (unsigned*)(F.ctl + CW_BAR); bar.x = 0; bar.st = nullptr;
    if (!MK_PER_PHASE) bar = xcd_barrier_post((unsigned*)(F.ctl + CW_BAR), F.MISC + 8);
    const int lo = args.ph_lo, hi = args.ph_hi;
#ifndef PH_MASK
#define PH_MASK 0x1FFF
#endif
#define IN(k) ((((PH_MASK) >> (k)) & 1) && lo <= (k) && (k) < hi)
#ifndef PROBE_BARX
#define PROBE_BARX 1
#endif
#define SEAM(k) do { if (IN(k) && IN((k) + 1)) { for (int bx_ = 0; bx_ < PROBE_BARX; ++bx_) xcd_barrier(bar); } } while (0)
    unsigned long long* ssq = (unsigned long long*)(ws + WS_SSQ);
    bf16* XB = (bf16*)(ws + WS_XB); bf16* AM = (bf16*)(ws + WS_AM); bf16* HB = (bf16*)(ws + WS_H);
    const int bid = (int)blockIdx.x;
    constexpr bool dup = PM != 0;
    bf16* TRX = (bf16*)(ws + WS_END); unsigned long long* TRS = (unsigned long long*)(ws + WS_END + 64 * MiB);

    if (IN(0)) { p0_prologue(F, P); } SEAM(0);
    if (IN(1)) { pg8::Gemm g{XB, (const bf16*)(ws + WS_WIN0), M, 1536, D}; pg8::StaticOrder So; So.init(M, 1536, F.G, bid);
        pg8::EpiInL0 E{(bf16*)(ws + WS_UB), (bf16*)(ws + WS_PB), ssq};
        pg8::gemm_phase<pg8::EpiInL0, pg8::StaticOrder, true, true>(F.lds + RING_OFF, g, So, E); } SEAM(1);
    if (IN(2)) { for (int it = F.vcu; it < 1024; it += F.G) {
#ifndef NO_CONV
            if (it < 512 && PM != 4 && PM != 9) mix0_conv_item<PM>(F, P, it);
#endif
#ifndef NO_POOL
            if (it >= 512 && PM != 3 && PM != 9) mix0_pool_item(F, P, it - 512);
#endif
 } } SEAM(2);
    if (IN(3)) { pg8::Gemm g{AM, (const bf16*)(ws + WS_WOUT0), M, D, D}; pg8::StaticOrder So; So.init(M, D, F.G, bid);
        pg8::EpiResid E{XB, dup ? TRS : ssq + M, dup ? TRX : XB, PM, false};
        pg8::gemm_phase<pg8::EpiResid, pg8::StaticOrder, true, true>(F.lds + RING_OFF, g, So, E); } SEAM(3);
    if (IN(4)) { pg8::Gemm g{XB, (const bf16*)(ws + WS_WGU0), M, 2 * FF, D}; pg8::StaticOrderT<(PM == 40 ? 4 : PM == 41 ? 16 : PM == 42 ? 32 : PM == 43 ? 2 : 8)> So; So.init(M, 2 * FF, F.G, bid);
        pg8::EpiSwiGLU E{HB, ssq + M, PM};
        pg8::gemm_phase<pg8::EpiSwiGLU, decltype(So), (PM != 20 && PM != 22), (PM != 21 && PM != 22)>(F.lds + RING_OFF, g, So, E); } SEAM(4);
    if (IN(5)) { pg8::Gemm g{HB, (const bf16*)(ws + WS_WDN0), M, D, FF}; pg8::StaticOrder So; So.init(M, D, F.G, bid);
        pg8::EpiResid E{XB, dup ? TRS : ssq + 2 * M, dup ? TRX : XB, PM, false};
        pg8::gemm_phase<pg8::EpiResid, pg8::StaticOrder, true, true>(F.lds + RING_OFF, g, So, E); } SEAM(5);
    if (IN(6)) {
        { pg8::Gemm g{(const bf16*)(ws + WS_WPQ1), XB, 1024, M, D}; pg8::StaticOrder So; So.init(1024, M, F.G, bid);
          pg8::EpiPQT E{(bf16*)(ws + WS_PQT), ssq + 2 * M, PM};
          pg8::gemm_phase<pg8::EpiPQT, pg8::StaticOrder, true, true>(F.lds + RING_OFF, g, So, E); }
#pragma unroll 1
        for (int rnd = 0; rnd < 2; ++rnd) { pg8::Gemm g{XB, (const bf16*)(ws + WS_WUV1), M, 1024, D}; pg8::RoundOrder So; So.init(M, 1024, F.G, bid); So.round = rnd;
          pg8::EpiSGU E{AM, ssq + 2 * M, P.in[13], P.in[14], (const bf16*)(ws + WS_WSB), P.in[16]};
          pg8::gemm_phase<pg8::EpiSGU, pg8::RoundOrder, false, true>(F.lds + RING_OFF, g, So, E); }
    } SEAM(6);
    if (IN(7)) {
        if (PM != 12) { fft_stage1(F, P); }
    } SEAM(7);
    if (IN(8)) { pg8::Gemm g{(const bf16*)(ws + WS_DFT), (const bf16*)(ws + WS_ZP), 256, NB * 16 * 512, 512}; pg8::StaticOrder So; So.init(256, NB * 16 * 512, F.G, bid);
        pg8::EpiDFT2 E{AM};
        pg8::gemm_phase<pg8::EpiDFT2, pg8::StaticOrder, true, true>(F.lds + RING_OFF, g, So, E); } SEAM(8);
    if (IN(9)) { pg8::Gemm g{AM, (const bf16*)(ws + WS_WOUT1), M, D, D}; pg8::StaticOrder So; So.init(M, D, F.G, bid);
        pg8::EpiResid E{XB, dup ? TRS : ssq + 3 * M, dup ? TRX : XB, PM, false};
        pg8::gemm_phase<pg8::EpiResid, pg8::StaticOrder, true, true>(F.lds + RING_OFF, g, So, E); } SEAM(9);
    if (IN(10)) { pg8::Gemm g{XB, (const bf16*)(ws + WS_WGU1), M, 2 * FF, D}; pg8::StaticOrder So; So.init(M, 2 * FF, F.G, bid);
        pg8::EpiSwiGLU E{HB, ssq + 3 * M, PM};
        pg8::gemm_phase<pg8::EpiSwiGLU, pg8::StaticOrder, true, true>(F.lds + RING_OFF, g, So, E); } SEAM(10);
    if (IN(11)) { pg8::Gemm g{HB, (const bf16*)(ws + WS_WDN1), M, D, FF}; pg8::StaticOrder So; So.init(M, D, F.G, bid);
        pg8::EpiResid E{XB, dup ? TRS : ssq + 4 * M, dup ? TRX : XB, PM, true};
        pg8::gemm_phase<pg8::EpiResid, pg8::StaticOrder, true, true>(F.lds + RING_OFF, g, So, E); } SEAM(11);
    if (IN(12)) {
        const float* gf = P.in[21]; const unsigned long long* ssq4 = ssq + 4 * M;
        const int gw = F.vcu * NWAVES + F.wave, NGW = F.G * NWAVES;
        for (int m0 = 4 * gw; m0 < M; m0 += 4 * NGW) {
            u32x2g xx[4][4]; unsigned long long q[4];
#pragma unroll
            for (int r = 0; r < 4; ++r) { const GAS u32x2g* xr = (const GAS u32x2g*)(XB + (size_t)(m0 + r) * D) + F.lane; q[r] = ssq4[m0 + r];
#pragma unroll
                for (int j = 0; j < 4; ++j) xx[r][j] = xr[64 * j]; }
            const GAS f32x4* gr = (const GAS f32x4*)gf + F.lane;
            f32x4 gg[4];
#pragma unroll
            for (int j = 0; j < 4; ++j) gg[j] = gr[64 * j];
#pragma unroll
            for (int r = 0; r < 4; ++r) { const float rs = pg8::rstd_of(q[r]); GAS f32x4* orow = (GAS f32x4*)(P.out + (size_t)(m0 + r) * D) + F.lane;
#pragma unroll
                for (int j = 0; j < 4; ++j) { f32x4 v; v.x = bf_lo(xx[r][j].x); v.y = bf_hi(xx[r][j].x); v.z = bf_lo(xx[r][j].y); v.w = bf_hi(xx[r][j].y); orow[64 * j] = v * rs * gg[j]; } }
        }
    }
#undef IN
#undef SEAM
}
__global__ void __launch_bounds__(NWAVES * 64, 2) mk_fwd(Args args) { mk_body<0>(args); }
#ifdef PROBE_PHASE
#ifndef PROBE_MODE
#define PROBE_MODE 1
#endif
__global__ void __launch_bounds__(NWAVES * 64, 2) mk_probe(Args args) { mk_body<PROBE_MODE>(args); }
#endif

extern "C" void kernel_launch(void* const* d_in, const int* in_sizes, int n_in, void* d_out, int out_size, void* d_ws, size_t ws_size, hipStream_t stream) {
    static int grid = 0;
    if (grid == 0) {
        if (n_in != 22 || in_sizes[0] != M * D || out_size != M * D || ws_size < WS_END) { fprintf(stderr, "kernel_launch: unexpected shapes (n_in %d, in0 %d, out %d, ws %zu); nothing launched\n", n_in, n_in > 0 ? in_sizes[0] : -1, out_size, ws_size); grid = -1; return; }
        int dev = 0, cus = 0, per_cu = 0;
        if (hipGetDevice(&dev) != hipSuccess || hipDeviceGetAttribute(&cus, hipDeviceAttributeMultiprocessorCount, dev) != hipSuccess) { grid = -1; return; }
#ifdef PROBE_PHASE
        (void)hipFuncSetAttribute((const void*)mk_probe, hipFuncAttributeMaxDynamicSharedMemorySize, LDS_BYTES);
#endif
        if (hipFuncSetAttribute((const void*)mk_fwd, hipFuncAttributeMaxDynamicSharedMemorySize, LDS_BYTES) != hipSuccess) { fprintf(stderr, "kernel_launch: hipFuncSetAttribute failed\n"); grid = -1; return; }
        if (hipOccupancyMaxActiveBlocksPerMultiprocessor(&per_cu, (const void*)mk_fwd, NWAVES * 64, LDS_BYTES) != hipSuccess || per_cu < 1) { fprintf(stderr, "kernel_launch: occupancy query says %d blocks per CU\n", per_cu); per_cu = 1; }
        (void)hipGetLastError();
        grid = (cus / 8) * 8;
    }
    if (grid < 0) return;
    if (hipMemsetAsync((char*)d_ws + WS_CTL, 0, CTL_ZERO_BYTES, stream) != hipSuccess) { fprintf(stderr, "kernel_launch: hipMemsetAsync failed\n"); return; }
    Args a{};
    for (int i = 0; i < 22; ++i) a.in[i] = (const float*)d_in[i];
    a.out = (float*)d_out; a.ws = (unsigned char*)d_ws;
#if MK_PER_PHASE
    for (int ph = 0; ph < N_PHASES; ++ph) { a.ph_lo = ph; a.ph_hi = ph + 1; a.li = ph;
        hipLaunchKernelGGL(mk_fwd, dim3(grid), dim3(NWAVES * 64), LDS_BYTES, stream, a); }
#else
    a.ph_lo = 0; a.ph_hi = N_PHASES; a.li = 0;
#ifdef PROBE_PHASE
#ifndef PROBE_MODE
#define PROBE_MODE 1
#endif
    { void* kargs0[] = {&a};
      hipError_t e0 = hipLaunchCooperativeKernel((const void*)mk_fwd, dim3(grid), dim3(NWAVES * 64), kargs0, LDS_BYTES, stream);
      if (e0 != hipSuccess) fprintf(stderr, "kernel_launch: cooperative launch failed: %s (grid %d)\n", hipGetErrorString(e0), grid);
      Args a2 = a; a2.ph_lo = PROBE_PHASE; a2.ph_hi = PROBE_PHASE + 1; a2.pad = PROBE_MODE;
      hipLaunchKernelGGL(mk_probe, dim3(grid), dim3(NWAVES * 64), LDS_BYTES, stream, a2); }
#elif defined(MK_PLAIN_LAUNCH)
    hipLaunchKernelGGL(mk_fwd, dim3(grid), dim3(NWAVES * 64), LDS_BYTES, stream, a);
#else
    void* kargs[] = {&a};
    hipError_t e = hipLaunchCooperativeKernel((const void*)mk_fwd, dim3(grid), dim3(NWAVES * 64), kargs, LDS_BYTES, stream);
    if (e != hipSuccess) fprintf(stderr, "kernel_launch: cooperative launch failed: %s (grid %d)\n", hipGetErrorString(e), grid);
#endif
#endif
}
```
